# Optimizing an MI355X kernel written in HIP

```python
import jax, jax.numpy as jnp
from jax import lax
import numpy as np

D_MODEL = 1024
BATCH = 32
SEQ = 2048
DEPTH = 2
DEC_BATCH = 8
DEC_SEQ = 32
PAST_LEN = 2048

CHUNK = 64
N_MIXERS = 2
N_LAYERS_A = (DEPTH + 1) // 2
N_LAYERS_B = DEPTH // 2
EPS = 1e-6
NEG_INF = -1e30

A_HEADS = 16
A_HEAD_DIM = D_MODEL // A_HEADS
A_BAND_CHUNKS = 8
A_WINDOW = A_BAND_CHUNKS * CHUNK
REL_CLIP = 128

B_HEADS = 16
B_NOPE = 64
B_ROPE = 32
B_VDIM = 64
KV_LORA = 256
Q_LORA = 384
B_IN = Q_LORA + KV_LORA + B_ROPE + B_HEADS * B_VDIM
ROPE_THETA = 10000.0
Q_BLOCK = 128

kernel_name = "hybrid_streaming_band_mla_step"


def rms_norm(x, g):
    xf = x.astype(jnp.float32)
    y = xf * lax.rsqrt(jnp.mean(xf * xf, axis=-1, keepdims=True) + EPS)
    return (y * g.astype(jnp.float32)).astype(x.dtype)


def ada_norm(x, c, g, w_ada, b_ada):
    mod = jax.nn.silu(c) @ w_ada + b_ada
    shift, scale, gate = jnp.split(mod[:, None, :], 3, axis=-1)
    return rms_norm(x, g) * (1 + scale) + shift, gate


def rotary(x, pos):
    half = x.shape[-1] // 2
    inv = ROPE_THETA ** (-jnp.arange(half, dtype=jnp.float32) / half)
    ang = pos.astype(jnp.float32)[:, None] * inv[None, :]
    cos = jnp.cos(ang)[:, None, :]
    sin = jnp.sin(ang)[:, None, :]
    xf = x.astype(jnp.float32)
    x1, x2 = xf[..., :half], xf[..., half:]
    return jnp.concatenate([x1 * cos - x2 * sin, x2 * cos + x1 * sin], -1).astype(x.dtype)


def chunk_mask(qpos, kpos, n_prev):
    qc = (qpos // CHUNK)[:, None]
    kc = (kpos // CHUNK)[None, :]
    m = (kc <= qc) & (kpos[None, :] >= 0)
    if n_prev is not None:
        m = m & (kc >= qc - n_prev)
    return m


def rel_bias(table, qpos, kpos):
    rel = jnp.clip(qpos[:, None] - kpos[None, :], -REL_CLIP, REL_CLIP) + REL_CLIP
    return table[:, rel].astype(jnp.float32)


def attend(q, k, v, bias, mask, scale):
    s = jnp.einsum('bqhd,bkhd->bhqk', q, k).astype(jnp.float32) * scale
    if bias is not None:
        s = s + bias[None]
    s = jnp.where(mask[None, None], s, NEG_INF)
    p = jax.nn.softmax(s, axis=-1).astype(v.dtype)
    return jnp.einsum('bhqk,bkhd->bqhd', p, v)


def a_project(h, w_in, g_q, g_k):
    B, L, _ = h.shape
    q, k, v, z = jnp.split(h @ w_in, 4, axis=-1)
    q = rms_norm(q.reshape(B, L, A_HEADS, A_HEAD_DIM), g_q)
    k = rms_norm(k.reshape(B, L, A_HEADS, A_HEAD_DIM), g_k)
    v = v.reshape(B, L, A_HEADS, A_HEAD_DIM)
    return q, k, v, z


def a_prompt(h, w_in, g_q, g_k, table, w_out):
    B, S, _ = h.shape
    q, k, v, z = a_project(h, w_in, g_q, g_k)
    n_chunks = S // CHUNK
    pad = A_WINDOW
    band = A_WINDOW + CHUNK
    kp = jnp.pad(k, ((0, 0), (pad, 0), (0, 0), (0, 0)))
    vp = jnp.pad(v, ((0, 0), (pad, 0), (0, 0), (0, 0)))
    qc = q.reshape(B, n_chunks, CHUNK, A_HEADS, A_HEAD_DIM).transpose(1, 0, 2, 3, 4)
    q_off = jnp.arange(CHUNK, dtype=jnp.int32)
    k_off = jnp.arange(band, dtype=jnp.int32)
    scale = A_HEAD_DIM ** -0.5

    def one_chunk(args):
        ci, qi = args
        start = ci * CHUNK
        kb = lax.dynamic_slice_in_dim(kp, start, band, axis=1)
        vb = lax.dynamic_slice_in_dim(vp, start, band, axis=1)
        qpos = start + q_off
        kpos = start - pad + k_off
        return attend(qi, kb, vb, rel_bias(table, qpos, kpos),
                      chunk_mask(qpos, kpos, A_BAND_CHUNKS), scale)

    o = lax.map(one_chunk, (jnp.arange(n_chunks, dtype=jnp.int32), qc))
    o = o.transpose(1, 0, 2, 3, 4).reshape(B, S, A_HEADS * A_HEAD_DIM)
    y = (o * jax.nn.silu(z)) @ w_out
    rows = min(A_WINDOW, S)
    return y, k[:, S - rows:], v[:, S - rows:]


def a_sample(h, cache_k, cache_v, w_in, g_q, g_k, table, w_out):
    B, T, _ = h.shape
    q, k, v, z = a_project(h, w_in, g_q, g_k)
    n_cache = cache_k.shape[1]
    kk = jnp.concatenate([cache_k, k], axis=1)
    vv = jnp.concatenate([cache_v, v], axis=1)
    qpos = PAST_LEN + jnp.arange(T, dtype=jnp.int32)
    kpos = jnp.concatenate([PAST_LEN - n_cache + jnp.arange(n_cache, dtype=jnp.int32), qpos])
    o = attend(q, kk, vv, rel_bias(table, qpos, kpos),
               chunk_mask(qpos, kpos, A_BAND_CHUNKS), A_HEAD_DIM ** -0.5)
    y = (o.reshape(B, T, A_HEADS * A_HEAD_DIM) * jax.nn.silu(z)) @ w_out
    return y, k, v


def mla_inputs(h, pos, w_in, g_cq, w_uq, g_ckv, g_qn, g_qr, g_kr):
    B, L, _ = h.shape
    c_q, c_kv, k_r, z = jnp.split(h @ w_in, [Q_LORA, Q_LORA + KV_LORA, Q_LORA + KV_LORA + B_ROPE], axis=-1)
    q = (rms_norm(c_q, g_cq) @ w_uq).reshape(B, L, B_HEADS, B_NOPE + B_ROPE)
    q = jnp.concatenate([rms_norm(q[..., :B_NOPE], g_qn),
                         rotary(rms_norm(q[..., B_NOPE:], g_qr), pos)], axis=-1)
    c_kv = rms_norm(c_kv, g_ckv)
    k_r = rotary(rms_norm(k_r, g_kr)[:, :, None, :], pos)[:, :, 0, :]
    return q, c_kv, k_r, z


def mla_keys(c_kv, k_r, w_ukv, g_kn):
    B, L, _ = c_kv.shape
    kv = (c_kv @ w_ukv).reshape(B, L, B_HEADS, B_NOPE + B_VDIM)
    k = jnp.concatenate([rms_norm(kv[..., :B_NOPE], g_kn),
                         jnp.broadcast_to(k_r[:, :, None, :], (B, L, B_HEADS, B_ROPE))], axis=-1)
    return k, kv[..., B_NOPE:]


def b_prompt(h, w_in, g_cq, w_uq, g_ckv, w_ukv, g_qn, g_qr, g_kn, g_kr, w_out):
    B, S, _ = h.shape
    pos = jnp.arange(S, dtype=jnp.int32)
    q, c_kv, k_r, z = mla_inputs(h, pos, w_in, g_cq, w_uq, g_ckv, g_qn, g_qr, g_kr)
    k, v = mla_keys(c_kv, k_r, w_ukv, g_kn)
    n_blocks = S // Q_BLOCK
    qb = q.reshape(B, n_blocks, Q_BLOCK, B_HEADS, B_NOPE + B_ROPE).transpose(1, 0, 2, 3, 4)
    q_off = jnp.arange(Q_BLOCK, dtype=jnp.int32)
    scale = (B_NOPE + B_ROPE) ** -0.5

    def one_block(args):
        bi, qi = args
        qpos = bi * Q_BLOCK + q_off
        return attend(qi, k, v, None, chunk_mask(qpos, pos, None), scale)

    o = lax.map(one_block, (jnp.arange(n_blocks, dtype=jnp.int32), qb))
    o = o.transpose(1, 0, 2, 3, 4).reshape(B, S, B_HEADS * B_VDIM)
    y = (o * jax.nn.silu(z)) @ w_out
    return y, c_kv, k_r


def b_sample(h, cache_ckv, cache_kr, w_in, g_cq, w_uq, g_ckv, w_ukv, g_qn, g_qr, g_kn, g_kr, w_out):
    B, T, _ = h.shape
    qpos = PAST_LEN + jnp.arange(T, dtype=jnp.int32)
    q, c_kv, k_r, z = mla_inputs(h, qpos, w_in, g_cq, w_uq, g_ckv, g_qn, g_qr, g_kr)
    k, v = mla_keys(jnp.concatenate([cache_ckv, c_kv], axis=1),
                    jnp.concatenate([cache_kr, k_r], axis=1), w_ukv, g_kn)
    kpos = jnp.arange(PAST_LEN + T, dtype=jnp.int32)
    o = attend(q, k, v, None, chunk_mask(qpos, kpos, None), (B_NOPE + B_ROPE) ** -0.5)
    y = (o.reshape(B, T, B_HEADS * B_VDIM) * jax.nn.silu(z)) @ w_out
    return y, c_kv, k_r


def setup_inputs(seed: int = 0) -> dict:
    key = jax.random.key(seed)
    ks = jax.random.split(key, 32)
    f32 = jnp.float32

    def nrm(k, shape, s):
        return jax.random.normal(k, shape, f32) * s

    def gain(k, shape):
        return 1.0 + 0.02 * jax.random.normal(k, shape, f32)

    a_cache = min(A_WINDOW, PAST_LEN)
    D = D_MODEL
    return {
        "x_prompt": nrm(ks[0], (BATCH, SEQ, D), 1.0),
        "x_sample": nrm(ks[1], (DEC_BATCH, DEC_SEQ, D), 1.0),
        "cache_a_k": nrm(ks[2], (N_LAYERS_A, DEC_BATCH, a_cache, A_HEADS, A_HEAD_DIM), 1.0),
        "cache_a_v": nrm(ks[3], (N_LAYERS_A, DEC_BATCH, a_cache, A_HEADS, A_HEAD_DIM), 1.0),
        "cache_mla_ckv": nrm(ks[4], (N_LAYERS_B, DEC_BATCH, PAST_LEN, KV_LORA), 1.0),
        "cache_mla_krope": nrm(ks[5], (N_LAYERS_B, DEC_BATCH, PAST_LEN, B_ROPE), 1.0),
        "c_prompt": nrm(ks[6], (BATCH, D), 1.0),
        "c_sample": nrm(ks[7], (DEC_BATCH, D), 1.0),
        "norm_g": gain(ks[8], (DEPTH, D)),
        "ada_w": nrm(ks[9], (DEPTH, D, 3 * D), 0.5 * D ** -0.5),
        "ada_b": nrm(ks[10], (DEPTH, 3 * D), 0.02),
        "a_w_in": nrm(ks[11], (N_LAYERS_A, D, 4 * D), D ** -0.5),
        "a_g_q": gain(ks[12], (N_LAYERS_A, A_HEAD_DIM)),
        "a_g_k": gain(ks[13], (N_LAYERS_A, A_HEAD_DIM)),
        "a_rel_bias": nrm(ks[14], (N_LAYERS_A, A_HEADS, 2 * REL_CLIP + 1), 0.5),
        "a_w_out": nrm(ks[15], (N_LAYERS_A, D, D), D ** -0.5),
        "b_w_in": nrm(ks[16], (N_LAYERS_B, D, B_IN), D ** -0.5),
        "b_g_cq": gain(ks[17], (N_LAYERS_B, Q_LORA)),
        "b_w_uq": nrm(ks[18], (N_LAYERS_B, Q_LORA, B_HEADS * (B_NOPE + B_ROPE)), Q_LORA ** -0.5),
        "b_g_ckv": gain(ks[19], (N_LAYERS_B, KV_LORA)),
        "b_w_ukv": nrm(ks[20], (N_LAYERS_B, KV_LORA, B_HEADS * (B_NOPE + B_VDIM)), KV_LORA ** -0.5),
        "b_g_qn": gain(ks[21], (N_LAYERS_B, B_NOPE)),
        "b_g_qr": gain(ks[22], (N_LAYERS_B, B_ROPE)),
        "b_g_kn": gain(ks[23], (N_LAYERS_B, B_NOPE)),
        "b_g_kr": gain(ks[24], (N_LAYERS_B, B_ROPE)),
        "b_w_out": nrm(ks[25], (N_LAYERS_B, B_HEADS * B_VDIM, D), (B_HEADS * B_VDIM) ** -0.5),
    }


def reference(x_prompt, x_sample, cache_a_k, cache_a_v, cache_mla_ckv, cache_mla_krope,
              c_prompt, c_sample, norm_g, ada_w, ada_b,
              a_w_in, a_g_q, a_g_k, a_rel_bias, a_w_out,
              b_w_in, b_g_cq, b_w_uq, b_g_ckv, b_w_ukv, b_g_qn, b_g_qr, b_g_kn, b_g_kr, b_w_out):
    y_p, y_s = x_prompt, x_sample
    akp, avp, aks, avs = [], [], [], []
    bcp, brp, bcs, brs = [], [], [], []
    for i in range(DEPTH):
        j = i // N_MIXERS
        h_p, gate_p = ada_norm(y_p, c_prompt, norm_g[i], ada_w[i], ada_b[i])
        h_s, gate_s = ada_norm(y_s, c_sample, norm_g[i], ada_w[i], ada_b[i])
        if i % N_MIXERS == 0:
            out_p, k_new_p, v_new_p = a_prompt(h_p, a_w_in[j], a_g_q[j], a_g_k[j], a_rel_bias[j], a_w_out[j])
            out_s, k_new_s, v_new_s = a_sample(h_s, cache_a_k[j], cache_a_v[j], a_w_in[j], a_g_q[j],
                                               a_g_k[j], a_rel_bias[j], a_w_out[j])
            akp.append(k_new_p); avp.append(v_new_p); aks.append(k_new_s); avs.append(v_new_s)
        else:
            out_p, ckv_p, kr_p = b_prompt(h_p, b_w_in[j], b_g_cq[j], b_w_uq[j], b_g_ckv[j], b_w_ukv[j],
                                          b_g_qn[j], b_g_qr[j], b_g_kn[j], b_g_kr[j], b_w_out[j])
            out_s, ckv_s, kr_s = b_sample(h_s, cache_mla_ckv[j], cache_mla_krope[j], b_w_in[j], b_g_cq[j],
                                          b_w_uq[j], b_g_ckv[j], b_w_ukv[j], b_g_qn[j], b_g_qr[j],
                                          b_g_kn[j], b_g_kr[j], b_w_out[j])
            bcp.append(ckv_p); brp.append(kr_p); bcs.append(ckv_s); brs.append(kr_s)
        y_p = y_p + gate_p * out_p
        y_s = y_s + gate_s * out_s
    return (y_p, y_s,
            jnp.stack(akp), jnp.stack(avp), jnp.stack(aks), jnp.stack(avs),
            jnp.stack(bcp), jnp.stack(brp), jnp.stack(bcs), jnp.stack(brs))
```

```cpp
#include <hip/hip_runtime.h>
#include <hip/hip_cooperative_groups.h>
#include <cstdio>
#include <cstdint>
namespace cg = cooperative_groups;
#ifndef MULTI_LAUNCH
#define MULTI_LAUNCH 1
#endif
constexpr int DMODEL = 1024, NBP = 32, SEQ = 2048, NBS = 8, TS = 32;
constexpr int MP = NBP * SEQ;
constexpr int M1 = MP + NBS * TS;
constexpr int SA_STRIDE = 576;
constexpr int RA = MP + NBS * SA_STRIDE;
constexpr int SB_STRIDE = 2112;
constexpr int R2 = MP + NBS * SB_STRIDE;
constexpr float EPSN = 1e-6f;
constexpr float LOG2E = 1.4426950408889634f;
constexpr float QSCALE_A = 0.125f * LOG2E;
constexpr float QSCALE_B = 0.10206207261596575f * LOG2E;
namespace pg8 {
#define PG8_LAS __attribute__((address_space(3)))
typedef unsigned short bf16_t;
typedef short bf16x8 __attribute__((ext_vector_type(8)));
typedef float f32x4 __attribute__((ext_vector_type(4)));
typedef unsigned u32x4 __attribute__((ext_vector_type(4)));
constexpr int BM = 256, BK = 64, HALF = 128, HTB = HALF * BK * 2  , STAGE_BYTES = 8 * HTB, NXCD = 8, WGM = 8;

__host__ __device__ __forceinline__ int lds_byte(int r, int c) { const int st = (r >> 4) * 2 + (c >> 5), rr = r & 15, cc = c & 31, ob = rr * 64 + cc * 2; return st * 1024 + (ob ^ (((ob >> 9) & 1) << 5)); }
__host__ __device__ __forceinline__ void stage_rc(int b, int& R, int& C) { const int st = b / 1024, sb = b % 1024, swz = sb ^ (((sb >> 9) & 1) << 5); R = (st >> 1) * 16 + swz / 64; C = (st & 1) * 32 + (swz % 64) / 2; }
__host__ __device__ __forceinline__ int perm32(int rho) { const int n = rho >> 4, i = rho & 15; return 8 * (i >> 2) + 4 * n + (i & 3); }

struct Unit { int pm, pn; };
struct Gemm { const bf16_t* A; const bf16_t* Bt; int M, N, K; };

struct StaticOrder {
    int nM, nN, nwg, G, c;
    __host__ __device__ void init(int M, int N, int G_, int c_) { nM = M / BM; nN = N / BM; nwg = nM * nN; G = G_; c = c_; }
    __host__ __device__ bool next(int i, Unit& u) const {
        const long L = (long)i * G + c; if (L >= nwg) return false;
        int wgid = (int)L; { const int q = nwg / NXCD, r = nwg % NXCD, xcd = wgid % NXCD, off = wgid / NXCD; wgid = (xcd < r ? xcd * (q + 1) : r * (q + 1) + (xcd - r) * q) + off; }
        const int nig = WGM * nN, gid = wgid / nig, fm = gid * WGM, gsz = (nM - fm) < WGM ? (nM - fm) : WGM;
        u.pm = fm + ((wgid % nig) % gsz); u.pn = (wgid % nig) / gsz; return true;
    }
    __device__ __forceinline__ void a_ready(const Unit&) const {}
    __device__ __forceinline__ void done(const Unit&) const {}
};

__device__ __forceinline__ unsigned cvt_pk_bf16(float lo, float hi) { unsigned r; asm volatile("v_cvt_pk_bf16_f32 %0, %1, %2" : "=v"(r) : "v"(lo), "v"(hi)); return r; }
template <class Epi, class Sched, bool ALIGN_EPI = false, bool SP2 = false>
__device__ __forceinline__ void gemm_phase(PG8_LAS unsigned char* lds, const Gemm g, const Sched& S, const Epi& E) {
    const int tid = threadIdx.x, wid = __builtin_amdgcn_readfirstlane(tid >> 6), lane = tid & 63, wr = wid >> 2, wc = wid & 3, fr = lane & 15, fq = lane >> 4;
    const int K = g.K, nt = K / BK;
    unsigned voffA[2], voffB[2];
#pragma unroll
    for (int i = 0; i < 2; ++i) { int R, C; stage_rc(tid * 16 + i * 8192, R, C); const int Rb = Epi::PERM ? ((R & ~31) + perm32(R & 31)) : R;
        voffA[i] = (unsigned)(R * K + C) * 2u; voffB[i] = (unsigned)(Rb * K + C) * 2u; }
    const size_t kstep = (size_t)(BK * 2);
    const size_t hstep = (size_t)HALF * K * 2;
    const size_t tstep = 2 * hstep;
    const unsigned ldsw = (unsigned)wid * 1024u;
    const int aoff = lds_byte(wr * 64 + fr, fq * 8), boff = lds_byte(wc * 32 + fr, fq * 8);
#define PG8_SA(b, h) (((b) * 2 + (h)) * HTB)
#define PG8_SB(b, h) ((4 + (b) * 2 + (h)) * HTB)
#define PG8_STAGE(bufoff, gbase, voff) do { _Pragma("unroll") for (int _i = 0; _i < 2; ++_i) \
        __builtin_amdgcn_global_load_lds((const unsigned*)((const char*)(gbase) + (voff)[_i]), (PG8_LAS unsigned*)(lds + (bufoff) + ldsw + _i * 8192), 16, 0, 0); } while (0)
#define PG8_LDA(dst, b, h) do { _Pragma("unroll") for (int m = 0; m < 4; ++m) _Pragma("unroll") for (int k = 0; k < 2; ++k) dst[m][k] = *(const PG8_LAS bf16x8*)(lds + PG8_SA(b, h) + aoff + m * 2048 + k * 1024); } while (0)
#define PG8_LDB(dst, b, h) do { _Pragma("unroll") for (int n = 0; n < 2; ++n) _Pragma("unroll") for (int k = 0; k < 2; ++k) dst[n][k] = *(const PG8_LAS bf16x8*)(lds + PG8_SB(b, h) + boff + n * 2048 + k * 1024); } while (0)
#define PG8_MMA(ai, bj, At, Bt) do { __builtin_amdgcn_s_setprio(1); _Pragma("unroll") for (int m = 0; m < 4; ++m) _Pragma("unroll") for (int n = 0; n < 2; ++n) _Pragma("unroll") for (int k = 0; k < 2; ++k) \
        acc[ai][bj][m][n] = __builtin_amdgcn_mfma_f32_16x16x32_bf16(Bt[n][k], At[m][k], acc[ai][bj][m][n], 0, 0, 0); __builtin_amdgcn_s_setprio(0); } while (0)
#define PG8_WAIT_V(n) asm volatile("s_waitcnt vmcnt(" #n ")" ::: "memory")
#define PG8_WAIT_L(n) asm volatile("s_waitcnt lgkmcnt(" #n ")" ::: "memory")
#define PG8_BAR __builtin_amdgcn_s_barrier()
#define PG8_SCHED __builtin_amdgcn_sched_barrier(0)
    Unit cur, nxt; int ui = 0;
    if (!S.next(0, cur)) return;
    f32x4 acc[2][2][4][2];
#pragma unroll
    for (int a = 0; a < 2; ++a)
#pragma unroll
        for (int b = 0; b < 2; ++b)
#pragma unroll
            for (int m = 0; m < 4; ++m)
#pragma unroll
                for (int n = 0; n < 2; ++n) acc[a][b][m][n] = (f32x4){0.f, 0.f, 0.f, 0.f};
    bf16x8 At[4][2], B0[2][2], B1[2][2];
    const char* cA = (const char*)g.A + (size_t)cur.pm * tstep; const char* cB = (const char*)g.Bt + (size_t)cur.pn * tstep;
    S.a_ready(cur);
    if constexpr (SP2) {
        PG8_STAGE(PG8_SB(0, 0), cB, voffB); PG8_STAGE(PG8_SB(0, 1), cB + hstep, voffB); PG8_STAGE(PG8_SA(0, 0), cA, voffA); PG8_STAGE(PG8_SA(0, 1), cA + hstep, voffA);
        if (wr == 1) PG8_BAR;
        PG8_WAIT_V(2); PG8_BAR;
        PG8_STAGE(PG8_SB(1, 0), cB + kstep, voffB); PG8_STAGE(PG8_SA(1, 0), cA + kstep, voffA); PG8_STAGE(PG8_SB(1, 1), cB + hstep + kstep, voffB);
        PG8_WAIT_V(6); PG8_BAR;
    } else {
        PG8_STAGE(PG8_SB(0, 0), cB, voffB); PG8_STAGE(PG8_SA(0, 0), cA, voffA); PG8_STAGE(PG8_SB(0, 1), cB + hstep, voffB); PG8_STAGE(PG8_SA(0, 1), cA + hstep, voffA);
        if (wr == 1) PG8_BAR;
        PG8_WAIT_V(4); PG8_BAR;
        PG8_STAGE(PG8_SB(1, 0), cB + kstep, voffB); PG8_STAGE(PG8_SA(1, 0), cA + kstep, voffA); PG8_STAGE(PG8_SB(1, 1), cB + hstep + kstep, voffB);
        PG8_WAIT_V(6); PG8_BAR;
    }
    for (;;) {
        const bool has_next = S.next(ui + 1, nxt);
        const char* nA = has_next ? (const char*)g.A + (size_t)nxt.pm * tstep : cA; const char* nB = has_next ? (const char*)g.Bt + (size_t)nxt.pn * tstep : cB;
        for (int t = 0; t < nt; t += 2) {
            const bool last = (t == nt - 2);
            const char* a1 = cA + (size_t)(t + 1) * kstep;
            const char* a2 = last ? nA : cA + (size_t)(t + 2) * kstep; const char* b2 = last ? nB : cB + (size_t)(t + 2) * kstep;
            const char* a3 = a2 + kstep; const char* b3 = b2 + kstep;
            if (last && has_next) S.a_ready(nxt);
            if constexpr (SP2) {
            PG8_LDB(B0, 0, 0); PG8_LDB(B1, 0, 1); PG8_SCHED; PG8_LDA(At, 0, 0); PG8_STAGE(PG8_SA(1, 1), a1 + hstep, voffA);
            PG8_WAIT_V(8); PG8_WAIT_L(0); PG8_BAR; PG8_MMA(0, 0, At, B0); PG8_MMA(0, 1, At, B1); PG8_BAR; PG8_SCHED;
            PG8_LDA(At, 0, 1); PG8_STAGE(PG8_SB(0, 0), b2, voffB); PG8_STAGE(PG8_SB(0, 1), b2 + hstep, voffB); PG8_STAGE(PG8_SA(0, 0), a2, voffA);
            PG8_WAIT_V(8); PG8_WAIT_L(0); PG8_BAR; PG8_MMA(1, 0, At, B0); PG8_MMA(1, 1, At, B1); PG8_BAR; PG8_SCHED;
            PG8_LDB(B0, 1, 0); PG8_LDB(B1, 1, 1); PG8_SCHED; PG8_LDA(At, 1, 0); PG8_STAGE(PG8_SA(0, 1), a2 + hstep, voffA);
            PG8_WAIT_V(8); PG8_WAIT_L(0); PG8_BAR; PG8_MMA(0, 0, At, B0); PG8_MMA(0, 1, At, B1); PG8_BAR; PG8_SCHED;
            PG8_LDA(At, 1, 1); PG8_STAGE(PG8_SB(1, 0), b3, voffB); PG8_STAGE(PG8_SB(1, 1), b3 + hstep, voffB); PG8_STAGE(PG8_SA(1, 0), a3, voffA);
            PG8_WAIT_V(8); PG8_WAIT_L(0); PG8_BAR; PG8_MMA(1, 0, At, B0); PG8_MMA(1, 1, At, B1); PG8_BAR; PG8_SCHED;
            } else {
            PG8_LDB(B0, 0, 0); PG8_SCHED; PG8_LDA(At, 0, 0); PG8_STAGE(PG8_SA(1, 1), a1 + hstep, voffA);
            PG8_WAIT_L(8); PG8_BAR; PG8_WAIT_L(0); PG8_MMA(0, 0, At, B0); PG8_BAR; PG8_SCHED;
            PG8_LDB(B1, 0, 1); PG8_STAGE(PG8_SB(0, 0), b2, voffB);
            PG8_BAR; PG8_WAIT_L(0); PG8_MMA(0, 1, At, B1); PG8_BAR;
            PG8_LDA(At, 0, 1); PG8_STAGE(PG8_SA(0, 0), a2, voffA);
            PG8_BAR; PG8_WAIT_L(0); PG8_MMA(1, 0, At, B0); PG8_BAR; PG8_SCHED;
            PG8_STAGE(PG8_SB(0, 1), b2 + hstep, voffB);
            PG8_WAIT_V(6); PG8_BAR; PG8_MMA(1, 1, At, B1); PG8_BAR;
            PG8_LDB(B0, 1, 0); PG8_SCHED; PG8_LDA(At, 1, 0); PG8_STAGE(PG8_SA(0, 1), a2 + hstep, voffA);
            PG8_WAIT_L(8); PG8_BAR; PG8_WAIT_L(0); PG8_MMA(0, 0, At, B0); PG8_BAR; PG8_SCHED;
            PG8_LDB(B1, 1, 1); PG8_STAGE(PG8_SB(1, 0), b3, voffB);
            PG8_BAR; PG8_WAIT_L(0); PG8_MMA(0, 1, At, B1); PG8_BAR;
            PG8_LDA(At, 1, 1); PG8_STAGE(PG8_SA(1, 0), a3, voffA);
            PG8_BAR; PG8_WAIT_L(0); PG8_MMA(1, 0, At, B0); PG8_BAR; PG8_SCHED;
            PG8_STAGE(PG8_SB(1, 1), b3 + hstep, voffB);
            PG8_WAIT_V(6); PG8_BAR; PG8_MMA(1, 1, At, B1); PG8_BAR;
            }
        }
        if constexpr (ALIGN_EPI) { if (wr == 0) PG8_BAR; }
        if constexpr (!Epi::AFTER_DRAIN) { E(acc, cur, wr, wc, fr, fq); S.done(cur); }
        if (!has_next) break;
#pragma unroll
        for (int a = 0; a < 2; ++a)
#pragma unroll
            for (int b = 0; b < 2; ++b)
#pragma unroll
                for (int m = 0; m < 4; ++m)
#pragma unroll
                    for (int n = 0; n < 2; ++n) acc[a][b][m][n] = (f32x4){0.f, 0.f, 0.f, 0.f};
        cur = nxt; cA = nA; cB = nB; ++ui;
        if constexpr (ALIGN_EPI) { if (wr == 1) PG8_BAR; }
    }
    PG8_WAIT_V(0);
    if constexpr (!ALIGN_EPI) { if (wr == 0) PG8_BAR; }
    PG8_BAR;
    if constexpr (Epi::AFTER_DRAIN) { E.fused(acc, cur, wr, wc, fr, fq, lds, wid, lane); S.done(cur); }
#undef PG8_SA
#undef PG8_SB
#undef PG8_STAGE
#undef PG8_LDA
#undef PG8_LDB
#undef PG8_MMA
#undef PG8_WAIT_V
#undef PG8_WAIT_L
#undef PG8_BAR
#undef PG8_SCHED
}
typedef unsigned u32x2 __attribute__((ext_vector_type(2)));
typedef float f32x2 __attribute__((ext_vector_type(2)));
typedef __bf16 bf16x2_t __attribute__((ext_vector_type(2)));
__device__ __forceinline__ unsigned pkbf(float lo, float hi) { f32x2 v = {lo, hi}; bf16x2_t b = __builtin_convertvector(v, bf16x2_t); return __builtin_bit_cast(unsigned, b); }
__device__ __forceinline__ u32x2 pk4(f32x4 v) { u32x2 r; r.x = pkbf(v[0], v[1]); r.y = pkbf(v[2], v[3]); return r; }
__device__ __forceinline__ float silu_f(float v) { return v * __builtin_amdgcn_rcpf(1.f + __expf(-v)); }
__device__ __forceinline__ f32x4 silu4(f32x4 v) { f32x4 o; o[0] = silu_f(v[0]); o[1] = silu_f(v[1]); o[2] = silu_f(v[2]); o[3] = silu_f(v[3]); return o; }
__device__ __forceinline__ float ssq4(f32x4 v) { return (v[0] * v[0] + v[1] * v[1]) + (v[2] * v[2] + v[3] * v[3]); }
__device__ __forceinline__ float red_fq(float s) { s += __shfl_xor(s, 16); s += __shfl_xor(s, 32); return s; }

struct EpiAin {
    static constexpr bool PERM = false, AFTER_DRAIN = false;
    bf16_t *Q, *K, *V, *Z; const float *gq, *gk; float *okp, *ovp, *oks, *ovs;
    __device__ __forceinline__ void operator()(const f32x4 (&acc)[2][2][4][2], const Unit& u, int wr, int wc, int fr, int fq) const {
        const int sec = u.pn >> 2, head = (u.pn & 3) * 4 + wc, cb = head * 64 + 4 * fq;
        f32x4 g[2][2];
#pragma unroll
        for (int bj = 0; bj < 2; ++bj)
#pragma unroll
            for (int n = 0; n < 2; ++n) g[bj][n] = (sec < 2) ? *(const f32x4*)((sec == 0 ? gq : gk) + 32 * bj + 16 * n + 4 * fq) : (f32x4){1.f, 1.f, 1.f, 1.f};
#pragma unroll
        for (int ai = 0; ai < 2; ++ai)
#pragma unroll
            for (int m = 0; m < 4; ++m) {
                const int row = u.pm * BM + ai * HALF + wr * 64 + m * 16 + fr;
                f32x4 v[2][2];
#pragma unroll
                for (int bj = 0; bj < 2; ++bj)
#pragma unroll
                    for (int n = 0; n < 2; ++n) v[bj][n] = acc[ai][bj][m][n];
                if (sec < 2) {
                    float s = (ssq4(v[0][0]) + ssq4(v[0][1])) + (ssq4(v[1][0]) + ssq4(v[1][1]));
                    s = red_fq(s);
                    const float r = rsqrtf(s * (1.f / 64.f) + EPSN) * (sec == 0 ? QSCALE_A : 1.f);
#pragma unroll
                    for (int bj = 0; bj < 2; ++bj)
#pragma unroll
                        for (int n = 0; n < 2; ++n) v[bj][n] = v[bj][n] * g[bj][n] * r;
                } else if (sec == 3) {
#pragma unroll
                    for (int bj = 0; bj < 2; ++bj)
#pragma unroll
                        for (int n = 0; n < 2; ++n) v[bj][n] = silu4(v[bj][n]);
                }
                if (sec == 0 || sec == 3) {
                    bf16_t* d = (sec == 0 ? Q : Z) + (size_t)row * 1024 + cb;
#pragma unroll
                    for (int bj = 0; bj < 2; ++bj)
#pragma unroll
                        for (int n = 0; n < 2; ++n) *(u32x2*)(d + 32 * bj + 16 * n) = pk4(v[bj][n]);
                } else {
                    size_t drow; float* of = nullptr;
                    if (row < MP) { drow = (size_t)row; const int pos = row & (SEQ - 1); if (pos >= SEQ - 512) of = (sec == 1 ? okp : ovp) + ((size_t)((row >> 11) * 512 + pos - (SEQ - 512))) * 1024; }
                    else { const int rs = row - MP; drow = (size_t)MP + (size_t)(rs >> 5) * SA_STRIDE + 512 + (rs & 31); of = (sec == 1 ? oks : ovs) + (size_t)rs * 1024; }
                    bf16_t* d = (sec == 1 ? K : V) + drow * 1024 + cb;
#pragma unroll
                    for (int bj = 0; bj < 2; ++bj)
#pragma unroll
                        for (int n = 0; n < 2; ++n) { *(u32x2*)(d + 32 * bj + 16 * n) = pk4(v[bj][n]); if (of) *(f32x4*)(of + cb + 32 * bj + 16 * n) = v[bj][n]; }
                }
                asm volatile("" ::: "memory");
            }
    }
};
struct EpiRes {
    static constexpr bool PERM = false, AFTER_DRAIN = false;
    const float *xp, *xs; float *yp, *ys; const float* gate;
    __device__ __forceinline__ void operator()(const f32x4 (&acc)[2][2][4][2], const Unit& u, int wr, int wc, int fr, int fq) const {
        const int cb = u.pn * 256 + wc * 64 + 4 * fq;
#pragma unroll
        for (int ai = 0; ai < 2; ++ai)
#pragma unroll
            for (int m = 0; m < 4; ++m) {
                const int row = u.pm * BM + ai * HALF + wr * 64 + m * 16 + fr;
                const float* xi; float* yo; int bb;
                if (row < MP) { xi = xp + (size_t)row * 1024; yo = yp + (size_t)row * 1024; bb = row >> 11; }
                else { const int rs = row - MP; xi = xs + (size_t)rs * 1024; yo = ys + (size_t)rs * 1024; bb = NBP + (rs >> 5); }
                const float* gp = gate + (size_t)bb * 3072;
#pragma unroll
                for (int bj = 0; bj < 2; ++bj)
#pragma unroll
                    for (int n = 0; n < 2; ++n) { const int c = cb + 32 * bj + 16 * n; const f32x4 o = *(const f32x4*)(xi + c) + *(const f32x4*)(gp + c) * acc[ai][bj][m][n]; *(f32x4*)(yo + c) = o; }
                asm volatile("" ::: "memory");
            }
    }
};
struct EpiBin {
    static constexpr bool PERM = false, AFTER_DRAIN = false;
    bf16_t* Z; float* RAW;
    __device__ __forceinline__ void operator()(const f32x4 (&acc)[2][2][4][2], const Unit& u, int wr, int wc, int fr, int fq) const {
        const int cb = u.pn * 256 + wc * 64 + 4 * fq;
#pragma unroll
        for (int ai = 0; ai < 2; ++ai)
#pragma unroll
            for (int m = 0; m < 4; ++m) {
                const int row = u.pm * BM + ai * HALF + wr * 64 + m * 16 + fr;
#pragma unroll
                for (int bj = 0; bj < 2; ++bj)
#pragma unroll
                    for (int n = 0; n < 2; ++n) { const int c = cb + 32 * bj + 16 * n;
                        if (u.pn < 4) *(u32x2*)(Z + (size_t)row * 1024 + c) = pk4(silu4(acc[ai][bj][m][n]));
                        else *(f32x4*)(RAW + (size_t)row * 768 + (c - 1024)) = acc[ai][bj][m][n]; }
            }
    }
};
struct EpiUq {
    static constexpr bool PERM = false, AFTER_DRAIN = false;
    bf16_t* Q; const float *gqn, *gqr, *CS;
    __device__ __forceinline__ void operator()(const f32x4 (&acc)[2][2][4][2], const Unit& u, int wr, int wc, int fr, int fq) const {
        if (u.pn < 4) {
            const int head = u.pn * 4 + wc;
#pragma unroll
            for (int ai = 0; ai < 2; ++ai)
#pragma unroll
                for (int m = 0; m < 4; ++m) {
                    const int row = u.pm * BM + ai * HALF + wr * 64 + m * 16 + fr;
                    float s = (ssq4(acc[ai][0][m][0]) + ssq4(acc[ai][0][m][1])) + (ssq4(acc[ai][1][m][0]) + ssq4(acc[ai][1][m][1]));
                    s = red_fq(s);
                    const float r = rsqrtf(s * (1.f / 64.f) + EPSN) * QSCALE_B;
                    bf16_t* d = Q + (size_t)row * 1536 + head * 96 + 4 * fq;
#pragma unroll
                    for (int bj = 0; bj < 2; ++bj)
#pragma unroll
                        for (int n = 0; n < 2; ++n) *(u32x2*)(d + 32 * bj + 16 * n) = pk4(acc[ai][bj][m][n] * *(const f32x4*)(gqn + 32 * bj + 16 * n + 4 * fq) * r);
                    asm volatile("" ::: "memory");
                }
        } else {
#pragma unroll
            for (int ai = 0; ai < 2; ++ai)
#pragma unroll
                for (int m = 0; m < 4; ++m) {
                    const int row = u.pm * BM + ai * HALF + wr * 64 + m * 16 + fr;
                    const int pos = row < MP ? (row & (SEQ - 1)) : SEQ + ((row - MP) & 31);
#pragma unroll
                    for (int bj = 0; bj < 2; ++bj) {
                        const int hr = (u.pn - 4) * 8 + wc * 2 + bj;
                        float s = ssq4(acc[ai][bj][m][0]) + ssq4(acc[ai][bj][m][1]);
                        s = red_fq(s);
                        const float r = rsqrtf(s * (1.f / 32.f) + EPSN);
                        const f32x4 x1 = acc[ai][bj][m][0] * *(const f32x4*)(gqr + 4 * fq) * r, x2 = acc[ai][bj][m][1] * *(const f32x4*)(gqr + 16 + 4 * fq) * r;
                        const f32x4 cs = *(const f32x4*)(CS + pos * 32 + 4 * fq), sn = *(const f32x4*)(CS + pos * 32 + 16 + 4 * fq);
                        bf16_t* d = Q + (size_t)row * 1536 + hr * 96 + 64 + 4 * fq;
                        *(u32x2*)d = pk4((x1 * cs - x2 * sn) * QSCALE_B); *(u32x2*)(d + 16) = pk4((x2 * cs + x1 * sn) * QSCALE_B);
                        asm volatile("" ::: "memory");
                    }
                }
        }
    }
};
struct EpiUkv {
    static constexpr bool PERM = false, AFTER_DRAIN = false;
    bf16_t *KN, *VB; const float* gkn;
    __device__ __forceinline__ void operator()(const f32x4 (&acc)[2][2][4][2], const Unit& u, int wr, int wc, int fr, int fq) const {
        const bool isk = u.pn < 4; const int head = (u.pn & 3) * 4 + wc;
#pragma unroll
        for (int ai = 0; ai < 2; ++ai)
#pragma unroll
            for (int m = 0; m < 4; ++m) {
                const int row = u.pm * BM + ai * HALF + wr * 64 + m * 16 + fr;
                float r = 1.f;
                if (isk) { float s = (ssq4(acc[ai][0][m][0]) + ssq4(acc[ai][0][m][1])) + (ssq4(acc[ai][1][m][0]) + ssq4(acc[ai][1][m][1])); s = red_fq(s); r = rsqrtf(s * (1.f / 64.f) + EPSN); }
                bf16_t* d = (isk ? KN : VB) + (size_t)row * 1024 + head * 64 + 4 * fq;
#pragma unroll
                for (int bj = 0; bj < 2; ++bj)
#pragma unroll
                    for (int n = 0; n < 2; ++n) { const f32x4 gg = isk ? *(const f32x4*)(gkn + 32 * bj + 16 * n + 4 * fq) : (f32x4){1.f, 1.f, 1.f, 1.f}; *(u32x2*)(d + 32 * bj + 16 * n) = pk4(acc[ai][bj][m][n] * gg * r); }
                asm volatile("" ::: "memory");
            }
    }
};
}
namespace at {
#define ALAS __attribute__((address_space(3)))
typedef unsigned short bf16_t;
typedef short bf16x8 __attribute__((ext_vector_type(8)));
typedef short s16x4 __attribute__((ext_vector_type(4)));
typedef float f32x16 __attribute__((ext_vector_type(16)));
typedef float f32x4 __attribute__((ext_vector_type(4)));
typedef unsigned u32x4 __attribute__((ext_vector_type(4)));
typedef unsigned u32x2 __attribute__((ext_vector_type(2)));
constexpr int KROW = 144, KHEAD = 64 * KROW, VROW = 136, VHEAD = 64 * VROW + 8, RROW = 80;
constexpr int KBUF = 4 * KHEAD, VBUF = 4 * VHEAD, RBUF = 64 * RROW, STAGE = KBUF + VBUF + RBUF;
constexpr int TBL_OFF = KBUF + VBUF, LDS_BYTES = 2 * STAGE;
static_assert(4 * 257 * 4 <= RBUF, "bias table");
struct AttnUnit { int qrow0, nq, krow0, nt, lastvalid, hg, D0; };
__device__ __forceinline__ int crow(int r, int hi) { return (r & 3) + 8 * (r >> 2) + 4 * hi; }

template <bool MLA>
__device__ __forceinline__ void attn_unit(ALAS unsigned char* lds, const AttnUnit u, const bf16_t* __restrict__ Q, const bf16_t* __restrict__ Kn, const bf16_t* __restrict__ Kr,
                                          const bf16_t* __restrict__ V, const bf16_t* __restrict__ Z, bf16_t* __restrict__ U, const float* __restrict__ tbl) {
    const int tid = threadIdx.x, lane = tid & 63, wid = __builtin_amdgcn_readfirstlane(tid >> 6), l32 = lane & 31, hi = lane >> 5;
    const int hl = wid >> 1, qh = wid & 1, head = u.hg * 4 + hl;
    const bool active = qh * 32 < u.nq;
    constexpr int QS = MLA ? 1536 : 1024, HS = MLA ? 96 : 64, ND0 = MLA ? 6 : 4;
    ALAS float* tb = (ALAS float*)(lds + TBL_OFF);
    if (!MLA) { for (int i = tid; i < 4 * 257; i += 512) tb[i] = tbl[(size_t)(u.hg * 4) * 257 + i] * LOG2E; }
    const int qrow = u.qrow0 + (active ? qh * 32 : 0) + l32;
    bf16x8 qf[ND0];
#pragma unroll
    for (int d0 = 0; d0 < ND0; ++d0) qf[d0] = *(const bf16x8*)(Q + (size_t)qrow * QS + head * HS + d0 * 16 + hi * 8);
    u32x4 kreg[4]; u32x2 vreg[2][4]; u32x4 rreg;
#define AT_GLOAD(ti) do { const size_t kr_ = (size_t)(u.krow0 + 64 * (ti)); \
        _Pragma("unroll") for (int i_ = 0; i_ < 4; ++i_) { const int id_ = tid + 512 * i_; kreg[i_] = *(const u32x4*)(Kn + (kr_ + (id_ >> 5)) * 1024 + u.hg * 256 + (id_ & 31) * 8); } \
        _Pragma("unroll") for (int i_ = 0; i_ < 2; ++i_) { const int mt_ = tid + 512 * i_, dq_ = mt_ & 63, kvq_ = mt_ >> 6; \
            _Pragma("unroll") for (int a_ = 0; a_ < 4; ++a_) vreg[i_][a_] = *(const u32x2*)(V + (kr_ + 4 * kvq_ + a_) * 1024 + u.hg * 256 + dq_ * 4); } \
        if (MLA) { if (tid < 256) rreg = *(const u32x4*)(Kr + (kr_ + (tid >> 2)) * 32 + (tid & 3) * 8); } } while (0)
#define AT_SWRITE(st) do { ALAS unsigned char* sb_ = lds + (st) * STAGE; \
        _Pragma("unroll") for (int i_ = 0; i_ < 4; ++i_) { const int id_ = tid + 512 * i_, row_ = id_ >> 5, cc_ = id_ & 31; \
            *(ALAS u32x4*)(sb_ + (cc_ >> 3) * KHEAD + row_ * KROW + (cc_ & 7) * 16) = kreg[i_]; } \
        _Pragma("unroll") for (int i_ = 0; i_ < 2; ++i_) { const int mt_ = tid + 512 * i_, dq_ = mt_ & 63, kvq_ = mt_ >> 6; \
            ALAS unsigned char* vb_ = sb_ + KBUF + (dq_ >> 4) * VHEAD; \
            _Pragma("unroll") for (int jj_ = 0; jj_ < 4; ++jj_) { const int d_ = 4 * (dq_ & 15) + jj_; u32x2 o_; \
                const unsigned sel_ = (jj_ & 1) ? 0x07060302u : 0x05040100u; \
                if (jj_ < 2) { o_.x = __builtin_amdgcn_perm(vreg[i_][1].x, vreg[i_][0].x, sel_); o_.y = __builtin_amdgcn_perm(vreg[i_][3].x, vreg[i_][2].x, sel_); } \
                else         { o_.x = __builtin_amdgcn_perm(vreg[i_][1].y, vreg[i_][0].y, sel_); o_.y = __builtin_amdgcn_perm(vreg[i_][3].y, vreg[i_][2].y, sel_); } \
                *(ALAS u32x2*)(vb_ + d_ * VROW + kvq_ * 8) = o_; } } \
        if (MLA) { if (tid < 256) { const int row_ = tid >> 2, cc_ = tid & 3; *(ALAS u32x4*)(sb_ + KBUF + VBUF + row_ * RROW + cc_ * 16) = rreg; } } } while (0)
    float mrun = -INFINITY, lrun = 0.f;
    f32x16 o0 = f32x16{}, o1 = f32x16{};
    AT_GLOAD(0); AT_SWRITE(0);
    __syncthreads();
    for (int ti = 0; ti < u.nt; ++ti) {
        const bool more = ti + 1 < u.nt;
        if (more) AT_GLOAD(ti + 1);
        if (active) {
            ALAS unsigned char* sb = lds + (ti & 1) * STAGE;
            ALAS unsigned char* kb = sb + hl * KHEAD + l32 * KROW + hi * 16;
            f32x16 p[2];
            if (!MLA) {
                const int dmin = u.D0 - 64 * ti - 63;
                if (dmin >= 128) { const float c = tb[hl * 257 + 256];
#pragma unroll
                    for (int r = 0; r < 16; ++r) { p[0][r] = c; p[1][r] = c; } }
                else { const int dq = u.D0 + qh * 32 + l32 - 64 * ti;
#pragma unroll
                    for (int blk = 0; blk < 2; ++blk)
#pragma unroll
                        for (int r = 0; r < 16; ++r) { int df = dq - 32 * blk - crow(r, hi); df = df < -128 ? -128 : (df > 128 ? 128 : df); p[blk][r] = tb[hl * 257 + df + 128]; } }
            } else { p[0] = f32x16{}; p[1] = f32x16{}; }
#pragma unroll
            for (int blk = 0; blk < 2; ++blk) {
#pragma unroll
                for (int d0 = 0; d0 < 4; ++d0) {
                    const bf16x8 a = *(const ALAS bf16x8*)(kb + blk * 32 * KROW + d0 * 32);
                    p[blk] = __builtin_amdgcn_mfma_f32_32x32x16_bf16(a, qf[d0], p[blk], 0, 0, 0);
                }
                if (MLA) {
                    ALAS unsigned char* rb = sb + KBUF + VBUF + l32 * RROW + hi * 16;
#pragma unroll
                    for (int d0 = 4; d0 < ND0; ++d0) {
                        const bf16x8 a = *(const ALAS bf16x8*)(rb + blk * 32 * RROW + (d0 - 4) * 32);
                        p[blk] = __builtin_amdgcn_mfma_f32_32x32x16_bf16(a, qf[d0], p[blk], 0, 0, 0);
                    }
                }
            }
            if (!more && u.lastvalid < 64) {
#pragma unroll
                for (int r = 0; r < 16; ++r) p[1][r] = -INFINITY;
            }
            float mx = p[0][0];
#pragma unroll
            for (int r = 1; r < 16; ++r) mx = fmaxf(mx, p[0][r]);
#pragma unroll
            for (int r = 0; r < 16; ++r) mx = fmaxf(mx, p[1][r]);
            mx = fmaxf(mx, __shfl_xor(mx, 32));
            const float mnew = fmaxf(mrun, mx);
            if (__any(mnew > mrun)) {
                const float al = __builtin_amdgcn_exp2f(mrun - mnew);
                lrun *= al;
#pragma unroll
                for (int r = 0; r < 16; ++r) { o0[r] *= al; o1[r] *= al; }
                mrun = mnew;
            }
            float ls = 0.f;
#pragma unroll
            for (int blk = 0; blk < 2; ++blk)
#pragma unroll
                for (int r = 0; r < 16; ++r) { p[blk][r] = __builtin_amdgcn_exp2f(p[blk][r] - mrun); ls += p[blk][r]; }
            lrun += ls;
            bf16x8 pk[4];
#pragma unroll
            for (int j = 0; j < 4; ++j) { u32x4 w;
                const int b = j >> 1, r0 = 8 * (j & 1);
                w.x = pg8::pkbf(p[b][r0 + 0], p[b][r0 + 1]); w.y = pg8::pkbf(p[b][r0 + 2], p[b][r0 + 3]); w.z = pg8::pkbf(p[b][r0 + 4], p[b][r0 + 5]); w.w = pg8::pkbf(p[b][r0 + 6], p[b][r0 + 7]);
                pk[j] = __builtin_bit_cast(bf16x8, w); }
            ALAS unsigned char* vb = sb + KBUF + hl * VHEAD + l32 * VROW + hi * 8;
#pragma unroll
            for (int dblk = 0; dblk < 2; ++dblk) {
#pragma unroll
                for (int j = 0; j < 4; ++j) {
                    const s16x4 lo = *(const ALAS s16x4*)(vb + dblk * 32 * VROW + j * 32);
                    const s16x4 hh = *(const ALAS s16x4*)(vb + dblk * 32 * VROW + j * 32 + 16);
                    const bf16x8 vf = (bf16x8){lo[0], lo[1], lo[2], lo[3], hh[0], hh[1], hh[2], hh[3]};
                    if (dblk == 0) o0 = __builtin_amdgcn_mfma_f32_32x32x16_bf16(vf, pk[j], o0, 0, 0, 0);
                    else           o1 = __builtin_amdgcn_mfma_f32_32x32x16_bf16(vf, pk[j], o1, 0, 0, 0);
                }
            }
        }
        if (more) AT_SWRITE((ti + 1) & 1);
        __syncthreads();
    }
    if (active) {
        const float lt = lrun + __shfl_xor(lrun, 32);
        const float inv = 1.f / lt;
        const size_t ob = (size_t)qrow * 1024 + head * 64 + 4 * hi;
#pragma unroll
        for (int dblk = 0; dblk < 2; ++dblk)
#pragma unroll
            for (int g = 0; g < 4; ++g) {
                const u32x2 zz = *(const u32x2*)(Z + ob + 32 * dblk + 8 * g);
                const float z0 = __uint_as_float(zz.x << 16), z1 = __uint_as_float(zz.x & 0xffff0000u), z2 = __uint_as_float(zz.y << 16), z3 = __uint_as_float(zz.y & 0xffff0000u);
                const f32x16& o = dblk == 0 ? o0 : o1;
                u32x2 w; w.x = pg8::pkbf(o[4 * g + 0] * inv * z0, o[4 * g + 1] * inv * z1); w.y = pg8::pkbf(o[4 * g + 2] * inv * z2, o[4 * g + 3] * inv * z3);
                *(u32x2*)(U + ob + 32 * dblk + 8 * g) = w;
            }
    }
#undef AT_GLOAD
#undef AT_SWRITE
}
}
#define LAS __attribute__((address_space(3)))
typedef unsigned short bf16;
typedef unsigned v4u __attribute__((ext_vector_type(4)));
typedef unsigned v2u __attribute__((ext_vector_type(2)));
typedef float f32x4 __attribute__((ext_vector_type(4)));
constexpr size_t MiB = 1u << 20;
constexpr size_t WS_MOD = 0;
constexpr size_t MOD_BYTES = 2 * 40 * 3072 * 4;
constexpr size_t WS_CS = 1 * MiB;
constexpr size_t WS_W_AIN = 4 * MiB, WS_W_AOUT = 12 * MiB, WS_W_BIN = 14 * MiB, WS_W_UQ = 18 * MiB, WS_W_UKV = 20 * MiB, WS_W_BOUT = 22 * MiB;
constexpr size_t WS_H = 24 * MiB;
constexpr size_t WS_CKV = 153 * MiB;
constexpr size_t WS_KR = 194 * MiB;
constexpr size_t WS_X = 200 * MiB;
constexpr size_t WS_QA = WS_X, WS_KA = WS_X + 129 * MiB, WS_VA = WS_X + 267 * MiB, WS_ZA = WS_X + 405 * MiB;
constexpr size_t WS_ZB = WS_X, WS_RAW = WS_X + 129 * MiB, WS_QB = WS_RAW, WS_CQ = WS_X + 322 * MiB, WS_KN = WS_X + 371 * MiB, WS_VB = WS_X + 532 * MiB;
constexpr size_t WS_END = WS_X + 694 * MiB;
static_assert((size_t)M1 * 1024 * 2 <= 129 * MiB && (size_t)RA * 1024 * 2 <= 138 * MiB && (size_t)M1 * 768 * 4 <= 193 * MiB && (size_t)M1 * 384 * 2 <= 49 * MiB && (size_t)R2 * 1024 * 2 <= 161 * MiB, "ws map");
static_assert((size_t)R2 * 256 * 2 <= 41 * MiB && (size_t)R2 * 32 * 2 <= 6 * MiB && WS_ZA + 129 * MiB <= WS_END && WS_VB + 161 * MiB <= WS_END && WS_END <= 1024 * MiB, "ws map");
constexpr size_t O_YP = 0, O_YS = 67108864, O_AKP = 67371008, O_AVP = 84148224, O_AKS = 100925440, O_AVS = 101187584, O_CKVP = 101449728, O_KRP = 118226944, O_CKVS = 120324096, O_KRS = 120389632;
constexpr int LDS_TOTAL = 153664;
static_assert(at::LDS_BYTES <= LDS_TOTAL && pg8::STAGE_BYTES <= LDS_TOTAL, "LDS");

__device__ __forceinline__ float wave_sum(float v) {
#pragma unroll
    for (int o = 1; o < 64; o <<= 1) v += __shfl_xor(v, o);
    return v;
}
__device__ __forceinline__ unsigned pk2(float lo, float hi) { return pg8::pkbf(lo, hi); }
__device__ __forceinline__ int src_col(int gemm, int g) {
    const int lc = ((g >> 3) * 8 + (g & 3) * 2 + ((g >> 2) & 1)) * 32;
    switch (gemm) {
    case 2: if (lc < 1024) return 672 + lc; if (lc < 1408) return lc - 1024; if (lc < 1664) return 384 + (lc - 1408); if (lc < 1696) return 640 + (lc - 1664); return -1;
    case 3: if (lc < 1024) return (lc >> 6) * 96 + (lc & 63); return ((lc - 1024) >> 5) * 96 + 64;
    case 4: if (lc < 1024) return (lc >> 6) * 128 + (lc & 63); return ((lc - 1024) >> 6) * 128 + 64 + (lc & 63);
    default: return lc;
    }
}
__device__ __forceinline__ void transpose_item(const float* W, int K, int Nsrc, int sc, bf16* WT, int g, int k0, LAS float* scr, int lane) {
#pragma unroll 8
    for (int i = 0; i < 32; ++i) { const int kk = 2 * i + (lane >> 5); scr[kk * 33 + (lane & 31)] = sc >= 0 ? W[(size_t)(k0 + kk) * Nsrc + sc + (lane & 31)] : 0.f; }
    asm volatile("s_waitcnt lgkmcnt(0)" ::: "memory");
    const int c = lane & 7;
#pragma unroll
    for (int j = 0; j < 4; ++j) { const int n = (lane >> 3) + 8 * j; const LAS float* s = scr + (8 * c) * 33 + n;
        v4u o; o.x = pk2(s[0 * 33], s[1 * 33]); o.y = pk2(s[2 * 33], s[3 * 33]); o.z = pk2(s[4 * 33], s[5 * 33]); o.w = pk2(s[6 * 33], s[7 * 33]);
        *(v4u*)(WT + (size_t)(32 * g + n) * K + k0 + 8 * c) = o; }
    asm volatile("s_waitcnt lgkmcnt(0)" ::: "memory");
}
__device__ __forceinline__ void cvt8(const float* s, bf16* d) { const f32x4 a = *(const f32x4*)s, b = *(const f32x4*)(s + 4); v4u o; o.x = pk2(a[0], a[1]); o.y = pk2(a[2], a[3]); o.z = pk2(b[0], b[1]); o.w = pk2(b[2], b[3]); *(v4u*)d = o; }

struct Args { const float* in[26]; float* out; unsigned char* ws; int ph_lo, ph_hi; };

__device__ __forceinline__ void adanorm_rows(const float* xp, const float* xs, const float* g, const float* mod, bf16* H, int gw, int NGW, int lane) {
    for (int row = gw; row < M1; row += NGW) {
        const float* xr; int bb;
        if (row < MP) { xr = xp + (size_t)row * 1024; bb = row >> 11; } else { xr = xs + (size_t)(row - MP) * 1024; bb = NBP + ((row - MP) >> 5); }
        const float* md = mod + (size_t)bb * 3072;
        f32x4 v[4]; float s = 0.f;
#pragma unroll
        for (int j = 0; j < 4; ++j) { v[j] = *(const f32x4*)(xr + 4 * lane + 256 * j); s += pg8::ssq4(v[j]); }
        const float r = rsqrtf(wave_sum(s) * (1.f / 1024.f) + EPSN);
#pragma unroll
        for (int j = 0; j < 4; ++j) { const int c = 4 * lane + 256 * j;
            const f32x4 gg = *(const f32x4*)(g + c), sh = *(const f32x4*)(md + c), sc = *(const f32x4*)(md + 1024 + c);
            const f32x4 h = v[j] * r * gg * (sc + 1.f) + sh;
            v2u o; o.x = pk2(h[0], h[1]); o.y = pk2(h[2], h[3]); *(v2u*)(H + (size_t)row * 1024 + c) = o; }
    }
}

__global__ void __launch_bounds__(512, 2) hybrid_fwd(Args args) {
    extern __shared__ __attribute__((aligned(16))) unsigned char lds_raw[];
    LAS unsigned char* lds = (LAS unsigned char*)lds_raw;
    const int tid = threadIdx.x, lane = tid & 63, wave = __builtin_amdgcn_readfirstlane(tid >> 6);
    const int G = gridDim.x, bid = blockIdx.x;
    const int gw = bid * 8 + wave, NGW = G * 8;
    const int gt = bid * 512 + tid, NGT = G * 512;
    const int lo = args.ph_lo, hi = args.ph_hi;
#ifndef PHMASK
#define PHMASK 0x7ff
#endif
#define IN(k) (((PHMASK >> (k)) & 1) && lo <= (k) && (k) < hi)
typedef const __attribute__((address_space(4))) Args* KArgs;
#define PHASE_ARGS() KArgs A = (KArgs)__builtin_amdgcn_kernarg_segment_ptr(); asm volatile("" : "+s"(A)); unsigned char* ws = A->ws; float* out = A->out; (void)ws; (void)out
#define WSP(T, off) ((T*)(ws + (off)))
#define SEAM(k) do { if (IN(k) && IN((k) + 1)) { cg::this_grid().sync(); } } while (0)

    if (IN(0)) {
        PHASE_ARGS();
        float* mod = WSP(float, WS_MOD); float* CS = WSP(float, WS_CS);
        bf16 *W_AIN = WSP(bf16, WS_W_AIN), *W_AOUT = WSP(bf16, WS_W_AOUT), *W_BIN = WSP(bf16, WS_W_BIN), *W_UQ = WSP(bf16, WS_W_UQ), *W_UKV = WSP(bf16, WS_W_UKV), *W_BOUT = WSP(bf16, WS_W_BOUT);
        bf16 *KA = WSP(bf16, WS_KA), *VA = WSP(bf16, WS_VA), *CKV = WSP(bf16, WS_CKV), *KR = WSP(bf16, WS_KR);
        {
            LAS float* scr = (LAS float*)(lds + wave * 10240);
            constexpr int I0 = 16 * 128, I1 = 16 * 32, I2 = 16 * 56, I3 = 6 * 48, I4 = 4 * 64, I5 = 16 * 32;
            for (int it = gw; it < I0 + I1 + I2 + I3 + I4 + I5; it += NGW) {
                int r = it;
                if (r < I0) { const int g = r % 128; transpose_item(A->in[11], 1024, 4096, src_col(0, g), W_AIN, g, (r / 128) * 64, scr, lane); continue; } r -= I0;
                if (r < I1) { const int g = r % 32; transpose_item(A->in[15], 1024, 1024, src_col(1, g), W_AOUT, g, (r / 32) * 64, scr, lane); continue; } r -= I1;
                if (r < I2) { const int g = r % 56; transpose_item(A->in[16], 1024, 1696, src_col(2, g), W_BIN, g, (r / 56) * 64, scr, lane); continue; } r -= I2;
                if (r < I3) { const int g = r % 48; transpose_item(A->in[18], 384, 1536, src_col(3, g), W_UQ, g, (r / 48) * 64, scr, lane); continue; } r -= I3;
                if (r < I4) { const int g = r % 64; transpose_item(A->in[20], 256, 2048, src_col(4, g), W_UKV, g, (r / 64) * 64, scr, lane); continue; } r -= I4;
                { const int g = r % 32; transpose_item(A->in[25], 1024, 1024, src_col(5, g), W_BOUT, g, (r / 32) * 64, scr, lane); }
            }
        }
        for (int it = bid; it < 2 * 48; it += G) {
            const int l = it / 48, jb = it % 48;
            LAS float* sl = (LAS float*)(lds + wave * 10240);
            float acc[40];
#pragma unroll
            for (int b = 0; b < 40; ++b) acc[b] = 0.f;
            for (int pass = 0; pass < 2; ++pass) {
                const int k0 = (wave + 8 * pass) * 64;
                for (int e = lane; e < 40 * 64; e += 64) { const int bb = e >> 6, k = e & 63; const float c = bb < NBP ? A->in[6][(size_t)bb * 1024 + k0 + k] : A->in[7][(size_t)(bb - NBP) * 1024 + k0 + k]; sl[e] = c / (1.f + __expf(-c)); }
                asm volatile("s_waitcnt lgkmcnt(0)" ::: "memory");
                const float* W = A->in[9] + (size_t)l * 1024 * 3072 + (size_t)k0 * 3072 + jb * 64 + lane;
                for (int k = 0; k < 64; k += 4) {
                    const float w0 = W[(size_t)k * 3072], w1 = W[(size_t)(k + 1) * 3072], w2 = W[(size_t)(k + 2) * 3072], w3 = W[(size_t)(k + 3) * 3072];
#pragma unroll
                    for (int b = 0; b < 40; ++b) { const f32x4 sv = *(const LAS f32x4*)(sl + b * 64 + k); acc[b] += (sv[0] * w0 + sv[1] * w1) + (sv[2] * w2 + sv[3] * w3); }
                }
                asm volatile("s_waitcnt lgkmcnt(0)" ::: "memory");
            }
            __syncthreads();
            LAS float* red = (LAS float*)lds;
#pragma unroll
            for (int b = 0; b < 40; ++b) red[(wave * 40 + b) * 64 + lane] = acc[b];
            __syncthreads();
            for (int e = tid; e < 40 * 64; e += 512) { const int b = e >> 6, j = e & 63; float sum = A->in[10][(size_t)l * 3072 + jb * 64 + j];
#pragma unroll
                for (int w = 0; w < 8; ++w) sum += red[(w * 40 + b) * 64 + j];
                mod[((size_t)l * 40 + b) * 3072 + jb * 64 + j] = sum; }
            __syncthreads();
        }
        for (int i = gt; i < NBS * SA_STRIDE * 128; i += NGT) {
            const int c8 = i & 127, rr = (i >> 7) % SA_STRIDE, bs = (i >> 7) / SA_STRIDE;
            const size_t d = ((size_t)MP + (size_t)bs * SA_STRIDE + rr) * 1024 + c8 * 8;
            if (rr < 512) { const size_t s = ((size_t)bs * 512 + rr) * 1024 + c8 * 8; cvt8(A->in[2] + s, KA + d); cvt8(A->in[3] + s, VA + d); }
            else if (rr >= 544) { *(v4u*)(KA + d) = (v4u){0, 0, 0, 0}; *(v4u*)(VA + d) = (v4u){0, 0, 0, 0}; }
        }
        for (int i = gt; i < NBS * SB_STRIDE * 32; i += NGT) {
            const int c8 = i & 31, rr = (i >> 5) % SB_STRIDE, bs = (i >> 5) / SB_STRIDE;
            const size_t d = ((size_t)MP + (size_t)bs * SB_STRIDE + rr) * 256 + c8 * 8;
            if (rr < 2048) cvt8(A->in[4] + ((size_t)bs * 2048 + rr) * 256 + c8 * 8, CKV + d);
            else if (rr >= 2080) *(v4u*)(CKV + d) = (v4u){0, 0, 0, 0};
        }
        for (int i = gt; i < NBS * SB_STRIDE * 4; i += NGT) {
            const int c8 = i & 3, rr = (i >> 2) % SB_STRIDE, bs = (i >> 2) / SB_STRIDE;
            const size_t d = ((size_t)MP + (size_t)bs * SB_STRIDE + rr) * 32 + c8 * 8;
            if (rr < 2048) cvt8(A->in[5] + ((size_t)bs * 2048 + rr) * 32 + c8 * 8, KR + d);
            else if (rr >= 2080) *(v4u*)(KR + d) = (v4u){0, 0, 0, 0};
        }
        for (int i = gt; i < 2112 * 16; i += NGT) {
            const int pos = i >> 4, k = i & 15;
            const float inv = exp2f(-(float)k * (13.287712379549449f / 16.f));
            const float ang = (float)pos * inv;
            const double tr = (double)ang * 0.15915494309189535;
            const float fr = (float)(tr - floor(tr + 0.5));
            CS[pos * 32 + k] = __builtin_amdgcn_cosf(fr); CS[pos * 32 + 16 + k] = __builtin_amdgcn_sinf(fr);
        }
    }
    SEAM(0);
    if (IN(1)) { PHASE_ARGS(); adanorm_rows(A->in[0], A->in[1], A->in[8], WSP(float, WS_MOD), WSP(bf16, WS_H), gw, NGW, lane); }
    SEAM(1);
    if (IN(2)) {
        PHASE_ARGS();
        int Kop = 1024; asm volatile("" : "+s"(Kop)); pg8::Gemm g{WSP(bf16, WS_H), WSP(bf16, WS_W_AIN), M1, 4096, Kop}; pg8::StaticOrder S; S.init(M1, 4096, G, bid);
        pg8::EpiAin E{WSP(bf16, WS_QA), WSP(bf16, WS_KA), WSP(bf16, WS_VA), WSP(bf16, WS_ZA), A->in[12], A->in[13], out + O_AKP, out + O_AVP, out + O_AKS, out + O_AVS};
        pg8::gemm_phase<pg8::EpiAin, pg8::StaticOrder, true, true>(lds, g, S, E);
    }
    SEAM(2);
    if (IN(3)) {
        PHASE_ARGS();
        bf16 *QA = WSP(bf16, WS_QA), *KA = WSP(bf16, WS_KA), *VA = WSP(bf16, WS_VA), *ZA = WSP(bf16, WS_ZA), *H = WSP(bf16, WS_H); const float* tblp = A->in[14];
        __syncthreads();
        for (int u = bid; u < 4096 + 32; u += G) {
            at::AttnUnit a;
            if (u < 4096) { const int hg = u & 3, b = (u >> 2) & 31, c = u >> 7, t0 = c > 8 ? c - 8 : 0;
                a.qrow0 = b * SEQ + 64 * c; a.nq = 64; a.krow0 = b * SEQ + 64 * t0; a.nt = c - t0 + 1; a.lastvalid = 64; a.hg = hg; a.D0 = 64 * (c - t0); }
            else { const int s = u - 4096, hg = s & 3, bs = s >> 2;
                a.qrow0 = MP + bs * TS; a.nq = 32; a.krow0 = MP + bs * SA_STRIDE; a.nt = 9; a.lastvalid = 32; a.hg = hg; a.D0 = 512; }
            at::attn_unit<false>(lds, a, QA, KA, nullptr, VA, ZA, H, tblp);
        }
    }
    SEAM(3);
    if (IN(4)) {
        PHASE_ARGS();
        int Kop = 1024; asm volatile("" : "+s"(Kop)); pg8::Gemm g{WSP(bf16, WS_H), WSP(bf16, WS_W_AOUT), M1, 1024, Kop}; pg8::StaticOrder S; S.init(M1, 1024, G, bid);
        pg8::EpiRes E{A->in[0], A->in[1], out + O_YP, out + O_YS, WSP(float, WS_MOD) + 2048};
        pg8::gemm_phase<pg8::EpiRes, pg8::StaticOrder, true, true>(lds, g, S, E);
    }
    SEAM(4);
    if (IN(5)) { PHASE_ARGS(); adanorm_rows(out + O_YP, out + O_YS, A->in[8] + 1024, WSP(float, WS_MOD) + 40 * 3072, WSP(bf16, WS_H), gw, NGW, lane); }
    SEAM(5);
    if (IN(6)) {
        PHASE_ARGS();
        int Kop = 1024; asm volatile("" : "+s"(Kop)); pg8::Gemm g{WSP(bf16, WS_H), WSP(bf16, WS_W_BIN), M1, 1792, Kop}; pg8::StaticOrder S; S.init(M1, 1792, G, bid);
        pg8::EpiBin E{WSP(bf16, WS_ZB), WSP(float, WS_RAW)};
        pg8::gemm_phase<pg8::EpiBin, pg8::StaticOrder, true, true>(lds, g, S, E);
    }
    SEAM(6);
    if (IN(7)) {
        PHASE_ARGS();
        const float* RAW = WSP(float, WS_RAW); const float* CS = WSP(float, WS_CS); bf16 *CQ = WSP(bf16, WS_CQ), *CKV = WSP(bf16, WS_CKV), *KR = WSP(bf16, WS_KR);
        const float *gcq = A->in[17], *gckv = A->in[19], *gkr = A->in[24];
        for (int row = gw; row < M1; row += NGW) {
            const float* rw = RAW + (size_t)row * 768;
            int pos; size_t drow, orow;
            if (row < MP) { pos = row & (SEQ - 1); drow = (size_t)row; orow = (size_t)row; }
            else { const int rs = row - MP; pos = SEQ + (rs & 31); drow = (size_t)MP + (size_t)(rs >> 5) * SB_STRIDE + 2048 + (rs & 31); orow = (size_t)rs; }
            float* ockv = (row < MP ? out + O_CKVP : out + O_CKVS) + orow * 256;
            float* okr = (row < MP ? out + O_KRP : out + O_KRS) + orow * 32;
            float q[6]; float s = 0.f;
#pragma unroll
            for (int j = 0; j < 6; ++j) { q[j] = rw[lane + 64 * j]; s += q[j] * q[j]; }
            float r = rsqrtf(wave_sum(s) * (1.f / 384.f) + EPSN);
#pragma unroll
            for (int j = 0; j < 6; ++j) { const float v = q[j] * r * gcq[lane + 64 * j]; const unsigned b = pk2(v, 0.f); CQ[(size_t)row * 384 + lane + 64 * j] = (bf16)(b & 0xffffu); }
            const f32x4 kv = *(const f32x4*)(rw + 384 + 4 * lane);
            r = rsqrtf(wave_sum(pg8::ssq4(kv)) * (1.f / 256.f) + EPSN);
            const f32x4 kvn = kv * r * *(const f32x4*)(gckv + 4 * lane);
            *(f32x4*)(ockv + 4 * lane) = kvn;
            { v2u o; o.x = pk2(kvn[0], kvn[1]); o.y = pk2(kvn[2], kvn[3]); *(v2u*)(CKV + drow * 256 + 4 * lane) = o; }
            const float kr = lane < 32 ? rw[640 + lane] : 0.f;
            r = rsqrtf(wave_sum(kr * kr) * (1.f / 32.f) + EPSN);
            const float kn = kr * r * (lane < 32 ? gkr[lane] : 0.f);
            const float pr = __shfl_xor(kn, 16);
            const float cs = CS[pos * 32 + (lane & 15)], sn = CS[pos * 32 + 16 + (lane & 15)];
            const float ro = (lane & 16) ? (kn * cs + pr * sn) : (kn * cs - pr * sn);
            if (lane < 32) { okr[lane] = ro; const unsigned b = pk2(ro, 0.f); KR[drow * 32 + lane] = (bf16)(b & 0xffffu); }
        }
    }
    SEAM(7);
    if (IN(8)) {
        { PHASE_ARGS(); int Kop = 384; asm volatile("" : "+s"(Kop)); pg8::Gemm g{WSP(bf16, WS_CQ), WSP(bf16, WS_W_UQ), M1, 1536, Kop}; pg8::StaticOrder S; S.init(M1, 1536, G, bid);
          pg8::EpiUq E{WSP(bf16, WS_QB), A->in[21], A->in[22], WSP(float, WS_CS)};
          pg8::gemm_phase<pg8::EpiUq, pg8::StaticOrder, true, true>(lds, g, S, E); }
        __syncthreads();
        { PHASE_ARGS(); int Kop = 256; asm volatile("" : "+s"(Kop)); pg8::Gemm g{WSP(bf16, WS_CKV), WSP(bf16, WS_W_UKV), R2, 2048, Kop}; pg8::StaticOrder S; S.init(R2, 2048, G, bid);
          pg8::EpiUkv E{WSP(bf16, WS_KN), WSP(bf16, WS_VB), A->in[23]};
          pg8::gemm_phase<pg8::EpiUkv, pg8::StaticOrder, true, true>(lds, g, S, E); }
    }
    SEAM(8);
    if (IN(9)) {
        PHASE_ARGS();
        bf16 *QB = WSP(bf16, WS_QB), *KN = WSP(bf16, WS_KN), *KR = WSP(bf16, WS_KR), *VB = WSP(bf16, WS_VB), *ZB = WSP(bf16, WS_ZB), *H = WSP(bf16, WS_H);
        __syncthreads();
        for (int u = bid; u < 4096; u += G) {
            at::AttnUnit a; const int hg = u & 3, b = (u >> 2) & 31, c = 31 - (u >> 7);
            a.qrow0 = b * SEQ + 64 * c; a.nq = 64; a.krow0 = b * SEQ; a.nt = c + 1; a.lastvalid = 64; a.hg = hg; a.D0 = 0;
            at::attn_unit<true>(lds, a, QB, KN, KR, VB, ZB, H, nullptr);
        }
        for (int s = (bid + G - (128 % G)) % G; s < 32; s += G) {
            at::AttnUnit a; const int hg = s & 3, bs = s >> 2;
            a.qrow0 = MP + bs * TS; a.nq = 32; a.krow0 = MP + bs * SB_STRIDE; a.nt = 33; a.lastvalid = 32; a.hg = hg; a.D0 = 0;
            at::attn_unit<true>(lds, a, QB, KN, KR, VB, ZB, H, nullptr);
        }
    }
    SEAM(9);
    if (IN(10)) {
        PHASE_ARGS();
        int Kop = 1024; asm volatile("" : "+s"(Kop)); pg8::Gemm g{WSP(bf16, WS_H), WSP(bf16, WS_W_BOUT), M1, 1024, Kop}; pg8::StaticOrder S; S.init(M1, 1024, G, bid);
        pg8::EpiRes E{out + O_YP, out + O_YS, out + O_YP, out + O_YS, WSP(float, WS_MOD) + 40 * 3072 + 2048};
        pg8::gemm_phase<pg8::EpiRes, pg8::StaticOrder, true, true>(lds, g, S, E);
    }
#undef IN
#undef SEAM
}

constexpr int N_PHASES = 11;
extern "C" void kernel_launch(void* const* d_in, const int* in_sizes, int n_in, void* d_out, int out_size, void* d_ws, size_t ws_size, hipStream_t stream) {
    static int grid = 0;
    if (grid == 0) {
        if (n_in != 26 || ws_size < WS_END) { fprintf(stderr, "kernel_launch: unexpected inputs (n_in %d, ws %zu, need %zu)\n", n_in, ws_size, (size_t)WS_END); grid = -1; return; }
        int dev = 0, cus = 0, per_cu = 0;
        hipGetDevice(&dev); hipDeviceGetAttribute(&cus, hipDeviceAttributeMultiprocessorCount, dev);
        hipFuncSetAttribute((const void*)hybrid_fwd, hipFuncAttributeMaxDynamicSharedMemorySize, LDS_TOTAL);
        hipOccupancyMaxActiveBlocksPerMultiprocessor(&per_cu, (const void*)hybrid_fwd, 512, LDS_TOTAL);
        if (per_cu < 1) { fprintf(stderr, "kernel_launch: occupancy query says %d blocks per CU\n", per_cu); per_cu = 1; }
        (void)hipGetLastError();
        grid = cus * per_cu;
    }
    if (grid < 0) return;
    Args a{};
    for (int i = 0; i < 26; ++i) a.in[i] = (const float*)d_in[i];
    a.out = (float*)d_out; a.ws = (unsigned char*)d_ws;
#if MULTI_LAUNCH
    for (int p = 0; p < N_PHASES; ++p) { a.ph_lo = p; a.ph_hi = p + 1; hipLaunchKernelGGL(hybrid_fwd, dim3(grid), dim3(512), LDS_TOTAL, stream, a); }
#else
    a.ph_lo = 0; a.ph_hi = N_PHASES;
    void* kargs[] = {&a};
    hipError_t e = hipLaunchCooperativeKernel((const void*)hybrid_fwd, dim3(grid), dim3(512), kargs, LDS_TOTAL, stream);
    if (e != hipSuccess) fprintf(stderr, "cooperative launch failed: %s (grid %d)\n", hipGetErrorString(e), grid);
#endif
}
```

```cpp
#include <hip/hip_runtime.h>
#include <hip/hip_cooperative_groups.h>
#include <cstdio>
#include <cstdint>
namespace cg = cooperative_groups;
#ifndef MULTI_LAUNCH
#define MULTI_LAUNCH 0
#endif
constexpr int DMODEL = 1024, NBP = 32, SEQ = 2048, NBS = 8, TS = 32;
constexpr int MP = NBP * SEQ;
constexpr int M1 = MP + NBS * TS;
constexpr int SA_STRIDE = 576;
constexpr int RA = MP + NBS * SA_STRIDE;
constexpr int SB_STRIDE = 2112;
constexpr int R2 = MP + NBS * SB_STRIDE;
constexpr float EPSN = 1e-6f;
constexpr float LOG2E = 1.4426950408889634f;
constexpr float QSCALE_A = 0.125f * LOG2E;
constexpr float QSCALE_B = 0.10206207261596575f * LOG2E;
namespace pg8 {
#define PG8_LAS __attribute__((address_space(3)))
typedef unsigned short bf16_t;
typedef short bf16x8 __attribute__((ext_vector_type(8)));
typedef float f32x4 __attribute__((ext_vector_type(4)));
typedef unsigned u32x4 __attribute__((ext_vector_type(4)));
constexpr int BM = 256, BK = 64, HALF = 128, HTB = HALF * BK * 2  , STAGE_BYTES = 8 * HTB, NXCD = 8, WGM = 8;

__host__ __device__ __forceinline__ int lds_byte(int r, int c) { const int st = (r >> 4) * 2 + (c >> 5), rr = r & 15, cc = c & 31, ob = rr * 64 + cc * 2; return st * 1024 + (ob ^ (((ob >> 9) & 1) << 5)); }
__host__ __device__ __forceinline__ void stage_rc(int b, int& R, int& C) { const int st = b / 1024, sb = b % 1024, swz = sb ^ (((sb >> 9) & 1) << 5); R = (st >> 1) * 16 + swz / 64; C = (st & 1) * 32 + (swz % 64) / 2; }
__host__ __device__ __forceinline__ int perm32(int rho) { const int n = rho >> 4, i = rho & 15; return 8 * (i >> 2) + 4 * n + (i & 3); }

struct Unit { int pm, pn; };
struct Gemm { const bf16_t* A; const bf16_t* Bt; int M, N, K; };

struct StaticOrder {
    int nM, nN, nwg, G, c;
    __host__ __device__ void init(int M, int N, int G_, int c_) { nM = M / BM; nN = N / BM; nwg = nM * nN; G = G_; c = c_; }
    __host__ __device__ bool next(int i, Unit& u) const {
        const long L = (long)i * G + c; if (L >= nwg) return false;
        int wgid = (int)L; { const int q = nwg / NXCD, r = nwg % NXCD, xcd = wgid % NXCD, off = wgid / NXCD; wgid = (xcd < r ? xcd * (q + 1) : r * (q + 1) + (xcd - r) * q) + off; }
        const int nig = WGM * nN, gid = wgid / nig, fm = gid * WGM, gsz = (nM - fm) < WGM ? (nM - fm) : WGM;
        u.pm = fm + ((wgid % nig) % gsz); u.pn = (wgid % nig) / gsz; return true;
    }
    __device__ __forceinline__ void a_ready(const Unit&) const {}
    __device__ __forceinline__ void done(const Unit&) const {}
};

__device__ __forceinline__ unsigned cvt_pk_bf16(float lo, float hi) { unsigned r; asm volatile("v_cvt_pk_bf16_f32 %0, %1, %2" : "=v"(r) : "v"(lo), "v"(hi)); return r; }
template <class Epi, class Sched, bool ALIGN_EPI = false, bool SP2 = false>
__device__ __forceinline__ void gemm_phase(PG8_LAS unsigned char* lds, const Gemm g, const Sched& S, const Epi& E) {
    const int tid = threadIdx.x, wid = __builtin_amdgcn_readfirstlane(tid >> 6), lane = tid & 63, wr = wid >> 2, wc = wid & 3, fr = lane & 15, fq = lane >> 4;
    const int K = g.K, nt = K / BK;
    unsigned voffA[2], voffB[2];
#pragma unroll
    for (int i = 0; i < 2; ++i) { int R, C; stage_rc(tid * 16 + i * 8192, R, C); const int Rb = Epi::PERM ? ((R & ~31) + perm32(R & 31)) : R;
        voffA[i] = (unsigned)(R * K + C) * 2u; voffB[i] = (unsigned)(Rb * K + C) * 2u; }
    const size_t kstep = (size_t)(BK * 2);
    const size_t hstep = (size_t)HALF * K * 2;
    const size_t tstep = 2 * hstep;
    const unsigned ldsw = (unsigned)wid * 1024u;
    const int aoff = lds_byte(wr * 64 + fr, fq * 8), boff = lds_byte(wc * 32 + fr, fq * 8);
#define PG8_SA(b, h) (((b) * 2 + (h)) * HTB)
#define PG8_SB(b, h) ((4 + (b) * 2 + (h)) * HTB)
#define PG8_STAGE(bufoff, gbase, voff) do { _Pragma("unroll") for (int _i = 0; _i < 2; ++_i) \
        __builtin_amdgcn_global_load_lds((const unsigned*)((const char*)(gbase) + (voff)[_i]), (PG8_LAS unsigned*)(lds + (bufoff) + ldsw + _i * 8192), 16, 0, 0); } while (0)
#define PG8_LDA(dst, b, h) do { _Pragma("unroll") for (int m = 0; m < 4; ++m) _Pragma("unroll") for (int k = 0; k < 2; ++k) dst[m][k] = *(const PG8_LAS bf16x8*)(lds + PG8_SA(b, h) + aoff + m * 2048 + k * 1024); } while (0)
#define PG8_LDB(dst, b, h) do { _Pragma("unroll") for (int n = 0; n < 2; ++n) _Pragma("unroll") for (int k = 0; k < 2; ++k) dst[n][k] = *(const PG8_LAS bf16x8*)(lds + PG8_SB(b, h) + boff + n * 2048 + k * 1024); } while (0)
#define PG8_MMA(ai, bj, At, Bt) do { __builtin_amdgcn_s_setprio(1); _Pragma("unroll") for (int m = 0; m < 4; ++m) _Pragma("unroll") for (int n = 0; n < 2; ++n) _Pragma("unroll") for (int k = 0; k < 2; ++k) \
        acc[ai][bj][m][n] = __builtin_amdgcn_mfma_f32_16x16x32_bf16(Bt[n][k], At[m][k], acc[ai][bj][m][n], 0, 0, 0); __builtin_amdgcn_s_setprio(0); } while (0)
#define PG8_WAIT_V(n) asm volatile("s_waitcnt vmcnt(" #n ")" ::: "memory")
#define PG8_WAIT_L(n) asm volatile("s_waitcnt lgkmcnt(" #n ")" ::: "memory")
#define PG8_BAR __builtin_amdgcn_s_barrier()
#define PG8_SCHED __builtin_amdgcn_sched_barrier(0)
    Unit cur, nxt; int ui = 0;
    if (!S.next(0, cur)) return;
    f32x4 acc[2][2][4][2];
#pragma unroll
    for (int a = 0; a < 2; ++a)
#pragma unroll
        for (int b = 0; b < 2; ++b)
#pragma unroll
            for (int m = 0; m < 4; ++m)
#pragma unroll
                for (int n = 0; n < 2; ++n) acc[a][b][m][n] = (f32x4){0.f, 0.f, 0.f, 0.f};
    bf16x8 At[4][2], B0[2][2], B1[2][2];
    const char* cA = (const char*)g.A + (size_t)cur.pm * tstep; const char* cB = (const char*)g.Bt + (size_t)cur.pn * tstep;
    S.a_ready(cur);
    if constexpr (SP2) {
        PG8_STAGE(PG8_SB(0, 0), cB, voffB); PG8_STAGE(PG8_SB(0, 1), cB + hstep, voffB); PG8_STAGE(PG8_SA(0, 0), cA, voffA); PG8_STAGE(PG8_SA(0, 1), cA + hstep, voffA);
        if (wr == 1) PG8_BAR;
        PG8_WAIT_V(2); PG8_BAR;
        PG8_STAGE(PG8_SB(1, 0), cB + kstep, voffB); PG8_STAGE(PG8_SA(1, 0), cA + kstep, voffA); PG8_STAGE(PG8_SB(1, 1), cB + hstep + kstep, voffB);
        PG8_WAIT_V(6); PG8_BAR;
    } else {
        PG8_STAGE(PG8_SB(0, 0), cB, voffB); PG8_STAGE(PG8_SA(0, 0), cA, voffA); PG8_STAGE(PG8_SB(0, 1), cB + hstep, voffB); PG8_STAGE(PG8_SA(0, 1), cA + hstep, voffA);
        if (wr == 1) PG8_BAR;
        PG8_WAIT_V(4); PG8_BAR;
        PG8_STAGE(PG8_SB(1, 0), cB + kstep, voffB); PG8_STAGE(PG8_SA(1, 0), cA + kstep, voffA); PG8_STAGE(PG8_SB(1, 1), cB + hstep + kstep, voffB);
        PG8_WAIT_V(6); PG8_BAR;
    }
    for (;;) {
        const bool has_next = S.next(ui + 1, nxt);
        const char* nA = has_next ? (const char*)g.A + (size_t)nxt.pm * tstep : cA; const char* nB = has_next ? (const char*)g.Bt + (size_t)nxt.pn * tstep : cB;
        for (int t = 0; t < nt; t += 2) {
            const bool last = (t == nt - 2);
            const char* a1 = cA + (size_t)(t + 1) * kstep;
            const char* a2 = last ? nA : cA + (size_t)(t + 2) * kstep; const char* b2 = last ? nB : cB + (size_t)(t + 2) * kstep;
            const char* a3 = a2 + kstep; const char* b3 = b2 + kstep;
            if (last && has_next) S.a_ready(nxt);
            if constexpr (SP2) {
            PG8_LDB(B0, 0, 0); PG8_LDB(B1, 0, 1); PG8_SCHED; PG8_LDA(At, 0, 0); PG8_STAGE(PG8_SA(1, 1), a1 + hstep, voffA);
            PG8_WAIT_V(8); PG8_WAIT_L(0); PG8_BAR; PG8_MMA(0, 0, At, B0); PG8_MMA(0, 1, At, B1); PG8_BAR; PG8_SCHED;
            PG8_LDA(At, 0, 1); PG8_STAGE(PG8_SB(0, 0), b2, voffB); PG8_STAGE(PG8_SB(0, 1), b2 + hstep, voffB); PG8_STAGE(PG8_SA(0, 0), a2, voffA);
            PG8_WAIT_V(8); PG8_WAIT_L(0); PG8_BAR; PG8_MMA(1, 0, At, B0); PG8_MMA(1, 1, At, B1); PG8_BAR; PG8_SCHED;
            PG8_LDB(B0, 1, 0); PG8_LDB(B1, 1, 1); PG8_SCHED; PG8_LDA(At, 1, 0); PG8_STAGE(PG8_SA(0, 1), a2 + hstep, voffA);
            PG8_WAIT_V(8); PG8_WAIT_L(0); PG8_BAR; PG8_MMA(0, 0, At, B0); PG8_MMA(0, 1, At, B1); PG8_BAR; PG8_SCHED;
            PG8_LDA(At, 1, 1); PG8_STAGE(PG8_SB(1, 0), b3, voffB); PG8_STAGE(PG8_SB(1, 1), b3 + hstep, voffB); PG8_STAGE(PG8_SA(1, 0), a3, voffA);
            PG8_WAIT_V(8); PG8_WAIT_L(0); PG8_BAR; PG8_MMA(1, 0, At, B0); PG8_MMA(1, 1, At, B1); PG8_BAR; PG8_SCHED;
            } else {
            PG8_LDB(B0, 0, 0); PG8_SCHED; PG8_LDA(At, 0, 0); PG8_STAGE(PG8_SA(1, 1), a1 + hstep, voffA);
            PG8_WAIT_L(8); PG8_BAR; PG8_WAIT_L(0); PG8_MMA(0, 0, At, B0); PG8_BAR; PG8_SCHED;
            PG8_LDB(B1, 0, 1); PG8_STAGE(PG8_SB(0, 0), b2, voffB);
            PG8_BAR; PG8_WAIT_L(0); PG8_MMA(0, 1, At, B1); PG8_BAR;
            PG8_LDA(At, 0, 1); PG8_STAGE(PG8_SA(0, 0), a2, voffA);
            PG8_BAR; PG8_WAIT_L(0); PG8_MMA(1, 0, At, B0); PG8_BAR; PG8_SCHED;
            PG8_STAGE(PG8_SB(0, 1), b2 + hstep, voffB);
            PG8_WAIT_V(6); PG8_BAR; PG8_MMA(1, 1, At, B1); PG8_BAR;
            PG8_LDB(B0, 1, 0); PG8_SCHED; PG8_LDA(At, 1, 0); PG8_STAGE(PG8_SA(0, 1), a2 + hstep, voffA);
            PG8_WAIT_L(8); PG8_BAR; PG8_WAIT_L(0); PG8_MMA(0, 0, At, B0); PG8_BAR; PG8_SCHED;
            PG8_LDB(B1, 1, 1); PG8_STAGE(PG8_SB(1, 0), b3, voffB);
            PG8_BAR; PG8_WAIT_L(0); PG8_MMA(0, 1, At, B1); PG8_BAR;
            PG8_LDA(At, 1, 1); PG8_STAGE(PG8_SA(1, 0), a3, voffA);
            PG8_BAR; PG8_WAIT_L(0); PG8_MMA(1, 0, At, B0); PG8_BAR; PG8_SCHED;
            PG8_STAGE(PG8_SB(1, 1), b3 + hstep, voffB);
            PG8_WAIT_V(6); PG8_BAR; PG8_MMA(1, 1, At, B1); PG8_BAR;
            }
        }
        if constexpr (ALIGN_EPI) { if (wr == 0) PG8_BAR; }
        if constexpr (!Epi::AFTER_DRAIN) { E(acc, cur, wr, wc, fr, fq); S.done(cur); }
        if (!has_next) break;
#pragma unroll
        for (int a = 0; a < 2; ++a)
#pragma unroll
            for (int b = 0; b < 2; ++b)
#pragma unroll
                for (int m = 0; m < 4; ++m)
#pragma unroll
                    for (int n = 0; n < 2; ++n) acc[a][b][m][n] = (f32x4){0.f, 0.f, 0.f, 0.f};
        cur = nxt; cA = nA; cB = nB; ++ui;
        if constexpr (ALIGN_EPI) { if (wr == 1) PG8_BAR; }
    }
    PG8_WAIT_V(0);
    if constexpr (!ALIGN_EPI) { if (wr == 0) PG8_BAR; }
    PG8_BAR;
    if constexpr (Epi::AFTER_DRAIN) { E.fused(acc, cur, wr, wc, fr, fq, lds, wid, lane); S.done(cur); }
#undef PG8_SA
#undef PG8_SB
#undef PG8_STAGE
#undef PG8_LDA
#undef PG8_LDB
#undef PG8_MMA
#undef PG8_WAIT_V
#undef PG8_WAIT_L
#undef PG8_BAR
#undef PG8_SCHED
}
typedef unsigned u32x2 __attribute__((ext_vector_type(2)));
typedef float f32x2 __attribute__((ext_vector_type(2)));
typedef __bf16 bf16x2_t __attribute__((ext_vector_type(2)));
__device__ __forceinline__ unsigned pkbf(float lo, float hi) { f32x2 v = {lo, hi}; bf16x2_t b = __builtin_convertvector(v, bf16x2_t); return __builtin_bit_cast(unsigned, b); }
__device__ __forceinline__ u32x2 pk4(f32x4 v) { u32x2 r; r.x = pkbf(v[0], v[1]); r.y = pkbf(v[2], v[3]); return r; }
__device__ __forceinline__ float silu_f(float v) { return v * __builtin_amdgcn_rcpf(1.f + __expf(-v)); }
__device__ __forceinline__ f32x4 silu4(f32x4 v) { f32x4 o; o[0] = silu_f(v[0]); o[1] = silu_f(v[1]); o[2] = silu_f(v[2]); o[3] = silu_f(v[3]); return o; }
__device__ __forceinline__ float ssq4(f32x4 v) { return (v[0] * v[0] + v[1] * v[1]) + (v[2] * v[2] + v[3] * v[3]); }
__device__ __forceinline__ float red_fq(float s) { s += __shfl_xor(s, 16); s += __shfl_xor(s, 32); return s; }

struct EpiAin {
    static constexpr bool PERM = false, AFTER_DRAIN = false;
    bf16_t *Q, *K, *V, *Z; const float *gq, *gk; float *okp, *ovp, *oks, *ovs;
    __device__ __forceinline__ void operator()(const f32x4 (&acc)[2][2][4][2], const Unit& u, int wr, int wc, int fr, int fq) const {
        const int sec = u.pn >> 2, head = (u.pn & 3) * 4 + wc, cb = head * 64 + 4 * fq;
        f32x4 g[2][2];
#pragma unroll
        for (int bj = 0; bj < 2; ++bj)
#pragma unroll
            for (int n = 0; n < 2; ++n) g[bj][n] = (sec < 2) ? *(const f32x4*)((sec == 0 ? gq : gk) + 32 * bj + 16 * n + 4 * fq) : (f32x4){1.f, 1.f, 1.f, 1.f};
#pragma unroll
        for (int ai = 0; ai < 2; ++ai)
#pragma unroll
            for (int m = 0; m < 4; ++m) {
                const int row = u.pm * BM + ai * HALF + wr * 64 + m * 16 + fr;
                f32x4 v[2][2];
#pragma unroll
                for (int bj = 0; bj < 2; ++bj)
#pragma unroll
                    for (int n = 0; n < 2; ++n) v[bj][n] = acc[ai][bj][m][n];
                if (sec < 2) {
                    float s = (ssq4(v[0][0]) + ssq4(v[0][1])) + (ssq4(v[1][0]) + ssq4(v[1][1]));
                    s = red_fq(s);
                    const float r = rsqrtf(s * (1.f / 64.f) + EPSN) * (sec == 0 ? QSCALE_A : 1.f);
#pragma unroll
                    for (int bj = 0; bj < 2; ++bj)
#pragma unroll
                        for (int n = 0; n < 2; ++n) v[bj][n] = v[bj][n] * g[bj][n] * r;
                } else if (sec == 3) {
#pragma unroll
                    for (int bj = 0; bj < 2; ++bj)
#pragma unroll
                        for (int n = 0; n < 2; ++n) v[bj][n] = silu4(v[bj][n]);
                }
                if (sec == 0 || sec == 3) {
                    bf16_t* d = (sec == 0 ? Q : Z) + (size_t)row * 1024 + cb;
#pragma unroll
                    for (int bj = 0; bj < 2; ++bj)
#pragma unroll
                        for (int n = 0; n < 2; ++n) *(u32x2*)(d + 32 * bj + 16 * n) = pk4(v[bj][n]);
                } else {
                    size_t drow; float* of = nullptr;
                    if (row < MP) { drow = (size_t)row; const int pos = row & (SEQ - 1); if (pos >= SEQ - 512) of = (sec == 1 ? okp : ovp) + ((size_t)((row >> 11) * 512 + pos - (SEQ - 512))) * 1024; }
                    else { const int rs = row - MP; drow = (size_t)MP + (size_t)(rs >> 5) * SA_STRIDE + 512 + (rs & 31); of = (sec == 1 ? oks : ovs) + (size_t)rs * 1024; }
                    bf16_t* d = (sec == 1 ? K : V) + drow * 1024 + cb;
#pragma unroll
                    for (int bj = 0; bj < 2; ++bj)
#pragma unroll
                        for (int n = 0; n < 2; ++n) { *(u32x2*)(d + 32 * bj + 16 * n) = pk4(v[bj][n]); if (of) *(f32x4*)(of + cb + 32 * bj + 16 * n) = v[bj][n]; }
                }
                asm volatile("" ::: "memory");
            }
    }
};
struct EpiRes {
    static constexpr bool PERM = false, AFTER_DRAIN = false;
    const float *xp, *xs; float *yp, *ys; const float* gate;
    __device__ __forceinline__ void operator()(const f32x4 (&acc)[2][2][4][2], const Unit& u, int wr, int wc, int fr, int fq) const {
        const int cb = u.pn * 256 + wc * 64 + 4 * fq;
#pragma unroll
        for (int ai = 0; ai < 2; ++ai)
#pragma unroll
            for (int m = 0; m < 4; ++m) {
                const int row = u.pm * BM + ai * HALF + wr * 64 + m * 16 + fr;
                const float* xi; float* yo; int bb;
                if (row < MP) { xi = xp + (size_t)row * 1024; yo = yp + (size_t)row * 1024; bb = row >> 11; }
                else { const int rs = row - MP; xi = xs + (size_t)rs * 1024; yo = ys + (size_t)rs * 1024; bb = NBP + (rs >> 5); }
                const float* gp = gate + (size_t)bb * 3072;
#pragma unroll
                for (int bj = 0; bj < 2; ++bj)
#pragma unroll
                    for (int n = 0; n < 2; ++n) { const int c = cb + 32 * bj + 16 * n; const f32x4 o = *(const f32x4*)(xi + c) + *(const f32x4*)(gp + c) * acc[ai][bj][m][n]; *(f32x4*)(yo + c) = o; }
                asm volatile("" ::: "memory");
            }
    }
};
struct EpiBin {
    static constexpr bool PERM = false, AFTER_DRAIN = false;
    bf16_t* Z; float* RAW;
    __device__ __forceinline__ void operator()(const f32x4 (&acc)[2][2][4][2], const Unit& u, int wr, int wc, int fr, int fq) const {
        const int cb = u.pn * 256 + wc * 64 + 4 * fq;
#pragma unroll
        for (int ai = 0; ai < 2; ++ai)
#pragma unroll
            for (int m = 0; m < 4; ++m) {
                const int row = u.pm * BM + ai * HALF + wr * 64 + m * 16 + fr;
#pragma unroll
                for (int bj = 0; bj < 2; ++bj)
#pragma unroll
                    for (int n = 0; n < 2; ++n) { const int c = cb + 32 * bj + 16 * n;
                        if (u.pn < 4) *(u32x2*)(Z + (size_t)row * 1024 + c) = pk4(silu4(acc[ai][bj][m][n]));
                        else *(f32x4*)(RAW + (size_t)row * 768 + (c - 1024)) = acc[ai][bj][m][n]; }
            }
    }
};
struct EpiUq {
    static constexpr bool PERM = false, AFTER_DRAIN = false;
    bf16_t* Q; const float *gqn, *gqr, *CS;
    __device__ __forceinline__ void operator()(const f32x4 (&acc)[2][2][4][2], const Unit& u, int wr, int wc, int fr, int fq) const {
        if (u.pn < 4) {
            const int head = u.pn * 4 + wc;
#pragma unroll
            for (int ai = 0; ai < 2; ++ai)
#pragma unroll
                for (int m = 0; m < 4; ++m) {
                    const int row = u.pm * BM + ai * HALF + wr * 64 + m * 16 + fr;
                    float s = (ssq4(acc[ai][0][m][0]) + ssq4(acc[ai][0][m][1])) + (ssq4(acc[ai][1][m][0]) + ssq4(acc[ai][1][m][1]));
                    s = red_fq(s);
                    const float r = rsqrtf(s * (1.f / 64.f) + EPSN) * QSCALE_B;
                    bf16_t* d = Q + (size_t)row * 1536 + head * 96 + 4 * fq;
#pragma unroll
                    for (int bj = 0; bj < 2; ++bj)
#pragma unroll
                        for (int n = 0; n < 2; ++n) *(u32x2*)(d + 32 * bj + 16 * n) = pk4(acc[ai][bj][m][n] * *(const f32x4*)(gqn + 32 * bj + 16 * n + 4 * fq) * r);
                    asm volatile("" ::: "memory");
                }
        } else {
#pragma unroll
            for (int ai = 0; ai < 2; ++ai)
#pragma unroll
                for (int m = 0; m < 4; ++m) {
                    const int row = u.pm * BM + ai * HALF + wr * 64 + m * 16 + fr;
                    const int pos = row < MP ? (row & (SEQ - 1)) : SEQ + ((row - MP) & 31);
#pragma unroll
                    for (int bj = 0; bj < 2; ++bj) {
                        const int hr = (u.pn - 4) * 8 + wc * 2 + bj;
                        float s = ssq4(acc[ai][bj][m][0]) + ssq4(acc[ai][bj][m][1]);
                        s = red_fq(s);
                        const float r = rsqrtf(s * (1.f / 32.f) + EPSN);
                        const f32x4 x1 = acc[ai][bj][m][0] * *(const f32x4*)(gqr + 4 * fq) * r, x2 = acc[ai][bj][m][1] * *(const f32x4*)(gqr + 16 + 4 * fq) * r;
                        const f32x4 cs = *(const f32x4*)(CS + pos * 32 + 4 * fq), sn = *(const f32x4*)(CS + pos * 32 + 16 + 4 * fq);
                        bf16_t* d = Q + (size_t)row * 1536 + hr * 96 + 64 + 4 * fq;
                        *(u32x2*)d = pk4((x1 * cs - x2 * sn) * QSCALE_B); *(u32x2*)(d + 16) = pk4((x2 * cs + x1 * sn) * QSCALE_B);
                        asm volatile("" ::: "memory");
                    }
                }
        }
    }
};
struct EpiUkv {
    static constexpr bool PERM = false, AFTER_DRAIN = false;
    bf16_t *KN, *VB; const float* gkn;
    __device__ __forceinline__ void operator()(const f32x4 (&acc)[2][2][4][2], const Unit& u, int wr, int wc, int fr, int fq) const {
        const bool isk = u.pn < 4; const int head = (u.pn & 3) * 4 + wc;
#pragma unroll
        for (int ai = 0; ai < 2; ++ai)
#pragma unroll
            for (int m = 0; m < 4; ++m) {
                const int row = u.pm * BM + ai * HALF + wr * 64 + m * 16 + fr;
                float r = 1.f;
                if (isk) { float s = (ssq4(acc[ai][0][m][0]) + ssq4(acc[ai][0][m][1])) + (ssq4(acc[ai][1][m][0]) + ssq4(acc[ai][1][m][1])); s = red_fq(s); r = rsqrtf(s * (1.f / 64.f) + EPSN); }
                bf16_t* d = (isk ? KN : VB) + (size_t)row * 1024 + head * 64 + 4 * fq;
#pragma unroll
                for (int bj = 0; bj < 2; ++bj)
#pragma unroll
                    for (int n = 0; n < 2; ++n) { const f32x4 gg = isk ? *(const f32x4*)(gkn + 32 * bj + 16 * n + 4 * fq) : (f32x4){1.f, 1.f, 1.f, 1.f}; *(u32x2*)(d + 32 * bj + 16 * n) = pk4(acc[ai][bj][m][n] * gg * r); }
                asm volatile("" ::: "memory");
            }
    }
};
}
namespace at {
#define ALAS __attribute__((address_space(3)))
typedef unsigned short bf16_t;
typedef short bf16x8 __attribute__((ext_vector_type(8)));
typedef short s16x4 __attribute__((ext_vector_type(4)));
typedef float f32x16 __attribute__((ext_vector_type(16)));
typedef float f32x4 __attribute__((ext_vector_type(4)));
typedef unsigned u32x4 __attribute__((ext_vector_type(4)));
typedef unsigned u32x2 __attribute__((ext_vector_type(2)));
constexpr int KROW = 144, KHEAD = 64 * KROW, VROW = 136, VHEAD = 64 * VROW + 8, RROW = 80;
constexpr int KBUF = 4 * KHEAD, VBUF = 4 * VHEAD, RBUF = 64 * RROW, STAGE = KBUF + VBUF + RBUF;
constexpr int TBL_OFF = KBUF + VBUF, LDS_BYTES = 2 * STAGE;
static_assert(4 * 257 * 4 <= RBUF, "bias table");
struct AttnUnit { int qrow0, nq, krow0, nt, lastvalid, hg, D0; };
__device__ __forceinline__ int crow(int r, int hi) { return (r & 3) + 8 * (r >> 2) + 4 * hi; }

template <bool MLA>
__device__ __forceinline__ void attn_unit(ALAS unsigned char* lds, const AttnUnit u, const bf16_t* __restrict__ Q, const bf16_t* __restrict__ Kn, const bf16_t* __restrict__ Kr,
                                          const bf16_t* __restrict__ V, const bf16_t* __restrict__ Z, bf16_t* __restrict__ U, const float* __restrict__ tbl) {
    const int tid = threadIdx.x, lane = tid & 63, wid = __builtin_amdgcn_readfirstlane(tid >> 6), l32 = lane & 31, hi = lane >> 5;
    const int hl = wid >> 1, qh = wid & 1, head = u.hg * 4 + hl;
    const bool active = qh * 32 < u.nq;
    constexpr int QS = MLA ? 1536 : 1024, HS = MLA ? 96 : 64, ND0 = MLA ? 6 : 4;
    ALAS float* tb = (ALAS float*)(lds + TBL_OFF);
    if (!MLA) { for (int i = tid; i < 4 * 257; i += 512) tb[i] = tbl[(size_t)(u.hg * 4) * 257 + i] * LOG2E; }
    const int qrow = u.qrow0 + (active ? qh * 32 : 0) + l32;
    bf16x8 qf[ND0];
#pragma unroll
    for (int d0 = 0; d0 < ND0; ++d0) qf[d0] = *(const bf16x8*)(Q + (size_t)qrow * QS + head * HS + d0 * 16 + hi * 8);
    u32x4 kreg[4]; u32x2 vreg[2][4]; u32x4 rreg;
#define AT_GLOAD(ti) do { const size_t kr_ = (size_t)(u.krow0 + 64 * (ti)); \
        _Pragma("unroll") for (int i_ = 0; i_ < 4; ++i_) { const int id_ = tid + 512 * i_; kreg[i_] = *(const u32x4*)(Kn + (kr_ + (id_ >> 5)) * 1024 + u.hg * 256 + (id_ & 31) * 8); } \
        _Pragma("unroll") for (int i_ = 0; i_ < 2; ++i_) { const int mt_ = tid + 512 * i_, dq_ = mt_ & 63, kvq_ = mt_ >> 6; \
            _Pragma("unroll") for (int a_ = 0; a_ < 4; ++a_) vreg[i_][a_] = *(const u32x2*)(V + (kr_ + 4 * kvq_ + a_) * 1024 + u.hg * 256 + dq_ * 4); } \
        if (MLA) { if (tid < 256) rreg = *(const u32x4*)(Kr + (kr_ + (tid >> 2)) * 32 + (tid & 3) * 8); } } while (0)
#define AT_SWRITE(st) do { ALAS unsigned char* sb_ = lds + (st) * STAGE; \
        _Pragma("unroll") for (int i_ = 0; i_ < 4; ++i_) { const int id_ = tid + 512 * i_, row_ = id_ >> 5, cc_ = id_ & 31; \
            *(ALAS u32x4*)(sb_ + (cc_ >> 3) * KHEAD + row_ * KROW + (cc_ & 7) * 16) = kreg[i_]; } \
        _Pragma("unroll") for (int i_ = 0; i_ < 2; ++i_) { const int mt_ = tid + 512 * i_, dq_ = mt_ & 63, kvq_ = mt_ >> 6; \
            ALAS unsigned char* vb_ = sb_ + KBUF + (dq_ >> 4) * VHEAD; \
            _Pragma("unroll") for (int jj_ = 0; jj_ < 4; ++jj_) { const int d_ = 4 * (dq_ & 15) + jj_; u32x2 o_; \
                const unsigned sel_ = (jj_ & 1) ? 0x07060302u : 0x05040100u; \
                if (jj_ < 2) { o_.x = __builtin_amdgcn_perm(vreg[i_][1].x, vreg[i_][0].x, sel_); o_.y = __builtin_amdgcn_perm(vreg[i_][3].x, vreg[i_][2].x, sel_); } \
                else         { o_.x = __builtin_amdgcn_perm(vreg[i_][1].y, vreg[i_][0].y, sel_); o_.y = __builtin_amdgcn_perm(vreg[i_][3].y, vreg[i_][2].y, sel_); } \
                *(ALAS u32x2*)(vb_ + d_ * VROW + kvq_ * 8) = o_; } } \
        if (MLA) { if (tid < 256) { const int row_ = tid >> 2, cc_ = tid & 3; *(ALAS u32x4*)(sb_ + KBUF + VBUF + row_ * RROW + cc_ * 16) = rreg; } } } while (0)
    float mrun = -INFINITY, lrun = 0.f;
    f32x16 o0 = f32x16{}, o1 = f32x16{};
    AT_GLOAD(0); AT_SWRITE(0);
    __syncthreads();
    for (int ti = 0; ti < u.nt; ++ti) {
        const bool more = ti + 1 < u.nt;
        if (more) AT_GLOAD(ti + 1);
        if (active) {
            ALAS unsigned char* sb = lds + (ti & 1) * STAGE;
            ALAS unsigned char* kb = sb + hl * KHEAD + l32 * KROW + hi * 16;
            f32x16 p[2];
            if (!MLA) {
                const int dmin = u.D0 - 64 * ti - 63;
                if (dmin >= 128) { const float c = tb[hl * 257 + 256];
#pragma unroll
                    for (int r = 0; r < 16; ++r) { p[0][r] = c; p[1][r] = c; } }
                else { const int dq = u.D0 + qh * 32 + l32 - 64 * ti;
#pragma unroll
                    for (int blk = 0; blk < 2; ++blk)
#pragma unroll
                        for (int r = 0; r < 16; ++r) { int df = dq - 32 * blk - crow(r, hi); df = df < -128 ? -128 : (df > 128 ? 128 : df); p[blk][r] = tb[hl * 257 + df + 128]; } }
            } else { p[0] = f32x16{}; p[1] = f32x16{}; }
#pragma unroll
            for (int blk = 0; blk < 2; ++blk) {
#pragma unroll
                for (int d0 = 0; d0 < 4; ++d0) {
                    const bf16x8 a = *(const ALAS bf16x8*)(kb + blk * 32 * KROW + d0 * 32);
                    p[blk] = __builtin_amdgcn_mfma_f32_32x32x16_bf16(a, qf[d0], p[blk], 0, 0, 0);
                }
                if (MLA) {
                    ALAS unsigned char* rb = sb + KBUF + VBUF + l32 * RROW + hi * 16;
#pragma unroll
                    for (int d0 = 4; d0 < ND0; ++d0) {
                        const bf16x8 a = *(const ALAS bf16x8*)(rb + blk * 32 * RROW + (d0 - 4) * 32);
                        p[blk] = __builtin_amdgcn_mfma_f32_32x32x16_bf16(a, qf[d0], p[blk], 0, 0, 0);
                    }
                }
            }
            if (!more && u.lastvalid < 64) {
#pragma unroll
                for (int r = 0; r < 16; ++r) p[1][r] = -INFINITY;
            }
            float mx = p[0][0];
#pragma unroll
            for (int r = 1; r < 16; ++r) mx = fmaxf(mx, p[0][r]);
#pragma unroll
            for (int r = 0; r < 16; ++r) mx = fmaxf(mx, p[1][r]);
            mx = fmaxf(mx, __shfl_xor(mx, 32));
            const float mnew = fmaxf(mrun, mx);
            if (__any(mnew > mrun)) {
                const float al = __builtin_amdgcn_exp2f(mrun - mnew);
                lrun *= al;
#pragma unroll
                for (int r = 0; r < 16; ++r) { o0[r] *= al; o1[r] *= al; }
                mrun = mnew;
            }
            float ls = 0.f;
#pragma unroll
            for (int blk = 0; blk < 2; ++blk)
#pragma unroll
                for (int r = 0; r < 16; ++r) { p[blk][r] = __builtin_amdgcn_exp2f(p[blk][r] - mrun); ls += p[blk][r]; }
            lrun += ls;
            bf16x8 pk[4];
#pragma unroll
            for (int j = 0; j < 4; ++j) { u32x4 w;
                const int b = j >> 1, r0 = 8 * (j & 1);
                w.x = pg8::pkbf(p[b][r0 + 0], p[b][r0 + 1]); w.y = pg8::pkbf(p[b][r0 + 2], p[b][r0 + 3]); w.z = pg8::pkbf(p[b][r0 + 4], p[b][r0 + 5]); w.w = pg8::pkbf(p[b][r0 + 6], p[b][r0 + 7]);
                pk[j] = __builtin_bit_cast(bf16x8, w); }
            ALAS unsigned char* vb = sb + KBUF + hl * VHEAD + l32 * VROW + hi * 8;
#pragma unroll
            for (int dblk = 0; dblk < 2; ++dblk) {
#pragma unroll
                for (int j = 0; j < 4; ++j) {
                    const s16x4 lo = *(const ALAS s16x4*)(vb + dblk * 32 * VROW + j * 32);
                    const s16x4 hh = *(const ALAS s16x4*)(vb + dblk * 32 * VROW + j * 32 + 16);
                    const bf16x8 vf = (bf16x8){lo[0], lo[1], lo[2], lo[3], hh[0], hh[1], hh[2], hh[3]};
                    if (dblk == 0) o0 = __builtin_amdgcn_mfma_f32_32x32x16_bf16(vf, pk[j], o0, 0, 0, 0);
                    else           o1 = __builtin_amdgcn_mfma_f32_32x32x16_bf16(vf, pk[j], o1, 0, 0, 0);
                }
            }
        }
        if (more) AT_SWRITE((ti + 1) & 1);
        __syncthreads();
    }
    if (active) {
        const float lt = lrun + __shfl_xor(lrun, 32);
        const float inv = 1.f / lt;
        const size_t ob = (size_t)qrow * 1024 + head * 64 + 4 * hi;
#pragma unroll
        for (int dblk = 0; dblk < 2; ++dblk)
#pragma unroll
            for (int g = 0; g < 4; ++g) {
                const u32x2 zz = *(const u32x2*)(Z + ob + 32 * dblk + 8 * g);
                const float z0 = __uint_as_float(zz.x << 16), z1 = __uint_as_float(zz.x & 0xffff0000u), z2 = __uint_as_float(zz.y << 16), z3 = __uint_as_float(zz.y & 0xffff0000u);
                const f32x16& o = dblk == 0 ? o0 : o1;
                u32x2 w; w.x = pg8::pkbf(o[4 * g + 0] * inv * z0, o[4 * g + 1] * inv * z1); w.y = pg8::pkbf(o[4 * g + 2] * inv * z2, o[4 * g + 3] * inv * z3);
                *(u32x2*)(U + ob + 32 * dblk + 8 * g) = w;
            }
    }
#undef AT_GLOAD
#undef AT_SWRITE
}
}
#define LAS __attribute__((address_space(3)))
typedef unsigned short bf16;
typedef unsigned v4u __attribute__((ext_vector_type(4)));
typedef unsigned v2u __attribute__((ext_vector_type(2)));
typedef float f32x4 __attribute__((ext_vector_type(4)));
constexpr size_t MiB = 1u << 20;
constexpr size_t WS_MOD = 0;
constexpr size_t MOD_BYTES = 2 * 40 * 3072 * 4;
constexpr size_t WS_CS = 1 * MiB;
constexpr size_t WS_W_AIN = 4 * MiB, WS_W_AOUT = 12 * MiB, WS_W_BIN = 14 * MiB, WS_W_UQ = 18 * MiB, WS_W_UKV = 20 * MiB, WS_W_BOUT = 22 * MiB;
constexpr size_t WS_H = 24 * MiB;
constexpr size_t WS_CKV = 153 * MiB;
constexpr size_t WS_KR = 194 * MiB;
constexpr size_t WS_X = 200 * MiB;
constexpr size_t WS_QA = WS_X, WS_KA = WS_X + 129 * MiB, WS_VA = WS_X + 267 * MiB, WS_ZA = WS_X + 405 * MiB;
constexpr size_t WS_ZB = WS_X, WS_RAW = WS_X + 129 * MiB, WS_QB = WS_RAW, WS_CQ = WS_X + 322 * MiB, WS_KN = WS_X + 371 * MiB, WS_VB = WS_X + 532 * MiB;
constexpr size_t WS_END = WS_X + 694 * MiB;
static_assert((size_t)M1 * 1024 * 2 <= 129 * MiB && (size_t)RA * 1024 * 2 <= 138 * MiB && (size_t)M1 * 768 * 4 <= 193 * MiB && (size_t)M1 * 384 * 2 <= 49 * MiB && (size_t)R2 * 1024 * 2 <= 161 * MiB, "ws map");
static_assert((size_t)R2 * 256 * 2 <= 41 * MiB && (size_t)R2 * 32 * 2 <= 6 * MiB && WS_ZA + 129 * MiB <= WS_END && WS_VB + 161 * MiB <= WS_END && WS_END <= 1024 * MiB, "ws map");
constexpr size_t O_YP = 0, O_YS = 67108864, O_AKP = 67371008, O_AVP = 84148224, O_AKS = 100925440, O_AVS = 101187584, O_CKVP = 101449728, O_KRP = 118226944, O_CKVS = 120324096, O_KRS = 120389632;
constexpr int LDS_TOTAL = 153664;
static_assert(at::LDS_BYTES <= LDS_TOTAL && pg8::STAGE_BYTES <= LDS_TOTAL, "LDS");

__device__ __forceinline__ float wave_sum(float v) {
#pragma unroll
    for (int o = 1; o < 64; o <<= 1) v += __shfl_xor(v, o);
    return v;
}
__device__ __forceinline__ unsigned pk2(float lo, float hi) { return pg8::pkbf(lo, hi); }
__device__ __forceinline__ int src_col(int gemm, int g) {
    const int lc = ((g >> 3) * 8 + (g & 3) * 2 + ((g >> 2) & 1)) * 32;
    switch (gemm) {
    case 2: if (lc < 1024) return 672 + lc; if (lc < 1408) return lc - 1024; if (lc < 1664) return 384 + (lc - 1408); if (lc < 1696) return 640 + (lc - 1664); return -1;
    case 3: if (lc < 1024) return (lc >> 6) * 96 + (lc & 63); return ((lc - 1024) >> 5) * 96 + 64;
    case 4: if (lc < 1024) return (lc >> 6) * 128 + (lc & 63); return ((lc - 1024) >> 6) * 128 + 64 + (lc & 63);
    default: return lc;
    }
}
__device__ __forceinline__ void transpose_item(const float* W, int K, int Nsrc, int sc, bf16* WT, int g, int k0, LAS float* scr, int lane) {
#pragma unroll 8
    for (int i = 0; i < 32; ++i) { const int kk = 2 * i + (lane >> 5); scr[kk * 33 + (lane & 31)] = sc >= 0 ? W[(size_t)(k0 + kk) * Nsrc + sc + (lane & 31)] : 0.f; }
    asm volatile("s_waitcnt lgkmcnt(0)" ::: "memory");
    const int c = lane & 7;
#pragma unroll
    for (int j = 0; j < 4; ++j) { const int n = (lane >> 3) + 8 * j; const LAS float* s = scr + (8 * c) * 33 + n;
        v4u o; o.x = pk2(s[0 * 33], s[1 * 33]); o.y = pk2(s[2 * 33], s[3 * 33]); o.z = pk2(s[4 * 33], s[5 * 33]); o.w = pk2(s[6 * 33], s[7 * 33]);
        *(v4u*)(WT + (size_t)(32 * g + n) * K + k0 + 8 * c) = o; }
    asm volatile("s_waitcnt lgkmcnt(0)" ::: "memory");
}
__device__ __forceinline__ void cvt8(const float* s, bf16* d) { const f32x4 a = *(const f32x4*)s, b = *(const f32x4*)(s + 4); v4u o; o.x = pk2(a[0], a[1]); o.y = pk2(a[2], a[3]); o.z = pk2(b[0], b[1]); o.w = pk2(b[2], b[3]); *(v4u*)d = o; }

struct Args { const float* in[26]; float* out; unsigned char* ws; int ph_lo, ph_hi; };

__device__ __forceinline__ void adanorm_rows(const float* xp, const float* xs, const float* g, const float* mod, bf16* H, int gw, int NGW, int lane) {
    for (int row = gw; row < M1; row += NGW) {
        const float* xr; int bb;
        if (row < MP) { xr = xp + (size_t)row * 1024; bb = row >> 11; } else { xr = xs + (size_t)(row - MP) * 1024; bb = NBP + ((row - MP) >> 5); }
        const float* md = mod + (size_t)bb * 3072;
        f32x4 v[4]; float s = 0.f;
#pragma unroll
        for (int j = 0; j < 4; ++j) { v[j] = *(const f32x4*)(xr + 4 * lane + 256 * j); s += pg8::ssq4(v[j]); }
        const float r = rsqrtf(wave_sum(s) * (1.f / 1024.f) + EPSN);
#pragma unroll
        for (int j = 0; j < 4; ++j) { const int c = 4 * lane + 256 * j;
            const f32x4 gg = *(const f32x4*)(g + c), sh = *(const f32x4*)(md + c), sc = *(const f32x4*)(md + 1024 + c);
            const f32x4 h = v[j] * r * gg * (sc + 1.f) + sh;
            v2u o; o.x = pk2(h[0], h[1]); o.y = pk2(h[2], h[3]); *(v2u*)(H + (size_t)row * 1024 + c) = o; }
    }
}

__global__ void __launch_bounds__(512, 2) hybrid_fwd(Args args) {
    extern __shared__ __attribute__((aligned(16))) unsigned char lds_raw[];
    LAS unsigned char* lds = (LAS unsigned char*)lds_raw;
    const int tid = threadIdx.x, lane = tid & 63, wave = __builtin_amdgcn_readfirstlane(tid >> 6);
    const int G = gridDim.x, bid = blockIdx.x;
    const int gw = bid * 8 + wave, NGW = G * 8;
    const int gt = bid * 512 + tid, NGT = G * 512;
    const int lo = args.ph_lo, hi = args.ph_hi;
#ifndef PHMASK
#define PHMASK 0x7ff
#endif
#define IN(k) (((PHMASK >> (k)) & 1) && lo <= (k) && (k) < hi)
typedef const __attribute__((address_space(4))) Args* KArgs;
#define PHASE_ARGS() KArgs A = (KArgs)__builtin_amdgcn_kernarg_segment_ptr(); asm volatile("" : "+s"(A)); unsigned char* ws = A->ws; float* out = A->out; (void)ws; (void)out
#define WSP(T, off) ((T*)(ws + (off)))
#define SEAM(k) do { if (IN(k) && IN((k) + 1)) { cg::this_grid().sync(); } } while (0)

    if (IN(0)) {
        PHASE_ARGS();
        float* mod = WSP(float, WS_MOD); float* CS = WSP(float, WS_CS);
        bf16 *W_AIN = WSP(bf16, WS_W_AIN), *W_AOUT = WSP(bf16, WS_W_AOUT), *W_BIN = WSP(bf16, WS_W_BIN), *W_UQ = WSP(bf16, WS_W_UQ), *W_UKV = WSP(bf16, WS_W_UKV), *W_BOUT = WSP(bf16, WS_W_BOUT);
        bf16 *KA = WSP(bf16, WS_KA), *VA = WSP(bf16, WS_VA), *CKV = WSP(bf16, WS_CKV), *KR = WSP(bf16, WS_KR);
        {
            LAS float* scr = (LAS float*)(lds + wave * 10240);
            constexpr int I0 = 16 * 128, I1 = 16 * 32, I2 = 16 * 56, I3 = 6 * 48, I4 = 4 * 64, I5 = 16 * 32;
            for (int it = gw; it < I0 + I1 + I2 + I3 + I4 + I5; it += NGW) {
                int r = it;
                if (r < I0) { const int g = r % 128; transpose_item(A->in[11], 1024, 4096, src_col(0, g), W_AIN, g, (r / 128) * 64, scr, lane); continue; } r -= I0;
                if (r < I1) { const int g = r % 32; transpose_item(A->in[15], 1024, 1024, src_col(1, g), W_AOUT, g, (r / 32) * 64, scr, lane); continue; } r -= I1;
                if (r < I2) { const int g = r % 56; transpose_item(A->in[16], 1024, 1696, src_col(2, g), W_BIN, g, (r / 56) * 64, scr, lane); continue; } r -= I2;
                if (r < I3) { const int g = r % 48; transpose_item(A->in[18], 384, 1536, src_col(3, g), W_UQ, g, (r / 48) * 64, scr, lane); continue; } r -= I3;
                if (r < I4) { const int g = r % 64; transpose_item(A->in[20], 256, 2048, src_col(4, g), W_UKV, g, (r / 64) * 64, scr, lane); continue; } r -= I4;
                { const int g = r % 32; transpose_item(A->in[25], 1024, 1024, src_col(5, g), W_BOUT, g, (r / 32) * 64, scr, lane); }
            }
        }
        for (int it = bid; it < 2 * 48; it += G) {
            const int l = it / 48, jb = it % 48;
            LAS float* sl = (LAS float*)(lds + wave * 10240);
            float acc[40];
#pragma unroll
            for (int b = 0; b < 40; ++b) acc[b] = 0.f;
            for (int pass = 0; pass < 2; ++pass) {
                const int k0 = (wave + 8 * pass) * 64;
                for (int e = lane; e < 40 * 64; e += 64) { const int bb = e >> 6, k = e & 63; const float c = bb < NBP ? A->in[6][(size_t)bb * 1024 + k0 + k] : A->in[7][(size_t)(bb - NBP) * 1024 + k0 + k]; sl[e] = c / (1.f + __expf(-c)); }
                asm volatile("s_waitcnt lgkmcnt(0)" ::: "memory");
                const float* W = A->in[9] + (size_t)l * 1024 * 3072 + (size_t)k0 * 3072 + jb * 64 + lane;
                for (int k = 0; k < 64; k += 4) {
                    const float w0 = W[(size_t)k * 3072], w1 = W[(size_t)(k + 1) * 3072], w2 = W[(size_t)(k + 2) * 3072], w3 = W[(size_t)(k + 3) * 3072];
#pragma unroll
                    for (int b = 0; b < 40; ++b) { const f32x4 sv = *(const LAS f32x4*)(sl + b * 64 + k); acc[b] += (sv[0] * w0 + sv[1] * w1) + (sv[2] * w2 + sv[3] * w3); }
                }
                asm volatile("s_waitcnt lgkmcnt(0)" ::: "memory");
            }
            __syncthreads();
            LAS float* red = (LAS float*)lds;
#pragma unroll
            for (int b = 0; b < 40; ++b) red[(wave * 40 + b) * 64 + lane] = acc[b];
            __syncthreads();
            for (int e = tid; e < 40 * 64; e += 512) { const int b = e >> 6, j = e & 63; float sum = A->in[10][(size_t)l * 3072 + jb * 64 + j];
#pragma unroll
                for (int w = 0; w < 8; ++w) sum += red[(w * 40 + b) * 64 + j];
                mod[((size_t)l * 40 + b) * 3072 + jb * 64 + j] = sum; }
            __syncthreads();
        }
        for (int i = gt; i < NBS * SA_STRIDE * 128; i += NGT) {
            const int c8 = i & 127, rr = (i >> 7) % SA_STRIDE, bs = (i >> 7) / SA_STRIDE;
            const size_t d = ((size_t)MP + (size_t)bs * SA_STRIDE + rr) * 1024 + c8 * 8;
            if (rr < 512) { const size_t s = ((size_t)bs * 512 + rr) * 1024 + c8 * 8; cvt8(A->in[2] + s, KA + d); cvt8(A->in[3] + s, VA + d); }
            else if (rr >= 544) { *(v4u*)(KA + d) = (v4u){0, 0, 0, 0}; *(v4u*)(VA + d) = (v4u){0, 0, 0, 0}; }
        }
        for (int i = gt; i < NBS * SB_STRIDE * 32; i += NGT) {
            const int c8 = i & 31, rr = (i >> 5) % SB_STRIDE, bs = (i >> 5) / SB_STRIDE;
            const size_t d = ((size_t)MP + (size_t)bs * SB_STRIDE + rr) * 256 + c8 * 8;
            if (rr < 2048) cvt8(A->in[4] + ((size_t)bs * 2048 + rr) * 256 + c8 * 8, CKV + d);
            else if (rr >= 2080) *(v4u*)(CKV + d) = (v4u){0, 0, 0, 0};
        }
        for (int i = gt; i < NBS * SB_STRIDE * 4; i += NGT) {
            const int c8 = i & 3, rr = (i >> 2) % SB_STRIDE, bs = (i >> 2) / SB_STRIDE;
            const size_t d = ((size_t)MP + (size_t)bs * SB_STRIDE + rr) * 32 + c8 * 8;
            if (rr < 2048) cvt8(A->in[5] + ((size_t)bs * 2048 + rr) * 32 + c8 * 8, KR + d);
            else if (rr >= 2080) *(v4u*)(KR + d) = (v4u){0, 0, 0, 0};
        }
        for (int i = gt; i < 2112 * 16; i += NGT) {
            const int pos = i >> 4, k = i & 15;
            const float inv = exp2f(-(float)k * (13.287712379549449f / 16.f));
            const float ang = (float)pos * inv;
            const double tr = (double)ang * 0.15915494309189535;
            const float fr = (float)(tr - floor(tr + 0.5));
            CS[pos * 32 + k] = __builtin_amdgcn_cosf(fr); CS[pos * 32 + 16 + k] = __builtin_amdgcn_sinf(fr);
        }
    }
    SEAM(0);
    if (IN(1)) { PHASE_ARGS(); adanorm_rows(A->in[0], A->in[1], A->in[8], WSP(float, WS_MOD), WSP(bf16, WS_H), gw, NGW, lane); }
    SEAM(1);
    if (IN(2)) {
        PHASE_ARGS();
        int Kop = 1024; asm volatile("" : "+s"(Kop)); pg8::Gemm g{WSP(bf16, WS_H), WSP(bf16, WS_W_AIN), M1, 4096, Kop}; pg8::StaticOrder S; S.init(M1, 4096, G, bid);
        pg8::EpiAin E{WSP(bf16, WS_QA), WSP(bf16, WS_KA), WSP(bf16, WS_VA), WSP(bf16, WS_ZA), A->in[12], A->in[13], out + O_AKP, out + O_AVP, out + O_AKS, out + O_AVS};
        pg8::gemm_phase<pg8::EpiAin, pg8::StaticOrder, true, true>(lds, g, S, E);
    }
    SEAM(2);
    if (IN(3)) {
        PHASE_ARGS();
        bf16 *QA = WSP(bf16, WS_QA), *KA = WSP(bf16, WS_KA), *VA = WSP(bf16, WS_VA), *ZA = WSP(bf16, WS_ZA), *H = WSP(bf16, WS_H); const float* tblp = A->in[14];
        __syncthreads();
        for (int u = bid; u < 4096 + 32; u += G) {
            at::AttnUnit a;
            if (u < 4096) { const int hg = u & 3, b = (u >> 2) & 31, c = u >> 7, t0 = c > 8 ? c - 8 : 0;
                a.qrow0 = b * SEQ + 64 * c; a.nq = 64; a.krow0 = b * SEQ + 64 * t0; a.nt = c - t0 + 1; a.lastvalid = 64; a.hg = hg; a.D0 = 64 * (c - t0); }
            else { const int s = u - 4096, hg = s & 3, bs = s >> 2;
                a.qrow0 = MP + bs * TS; a.nq = 32; a.krow0 = MP + bs * SA_STRIDE; a.nt = 9; a.lastvalid = 32; a.hg = hg; a.D0 = 512; }
            at::attn_unit<false>(lds, a, QA, KA, nullptr, VA, ZA, H, tblp);
        }
    }
    SEAM(3);
    if (IN(4)) {
        PHASE_ARGS();
        int Kop = 1024; asm volatile("" : "+s"(Kop)); pg8::Gemm g{WSP(bf16, WS_H), WSP(bf16, WS_W_AOUT), M1, 1024, Kop}; pg8::StaticOrder S; S.init(M1, 1024, G, bid);
        pg8::EpiRes E{A->in[0], A->in[1], out + O_YP, out + O_YS, WSP(float, WS_MOD) + 2048};
        pg8::gemm_phase<pg8::EpiRes, pg8::StaticOrder, true, true>(lds, g, S, E);
    }
    SEAM(4);
    if (IN(5)) { PHASE_ARGS(); adanorm_rows(out + O_YP, out + O_YS, A->in[8] + 1024, WSP(float, WS_MOD) + 40 * 3072, WSP(bf16, WS_H), gw, NGW, lane); }
    SEAM(5);
    if (IN(6)) {
        PHASE_ARGS();
        int Kop = 1024; asm volatile("" : "+s"(Kop)); pg8::Gemm g{WSP(bf16, WS_H), WSP(bf16, WS_W_BIN), M1, 1792, Kop}; pg8::StaticOrder S; S.init(M1, 1792, G, bid);
        pg8::EpiBin E{WSP(bf16, WS_ZB), WSP(float, WS_RAW)};
        pg8::gemm_phase<pg8::EpiBin, pg8::StaticOrder, true, true>(lds, g, S, E);
    }
    SEAM(6);
    if (IN(7)) {
        PHASE_ARGS();
        const float* RAW = WSP(float, WS_RAW); const float* CS = WSP(float, WS_CS); bf16 *CQ = WSP(bf16, WS_CQ), *CKV = WSP(bf16, WS_CKV), *KR = WSP(bf16, WS_KR);
        const float *gcq = A->in[17], *gckv = A->in[19], *gkr = A->in[24];
        for (int row = gw; row < M1; row += NGW) {
            const float* rw = RAW + (size_t)row * 768;
            int pos; size_t drow, orow;
            if (row < MP) { pos = row & (SEQ - 1); drow = (size_t)row; orow = (size_t)row; }
            else { const int rs = row - MP; pos = SEQ + (rs & 31); drow = (size_t)MP + (size_t)(rs >> 5) * SB_STRIDE + 2048 + (rs & 31); orow = (size_t)rs; }
            float* ockv = (row < MP ? out + O_CKVP : out + O_CKVS) + orow * 256;
            float* okr = (row < MP ? out + O_KRP : out + O_KRS) + orow * 32;
            float q[6]; float s = 0.f;
#pragma unroll
            for (int j = 0; j < 6; ++j) { q[j] = rw[lane + 64 * j]; s += q[j] * q[j]; }
            float r = rsqrtf(wave_sum(s) * (1.f / 384.f) + EPSN);
#pragma unroll
            for (int j = 0; j < 6; ++j) { const float v = q[j] * r * gcq[lane + 64 * j]; const unsigned b = pk2(v, 0.f); CQ[(size_t)row * 384 + lane + 64 * j] = (bf16)(b & 0xffffu); }
            const f32x4 kv = *(const f32x4*)(rw + 384 + 4 * lane);
            r = rsqrtf(wave_sum(pg8::ssq4(kv)) * (1.f / 256.f) + EPSN);
            const f32x4 kvn = kv * r * *(const f32x4*)(gckv + 4 * lane);
            *(f32x4*)(ockv + 4 * lane) = kvn;
            { v2u o; o.x = pk2(kvn[0], kvn[1]); o.y = pk2(kvn[2], kvn[3]); *(v2u*)(CKV + drow * 256 + 4 * lane) = o; }
            const float kr = lane < 32 ? rw[640 + lane] : 0.f;
            r = rsqrtf(wave_sum(kr * kr) * (1.f / 32.f) + EPSN);
            const float kn = kr * r * (lane < 32 ? gkr[lane] : 0.f);
            const float pr = __shfl_xor(kn, 16);
            const float cs = CS[pos * 32 + (lane & 15)], sn = CS[pos * 32 + 16 + (lane & 15)];
            const float ro = (lane & 16) ? (kn * cs + pr * sn) : (kn * cs - pr * sn);
            if (lane < 32) { okr[lane] = ro; const unsigned b = pk2(ro, 0.f); KR[drow * 32 + lane] = (bf16)(b & 0xffffu); }
        }
    }
    SEAM(7);
    if (IN(8)) {
        { PHASE_ARGS(); int Kop = 384; asm volatile("" : "+s"(Kop)); pg8::Gemm g{WSP(bf16, WS_CQ), WSP(bf16, WS_W_UQ), M1, 1536, Kop}; pg8::StaticOrder S; S.init(M1, 1536, G, bid);
          pg8::EpiUq E{WSP(bf16, WS_QB), A->in[21], A->in[22], WSP(float, WS_CS)};
          pg8::gemm_phase<pg8::EpiUq, pg8::StaticOrder, true, true>(lds, g, S, E); }
        __syncthreads();
        { PHASE_ARGS(); int Kop = 256; asm volatile("" : "+s"(Kop)); pg8::Gemm g{WSP(bf16, WS_CKV), WSP(bf16, WS_W_UKV), R2, 2048, Kop}; pg8::StaticOrder S; S.init(R2, 2048, G, bid);
          pg8::EpiUkv E{WSP(bf16, WS_KN), WSP(bf16, WS_VB), A->in[23]};
          pg8::gemm_phase<pg8::EpiUkv, pg8::StaticOrder, true, true>(lds, g, S, E); }
    }
    SEAM(8);
    if (IN(9)) {
        PHASE_ARGS();
        bf16 *QB = WSP(bf16, WS_QB), *KN = WSP(bf16, WS_KN), *KR = WSP(bf16, WS_KR), *VB = WSP(bf16, WS_VB), *ZB = WSP(bf16, WS_ZB), *H = WSP(bf16, WS_H);
        __syncthreads();
        for (int u = bid; u < 4096; u += G) {
            at::AttnUnit a; const int hg = u & 3, b = (u >> 2) & 31, c = 31 - (u >> 7);
            a.qrow0 = b * SEQ + 64 * c; a.nq = 64; a.krow0 = b * SEQ; a.nt = c + 1; a.lastvalid = 64; a.hg = hg; a.D0 = 0;
            at::attn_unit<true>(lds, a, QB, KN, KR, VB, ZB, H, nullptr);
        }
        for (int s = (bid + G - (128 % G)) % G; s < 32; s += G) {
            at::AttnUnit a; const int hg = s & 3, bs = s >> 2;
            a.qrow0 = MP + bs * TS; a.nq = 32; a.krow0 = MP + bs * SB_STRIDE; a.nt = 33; a.lastvalid = 32; a.hg = hg; a.D0 = 0;
            at::attn_unit<true>(lds, a, QB, KN, KR, VB, ZB, H, nullptr);
        }
    }
    SEAM(9);
    if (IN(10)) {
        PHASE_ARGS();
        int Kop = 1024; asm volatile("" : "+s"(Kop)); pg8::Gemm g{WSP(bf16, WS_H), WSP(bf16, WS_W_BOUT), M1, 1024, Kop}; pg8::StaticOrder S; S.init(M1, 1024, G, bid);
        pg8::EpiRes E{out + O_YP, out + O_YS, out + O_YP, out + O_YS, WSP(float, WS_MOD) + 40 * 3072 + 2048};
        pg8::gemm_phase<pg8::EpiRes, pg8::StaticOrder, true, true>(lds, g, S, E);
    }
#undef IN
#undef SEAM
}

constexpr int N_PHASES = 11;
extern "C" void kernel_launch(void* const* d_in, const int* in_sizes, int n_in, void* d_out, int out_size, void* d_ws, size_t ws_size, hipStream_t stream) {
    static int grid = 0;
    if (grid == 0) {
        if (n_in != 26 || ws_size < WS_END) { fprintf(stderr, "kernel_launch: unexpected inputs (n_in %d, ws %zu, need %zu)\n", n_in, ws_size, (size_t)WS_END); grid = -1; return; }
        int dev = 0, cus = 0, per_cu = 0;
        hipGetDevice(&dev); hipDeviceGetAttribute(&cus, hipDeviceAttributeMultiprocessorCount, dev);
        hipFuncSetAttribute((const void*)hybrid_fwd, hipFuncAttributeMaxDynamicSharedMemorySize, LDS_TOTAL);
        hipOccupancyMaxActiveBlocksPerMultiprocessor(&per_cu, (const void*)hybrid_fwd, 512, LDS_TOTAL);
        if (per_cu < 1) { fprintf(stderr, "kernel_launch: occupancy query says %d blocks per CU\n", per_cu); per_cu = 1; }
        (void)hipGetLastError();
        grid = cus * per_cu;
    }
    if (grid < 0) return;
    Args a{};
    for (int i = 0; i < 26; ++i) a.in[i] = (const float*)d_in[i];
    a.out = (float*)d_out; a.ws = (unsigned char*)d_ws;
#if MULTI_LAUNCH
    for (int p = 0; p < N_PHASES; ++p) { a.ph_lo = p; a.ph_hi = p + 1; hipLaunchKernelGGL(hybrid_fwd, dim3(grid), dim3(512), LDS_TOTAL, stream, a); }
#else
    a.ph_lo = 0; a.ph_hi = N_PHASES;
    void* kargs[] = {&a};
    hipError_t e = hipLaunchCooperativeKernel((const void*)hybrid_fwd, dim3(grid), dim3(512), kargs, LDS_TOTAL, stream);
    if (e != hipSuccess) fprintf(stderr, "cooperative launch failed: %s (grid %d)\n", hipGetErrorString(e), grid);
#endif
}
```

```cpp
#include <hip/hip_runtime.h>
#include <hip/hip_cooperative_groups.h>
#include <cstdio>
#include <cstdint>
namespace cg = cooperative_groups;
#ifndef MULTI_LAUNCH
#define MULTI_LAUNCH 0
#endif
constexpr int DMODEL = 1024, NBP = 32, SEQ = 2048, NBS = 8, TS = 32;
constexpr int MP = NBP * SEQ;
constexpr int M1 = MP + NBS * TS;
constexpr int SA_STRIDE = 576;
constexpr int RA = MP + NBS * SA_STRIDE;
constexpr int SB_STRIDE = 2112;
constexpr int R2 = MP + NBS * SB_STRIDE;
constexpr float EPSN = 1e-6f;
constexpr float LOG2E = 1.4426950408889634f;
constexpr float QSCALE_A = 0.125f * LOG2E;
constexpr float QSCALE_B = 0.10206207261596575f * LOG2E;
namespace pg8 {
#define PG8_LAS __attribute__((address_space(3)))
typedef unsigned short bf16_t;
typedef short bf16x8 __attribute__((ext_vector_type(8)));
typedef float f32x4 __attribute__((ext_vector_type(4)));
typedef unsigned u32x4 __attribute__((ext_vector_type(4)));
constexpr int BM = 256, BK = 64, HALF = 128, HTB = HALF * BK * 2  , STAGE_BYTES = 8 * HTB, NXCD = 8, WGM = 8;

__host__ __device__ __forceinline__ int lds_byte(int r, int c) { const int st = (r >> 4) * 2 + (c >> 5), rr = r & 15, cc = c & 31, ob = rr * 64 + cc * 2; return st * 1024 + (ob ^ (((ob >> 9) & 1) << 5)); }
__host__ __device__ __forceinline__ void stage_rc(int b, int& R, int& C) { const int st = b / 1024, sb = b % 1024, swz = sb ^ (((sb >> 9) & 1) << 5); R = (st >> 1) * 16 + swz / 64; C = (st & 1) * 32 + (swz % 64) / 2; }
__host__ __device__ __forceinline__ int perm32(int rho) { const int n = rho >> 4, i = rho & 15; return 8 * (i >> 2) + 4 * n + (i & 3); }

struct Unit { int pm, pn; };
struct Gemm { const bf16_t* A; const bf16_t* Bt; int M, N, K; };

struct StaticOrder {
    int nM, nN, nwg, G, c;
    __host__ __device__ void init(int M, int N, int G_, int c_) { nM = M / BM; nN = N / BM; nwg = nM * nN; G = G_; c = c_; }
    __host__ __device__ bool next(int i, Unit& u) const {
        const long L = (long)i * G + c; if (L >= nwg) return false;
        int wgid = (int)L; { const int q = nwg / NXCD, r = nwg % NXCD, xcd = wgid % NXCD, off = wgid / NXCD; wgid = (xcd < r ? xcd * (q + 1) : r * (q + 1) + (xcd - r) * q) + off; }
        const int nig = WGM * nN, gid = wgid / nig, fm = gid * WGM, gsz = (nM - fm) < WGM ? (nM - fm) : WGM;
        u.pm = fm + ((wgid % nig) % gsz); u.pn = (wgid % nig) / gsz; return true;
    }
    __device__ __forceinline__ void a_ready(const Unit&) const {}
    __device__ __forceinline__ void done(const Unit&) const {}
};

__device__ __forceinline__ unsigned cvt_pk_bf16(float lo, float hi) { unsigned r; asm volatile("v_cvt_pk_bf16_f32 %0, %1, %2" : "=v"(r) : "v"(lo), "v"(hi)); return r; }
template <class Epi, class Sched, bool ALIGN_EPI = false, bool SP2 = false>
__device__ __forceinline__ void gemm_phase(PG8_LAS unsigned char* lds, const Gemm g, const Sched& S, const Epi& E) {
    const int tid = threadIdx.x, wid = __builtin_amdgcn_readfirstlane(tid >> 6), lane = tid & 63, wr = wid >> 2, wc = wid & 3, fr = lane & 15, fq = lane >> 4;
    const int K = g.K, nt = K / BK;
    unsigned voffA[2], voffB[2];
#pragma unroll
    for (int i = 0; i < 2; ++i) { int R, C; stage_rc(tid * 16 + i * 8192, R, C); const int Rb = Epi::PERM ? ((R & ~31) + perm32(R & 31)) : R;
        voffA[i] = (unsigned)(R * K + C) * 2u; voffB[i] = (unsigned)(Rb * K + C) * 2u; }
    const size_t kstep = (size_t)(BK * 2);
    const size_t hstep = (size_t)HALF * K * 2;
    const size_t tstep = 2 * hstep;
    const unsigned ldsw = (unsigned)wid * 1024u;
    const int aoff = lds_byte(wr * 64 + fr, fq * 8), boff = lds_byte(wc * 32 + fr, fq * 8);
#define PG8_SA(b, h) (((b) * 2 + (h)) * HTB)
#define PG8_SB(b, h) ((4 + (b) * 2 + (h)) * HTB)
#define PG8_STAGE(bufoff, gbase, voff) do { _Pragma("unroll") for (int _i = 0; _i < 2; ++_i) \
        __builtin_amdgcn_global_load_lds((const unsigned*)((const char*)(gbase) + (voff)[_i]), (PG8_LAS unsigned*)(lds + (bufoff) + ldsw + _i * 8192), 16, 0, 0); } while (0)
#define PG8_LDA(dst, b, h) do { _Pragma("unroll") for (int m = 0; m < 4; ++m) _Pragma("unroll") for (int k = 0; k < 2; ++k) dst[m][k] = *(const PG8_LAS bf16x8*)(lds + PG8_SA(b, h) + aoff + m * 2048 + k * 1024); } while (0)
#define PG8_LDB(dst, b, h) do { _Pragma("unroll") for (int n = 0; n < 2; ++n) _Pragma("unroll") for (int k = 0; k < 2; ++k) dst[n][k] = *(const PG8_LAS bf16x8*)(lds + PG8_SB(b, h) + boff + n * 2048 + k * 1024); } while (0)
#define PG8_MMA(ai, bj, At, Bt) do { __builtin_amdgcn_s_setprio(1); _Pragma("unroll") for (int m = 0; m < 4; ++m) _Pragma("unroll") for (int n = 0; n < 2; ++n) _Pragma("unroll") for (int k = 0; k < 2; ++k) \
        acc[ai][bj][m][n] = __builtin_amdgcn_mfma_f32_16x16x32_bf16(Bt[n][k], At[m][k], acc[ai][bj][m][n], 0, 0, 0); __builtin_amdgcn_s_setprio(0); } while (0)
#define PG8_WAIT_V(n) asm volatile("s_waitcnt vmcnt(" #n ")" ::: "memory")
#define PG8_WAIT_L(n) asm volatile("s_waitcnt lgkmcnt(" #n ")" ::: "memory")
#define PG8_BAR __builtin_amdgcn_s_barrier()
#define PG8_SCHED __builtin_amdgcn_sched_barrier(0)
    Unit cur, nxt; int ui = 0;
    if (!S.next(0, cur)) return;
    f32x4 acc[2][2][4][2];
#pragma unroll
    for (int a = 0; a < 2; ++a)
#pragma unroll
        for (int b = 0; b < 2; ++b)
#pragma unroll
            for (int m = 0; m < 4; ++m)
#pragma unroll
                for (int n = 0; n < 2; ++n) acc[a][b][m][n] = (f32x4){0.f, 0.f, 0.f, 0.f};
    bf16x8 At[4][2], B0[2][2], B1[2][2];
    const char* cA = (const char*)g.A + (size_t)cur.pm * tstep; const char* cB = (const char*)g.Bt + (size_t)cur.pn * tstep;
    S.a_ready(cur);
    if constexpr (SP2) {
        PG8_STAGE(PG8_SB(0, 0), cB, voffB); PG8_STAGE(PG8_SB(0, 1), cB + hstep, voffB); PG8_STAGE(PG8_SA(0, 0), cA, voffA); PG8_STAGE(PG8_SA(0, 1), cA + hstep, voffA);
        if (wr == 1) PG8_BAR;
        PG8_WAIT_V(2); PG8_BAR;
        PG8_STAGE(PG8_SB(1, 0), cB + kstep, voffB); PG8_STAGE(PG8_SA(1, 0), cA + kstep, voffA); PG8_STAGE(PG8_SB(1, 1), cB + hstep + kstep, voffB);
        PG8_WAIT_V(6); PG8_BAR;
    } else {
        PG8_STAGE(PG8_SB(0, 0), cB, voffB); PG8_STAGE(PG8_SA(0, 0), cA, voffA); PG8_STAGE(PG8_SB(0, 1), cB + hstep, voffB); PG8_STAGE(PG8_SA(0, 1), cA + hstep, voffA);
        if (wr == 1) PG8_BAR;
        PG8_WAIT_V(4); PG8_BAR;
        PG8_STAGE(PG8_SB(1, 0), cB + kstep, voffB); PG8_STAGE(PG8_SA(1, 0), cA + kstep, voffA); PG8_STAGE(PG8_SB(1, 1), cB + hstep + kstep, voffB);
        PG8_WAIT_V(6); PG8_BAR;
    }
    for (;;) {
        const bool has_next = S.next(ui + 1, nxt);
        const char* nA = has_next ? (const char*)g.A + (size_t)nxt.pm * tstep : cA; const char* nB = has_next ? (const char*)g.Bt + (size_t)nxt.pn * tstep : cB;
        for (int t = 0; t < nt; t += 2) {
            const bool last = (t == nt - 2);
            const char* a1 = cA + (size_t)(t + 1) * kstep;
            const char* a2 = last ? nA : cA + (size_t)(t + 2) * kstep; const char* b2 = last ? nB : cB + (size_t)(t + 2) * kstep;
            const char* a3 = a2 + kstep; const char* b3 = b2 + kstep;
            if (last && has_next) S.a_ready(nxt);
            if constexpr (SP2) {
            PG8_LDB(B0, 0, 0); PG8_LDB(B1, 0, 1); PG8_SCHED; PG8_LDA(At, 0, 0); PG8_STAGE(PG8_SA(1, 1), a1 + hstep, voffA);
            PG8_WAIT_V(8); PG8_WAIT_L(0); PG8_BAR; PG8_MMA(0, 0, At, B0); PG8_MMA(0, 1, At, B1); PG8_BAR; PG8_SCHED;
            PG8_LDA(At, 0, 1); PG8_STAGE(PG8_SB(0, 0), b2, voffB); PG8_STAGE(PG8_SB(0, 1), b2 + hstep, voffB); PG8_STAGE(PG8_SA(0, 0), a2, voffA);
            PG8_WAIT_V(8); PG8_WAIT_L(0); PG8_BAR; PG8_MMA(1, 0, At, B0); PG8_MMA(1, 1, At, B1); PG8_BAR; PG8_SCHED;
            PG8_LDB(B0, 1, 0); PG8_LDB(B1, 1, 1); PG8_SCHED; PG8_LDA(At, 1, 0); PG8_STAGE(PG8_SA(0, 1), a2 + hstep, voffA);
            PG8_WAIT_V(8); PG8_WAIT_L(0); PG8_BAR; PG8_MMA(0, 0, At, B0); PG8_MMA(0, 1, At, B1); PG8_BAR; PG8_SCHED;
            PG8_LDA(At, 1, 1); PG8_STAGE(PG8_SB(1, 0), b3, voffB); PG8_STAGE(PG8_SB(1, 1), b3 + hstep, voffB); PG8_STAGE(PG8_SA(1, 0), a3, voffA);
            PG8_WAIT_V(8); PG8_WAIT_L(0); PG8_BAR; PG8_MMA(1, 0, At, B0); PG8_MMA(1, 1, At, B1); PG8_BAR; PG8_SCHED;
            } else {
            PG8_LDB(B0, 0, 0); PG8_SCHED; PG8_LDA(At, 0, 0); PG8_STAGE(PG8_SA(1, 1), a1 + hstep, voffA);
            PG8_WAIT_L(8); PG8_BAR; PG8_WAIT_L(0); PG8_MMA(0, 0, At, B0); PG8_BAR; PG8_SCHED;
            PG8_LDB(B1, 0, 1); PG8_STAGE(PG8_SB(0, 0), b2, voffB);
            PG8_BAR; PG8_WAIT_L(0); PG8_MMA(0, 1, At, B1); PG8_BAR;
            PG8_LDA(At, 0, 1); PG8_STAGE(PG8_SA(0, 0), a2, voffA);
            PG8_BAR; PG8_WAIT_L(0); PG8_MMA(1, 0, At, B0); PG8_BAR; PG8_SCHED;
            PG8_STAGE(PG8_SB(0, 1), b2 + hstep, voffB);
            PG8_WAIT_V(6); PG8_BAR; PG8_MMA(1, 1, At, B1); PG8_BAR;
            PG8_LDB(B0, 1, 0); PG8_SCHED; PG8_LDA(At, 1, 0); PG8_STAGE(PG8_SA(0, 1), a2 + hstep, voffA);
            PG8_WAIT_L(8); PG8_BAR; PG8_WAIT_L(0); PG8_MMA(0, 0, At, B0); PG8_BAR; PG8_SCHED;
            PG8_LDB(B1, 1, 1); PG8_STAGE(PG8_SB(1, 0), b3, voffB);
            PG8_BAR; PG8_WAIT_L(0); PG8_MMA(0, 1, At, B1); PG8_BAR;
            PG8_LDA(At, 1, 1); PG8_STAGE(PG8_SA(1, 0), a3, voffA);
            PG8_BAR; PG8_WAIT_L(0); PG8_MMA(1, 0, At, B0); PG8_BAR; PG8_SCHED;
            PG8_STAGE(PG8_SB(1, 1), b3 + hstep, voffB);
            PG8_WAIT_V(6); PG8_BAR; PG8_MMA(1, 1, At, B1); PG8_BAR;
            }
        }
        if constexpr (ALIGN_EPI) { if (wr == 0) PG8_BAR; }
        if constexpr (!Epi::AFTER_DRAIN) { E(acc, cur, wr, wc, fr, fq); S.done(cur); }
        if (!has_next) break;
#pragma unroll
        for (int a = 0; a < 2; ++a)
#pragma unroll
            for (int b = 0; b < 2; ++b)
#pragma unroll
                for (int m = 0; m < 4; ++m)
#pragma unroll
                    for (int n = 0; n < 2; ++n) acc[a][b][m][n] = (f32x4){0.f, 0.f, 0.f, 0.f};
        cur = nxt; cA = nA; cB = nB; ++ui;
        if constexpr (ALIGN_EPI) { if (wr == 1) PG8_BAR; }
    }
    PG8_WAIT_V(0);
    if constexpr (!ALIGN_EPI) { if (wr == 0) PG8_BAR; }
    PG8_BAR;
    if constexpr (Epi::AFTER_DRAIN) { E.fused(acc, cur, wr, wc, fr, fq, lds, wid, lane); S.done(cur); }
#undef PG8_SA
#undef PG8_SB
#undef PG8_STAGE
#undef PG8_LDA
#undef PG8_LDB
#undef PG8_MMA
#undef PG8_WAIT_V
#undef PG8_WAIT_L
#undef PG8_BAR
#undef PG8_SCHED
}
typedef unsigned u32x2 __attribute__((ext_vector_type(2)));
typedef float f32x2 __attribute__((ext_vector_type(2)));
typedef __bf16 bf16x2_t __attribute__((ext_vector_type(2)));
__device__ __forceinline__ unsigned pkbf(float lo, float hi) { f32x2 v = {lo, hi}; bf16x2_t b = __builtin_convertvector(v, bf16x2_t); return __builtin_bit_cast(unsigned, b); }
__device__ __forceinline__ u32x2 pk4(f32x4 v) { u32x2 r; r.x = pkbf(v[0], v[1]); r.y = pkbf(v[2], v[3]); return r; }
__device__ __forceinline__ float silu_f(float v) { return v * __builtin_amdgcn_rcpf(1.f + __expf(-v)); }
__device__ __forceinline__ f32x4 silu4(f32x4 v) { f32x4 o; o[0] = silu_f(v[0]); o[1] = silu_f(v[1]); o[2] = silu_f(v[2]); o[3] = silu_f(v[3]); return o; }
__device__ __forceinline__ float ssq4(f32x4 v) { return (v[0] * v[0] + v[1] * v[1]) + (v[2] * v[2] + v[3] * v[3]); }
__device__ __forceinline__ float red_fq(float s) { s += __shfl_xor(s, 16); s += __shfl_xor(s, 32); return s; }

struct EpiAin {
    static constexpr bool PERM = false, AFTER_DRAIN = false;
    bf16_t *Q, *K, *V, *Z; const float *gq, *gk; float *okp, *ovp, *oks, *ovs;
    __device__ __forceinline__ void operator()(const f32x4 (&acc)[2][2][4][2], const Unit& u, int wr, int wc, int fr, int fq) const {
        const int sec = u.pn >> 2, head = (u.pn & 3) * 4 + wc, cb = head * 64 + 4 * fq;
        f32x4 g[2][2];
#pragma unroll
        for (int bj = 0; bj < 2; ++bj)
#pragma unroll
            for (int n = 0; n < 2; ++n) g[bj][n] = (sec < 2) ? *(const f32x4*)((sec == 0 ? gq : gk) + 32 * bj + 16 * n + 4 * fq) : (f32x4){1.f, 1.f, 1.f, 1.f};
#pragma unroll
        for (int ai = 0; ai < 2; ++ai)
#pragma unroll
            for (int m = 0; m < 4; ++m) {
                const int row = u.pm * BM + ai * HALF + wr * 64 + m * 16 + fr;
                f32x4 v[2][2];
#pragma unroll
                for (int bj = 0; bj < 2; ++bj)
#pragma unroll
                    for (int n = 0; n < 2; ++n) v[bj][n] = acc[ai][bj][m][n];
                if (sec < 2) {
                    float s = (ssq4(v[0][0]) + ssq4(v[0][1])) + (ssq4(v[1][0]) + ssq4(v[1][1]));
                    s = red_fq(s);
                    const float r = rsqrtf(s * (1.f / 64.f) + EPSN) * (sec == 0 ? QSCALE_A : 1.f);
#pragma unroll
                    for (int bj = 0; bj < 2; ++bj)
#pragma unroll
                        for (int n = 0; n < 2; ++n) v[bj][n] = v[bj][n] * g[bj][n] * r;
                } else if (sec == 3) {
#pragma unroll
                    for (int bj = 0; bj < 2; ++bj)
#pragma unroll
                        for (int n = 0; n < 2; ++n) v[bj][n] = silu4(v[bj][n]);
                }
                if (sec == 0 || sec == 3) {
                    bf16_t* d = (sec == 0 ? Q : Z) + (size_t)row * 1024 + cb;
#pragma unroll
                    for (int bj = 0; bj < 2; ++bj)
#pragma unroll
                        for (int n = 0; n < 2; ++n) *(u32x2*)(d + 32 * bj + 16 * n) = pk4(v[bj][n]);
                } else {
                    size_t drow; float* of = nullptr;
                    if (row < MP) { drow = (size_t)row; const int pos = row & (SEQ - 1); if (pos >= SEQ - 512) of = (sec == 1 ? okp : ovp) + ((size_t)((row >> 11) * 512 + pos - (SEQ - 512))) * 1024; }
                    else { const int rs = row - MP; drow = (size_t)MP + (size_t)(rs >> 5) * SA_STRIDE + 512 + (rs & 31); of = (sec == 1 ? oks : ovs) + (size_t)rs * 1024; }
                    bf16_t* d = (sec == 1 ? K : V) + drow * 1024 + cb;
#pragma unroll
                    for (int bj = 0; bj < 2; ++bj)
#pragma unroll
                        for (int n = 0; n < 2; ++n) { *(u32x2*)(d + 32 * bj + 16 * n) = pk4(v[bj][n]); if (of) *(f32x4*)(of + cb + 32 * bj + 16 * n) = v[bj][n]; }
                }
                asm volatile("" ::: "memory");
            }
    }
};
struct EpiRes {
    static constexpr bool PERM = false, AFTER_DRAIN = false;
    const float *xp, *xs; float *yp, *ys; const float* gate;
    __device__ __forceinline__ void operator()(const f32x4 (&acc)[2][2][4][2], const Unit& u, int wr, int wc, int fr, int fq) const {
        const int cb = u.pn * 256 + wc * 64 + 4 * fq;
#pragma unroll
        for (int ai = 0; ai < 2; ++ai)
#pragma unroll
            for (int m = 0; m < 4; ++m) {
                const int row = u.pm * BM + ai * HALF + wr * 64 + m * 16 + fr;
                const float* xi; float* yo; int bb;
                if (row < MP) { xi = xp + (size_t)row * 1024; yo = yp + (size_t)row * 1024; bb = row >> 11; }
                else { const int rs = row - MP; xi = xs + (size_t)rs * 1024; yo = ys + (size_t)rs * 1024; bb = NBP + (rs >> 5); }
                const float* gp = gate + (size_t)bb * 3072;
#pragma unroll
                for (int bj = 0; bj < 2; ++bj)
#pragma unroll
                    for (int n = 0; n < 2; ++n) { const int c = cb + 32 * bj + 16 * n; const f32x4 o = *(const f32x4*)(xi + c) + *(const f32x4*)(gp + c) * acc[ai][bj][m][n]; *(f32x4*)(yo + c) = o; }
                asm volatile("" ::: "memory");
            }
    }
};
struct EpiBin {
    static constexpr bool PERM = false, AFTER_DRAIN = false;
    bf16_t* Z; float* RAW;
    __device__ __forceinline__ void operator()(const f32x4 (&acc)[2][2][4][2], const Unit& u, int wr, int wc, int fr, int fq) const {
        const int cb = u.pn * 256 + wc * 64 + 4 * fq;
#pragma unroll
        for (int ai = 0; ai < 2; ++ai)
#pragma unroll
            for (int m = 0; m < 4; ++m) {
                const int row = u.pm * BM + ai * HALF + wr * 64 + m * 16 + fr;
#pragma unroll
                for (int bj = 0; bj < 2; ++bj)
#pragma unroll
                    for (int n = 0; n < 2; ++n) { const int c = cb + 32 * bj + 16 * n;
                        if (u.pn < 4) *(u32x2*)(Z + (size_t)row * 1024 + c) = pk4(silu4(acc[ai][bj][m][n]));
                        else *(f32x4*)(RAW + (size_t)row * 768 + (c - 1024)) = acc[ai][bj][m][n]; }
            }
    }
};
struct EpiUq {
    static constexpr bool PERM = false, AFTER_DRAIN = false;
    bf16_t* Q; const float *gqn, *gqr, *CS;
    __device__ __forceinline__ void operator()(const f32x4 (&acc)[2][2][4][2], const Unit& u, int wr, int wc, int fr, int fq) const {
        if (u.pn < 4) {
            const int head = u.pn * 4 + wc;
#pragma unroll
            for (int ai = 0; ai < 2; ++ai)
#pragma unroll
                for (int m = 0; m < 4; ++m) {
                    const int row = u.pm * BM + ai * HALF + wr * 64 + m * 16 + fr;
                    float s = (ssq4(acc[ai][0][m][0]) + ssq4(acc[ai][0][m][1])) + (ssq4(acc[ai][1][m][0]) + ssq4(acc[ai][1][m][1]));
                    s = red_fq(s);
                    const float r = rsqrtf(s * (1.f / 64.f) + EPSN) * QSCALE_B;
                    bf16_t* d = Q + (size_t)row * 1536 + head * 96 + 4 * fq;
#pragma unroll
                    for (int bj = 0; bj < 2; ++bj)
#pragma unroll
                        for (int n = 0; n < 2; ++n) *(u32x2*)(d + 32 * bj + 16 * n) = pk4(acc[ai][bj][m][n] * *(const f32x4*)(gqn + 32 * bj + 16 * n + 4 * fq) * r);
                    asm volatile("" ::: "memory");
                }
        } else {
#pragma unroll
            for (int ai = 0; ai < 2; ++ai)
#pragma unroll
                for (int m = 0; m < 4; ++m) {
                    const int row = u.pm * BM + ai * HALF + wr * 64 + m * 16 + fr;
                    const int pos = row < MP ? (row & (SEQ - 1)) : SEQ + ((row - MP) & 31);
#pragma unroll
                    for (int bj = 0; bj < 2; ++bj) {
                        const int hr = (u.pn - 4) * 8 + wc * 2 + bj;
                        float s = ssq4(acc[ai][bj][m][0]) + ssq4(acc[ai][bj][m][1]);
                        s = red_fq(s);
                        const float r = rsqrtf(s * (1.f / 32.f) + EPSN);
                        const f32x4 x1 = acc[ai][bj][m][0] * *(const f32x4*)(gqr + 4 * fq) * r, x2 = acc[ai][bj][m][1] * *(const f32x4*)(gqr + 16 + 4 * fq) * r;
                        const f32x4 cs = *(const f32x4*)(CS + pos * 32 + 4 * fq), sn = *(const f32x4*)(CS + pos * 32 + 16 + 4 * fq);
                        bf16_t* d = Q + (size_t)row * 1536 + hr * 96 + 64 + 4 * fq;
                        *(u32x2*)d = pk4((x1 * cs - x2 * sn) * QSCALE_B); *(u32x2*)(d + 16) = pk4((x2 * cs + x1 * sn) * QSCALE_B);
                        asm volatile("" ::: "memory");
                    }
                }
        }
    }
};
struct EpiUkv {
    static constexpr bool PERM = false, AFTER_DRAIN = false;
    bf16_t *KN, *VB; const float* gkn;
    __device__ __forceinline__ void operator()(const f32x4 (&acc)[2][2][4][2], const Unit& u, int wr, int wc, int fr, int fq) const {
        const bool isk = u.pn < 4; const int head = (u.pn & 3) * 4 + wc;
#pragma unroll
        for (int ai = 0; ai < 2; ++ai)
#pragma unroll
            for (int m = 0; m < 4; ++m) {
                const int row = u.pm * BM + ai * HALF + wr * 64 + m * 16 + fr;
                float r = 1.f;
                if (isk) { float s = (ssq4(acc[ai][0][m][0]) + ssq4(acc[ai][0][m][1])) + (ssq4(acc[ai][1][m][0]) + ssq4(acc[ai][1][m][1])); s = red_fq(s); r = rsqrtf(s * (1.f / 64.f) + EPSN); }
                bf16_t* d = (isk ? KN : VB) + (size_t)row * 1024 + head * 64 + 4 * fq;
#pragma unroll
                for (int bj = 0; bj < 2; ++bj)
#pragma unroll
                    for (int n = 0; n < 2; ++n) { const f32x4 gg = isk ? *(const f32x4*)(gkn + 32 * bj + 16 * n + 4 * fq) : (f32x4){1.f, 1.f, 1.f, 1.f}; *(u32x2*)(d + 32 * bj + 16 * n) = pk4(acc[ai][bj][m][n] * gg * r); }
                asm volatile("" ::: "memory");
            }
    }
};
}
namespace at {
#define ALAS __attribute__((address_space(3)))
typedef unsigned short bf16_t;
typedef short bf16x8 __attribute__((ext_vector_type(8)));
typedef short s16x4 __attribute__((ext_vector_type(4)));
typedef float f32x16 __attribute__((ext_vector_type(16)));
typedef float f32x4 __attribute__((ext_vector_type(4)));
typedef unsigned u32x4 __attribute__((ext_vector_type(4)));
typedef unsigned u32x2 __attribute__((ext_vector_type(2)));
constexpr int KROW = 144, VROW = 144, RROW = 80;
constexpr int KBUF = 64 * KROW, VBUF = 64 * VROW, RBUF = 64 * RROW, STAGE = KBUF + VBUF + RBUF;
constexpr int NSTAGE = 2, TBL_OFF = NSTAGE * STAGE, LDS_BYTES = TBL_OFF + 1280;
struct AttnUnit { int qrow0, nq, krow0, nt, lastvalid, head, c0, tf; };
__device__ __forceinline__ int crow(int r, int hi) { return (r & 3) + 8 * (r >> 2) + 4 * hi; }

template <bool MLA>
__device__ __forceinline__ void attn_unit(ALAS unsigned char* lds, const AttnUnit u, const bf16_t* __restrict__ Q, const bf16_t* __restrict__ Kn, const bf16_t* __restrict__ Kr,
                                          const bf16_t* __restrict__ V, const bf16_t* __restrict__ Z, bf16_t* __restrict__ U, const float* __restrict__ tbl) {
    const int tid = threadIdx.x, lane = tid & 63, wid = __builtin_amdgcn_readfirstlane(tid >> 6), l32 = lane & 31, hi = lane >> 5;
    const int ci = wid >> 1, qh = wid & 1;
    const bool active = ci * 64 + qh * 32 < u.nq;
    const int cq = u.c0 + ci;
    constexpr int QS = MLA ? 1536 : 1024, HS = MLA ? 96 : 64, ND0 = MLA ? 6 : 4;
    constexpr float THR = 8.f;
    ALAS float* tb = (ALAS float*)(lds + TBL_OFF);
    if (!MLA) { if (tid < 320) tb[tid] = tid < 257 ? (tbl[(size_t)u.head * 257 + tid] - tbl[(size_t)u.head * 257 + 256]) * LOG2E : 0.f; }
    const int qrow = u.qrow0 + (active ? ci * 64 + qh * 32 : 0) + l32;
    bf16x8 qf[ND0];
#pragma unroll
    for (int d0 = 0; d0 < ND0; ++d0) qf[d0] = *(const bf16x8*)(Q + (size_t)qrow * QS + u.head * HS + d0 * 16 + hi * 8);
    const char* kbase = (const char*)(Kn + (size_t)u.krow0 * 1024 + u.head * 64);
    const char* vbase = (const char*)(V + (size_t)u.krow0 * 1024 + u.head * 64);
    const char* rbase = MLA ? (const char*)(Kr + (size_t)u.krow0 * 32) : nullptr;
    const unsigned koff = (unsigned)(((tid >> 3) * 1024 + (tid & 7) * 8) * 2);
    const int vkvq = (tid & 3) + 4 * ((tid >> 6) & 3), vdq = (tid >> 2) & 15;
    const unsigned voff = (unsigned)(((vkvq * 4) * 1024 + vdq * 4) * 2);
    const int vpos8 = (vkvq & ~3) + ((vkvq & 1) << 1) + ((vkvq >> 1) & 1);
    const unsigned roff = (unsigned)(((((tid - 256) >> 2) & 63) * 32 + (tid & 3) * 8) * 2);
    u32x4 kreg[1]; u32x2 vreg[1][4]; u32x4 rreg[1];
#define AT_GLOAD(ti, sx) do { const int tl_ = (ti) < u.nt ? (ti) : u.nt - 1; \
        kreg[sx] = *(const u32x4*)(kbase + (size_t)tl_ * 131072 + koff); \
        if (tid < 256) { const char* vb_ = vbase + (size_t)tl_ * 131072; \
            vreg[sx][0] = *(const u32x2*)(vb_ + voff); vreg[sx][1] = *(const u32x2*)(vb_ + voff + 2048); vreg[sx][2] = *(const u32x2*)(vb_ + 4096 + voff); vreg[sx][3] = *(const u32x2*)(vb_ + 4096 + voff + 2048); } \
        else if (MLA) { rreg[sx] = *(const u32x4*)(rbase + (size_t)tl_ * 4096 + roff); } } while (0)
#define AT_SWRITE(st, sx) do { ALAS unsigned char* sb_ = lds + (st) * STAGE; \
        *(ALAS u32x4*)(sb_ + (tid >> 3) * KROW + (tid & 7) * 16) = kreg[sx]; \
        if (tid < 256) { \
            _Pragma("unroll") for (int jj_ = 0; jj_ < 4; ++jj_) { const int d_ = 4 * vdq + jj_; u32x2 o_; \
                const unsigned sel_ = (jj_ & 1) ? 0x07060302u : 0x05040100u; \
                if (jj_ < 2) { o_.x = __builtin_amdgcn_perm(vreg[sx][1].x, vreg[sx][0].x, sel_); o_.y = __builtin_amdgcn_perm(vreg[sx][3].x, vreg[sx][2].x, sel_); } \
                else         { o_.x = __builtin_amdgcn_perm(vreg[sx][1].y, vreg[sx][0].y, sel_); o_.y = __builtin_amdgcn_perm(vreg[sx][3].y, vreg[sx][2].y, sel_); } \
                *(ALAS u32x2*)(sb_ + KBUF + d_ * VROW + vpos8 * 8) = o_; } } \
        else if (MLA) { const int t2_ = tid - 256; *(ALAS u32x4*)(sb_ + KBUF + VBUF + (t2_ >> 2) * RROW + (t2_ & 3) * 16) = rreg[sx]; } } while (0)
    float mref = 0.f;
    bool first = true;
    f32x16 negm = f32x16{}; asm volatile("" : "+v"(negm));
    f32x16 o0 = f32x16{}, o1 = f32x16{}, o2 = f32x16{};
    u32x4 onesw; { const unsigned v1 = (l32 == 0 || l32 == 4) ? 0x3f803f80u : 0u; onesw = (u32x4){v1, v1, v1, v1}; }
    const bf16x8 onesf = __builtin_bit_cast(bf16x8, onesw);
    f32x16 p[2];
    const int tgl = (qh * 32 + l32 + 128 - 4 * hi) * 4;
#define AT_QK(t, sg) do { const int kc_ = u.tf + (t); ALAS unsigned char* sb_ = lds + (sg) * STAGE; ALAS unsigned char* kb_ = sb_ + l32 * KROW + hi * 16; \
        bool near_ = false; \
        if (!MLA) { near_ = cq - kc_ < 3; \
            if (near_) { ALAS unsigned char* tp_ = (ALAS unsigned char*)tb + tgl + 256 * (cq - kc_); \
                _Pragma("unroll") for (int blk = 0; blk < 2; ++blk) _Pragma("unroll") for (int r = 0; r < 16; ++r) p[blk][r] = *(const ALAS float*)(tp_ - 4 * (32 * blk + (r & 3) + 8 * (r >> 2))) - mref; } } \
        bf16x8 ka_[4], kb2_[4]; ALAS unsigned char* rb_ = sb_ + KBUF + VBUF + l32 * RROW + hi * 16; \
        _Pragma("unroll") for (int d0 = 0; d0 < 4; ++d0) ka_[d0] = *(const ALAS bf16x8*)(kb_ + d0 * 32); \
        _Pragma("unroll") for (int d0 = 0; d0 < 4; ++d0) kb2_[d0] = *(const ALAS bf16x8*)(kb_ + 32 * KROW + d0 * 32); \
        __builtin_amdgcn_sched_barrier(0); \
        if (near_) p[0] = __builtin_amdgcn_mfma_f32_32x32x16_bf16(ka_[0], qf[0], p[0], 0, 0, 0); else p[0] = __builtin_amdgcn_mfma_f32_32x32x16_bf16(ka_[0], qf[0], negm, 0, 0, 0); \
        _Pragma("unroll") for (int d0 = 1; d0 < 4; ++d0) p[0] = __builtin_amdgcn_mfma_f32_32x32x16_bf16(ka_[d0], qf[d0], p[0], 0, 0, 0); \
        if (MLA) { __builtin_amdgcn_sched_barrier(0); ka_[0] = *(const ALAS bf16x8*)(rb_); ka_[1] = *(const ALAS bf16x8*)(rb_ + 32); ka_[2] = *(const ALAS bf16x8*)(rb_ + 32 * RROW); ka_[3] = *(const ALAS bf16x8*)(rb_ + 32 * RROW + 32); __builtin_amdgcn_sched_barrier(0); } \
        if (near_) p[1] = __builtin_amdgcn_mfma_f32_32x32x16_bf16(kb2_[0], qf[0], p[1], 0, 0, 0); else p[1] = __builtin_amdgcn_mfma_f32_32x32x16_bf16(kb2_[0], qf[0], negm, 0, 0, 0); \
        _Pragma("unroll") for (int d0 = 1; d0 < 4; ++d0) p[1] = __builtin_amdgcn_mfma_f32_32x32x16_bf16(kb2_[d0], qf[d0], p[1], 0, 0, 0); \
        if (MLA) { p[0] = __builtin_amdgcn_mfma_f32_32x32x16_bf16(ka_[0], qf[4], p[0], 0, 0, 0); p[1] = __builtin_amdgcn_mfma_f32_32x32x16_bf16(ka_[2], qf[4], p[1], 0, 0, 0); \
                   p[0] = __builtin_amdgcn_mfma_f32_32x32x16_bf16(ka_[1], qf[ND0 - 1], p[0], 0, 0, 0); p[1] = __builtin_amdgcn_mfma_f32_32x32x16_bf16(ka_[3], qf[ND0 - 1], p[1], 0, 0, 0); } \
        if ((t) == u.nt - 1 && u.lastvalid < 64) { _Pragma("unroll") for (int r = 0; r < 16; ++r) p[1][r] = -__builtin_inff(); } } while (0)
#define AT_SMPV(t, sg) do { ALAS unsigned char* vb_ = lds + (sg) * STAGE + KBUF + l32 * VROW + hi * 16; \
        bf16x8 vf_[2][4]; \
        _Pragma("unroll") for (int dblk = 0; dblk < 2; ++dblk) _Pragma("unroll") for (int j = 0; j < 4; ++j) vf_[dblk][j] = *(const ALAS bf16x8*)(vb_ + dblk * 32 * VROW + j * 32); \
        __builtin_amdgcn_sched_barrier(0); \
        float rm = p[0][0]; \
        _Pragma("unroll") for (int r = 1; r < 16; ++r) rm = fmaxf(rm, p[0][r]); \
        _Pragma("unroll") for (int r = 0; r < 16; ++r) rm = fmaxf(rm, p[1][r]); \
        rm = fmaxf(rm, __shfl_xor(rm, 32)); \
        if (first || __any(rm > THR)) { \
            const float dl = first ? rm : fmaxf(rm, 0.f); mref += dl; \
            _Pragma("unroll") for (int r = 0; r < 16; ++r) { p[0][r] -= dl; p[1][r] -= dl; } \
            _Pragma("unroll") for (int r = 0; r < 16; ++r) negm[r] = -mref; \
            asm volatile("" : "+v"(negm)); \
            if (!first) { const float al = __builtin_amdgcn_exp2f(-dl); o2[0] *= al; \
                _Pragma("unroll") for (int r = 0; r < 16; ++r) { o0[r] *= al; o1[r] *= al; } } \
            first = false; } \
        _Pragma("unroll") for (int blk = 0; blk < 2; ++blk) _Pragma("unroll") for (int r = 0; r < 16; ++r) p[blk][r] = __builtin_amdgcn_exp2f(p[blk][r]); \
        bf16x8 pk[4]; \
        _Pragma("unroll") for (int j = 0; j < 4; ++j) { u32x4 w; const int b = j >> 1, r0 = 8 * (j & 1); \
            w.x = pg8::pkbf(p[b][r0 + 0], p[b][r0 + 1]); w.y = pg8::pkbf(p[b][r0 + 2], p[b][r0 + 3]); w.z = pg8::pkbf(p[b][r0 + 4], p[b][r0 + 5]); w.w = pg8::pkbf(p[b][r0 + 6], p[b][r0 + 7]); \
            pk[j] = __builtin_bit_cast(bf16x8, w); } \
        _Pragma("unroll") for (int j = 0; j < 4; ++j) { \
            o0 = __builtin_amdgcn_mfma_f32_32x32x16_bf16(vf_[0][j], pk[j], o0, 0, 0, 0); \
            o1 = __builtin_amdgcn_mfma_f32_32x32x16_bf16(vf_[1][j], pk[j], o1, 0, 0, 0); \
            o2 = __builtin_amdgcn_mfma_f32_32x32x16_bf16(onesf, pk[j], o2, 0, 0, 0); } } while (0)
#define AT_TAKE(t) (active && (u.tf + (t)) <= cq && (MLA || (u.tf + (t)) >= cq - 8))
    AT_GLOAD(0, 0); AT_SWRITE(0, 0);
    __syncthreads();
    for (int ti = 0; ti < u.nt; ++ti) {
        const bool more = ti + 1 < u.nt;
        if (more) AT_GLOAD(ti + 1, 0);
        if (AT_TAKE(ti)) { AT_QK(ti, ti & 1); AT_SMPV(ti, ti & 1); }
        if (more) AT_SWRITE((ti + 1) & 1, 0);
        __syncthreads();
    }
#undef AT_QK
#undef AT_SMPV
#undef AT_TAKE
    if (active) {
        const float inv = 1.f / o2[0];
        const size_t ob = (size_t)qrow * 1024 + u.head * 64 + 4 * hi;
#pragma unroll
        for (int dblk = 0; dblk < 2; ++dblk)
#pragma unroll
            for (int g = 0; g < 4; ++g) {
                const u32x2 zz = *(const u32x2*)(Z + ob + 32 * dblk + 8 * g);
                const float z0 = __uint_as_float(zz.x << 16), z1 = __uint_as_float(zz.x & 0xffff0000u), z2 = __uint_as_float(zz.y << 16), z3 = __uint_as_float(zz.y & 0xffff0000u);
                const f32x16& o = dblk == 0 ? o0 : o1;
                u32x2 w; w.x = pg8::pkbf(o[4 * g + 0] * inv * z0, o[4 * g + 1] * inv * z1); w.y = pg8::pkbf(o[4 * g + 2] * inv * z2, o[4 * g + 3] * inv * z3);
                *(u32x2*)(U + ob + 32 * dblk + 8 * g) = w;
            }
    }
#undef AT_GLOAD
#undef AT_SWRITE
}
__device__ __forceinline__ bool prompt_unit(int k, int G, int bid, int& bh, int& qb) {
    if (G == 256) { if (k >= 16) return false; const int x = bid & 7, j = bid >> 3; bh = (4 * k + (j >> 3)) * 8 + x; qb = ((j & 7) + k) & 7; return true; }
    const int u = bid + k * G; if (u >= 4096) return false; bh = u >> 3; qb = u & 7; return true;
}
}
#define LAS __attribute__((address_space(3)))
typedef unsigned short bf16;
typedef unsigned v4u __attribute__((ext_vector_type(4)));
typedef unsigned v2u __attribute__((ext_vector_type(2)));
typedef float f32x4 __attribute__((ext_vector_type(4)));
constexpr size_t MiB = 1u << 20;
constexpr size_t WS_MOD = 0;
constexpr size_t MOD_BYTES = 2 * 40 * 3072 * 4;
constexpr size_t WS_CS = 1 * MiB;
constexpr size_t WS_W_AIN = 4 * MiB, WS_W_AOUT = 12 * MiB, WS_W_BIN = 14 * MiB, WS_W_UQ = 18 * MiB, WS_W_UKV = 20 * MiB, WS_W_BOUT = 22 * MiB;
constexpr size_t WS_H = 24 * MiB;
constexpr size_t WS_CKV = 153 * MiB;
constexpr size_t WS_KR = 194 * MiB;
constexpr size_t WS_X = 200 * MiB;
constexpr size_t WS_QA = WS_X, WS_KA = WS_X + 129 * MiB, WS_VA = WS_X + 267 * MiB, WS_ZA = WS_X + 405 * MiB;
constexpr size_t WS_ZB = WS_X, WS_RAW = WS_X + 129 * MiB, WS_QB = WS_RAW, WS_CQ = WS_X + 322 * MiB, WS_KN = WS_X + 371 * MiB, WS_VB = WS_X + 532 * MiB;
constexpr size_t WS_END = WS_X + 694 * MiB;
static_assert((size_t)M1 * 1024 * 2 <= 129 * MiB && (size_t)RA * 1024 * 2 <= 138 * MiB && (size_t)M1 * 768 * 4 <= 193 * MiB && (size_t)M1 * 384 * 2 <= 49 * MiB && (size_t)R2 * 1024 * 2 <= 161 * MiB, "ws map");
static_assert((size_t)R2 * 256 * 2 <= 41 * MiB && (size_t)R2 * 32 * 2 <= 6 * MiB && WS_ZA + 129 * MiB <= WS_END && WS_VB + 161 * MiB <= WS_END && WS_END <= 1024 * MiB, "ws map");
constexpr size_t O_YP = 0, O_YS = 67108864, O_AKP = 67371008, O_AVP = 84148224, O_AKS = 100925440, O_AVS = 101187584, O_CKVP = 101449728, O_KRP = 118226944, O_CKVS = 120324096, O_KRS = 120389632;
constexpr int LDS_TOTAL = 147456;
static_assert(at::LDS_BYTES <= LDS_TOTAL && pg8::STAGE_BYTES <= LDS_TOTAL, "LDS");

__device__ __forceinline__ float wave_sum(float v) {
#pragma unroll
    for (int o = 1; o < 64; o <<= 1) v += __shfl_xor(v, o);
    return v;
}
__device__ __forceinline__ unsigned pk2(float lo, float hi) { return pg8::pkbf(lo, hi); }
__device__ __forceinline__ int src_col(int gemm, int g) {
    const int lc = ((g >> 3) * 8 + (g & 3) * 2 + ((g >> 2) & 1)) * 32;
    switch (gemm) {
    case 2: if (lc < 1024) return 672 + lc; if (lc < 1408) return lc - 1024; if (lc < 1664) return 384 + (lc - 1408); if (lc < 1696) return 640 + (lc - 1664); return -1;
    case 3: if (lc < 1024) return (lc >> 6) * 96 + (lc & 63); return ((lc - 1024) >> 5) * 96 + 64;
    case 4: if (lc < 1024) return (lc >> 6) * 128 + (lc & 63); return ((lc - 1024) >> 6) * 128 + 64 + (lc & 63);
    default: return lc;
    }
}
__device__ __forceinline__ void transpose_item(const float* W, int K, int Nsrc, int sc, bf16* WT, int g, int k0, LAS float* scr, int lane) {
#pragma unroll 8
    for (int i = 0; i < 32; ++i) { const int kk = 2 * i + (lane >> 5); scr[kk * 33 + (lane & 31)] = sc >= 0 ? W[(size_t)(k0 + kk) * Nsrc + sc + (lane & 31)] : 0.f; }
    asm volatile("s_waitcnt lgkmcnt(0)" ::: "memory");
    const int c = lane & 7;
#pragma unroll
    for (int j = 0; j < 4; ++j) { const int n = (lane >> 3) + 8 * j; const LAS float* s = scr + (8 * c) * 33 + n;
        v4u o; o.x = pk2(s[0 * 33], s[1 * 33]); o.y = pk2(s[2 * 33], s[3 * 33]); o.z = pk2(s[4 * 33], s[5 * 33]); o.w = pk2(s[6 * 33], s[7 * 33]);
        *(v4u*)(WT + (size_t)(32 * g + n) * K + k0 + 8 * c) = o; }
    asm volatile("s_waitcnt lgkmcnt(0)" ::: "memory");
}
__device__ __forceinline__ void cvt8(const float* s, bf16* d) { const f32x4 a = *(const f32x4*)s, b = *(const f32x4*)(s + 4); v4u o; o.x = pk2(a[0], a[1]); o.y = pk2(a[2], a[3]); o.z = pk2(b[0], b[1]); o.w = pk2(b[2], b[3]); *(v4u*)d = o; }

struct Args { const float* in[26]; float* out; unsigned char* ws; int ph_lo, ph_hi; };

__device__ __forceinline__ void adanorm_rows(const float* xp, const float* xs, const float* g, const float* mod, bf16* H, int gw, int NGW, int lane) {
    for (int row = gw; row < M1; row += NGW) {
        const float* xr; int bb;
        if (row < MP) { xr = xp + (size_t)row * 1024; bb = row >> 11; } else { xr = xs + (size_t)(row - MP) * 1024; bb = NBP + ((row - MP) >> 5); }
        const float* md = mod + (size_t)bb * 3072;
        f32x4 v[4]; float s = 0.f;
#pragma unroll
        for (int j = 0; j < 4; ++j) { v[j] = *(const f32x4*)(xr + 4 * lane + 256 * j); s += pg8::ssq4(v[j]); }
        const float r = rsqrtf(wave_sum(s) * (1.f / 1024.f) + EPSN);
#pragma unroll
        for (int j = 0; j < 4; ++j) { const int c = 4 * lane + 256 * j;
            const f32x4 gg = *(const f32x4*)(g + c), sh = *(const f32x4*)(md + c), sc = *(const f32x4*)(md + 1024 + c);
            const f32x4 h = v[j] * r * gg * (sc + 1.f) + sh;
            v2u o; o.x = pk2(h[0], h[1]); o.y = pk2(h[2], h[3]); *(v2u*)(H + (size_t)row * 1024 + c) = o; }
    }
}

__global__ void __launch_bounds__(512, 2) hybrid_fwd(Args args) {
    extern __shared__ __attribute__((aligned(16))) unsigned char lds_raw[];
    LAS unsigned char* lds = (LAS unsigned char*)lds_raw;
    const int tid = threadIdx.x, lane = tid & 63, wave = __builtin_amdgcn_readfirstlane(tid >> 6);
    const int G = gridDim.x, bid = blockIdx.x;
    const int gw = bid * 8 + wave, NGW = G * 8;
    const int gt = bid * 512 + tid, NGT = G * 512;
    const int lo = args.ph_lo, hi = args.ph_hi;
#ifndef PHMASK
#define PHMASK 0x7ff
#endif
#ifndef PROBE_REP
#define PROBE_REP 0
#endif
#define REP(k) for (int rep_ = 0; rep_ < 1 + ((PROBE_REP >> (k)) & 1); ++rep_)
#define IN(k) (((PHMASK >> (k)) & 1) && lo <= (k) && (k) < hi)
typedef const __attribute__((address_space(4))) Args* KArgs;
#define PHASE_ARGS() KArgs A = (KArgs)__builtin_amdgcn_kernarg_segment_ptr(); asm volatile("" : "+s"(A)); unsigned char* ws = A->ws; float* out = A->out; (void)ws; (void)out
#define WSP(T, off) ((T*)(ws + (off)))
#define SEAM(k) do { if (IN(k) && IN((k) + 1)) { cg::this_grid().sync(); } } while (0)

    if (IN(0)) REP(0) {
        PHASE_ARGS();
        float* mod = WSP(float, WS_MOD); float* CS = WSP(float, WS_CS);
        bf16 *W_AIN = WSP(bf16, WS_W_AIN), *W_AOUT = WSP(bf16, WS_W_AOUT), *W_BIN = WSP(bf16, WS_W_BIN), *W_UQ = WSP(bf16, WS_W_UQ), *W_UKV = WSP(bf16, WS_W_UKV), *W_BOUT = WSP(bf16, WS_W_BOUT);
        bf16 *KA = WSP(bf16, WS_KA), *VA = WSP(bf16, WS_VA), *CKV = WSP(bf16, WS_CKV), *KR = WSP(bf16, WS_KR);
        {
            LAS float* scr = (LAS float*)(lds + wave * 10240);
            constexpr int I0 = 16 * 128, I1 = 16 * 32, I2 = 16 * 56, I3 = 6 * 48, I4 = 4 * 64, I5 = 16 * 32;
            for (int it = gw; it < I0 + I1 + I2 + I3 + I4 + I5; it += NGW) {
                int r = it;
                if (r < I0) { const int g = r % 128; transpose_item(A->in[11], 1024, 4096, src_col(0, g), W_AIN, g, (r / 128) * 64, scr, lane); continue; } r -= I0;
                if (r < I1) { const int g = r % 32; transpose_item(A->in[15], 1024, 1024, src_col(1, g), W_AOUT, g, (r / 32) * 64, scr, lane); continue; } r -= I1;
                if (r < I2) { const int g = r % 56; transpose_item(A->in[16], 1024, 1696, src_col(2, g), W_BIN, g, (r / 56) * 64, scr, lane); continue; } r -= I2;
                if (r < I3) { const int g = r % 48; transpose_item(A->in[18], 384, 1536, src_col(3, g), W_UQ, g, (r / 48) * 64, scr, lane); continue; } r -= I3;
                if (r < I4) { const int g = r % 64; transpose_item(A->in[20], 256, 2048, src_col(4, g), W_UKV, g, (r / 64) * 64, scr, lane); continue; } r -= I4;
                { const int g = r % 32; transpose_item(A->in[25], 1024, 1024, src_col(5, g), W_BOUT, g, (r / 32) * 64, scr, lane); }
            }
        }
        for (int it = bid; it < 2 * 48; it += G) {
            const int l = it / 48, jb = it % 48;
            LAS float* sl = (LAS float*)(lds + wave * 10240);
            float acc[40];
#pragma unroll
            for (int b = 0; b < 40; ++b) acc[b] = 0.f;
            for (int pass = 0; pass < 2; ++pass) {
                const int k0 = (wave + 8 * pass) * 64;
                for (int e = lane; e < 40 * 64; e += 64) { const int bb = e >> 6, k = e & 63; const float c = bb < NBP ? A->in[6][(size_t)bb * 1024 + k0 + k] : A->in[7][(size_t)(bb - NBP) * 1024 + k0 + k]; sl[e] = c / (1.f + __expf(-c)); }
                asm volatile("s_waitcnt lgkmcnt(0)" ::: "memory");
                const float* W = A->in[9] + (size_t)l * 1024 * 3072 + (size_t)k0 * 3072 + jb * 64 + lane;
                for (int k = 0; k < 64; k += 4) {
                    const float w0 = W[(size_t)k * 3072], w1 = W[(size_t)(k + 1) * 3072], w2 = W[(size_t)(k + 2) * 3072], w3 = W[(size_t)(k + 3) * 3072];
#pragma unroll
                    for (int b = 0; b < 40; ++b) { const f32x4 sv = *(const LAS f32x4*)(sl + b * 64 + k); acc[b] += (sv[0] * w0 + sv[1] * w1) + (sv[2] * w2 + sv[3] * w3); }
                }
                asm volatile("s_waitcnt lgkmcnt(0)" ::: "memory");
            }
            __syncthreads();
            LAS float* red = (LAS float*)lds;
#pragma unroll
            for (int b = 0; b < 40; ++b) red[(wave * 40 + b) * 64 + lane] = acc[b];
            __syncthreads();
            for (int e = tid; e < 40 * 64; e += 512) { const int b = e >> 6, j = e & 63; float sum = A->in[10][(size_t)l * 3072 + jb * 64 + j];
#pragma unroll
                for (int w = 0; w < 8; ++w) sum += red[(w * 40 + b) * 64 + j];
                mod[((size_t)l * 40 + b) * 3072 + jb * 64 + j] = sum; }
            __syncthreads();
        }
        for (int i = gt; i < NBS * SA_STRIDE * 128; i += NGT) {
            const int c8 = i & 127, rr = (i >> 7) % SA_STRIDE, bs = (i >> 7) / SA_STRIDE;
            const size_t d = ((size_t)MP + (size_t)bs * SA_STRIDE + rr) * 1024 + c8 * 8;
            if (rr < 512) { const size_t s = ((size_t)bs * 512 + rr) * 1024 + c8 * 8; cvt8(A->in[2] + s, KA + d); cvt8(A->in[3] + s, VA + d); }
            else if (rr >= 544) { *(v4u*)(KA + d) = (v4u){0, 0, 0, 0}; *(v4u*)(VA + d) = (v4u){0, 0, 0, 0}; }
        }
        for (int i = gt; i < NBS * SB_STRIDE * 32; i += NGT) {
            const int c8 = i & 31, rr = (i >> 5) % SB_STRIDE, bs = (i >> 5) / SB_STRIDE;
            const size_t d = ((size_t)MP + (size_t)bs * SB_STRIDE + rr) * 256 + c8 * 8;
            if (rr < 2048) cvt8(A->in[4] + ((size_t)bs * 2048 + rr) * 256 + c8 * 8, CKV + d);
            else if (rr >= 2080) *(v4u*)(CKV + d) = (v4u){0, 0, 0, 0};
        }
        for (int i = gt; i < NBS * SB_STRIDE * 4; i += NGT) {
            const int c8 = i & 3, rr = (i >> 2) % SB_STRIDE, bs = (i >> 2) / SB_STRIDE;
            const size_t d = ((size_t)MP + (size_t)bs * SB_STRIDE + rr) * 32 + c8 * 8;
            if (rr < 2048) cvt8(A->in[5] + ((size_t)bs * 2048 + rr) * 32 + c8 * 8, KR + d);
            else if (rr >= 2080) *(v4u*)(KR + d) = (v4u){0, 0, 0, 0};
        }
        for (int i = gt; i < 2112 * 16; i += NGT) {
            const int pos = i >> 4, k = i & 15;
            const float inv = exp2f(-(float)k * (13.287712379549449f / 16.f));
            const float ang = (float)pos * inv;
            const double tr = (double)ang * 0.15915494309189535;
            const float fr = (float)(tr - floor(tr + 0.5));
            CS[pos * 32 + k] = __builtin_amdgcn_cosf(fr); CS[pos * 32 + 16 + k] = __builtin_amdgcn_sinf(fr);
        }
    }
    SEAM(0);
    if (IN(1)) REP(1) { PHASE_ARGS(); adanorm_rows(A->in[0], A->in[1], A->in[8], WSP(float, WS_MOD), WSP(bf16, WS_H), gw, NGW, lane); }
    SEAM(1);
    if (IN(2)) REP(2) {
        PHASE_ARGS();
        int Kop = 1024; asm volatile("" : "+s"(Kop)); pg8::Gemm g{WSP(bf16, WS_H), WSP(bf16, WS_W_AIN), M1, 4096, Kop}; pg8::StaticOrder S; S.init(M1, 4096, G, bid);
        pg8::EpiAin E{WSP(bf16, WS_QA), WSP(bf16, WS_KA), WSP(bf16, WS_VA), WSP(bf16, WS_ZA), A->in[12], A->in[13], out + O_AKP, out + O_AVP, out + O_AKS, out + O_AVS};
        pg8::gemm_phase<pg8::EpiAin, pg8::StaticOrder, true, true>(lds, g, S, E);
    }
    SEAM(2);
    if (IN(3)) REP(3) {
        PHASE_ARGS();
        bf16 *QA = WSP(bf16, WS_QA), *KA = WSP(bf16, WS_KA), *VA = WSP(bf16, WS_VA), *ZA = WSP(bf16, WS_ZA), *H = WSP(bf16, WS_H); const float* tblp = A->in[14];
        __syncthreads();
        { int bh, qb;
          for (int k = 0; at::prompt_unit(k, G, bid, bh, qb); ++k) {
            at::AttnUnit a; const int b = bh >> 4, c0 = 4 * qb, tf = c0 > 8 ? c0 - 8 : 0;
            a.qrow0 = b * SEQ + 256 * qb; a.nq = 256; a.krow0 = b * SEQ + 64 * tf; a.nt = c0 + 3 - tf + 1; a.lastvalid = 64; a.head = bh & 15; a.c0 = c0; a.tf = tf;
            at::attn_unit<false>(lds, a, QA, KA, nullptr, VA, ZA, H, tblp);
          } }
        for (int s = bid; s < 128; s += G) {
            at::AttnUnit a; const int bs = s >> 4;
            a.qrow0 = MP + bs * TS; a.nq = 32; a.krow0 = MP + bs * SA_STRIDE; a.nt = 9; a.lastvalid = 32; a.head = s & 15; a.c0 = 8; a.tf = 0;
            at::attn_unit<false>(lds, a, QA, KA, nullptr, VA, ZA, H, tblp);
        }
    }
    SEAM(3);
    if (IN(4)) REP(4) {
        PHASE_ARGS();
        int Kop = 1024; asm volatile("" : "+s"(Kop)); pg8::Gemm g{WSP(bf16, WS_H), WSP(bf16, WS_W_AOUT), M1, 1024, Kop}; pg8::StaticOrder S; S.init(M1, 1024, G, bid);
        pg8::EpiRes E{A->in[0], A->in[1], out + O_YP, out + O_YS, WSP(float, WS_MOD) + 2048};
        pg8::gemm_phase<pg8::EpiRes, pg8::StaticOrder, true, true>(lds, g, S, E);
    }
    SEAM(4);
    if (IN(5)) REP(5) { PHASE_ARGS(); adanorm_rows(out + O_YP, out + O_YS, A->in[8] + 1024, WSP(float, WS_MOD) + 40 * 3072, WSP(bf16, WS_H), gw, NGW, lane); }
    SEAM(5);
    if (IN(6)) REP(6) {
        PHASE_ARGS();
        int Kop = 1024; asm volatile("" : "+s"(Kop)); pg8::Gemm g{WSP(bf16, WS_H), WSP(bf16, WS_W_BIN), M1, 1792, Kop}; pg8::StaticOrder S; S.init(M1, 1792, G, bid);
        pg8::EpiBin E{WSP(bf16, WS_ZB), WSP(float, WS_RAW)};
        pg8::gemm_phase<pg8::EpiBin, pg8::StaticOrder, true, true>(lds, g, S, E);
    }
    SEAM(6);
    if (IN(7)) REP(7) {
        PHASE_ARGS();
        const float* RAW = WSP(float, WS_RAW); const float* CS = WSP(float, WS_CS); bf16 *CQ = WSP(bf16, WS_CQ), *CKV = WSP(bf16, WS_CKV), *KR = WSP(bf16, WS_KR);
        const float *gcq = A->in[17], *gckv = A->in[19], *gkr = A->in[24];
        for (int row = gw; row < M1; row += NGW) {
            const float* rw = RAW + (size_t)row * 768;
            int pos; size_t drow, orow;
            if (row < MP) { pos = row & (SEQ - 1); drow = (size_t)row; orow = (size_t)row; }
            else { const int rs = row - MP; pos = SEQ + (rs & 31); drow = (size_t)MP + (size_t)(rs >> 5) * SB_STRIDE + 2048 + (rs & 31); orow = (size_t)rs; }
            float* ockv = (row < MP ? out + O_CKVP : out + O_CKVS) + orow * 256;
            float* okr = (row < MP ? out + O_KRP : out + O_KRS) + orow * 32;
            float q[6]; float s = 0.f;
#pragma unroll
            for (int j = 0; j < 6; ++j) { q[j] = rw[lane + 64 * j]; s += q[j] * q[j]; }
            float r = rsqrtf(wave_sum(s) * (1.f / 384.f) + EPSN);
#pragma unroll
            for (int j = 0; j < 6; ++j) { const float v = q[j] * r * gcq[lane + 64 * j]; const unsigned b = pk2(v, 0.f); CQ[(size_t)row * 384 + lane + 64 * j] = (bf16)(b & 0xffffu); }
            const f32x4 kv = *(const f32x4*)(rw + 384 + 4 * lane);
            r = rsqrtf(wave_sum(pg8::ssq4(kv)) * (1.f / 256.f) + EPSN);
            const f32x4 kvn = kv * r * *(const f32x4*)(gckv + 4 * lane);
            *(f32x4*)(ockv + 4 * lane) = kvn;
            { v2u o; o.x = pk2(kvn[0], kvn[1]); o.y = pk2(kvn[2], kvn[3]); *(v2u*)(CKV + drow * 256 + 4 * lane) = o; }
            const float kr = lane < 32 ? rw[640 + lane] : 0.f;
            r = rsqrtf(wave_sum(kr * kr) * (1.f / 32.f) + EPSN);
            const float kn = kr * r * (lane < 32 ? gkr[lane] : 0.f);
            const float pr = __shfl_xor(kn, 16);
            const float cs = CS[pos * 32 + (lane & 15)], sn = CS[pos * 32 + 16 + (lane & 15)];
            const float ro = (lane & 16) ? (kn * cs + pr * sn) : (kn * cs - pr * sn);
            if (lane < 32) { okr[lane] = ro; const unsigned b = pk2(ro, 0.f); KR[drow * 32 + lane] = (bf16)(b & 0xffffu); }
        }
    }
    SEAM(7);
    if (IN(8)) REP(8) {
        { PHASE_ARGS(); int Kop = 384; asm volatile("" : "+s"(Kop)); pg8::Gemm g{WSP(bf16, WS_CQ), WSP(bf16, WS_W_UQ), M1, 1536, Kop}; pg8::StaticOrder S; S.init(M1, 1536, G, bid);
          pg8::EpiUq E{WSP(bf16, WS_QB), A->in[21], A->in[22], WSP(float, WS_CS)};
          pg8::gemm_phase<pg8::EpiUq, pg8::StaticOrder, true, true>(lds, g, S, E); }
        __syncthreads();
        { PHASE_ARGS(); int Kop = 256; asm volatile("" : "+s"(Kop)); pg8::Gemm g{WSP(bf16, WS_CKV), WSP(bf16, WS_W_UKV), R2, 2048, Kop}; pg8::StaticOrder S; S.init(R2, 2048, G, bid);
          pg8::EpiUkv E{WSP(bf16, WS_KN), WSP(bf16, WS_VB), A->in[23]};
          pg8::gemm_phase<pg8::EpiUkv, pg8::StaticOrder, true, true>(lds, g, S, E); }
    }
    SEAM(8);
    if (IN(9)) REP(9) {
        PHASE_ARGS();
        bf16 *QB = WSP(bf16, WS_QB), *KN = WSP(bf16, WS_KN), *KR = WSP(bf16, WS_KR), *VB = WSP(bf16, WS_VB), *ZB = WSP(bf16, WS_ZB), *H = WSP(bf16, WS_H);
        __syncthreads();
        { int bh, qb;
          for (int k = 0; at::prompt_unit(k, G, bid, bh, qb); ++k) {
            at::AttnUnit a; const int b = bh >> 4;
            a.qrow0 = b * SEQ + 256 * qb; a.nq = 256; a.krow0 = b * SEQ; a.nt = 4 * qb + 4; a.lastvalid = 64; a.head = bh & 15; a.c0 = 4 * qb; a.tf = 0;
            at::attn_unit<true>(lds, a, QB, KN, KR, VB, ZB, H, nullptr);
          } }
        for (int s = bid; s < 128; s += G) {
            at::AttnUnit a; const int bs = s >> 4;
            a.qrow0 = MP + bs * TS; a.nq = 32; a.krow0 = MP + bs * SB_STRIDE; a.nt = 33; a.lastvalid = 32; a.head = s & 15; a.c0 = 32; a.tf = 0;
            at::attn_unit<true>(lds, a, QB, KN, KR, VB, ZB, H, nullptr);
        }
    }
    SEAM(9);
    if (IN(10)) REP(10) {
        PHASE_ARGS();
        int Kop = 1024; asm volatile("" : "+s"(Kop)); pg8::Gemm g{WSP(bf16, WS_H), WSP(bf16, WS_W_BOUT), M1, 1024, Kop}; pg8::StaticOrder S; S.init(M1, 1024, G, bid);
        pg8::EpiRes E{out + O_YP, out + O_YS, out + O_YP, out + O_YS, WSP(float, WS_MOD) + 40 * 3072 + 2048};
        pg8::gemm_phase<pg8::EpiRes, pg8::StaticOrder, true, true>(lds, g, S, E);
    }
#undef IN
#undef SEAM
}

constexpr int N_PHASES = 11;
extern "C" void kernel_launch(void* const* d_in, const int* in_sizes, int n_in, void* d_out, int out_size, void* d_ws, size_t ws_size, hipStream_t stream) {
    static int grid = 0;
    if (grid == 0) {
        if (n_in != 26 || ws_size < WS_END) { fprintf(stderr, "kernel_launch: unexpected inputs (n_in %d, ws %zu, need %zu)\n", n_in, ws_size, (size_t)WS_END); grid = -1; return; }
        int dev = 0, cus = 0, per_cu = 0;
        hipGetDevice(&dev); hipDeviceGetAttribute(&cus, hipDeviceAttributeMultiprocessorCount, dev);
        hipFuncSetAttribute((const void*)hybrid_fwd, hipFuncAttributeMaxDynamicSharedMemorySize, LDS_TOTAL);
        hipOccupancyMaxActiveBlocksPerMultiprocessor(&per_cu, (const void*)hybrid_fwd, 512, LDS_TOTAL);
        if (per_cu < 1) { fprintf(stderr, "kernel_launch: occupancy query says %d blocks per CU\n", per_cu); per_cu = 1; }
        (void)hipGetLastError();
        grid = cus * per_cu;
    }
    if (grid < 0) return;
    Args a{};
    for (int i = 0; i < 26; ++i) a.in[i] = (const float*)d_in[i];
    a.out = (float*)d_out; a.ws = (unsigned char*)d_ws;
#if MULTI_LAUNCH
    for (int p = 0; p < N_PHASES; ++p) { a.ph_lo = p; a.ph_hi = p + 1; hipLaunchKernelGGL(hybrid_fwd, dim3(grid), dim3(512), LDS_TOTAL, stream, a); }
#else
    a.ph_lo = 0; a.ph_hi = N_PHASES;
    void* kargs[] = {&a};
    hipError_t e = hipLaunchCooperativeKernel((const void*)hybrid_fwd, dim3(grid), dim3(512), kargs, LDS_TOTAL, stream);
    if (e != hipSuccess) fprintf(stderr, "cooperative launch failed: %s (grid %d)\n", hipGetErrorString(e), grid);
#endif
}
```

```cpp
#include <hip/hip_runtime.h>
#include <hip/hip_cooperative_groups.h>
#include <cstdio>
#include <cstdint>
namespace cg = cooperative_groups;
#ifndef MULTI_LAUNCH
#define MULTI_LAUNCH 0
#endif
constexpr int DMODEL = 1024, NBP = 32, SEQ = 2048, NBS = 8, TS = 32;
constexpr int MP = NBP * SEQ;
constexpr int M1 = MP + NBS * TS;
constexpr int SA_STRIDE = 576;
constexpr int RA = MP + NBS * SA_STRIDE;
constexpr int SB_STRIDE = 2112;
constexpr int R2 = MP + NBS * SB_STRIDE;
constexpr float EPSN = 1e-6f;
constexpr float LOG2E = 1.4426950408889634f;
constexpr float QSCALE_A = 0.125f * LOG2E;
constexpr float QSCALE_B = 0.10206207261596575f * LOG2E;
namespace pg8 {
#define PG8_LAS __attribute__((address_space(3)))
typedef unsigned short bf16_t;
typedef short bf16x8 __attribute__((ext_vector_type(8)));
typedef float f32x4 __attribute__((ext_vector_type(4)));
typedef unsigned u32x4 __attribute__((ext_vector_type(4)));
constexpr int BM = 256, BK = 64, HALF = 128, HTB = HALF * BK * 2  , STAGE_BYTES = 8 * HTB, NXCD = 8, WGM = 8;

__host__ __device__ __forceinline__ int lds_byte(int r, int c) { const int st = (r >> 4) * 2 + (c >> 5), rr = r & 15, cc = c & 31, ob = rr * 64 + cc * 2; return st * 1024 + (ob ^ (((ob >> 9) & 1) << 5)); }
__host__ __device__ __forceinline__ void stage_rc(int b, int& R, int& C) { const int st = b / 1024, sb = b % 1024, swz = sb ^ (((sb >> 9) & 1) << 5); R = (st >> 1) * 16 + swz / 64; C = (st & 1) * 32 + (swz % 64) / 2; }
__host__ __device__ __forceinline__ int perm32(int rho) { const int n = rho >> 4, i = rho & 15; return 8 * (i >> 2) + 4 * n + (i & 3); }

struct Unit { int pm, pn; };
struct Gemm { const bf16_t* A; const bf16_t* Bt; int M, N, K; };

struct StaticOrder {
    int nM, nN, nwg, G, c;
    __host__ __device__ void init(int M, int N, int G_, int c_) { nM = M / BM; nN = N / BM; nwg = nM * nN; G = G_; c = c_; }
    __host__ __device__ bool next(int i, Unit& u) const {
        const long L = (long)i * G + c; if (L >= nwg) return false;
        int wgid = (int)L; { const int q = nwg / NXCD, r = nwg % NXCD, xcd = wgid % NXCD, off = wgid / NXCD; wgid = (xcd < r ? xcd * (q + 1) : r * (q + 1) + (xcd - r) * q) + off; }
        const int nig = WGM * nN, gid = wgid / nig, fm = gid * WGM, gsz = (nM - fm) < WGM ? (nM - fm) : WGM;
        u.pm = fm + ((wgid % nig) % gsz); u.pn = (wgid % nig) / gsz; return true;
    }
    __device__ __forceinline__ void a_ready(const Unit&) const {}
    __device__ __forceinline__ void done(const Unit&) const {}
};

__device__ __forceinline__ unsigned cvt_pk_bf16(float lo, float hi) { unsigned r; asm volatile("v_cvt_pk_bf16_f32 %0, %1, %2" : "=v"(r) : "v"(lo), "v"(hi)); return r; }
template <class Epi, class Sched, bool ALIGN_EPI = false, bool SP2 = false>
__device__ __forceinline__ void gemm_phase(PG8_LAS unsigned char* lds, const Gemm g, const Sched& S, const Epi& E) {
    const int tid = threadIdx.x, wid = __builtin_amdgcn_readfirstlane(tid >> 6), lane = tid & 63, wr = wid >> 2, wc = wid & 3, fr = lane & 15, fq = lane >> 4;
    const int K = g.K, nt = K / BK;
    unsigned voffA[2], voffB[2];
#pragma unroll
    for (int i = 0; i < 2; ++i) { int R, C; stage_rc(tid * 16 + i * 8192, R, C); const int Rb = Epi::PERM ? ((R & ~31) + perm32(R & 31)) : R;
        voffA[i] = (unsigned)(R * K + C) * 2u; voffB[i] = (unsigned)(Rb * K + C) * 2u; }
    const size_t kstep = (size_t)(BK * 2);
    const size_t hstep = (size_t)HALF * K * 2;
    const size_t tstep = 2 * hstep;
    const unsigned ldsw = (unsigned)wid * 1024u;
    const int aoff = lds_byte(wr * 64 + fr, fq * 8), boff = lds_byte(wc * 32 + fr, fq * 8);
#define PG8_SA(b, h) (((b) * 2 + (h)) * HTB)
#define PG8_SB(b, h) ((4 + (b) * 2 + (h)) * HTB)
#define PG8_STAGE(bufoff, gbase, voff) do { _Pragma("unroll") for (int _i = 0; _i < 2; ++_i) \
        __builtin_amdgcn_global_load_lds((const unsigned*)((const char*)(gbase) + (voff)[_i]), (PG8_LAS unsigned*)(lds + (bufoff) + ldsw + _i * 8192), 16, 0, 0); } while (0)
#define PG8_LDA(dst, b, h) do { _Pragma("unroll") for (int m = 0; m < 4; ++m) _Pragma("unroll") for (int k = 0; k < 2; ++k) dst[m][k] = *(const PG8_LAS bf16x8*)(lds + PG8_SA(b, h) + aoff + m * 2048 + k * 1024); } while (0)
#define PG8_LDB(dst, b, h) do { _Pragma("unroll") for (int n = 0; n < 2; ++n) _Pragma("unroll") for (int k = 0; k < 2; ++k) dst[n][k] = *(const PG8_LAS bf16x8*)(lds + PG8_SB(b, h) + boff + n * 2048 + k * 1024); } while (0)
#define PG8_MMA(ai, bj, At, Bt) do { __builtin_amdgcn_s_setprio(1); _Pragma("unroll") for (int m = 0; m < 4; ++m) _Pragma("unroll") for (int n = 0; n < 2; ++n) _Pragma("unroll") for (int k = 0; k < 2; ++k) \
        acc[ai][bj][m][n] = __builtin_amdgcn_mfma_f32_16x16x32_bf16(Bt[n][k], At[m][k], acc[ai][bj][m][n], 0, 0, 0); __builtin_amdgcn_s_setprio(0); } while (0)
#define PG8_WAIT_V(n) asm volatile("s_waitcnt vmcnt(" #n ")" ::: "memory")
#define PG8_WAIT_L(n) asm volatile("s_waitcnt lgkmcnt(" #n ")" ::: "memory")
#define PG8_BAR __builtin_amdgcn_s_barrier()
#define PG8_SCHED __builtin_amdgcn_sched_barrier(0)
    Unit cur, nxt; int ui = 0;
    if (!S.next(0, cur)) return;
    f32x4 acc[2][2][4][2];
#pragma unroll
    for (int a = 0; a < 2; ++a)
#pragma unroll
        for (int b = 0; b < 2; ++b)
#pragma unroll
            for (int m = 0; m < 4; ++m)
#pragma unroll
                for (int n = 0; n < 2; ++n) acc[a][b][m][n] = (f32x4){0.f, 0.f, 0.f, 0.f};
    bf16x8 At[4][2], B0[2][2], B1[2][2];
    const char* cA = (const char*)g.A + (size_t)cur.pm * tstep; const char* cB = (const char*)g.Bt + (size_t)cur.pn * tstep;
    S.a_ready(cur);
    if constexpr (SP2) {
        PG8_STAGE(PG8_SB(0, 0), cB, voffB); PG8_STAGE(PG8_SB(0, 1), cB + hstep, voffB); PG8_STAGE(PG8_SA(0, 0), cA, voffA); PG8_STAGE(PG8_SA(0, 1), cA + hstep, voffA);
        if (wr == 1) PG8_BAR;
        PG8_WAIT_V(2); PG8_BAR;
        PG8_STAGE(PG8_SB(1, 0), cB + kstep, voffB); PG8_STAGE(PG8_SA(1, 0), cA + kstep, voffA); PG8_STAGE(PG8_SB(1, 1), cB + hstep + kstep, voffB);
        PG8_WAIT_V(6); PG8_BAR;
    } else {
        PG8_STAGE(PG8_SB(0, 0), cB, voffB); PG8_STAGE(PG8_SA(0, 0), cA, voffA); PG8_STAGE(PG8_SB(0, 1), cB + hstep, voffB); PG8_STAGE(PG8_SA(0, 1), cA + hstep, voffA);
        if (wr == 1) PG8_BAR;
        PG8_WAIT_V(4); PG8_BAR;
        PG8_STAGE(PG8_SB(1, 0), cB + kstep, voffB); PG8_STAGE(PG8_SA(1, 0), cA + kstep, voffA); PG8_STAGE(PG8_SB(1, 1), cB + hstep + kstep, voffB);
        PG8_WAIT_V(6); PG8_BAR;
    }
    for (;;) {
        const bool has_next = S.next(ui + 1, nxt);
        const char* nA = has_next ? (const char*)g.A + (size_t)nxt.pm * tstep : cA; const char* nB = has_next ? (const char*)g.Bt + (size_t)nxt.pn * tstep : cB;
        for (int t = 0; t < nt; t += 2) {
            const bool last = (t == nt - 2);
            const char* a1 = cA + (size_t)(t + 1) * kstep;
            const char* a2 = last ? nA : cA + (size_t)(t + 2) * kstep; const char* b2 = last ? nB : cB + (size_t)(t + 2) * kstep;
            const char* a3 = a2 + kstep; const char* b3 = b2 + kstep;
            if (last && has_next) S.a_ready(nxt);
            if constexpr (SP2) {
            PG8_LDB(B0, 0, 0); PG8_LDB(B1, 0, 1); PG8_SCHED; PG8_LDA(At, 0, 0); PG8_STAGE(PG8_SA(1, 1), a1 + hstep, voffA);
            PG8_WAIT_V(8); PG8_WAIT_L(0); PG8_BAR; PG8_MMA(0, 0, At, B0); PG8_MMA(0, 1, At, B1); PG8_BAR; PG8_SCHED;
            PG8_LDA(At, 0, 1); PG8_STAGE(PG8_SB(0, 0), b2, voffB); PG8_STAGE(PG8_SB(0, 1), b2 + hstep, voffB); PG8_STAGE(PG8_SA(0, 0), a2, voffA);
            PG8_WAIT_V(8); PG8_WAIT_L(0); PG8_BAR; PG8_MMA(1, 0, At, B0); PG8_MMA(1, 1, At, B1); PG8_BAR; PG8_SCHED;
            PG8_LDB(B0, 1, 0); PG8_LDB(B1, 1, 1); PG8_SCHED; PG8_LDA(At, 1, 0); PG8_STAGE(PG8_SA(0, 1), a2 + hstep, voffA);
            PG8_WAIT_V(8); PG8_WAIT_L(0); PG8_BAR; PG8_MMA(0, 0, At, B0); PG8_MMA(0, 1, At, B1); PG8_BAR; PG8_SCHED;
            PG8_LDA(At, 1, 1); PG8_STAGE(PG8_SB(1, 0), b3, voffB); PG8_STAGE(PG8_SB(1, 1), b3 + hstep, voffB); PG8_STAGE(PG8_SA(1, 0), a3, voffA);
            PG8_WAIT_V(8); PG8_WAIT_L(0); PG8_BAR; PG8_MMA(1, 0, At, B0); PG8_MMA(1, 1, At, B1); PG8_BAR; PG8_SCHED;
            } else {
            PG8_LDB(B0, 0, 0); PG8_SCHED; PG8_LDA(At, 0, 0); PG8_STAGE(PG8_SA(1, 1), a1 + hstep, voffA);
            PG8_WAIT_L(8); PG8_BAR; PG8_WAIT_L(0); PG8_MMA(0, 0, At, B0); PG8_BAR; PG8_SCHED;
            PG8_LDB(B1, 0, 1); PG8_STAGE(PG8_SB(0, 0), b2, voffB);
            PG8_BAR; PG8_WAIT_L(0); PG8_MMA(0, 1, At, B1); PG8_BAR;
            PG8_LDA(At, 0, 1); PG8_STAGE(PG8_SA(0, 0), a2, voffA);
            PG8_BAR; PG8_WAIT_L(0); PG8_MMA(1, 0, At, B0); PG8_BAR; PG8_SCHED;
            PG8_STAGE(PG8_SB(0, 1), b2 + hstep, voffB);
            PG8_WAIT_V(6); PG8_BAR; PG8_MMA(1, 1, At, B1); PG8_BAR;
            PG8_LDB(B0, 1, 0); PG8_SCHED; PG8_LDA(At, 1, 0); PG8_STAGE(PG8_SA(0, 1), a2 + hstep, voffA);
            PG8_WAIT_L(8); PG8_BAR; PG8_WAIT_L(0); PG8_MMA(0, 0, At, B0); PG8_BAR; PG8_SCHED;
            PG8_LDB(B1, 1, 1); PG8_STAGE(PG8_SB(1, 0), b3, voffB);
            PG8_BAR; PG8_WAIT_L(0); PG8_MMA(0, 1, At, B1); PG8_BAR;
            PG8_LDA(At, 1, 1); PG8_STAGE(PG8_SA(1, 0), a3, voffA);
            PG8_BAR; PG8_WAIT_L(0); PG8_MMA(1, 0, At, B0); PG8_BAR; PG8_SCHED;
            PG8_STAGE(PG8_SB(1, 1), b3 + hstep, voffB);
            PG8_WAIT_V(6); PG8_BAR; PG8_MMA(1, 1, At, B1); PG8_BAR;
            }
        }
        if constexpr (ALIGN_EPI) { if (wr == 0) PG8_BAR; }
        if constexpr (!Epi::AFTER_DRAIN) { E(acc, cur, wr, wc, fr, fq); S.done(cur); }
        if (!has_next) break;
#pragma unroll
        for (int a = 0; a < 2; ++a)
#pragma unroll
            for (int b = 0; b < 2; ++b)
#pragma unroll
                for (int m = 0; m < 4; ++m)
#pragma unroll
                    for (int n = 0; n < 2; ++n) acc[a][b][m][n] = (f32x4){0.f, 0.f, 0.f, 0.f};
        cur = nxt; cA = nA; cB = nB; ++ui;
        if constexpr (ALIGN_EPI) { if (wr == 1) PG8_BAR; }
    }
    PG8_WAIT_V(0);
    if constexpr (!ALIGN_EPI) { if (wr == 0) PG8_BAR; }
    PG8_BAR;
    if constexpr (Epi::AFTER_DRAIN) { E.fused(acc, cur, wr, wc, fr, fq, lds, wid, lane); S.done(cur); }
#undef PG8_SA
#undef PG8_SB
#undef PG8_STAGE
#undef PG8_LDA
#undef PG8_LDB
#undef PG8_MMA
#undef PG8_WAIT_V
#undef PG8_WAIT_L
#undef PG8_BAR
#undef PG8_SCHED
}
typedef unsigned u32x2 __attribute__((ext_vector_type(2)));
typedef float f32x2 __attribute__((ext_vector_type(2)));
typedef __bf16 bf16x2_t __attribute__((ext_vector_type(2)));
__device__ __forceinline__ unsigned pkbf(float lo, float hi) { f32x2 v = {lo, hi}; bf16x2_t b = __builtin_convertvector(v, bf16x2_t); return __builtin_bit_cast(unsigned, b); }
__device__ __forceinline__ u32x2 pk4(f32x4 v) { u32x2 r; r.x = pkbf(v[0], v[1]); r.y = pkbf(v[2], v[3]); return r; }
__device__ __forceinline__ float silu_f(float v) { return v * __builtin_amdgcn_rcpf(1.f + __expf(-v)); }
__device__ __forceinline__ f32x4 silu4(f32x4 v) { f32x4 o; o[0] = silu_f(v[0]); o[1] = silu_f(v[1]); o[2] = silu_f(v[2]); o[3] = silu_f(v[3]); return o; }
__device__ __forceinline__ float ssq4(f32x4 v) { return (v[0] * v[0] + v[1] * v[1]) + (v[2] * v[2] + v[3] * v[3]); }
__device__ __forceinline__ float red_fq(float s) { s += __shfl_xor(s, 16); s += __shfl_xor(s, 32); return s; }

struct EpiAin {
    static constexpr bool PERM = false, AFTER_DRAIN = false;
    bf16_t *Q, *K, *V, *Z; const float *gq, *gk; float *okp, *ovp, *oks, *ovs;
    __device__ __forceinline__ void operator()(const f32x4 (&acc)[2][2][4][2], const Unit& u, int wr, int wc, int fr, int fq) const {
        const int sec = u.pn >> 2, head = (u.pn & 3) * 4 + wc, cb = head * 64 + 4 * fq;
        f32x4 g[2][2];
#pragma unroll
        for (int bj = 0; bj < 2; ++bj)
#pragma unroll
            for (int n = 0; n < 2; ++n) g[bj][n] = (sec < 2) ? *(const f32x4*)((sec == 0 ? gq : gk) + 32 * bj + 16 * n + 4 * fq) : (f32x4){1.f, 1.f, 1.f, 1.f};
#pragma unroll
        for (int ai = 0; ai < 2; ++ai)
#pragma unroll
            for (int m = 0; m < 4; ++m) {
                const int row = u.pm * BM + ai * HALF + wr * 64 + m * 16 + fr;
                f32x4 v[2][2];
#pragma unroll
                for (int bj = 0; bj < 2; ++bj)
#pragma unroll
                    for (int n = 0; n < 2; ++n) v[bj][n] = acc[ai][bj][m][n];
                if (sec < 2) {
                    float s = (ssq4(v[0][0]) + ssq4(v[0][1])) + (ssq4(v[1][0]) + ssq4(v[1][1]));
                    s = red_fq(s);
                    const float r = rsqrtf(s * (1.f / 64.f) + EPSN) * (sec == 0 ? QSCALE_A : 1.f);
#pragma unroll
                    for (int bj = 0; bj < 2; ++bj)
#pragma unroll
                        for (int n = 0; n < 2; ++n) v[bj][n] = v[bj][n] * g[bj][n] * r;
                } else if (sec == 3) {
#pragma unroll
                    for (int bj = 0; bj < 2; ++bj)
#pragma unroll
                        for (int n = 0; n < 2; ++n) v[bj][n] = silu4(v[bj][n]);
                }
                if (sec == 0 || sec == 3) {
                    bf16_t* d = (sec == 0 ? Q : Z) + (size_t)row * 1024 + cb;
#pragma unroll
                    for (int bj = 0; bj < 2; ++bj)
#pragma unroll
                        for (int n = 0; n < 2; ++n) *(u32x2*)(d + 32 * bj + 16 * n) = pk4(v[bj][n]);
                } else {
                    size_t drow; float* of = nullptr;
                    if (row < MP) { drow = (size_t)row; const int pos = row & (SEQ - 1); if (pos >= SEQ - 512) of = (sec == 1 ? okp : ovp) + ((size_t)((row >> 11) * 512 + pos - (SEQ - 512))) * 1024; }
                    else { const int rs = row - MP; drow = (size_t)MP + (size_t)(rs >> 5) * SA_STRIDE + 512 + (rs & 31); of = (sec == 1 ? oks : ovs) + (size_t)rs * 1024; }
                    bf16_t* d = (sec == 1 ? K : V) + drow * 1024 + cb;
#pragma unroll
                    for (int bj = 0; bj < 2; ++bj)
#pragma unroll
                        for (int n = 0; n < 2; ++n) { *(u32x2*)(d + 32 * bj + 16 * n) = pk4(v[bj][n]); if (of) *(f32x4*)(of + cb + 32 * bj + 16 * n) = v[bj][n]; }
                }
                asm volatile("" ::: "memory");
            }
    }
};
struct EpiRes {
    static constexpr bool PERM = false, AFTER_DRAIN = false;
    const float *xp, *xs; float *yp, *ys; const float* gate;
    bf16_t* YG; const float* G1; float* ssq;
    __device__ __forceinline__ void operator()(const f32x4 (&acc)[2][2][4][2], const Unit& u, int wr, int wc, int fr, int fq) const {
        const int cb = u.pn * 256 + wc * 64 + 4 * fq;
#pragma unroll
        for (int ai = 0; ai < 2; ++ai)
#pragma unroll
            for (int m = 0; m < 4; ++m) {
                const int row = u.pm * BM + ai * HALF + wr * 64 + m * 16 + fr;
                const float* xi; float* yo; int bb;
                if (row < MP) { xi = xp + (size_t)row * 1024; yo = yp + (size_t)row * 1024; bb = row >> 11; }
                else { const int rs = row - MP; xi = xs + (size_t)rs * 1024; yo = ys + (size_t)rs * 1024; bb = NBP + (rs >> 5); }
                const float* gp = gate + (size_t)bb * 3072;
                float sq = 0.f;
#pragma unroll
                for (int bj = 0; bj < 2; ++bj)
#pragma unroll
                    for (int n = 0; n < 2; ++n) { const int c = cb + 32 * bj + 16 * n; const f32x4 o = *(const f32x4*)(xi + c) + *(const f32x4*)(gp + c) * acc[ai][bj][m][n]; *(f32x4*)(yo + c) = o;
                        if (YG) { sq += ssq4(o); *(u32x2*)(YG + (size_t)row * 1024 + c) = pk4(o * *(const f32x4*)(G1 + (size_t)bb * 1024 + c)); } }
                if (YG) { sq = red_fq(sq); if (fq == 0) atomicAdd(ssq + row, sq); }
                asm volatile("" ::: "memory");
            }
    }
};
struct EpiBin {
    static constexpr bool PERM = false, AFTER_DRAIN = false;
    bf16_t* Z; float* RAW; const float* ssq; const float* SW;
    __device__ __forceinline__ void operator()(const f32x4 (&acc)[2][2][4][2], const Unit& u, int wr, int wc, int fr, int fq) const {
        const int cb = u.pn * 256 + wc * 64 + 4 * fq;
#pragma unroll
        for (int ai = 0; ai < 2; ++ai)
#pragma unroll
            for (int m = 0; m < 4; ++m) {
                const int row = u.pm * BM + ai * HALF + wr * 64 + m * 16 + fr;
                const int bb = row < MP ? (row >> 11) : NBP + ((row - MP) >> 5);
                const float r = rsqrtf(ssq[row] * (1.f / 1024.f) + EPSN);
                const float* sw = SW + (size_t)bb * 1792;
#pragma unroll
                for (int bj = 0; bj < 2; ++bj)
#pragma unroll
                    for (int n = 0; n < 2; ++n) { const int c = cb + 32 * bj + 16 * n;
                        const f32x4 v = acc[ai][bj][m][n] * r + *(const f32x4*)(sw + c);
                        if (u.pn < 4) *(u32x2*)(Z + (size_t)row * 1024 + c) = pk4(silu4(v));
                        else *(f32x4*)(RAW + (size_t)row * 768 + (c - 1024)) = v; }
                asm volatile("" ::: "memory");
            }
    }
};
struct EpiUq {
    static constexpr bool PERM = false, AFTER_DRAIN = false;
    bf16_t* Q; const float *gqn, *gqr, *CS;
    __device__ __forceinline__ void operator()(const f32x4 (&acc)[2][2][4][2], const Unit& u, int wr, int wc, int fr, int fq) const {
        if (u.pn < 4) {
            const int head = u.pn * 4 + wc;
#pragma unroll
            for (int ai = 0; ai < 2; ++ai)
#pragma unroll
                for (int m = 0; m < 4; ++m) {
                    const int row = u.pm * BM + ai * HALF + wr * 64 + m * 16 + fr;
                    float s = (ssq4(acc[ai][0][m][0]) + ssq4(acc[ai][0][m][1])) + (ssq4(acc[ai][1][m][0]) + ssq4(acc[ai][1][m][1]));
                    s = red_fq(s);
                    const float r = rsqrtf(s * (1.f / 64.f) + EPSN) * QSCALE_B;
                    bf16_t* d = Q + (size_t)row * 1536 + head * 96 + 4 * fq;
#pragma unroll
                    for (int bj = 0; bj < 2; ++bj)
#pragma unroll
                        for (int n = 0; n < 2; ++n) *(u32x2*)(d + 32 * bj + 16 * n) = pk4(acc[ai][bj][m][n] * *(const f32x4*)(gqn + 32 * bj + 16 * n + 4 * fq) * r);
                    asm volatile("" ::: "memory");
                }
        } else {
#pragma unroll
            for (int ai = 0; ai < 2; ++ai)
#pragma unroll
                for (int m = 0; m < 4; ++m) {
                    const int row = u.pm * BM + ai * HALF + wr * 64 + m * 16 + fr;
                    const int pos = row < MP ? (row & (SEQ - 1)) : SEQ + ((row - MP) & 31);
#pragma unroll
                    for (int bj = 0; bj < 2; ++bj) {
                        const int hr = (u.pn - 4) * 8 + wc * 2 + bj;
                        float s = ssq4(acc[ai][bj][m][0]) + ssq4(acc[ai][bj][m][1]);
                        s = red_fq(s);
                        const float r = rsqrtf(s * (1.f / 32.f) + EPSN);
                        const f32x4 x1 = acc[ai][bj][m][0] * *(const f32x4*)(gqr + 4 * fq) * r, x2 = acc[ai][bj][m][1] * *(const f32x4*)(gqr + 16 + 4 * fq) * r;
                        const f32x4 cs = *(const f32x4*)(CS + pos * 32 + 4 * fq), sn = *(const f32x4*)(CS + pos * 32 + 16 + 4 * fq);
                        bf16_t* d = Q + (size_t)row * 1536 + hr * 96 + 64 + 4 * fq;
                        *(u32x2*)d = pk4((x1 * cs - x2 * sn) * QSCALE_B); *(u32x2*)(d + 16) = pk4((x2 * cs + x1 * sn) * QSCALE_B);
                        asm volatile("" ::: "memory");
                    }
                }
        }
    }
};
struct EpiUkv {
    static constexpr bool PERM = false, AFTER_DRAIN = false;
    bf16_t *KN, *VB; const float* gkn;
    __device__ __forceinline__ void operator()(const f32x4 (&acc)[2][2][4][2], const Unit& u, int wr, int wc, int fr, int fq) const {
        const bool isk = u.pn < 4; const int head = (u.pn & 3) * 4 + wc;
#pragma unroll
        for (int ai = 0; ai < 2; ++ai)
#pragma unroll
            for (int m = 0; m < 4; ++m) {
                const int row = u.pm * BM + ai * HALF + wr * 64 + m * 16 + fr;
                float r = 1.f;
                if (isk) { float s = (ssq4(acc[ai][0][m][0]) + ssq4(acc[ai][0][m][1])) + (ssq4(acc[ai][1][m][0]) + ssq4(acc[ai][1][m][1])); s = red_fq(s); r = rsqrtf(s * (1.f / 64.f) + EPSN); }
                bf16_t* d = (isk ? KN : VB) + (size_t)row * 1024 + head * 64 + 4 * fq;
#pragma unroll
                for (int bj = 0; bj < 2; ++bj)
#pragma unroll
                    for (int n = 0; n < 2; ++n) { const f32x4 gg = isk ? *(const f32x4*)(gkn + 32 * bj + 16 * n + 4 * fq) : (f32x4){1.f, 1.f, 1.f, 1.f}; *(u32x2*)(d + 32 * bj + 16 * n) = pk4(acc[ai][bj][m][n] * gg * r); }
                asm volatile("" ::: "memory");
            }
    }
};
}
namespace at {
#define ALAS __attribute__((address_space(3)))
typedef unsigned short bf16_t;
typedef short bf16x8 __attribute__((ext_vector_type(8)));
typedef short s16x4 __attribute__((ext_vector_type(4)));
typedef float f32x16 __attribute__((ext_vector_type(16)));
typedef float f32x4 __attribute__((ext_vector_type(4)));
typedef unsigned u32x4 __attribute__((ext_vector_type(4)));
typedef unsigned u32x2 __attribute__((ext_vector_type(2)));
constexpr int KROW = 144, VROW = 144, RROW = 80;
constexpr int KBUF = 64 * KROW, VBUF = 64 * VROW, RBUF = 64 * RROW, STAGE = KBUF + VBUF + RBUF;
constexpr int NSTAGE = 2, TBL_OFF = NSTAGE * STAGE, LDS_BYTES = TBL_OFF + 1280;
struct AttnUnit { int qrow0, nq, krow0, nt, lastvalid, head, c0, tf; };
__device__ __forceinline__ int crow(int r, int hi) { return (r & 3) + 8 * (r >> 2) + 4 * hi; }

template <bool MLA>
__device__ __forceinline__ void attn_unit(ALAS unsigned char* lds, const AttnUnit u, const bf16_t* __restrict__ Q, const bf16_t* __restrict__ Kn, const bf16_t* __restrict__ Kr,
                                          const bf16_t* __restrict__ V, const bf16_t* __restrict__ Z, bf16_t* __restrict__ U, const float* __restrict__ tbl) {
    const int tid = threadIdx.x, lane = tid & 63, wid = __builtin_amdgcn_readfirstlane(tid >> 6), l32 = lane & 31, hi = lane >> 5;
    const int ci = wid >> 1, qh = wid & 1;
    const bool active = ci * 64 + qh * 32 < u.nq;
    const int cq = u.c0 + ci;
    constexpr int QS = MLA ? 1536 : 1024, HS = MLA ? 96 : 64, ND0 = MLA ? 6 : 4;
    constexpr float THR = 8.f;
    ALAS float* tb = (ALAS float*)(lds + TBL_OFF);
    if (!MLA) { if (tid < 320) tb[tid] = tid < 257 ? (tbl[(size_t)u.head * 257 + tid] - tbl[(size_t)u.head * 257 + 256]) * LOG2E : 0.f; }
    const int qrow = u.qrow0 + (active ? ci * 64 + qh * 32 : 0) + l32;
    bf16x8 qf[ND0];
#pragma unroll
    for (int d0 = 0; d0 < ND0; ++d0) qf[d0] = *(const bf16x8*)(Q + (size_t)qrow * QS + u.head * HS + d0 * 16 + hi * 8);
    const char* kbase = (const char*)(Kn + (size_t)u.krow0 * 1024 + u.head * 64);
    const char* vbase = (const char*)(V + (size_t)u.krow0 * 1024 + u.head * 64);
    const char* rbase = MLA ? (const char*)(Kr + (size_t)u.krow0 * 32) : nullptr;
    const unsigned koff = (unsigned)(((tid >> 3) * 1024 + (tid & 7) * 8) * 2);
    const int vkvq = (tid & 3) + 4 * ((tid >> 6) & 3), vdq = (tid >> 2) & 15;
    const unsigned voff = (unsigned)(((vkvq * 4) * 1024 + vdq * 4) * 2);
    const int vpos8 = (vkvq & ~3) + ((vkvq & 1) << 1) + ((vkvq >> 1) & 1);
    const unsigned roff = (unsigned)(((((tid - 256) >> 2) & 63) * 32 + (tid & 3) * 8) * 2);
    u32x4 kreg[1]; u32x2 vreg[1][4]; u32x4 rreg[1];
#define AT_GLOAD(ti, sx) do { const int tl_ = (ti) < u.nt ? (ti) : u.nt - 1; \
        kreg[sx] = *(const u32x4*)(kbase + (size_t)tl_ * 131072 + koff); \
        if (tid < 256) { const char* vb_ = vbase + (size_t)tl_ * 131072; \
            vreg[sx][0] = *(const u32x2*)(vb_ + voff); vreg[sx][1] = *(const u32x2*)(vb_ + voff + 2048); vreg[sx][2] = *(const u32x2*)(vb_ + 4096 + voff); vreg[sx][3] = *(const u32x2*)(vb_ + 4096 + voff + 2048); } \
        else if (MLA) { rreg[sx] = *(const u32x4*)(rbase + (size_t)tl_ * 4096 + roff); } } while (0)
#define AT_SWRITE(st, sx) do { ALAS unsigned char* sb_ = lds + (st) * STAGE; \
        *(ALAS u32x4*)(sb_ + (tid >> 3) * KROW + (tid & 7) * 16) = kreg[sx]; \
        if (tid < 256) { \
            _Pragma("unroll") for (int jj_ = 0; jj_ < 4; ++jj_) { const int d_ = 4 * vdq + jj_; u32x2 o_; \
                const unsigned sel_ = (jj_ & 1) ? 0x07060302u : 0x05040100u; \
                if (jj_ < 2) { o_.x = __builtin_amdgcn_perm(vreg[sx][1].x, vreg[sx][0].x, sel_); o_.y = __builtin_amdgcn_perm(vreg[sx][3].x, vreg[sx][2].x, sel_); } \
                else         { o_.x = __builtin_amdgcn_perm(vreg[sx][1].y, vreg[sx][0].y, sel_); o_.y = __builtin_amdgcn_perm(vreg[sx][3].y, vreg[sx][2].y, sel_); } \
                *(ALAS u32x2*)(sb_ + KBUF + d_ * VROW + vpos8 * 8) = o_; } } \
        else if (MLA) { const int t2_ = tid - 256; *(ALAS u32x4*)(sb_ + KBUF + VBUF + (t2_ >> 2) * RROW + (t2_ & 3) * 16) = rreg[sx]; } } while (0)
    float mref = 0.f;
    bool first = true;
    f32x16 negm = f32x16{}; asm volatile("" : "+v"(negm));
    f32x16 o0 = f32x16{}, o1 = f32x16{}, o2 = f32x16{};
    u32x4 onesw; { const unsigned v1 = (l32 == 0 || l32 == 4) ? 0x3f803f80u : 0u; onesw = (u32x4){v1, v1, v1, v1}; }
    const bf16x8 onesf = __builtin_bit_cast(bf16x8, onesw);
    f32x16 p[2];
    const int tgl = (qh * 32 + l32 + 128 - 4 * hi) * 4;
#define AT_QK(t, sg) do { const int kc_ = u.tf + (t); ALAS unsigned char* sb_ = lds + (sg) * STAGE; ALAS unsigned char* kb_ = sb_ + l32 * KROW + hi * 16; \
        bool near_ = false; \
        if (!MLA) { near_ = cq - kc_ < 3; \
            if (near_) { ALAS unsigned char* tp_ = (ALAS unsigned char*)tb + tgl + 256 * (cq - kc_); \
                _Pragma("unroll") for (int blk = 0; blk < 2; ++blk) _Pragma("unroll") for (int r = 0; r < 16; ++r) p[blk][r] = *(const ALAS float*)(tp_ - 4 * (32 * blk + (r & 3) + 8 * (r >> 2))) - mref; } } \
        bf16x8 ka_[4], kb2_[4]; ALAS unsigned char* rb_ = sb_ + KBUF + VBUF + l32 * RROW + hi * 16; \
        _Pragma("unroll") for (int d0 = 0; d0 < 4; ++d0) ka_[d0] = *(const ALAS bf16x8*)(kb_ + d0 * 32); \
        _Pragma("unroll") for (int d0 = 0; d0 < 4; ++d0) kb2_[d0] = *(const ALAS bf16x8*)(kb_ + 32 * KROW + d0 * 32); \
        __builtin_amdgcn_sched_barrier(0); \
        if (near_) p[0] = __builtin_amdgcn_mfma_f32_32x32x16_bf16(ka_[0], qf[0], p[0], 0, 0, 0); else p[0] = __builtin_amdgcn_mfma_f32_32x32x16_bf16(ka_[0], qf[0], negm, 0, 0, 0); \
        _Pragma("unroll") for (int d0 = 1; d0 < 4; ++d0) p[0] = __builtin_amdgcn_mfma_f32_32x32x16_bf16(ka_[d0], qf[d0], p[0], 0, 0, 0); \
        if (MLA) { __builtin_amdgcn_sched_barrier(0); ka_[0] = *(const ALAS bf16x8*)(rb_); ka_[1] = *(const ALAS bf16x8*)(rb_ + 32); ka_[2] = *(const ALAS bf16x8*)(rb_ + 32 * RROW); ka_[3] = *(const ALAS bf16x8*)(rb_ + 32 * RROW + 32); __builtin_amdgcn_sched_barrier(0); } \
        if (near_) p[1] = __builtin_amdgcn_mfma_f32_32x32x16_bf16(kb2_[0], qf[0], p[1], 0, 0, 0); else p[1] = __builtin_amdgcn_mfma_f32_32x32x16_bf16(kb2_[0], qf[0], negm, 0, 0, 0); \
        _Pragma("unroll") for (int d0 = 1; d0 < 4; ++d0) p[1] = __builtin_amdgcn_mfma_f32_32x32x16_bf16(kb2_[d0], qf[d0], p[1], 0, 0, 0); \
        if (MLA) { p[0] = __builtin_amdgcn_mfma_f32_32x32x16_bf16(ka_[0], qf[4], p[0], 0, 0, 0); p[1] = __builtin_amdgcn_mfma_f32_32x32x16_bf16(ka_[2], qf[4], p[1], 0, 0, 0); \
                   p[0] = __builtin_amdgcn_mfma_f32_32x32x16_bf16(ka_[1], qf[ND0 - 1], p[0], 0, 0, 0); p[1] = __builtin_amdgcn_mfma_f32_32x32x16_bf16(ka_[3], qf[ND0 - 1], p[1], 0, 0, 0); } \
        if ((t) == u.nt - 1 && u.lastvalid < 64) { _Pragma("unroll") for (int r = 0; r < 16; ++r) p[1][r] = -__builtin_inff(); } } while (0)
#define AT_SMPV(t, sg) do { ALAS unsigned char* vb_ = lds + (sg) * STAGE + KBUF + l32 * VROW + hi * 16; \
        bf16x8 vf_[2][4]; \
        _Pragma("unroll") for (int dblk = 0; dblk < 2; ++dblk) _Pragma("unroll") for (int j = 0; j < 4; ++j) vf_[dblk][j] = *(const ALAS bf16x8*)(vb_ + dblk * 32 * VROW + j * 32); \
        __builtin_amdgcn_sched_barrier(0); \
        float rm = p[0][0]; \
        _Pragma("unroll") for (int r = 1; r < 16; ++r) rm = fmaxf(rm, p[0][r]); \
        _Pragma("unroll") for (int r = 0; r < 16; ++r) rm = fmaxf(rm, p[1][r]); \
        rm = fmaxf(rm, __shfl_xor(rm, 32)); \
        if (first || __any(rm > THR)) { \
            const float dl = first ? rm : fmaxf(rm, 0.f); mref += dl; \
            _Pragma("unroll") for (int r = 0; r < 16; ++r) { p[0][r] -= dl; p[1][r] -= dl; } \
            _Pragma("unroll") for (int r = 0; r < 16; ++r) negm[r] = -mref; \
            asm volatile("" : "+v"(negm)); \
            if (!first) { const float al = __builtin_amdgcn_exp2f(-dl); o2[0] *= al; \
                _Pragma("unroll") for (int r = 0; r < 16; ++r) { o0[r] *= al; o1[r] *= al; } } \
            first = false; } \
        _Pragma("unroll") for (int blk = 0; blk < 2; ++blk) _Pragma("unroll") for (int r = 0; r < 16; ++r) p[blk][r] = __builtin_amdgcn_exp2f(p[blk][r]); \
        bf16x8 pk[4]; \
        _Pragma("unroll") for (int j = 0; j < 4; ++j) { u32x4 w; const int b = j >> 1, r0 = 8 * (j & 1); \
            w.x = pg8::pkbf(p[b][r0 + 0], p[b][r0 + 1]); w.y = pg8::pkbf(p[b][r0 + 2], p[b][r0 + 3]); w.z = pg8::pkbf(p[b][r0 + 4], p[b][r0 + 5]); w.w = pg8::pkbf(p[b][r0 + 6], p[b][r0 + 7]); \
            pk[j] = __builtin_bit_cast(bf16x8, w); } \
        _Pragma("unroll") for (int j = 0; j < 4; ++j) { \
            o0 = __builtin_amdgcn_mfma_f32_32x32x16_bf16(vf_[0][j], pk[j], o0, 0, 0, 0); \
            o1 = __builtin_amdgcn_mfma_f32_32x32x16_bf16(vf_[1][j], pk[j], o1, 0, 0, 0); \
            o2 = __builtin_amdgcn_mfma_f32_32x32x16_bf16(onesf, pk[j], o2, 0, 0, 0); } } while (0)
#define AT_TAKE(t) (active && (u.tf + (t)) <= cq && (MLA || (u.tf + (t)) >= cq - 8))
    AT_GLOAD(0, 0); AT_SWRITE(0, 0);
    __syncthreads();
    for (int ti = 0; ti < u.nt; ++ti) {
        const bool more = ti + 1 < u.nt;
        if (more) AT_GLOAD(ti + 1, 0);
        if (AT_TAKE(ti)) { AT_QK(ti, ti & 1); AT_SMPV(ti, ti & 1); }
        if (more) AT_SWRITE((ti + 1) & 1, 0);
        __syncthreads();
    }
#undef AT_QK
#undef AT_SMPV
#undef AT_TAKE
    if (active) {
        const float inv = 1.f / o2[0];
        const size_t ob = (size_t)qrow * 1024 + u.head * 64 + 4 * hi;
#pragma unroll
        for (int dblk = 0; dblk < 2; ++dblk)
#pragma unroll
            for (int g = 0; g < 4; ++g) {
                const u32x2 zz = *(const u32x2*)(Z + ob + 32 * dblk + 8 * g);
                const float z0 = __uint_as_float(zz.x << 16), z1 = __uint_as_float(zz.x & 0xffff0000u), z2 = __uint_as_float(zz.y << 16), z3 = __uint_as_float(zz.y & 0xffff0000u);
                const f32x16& o = dblk == 0 ? o0 : o1;
                u32x2 w; w.x = pg8::pkbf(o[4 * g + 0] * inv * z0, o[4 * g + 1] * inv * z1); w.y = pg8::pkbf(o[4 * g + 2] * inv * z2, o[4 * g + 3] * inv * z3);
                *(u32x2*)(U + ob + 32 * dblk + 8 * g) = w;
            }
    }
#undef AT_GLOAD
#undef AT_SWRITE
}
__device__ __forceinline__ bool prompt_unit(int k, int G, int bid, int& bh, int& qb) {
    if (G == 256) { if (k >= 16) return false; const int x = bid & 7, j = bid >> 3; bh = (4 * k + (j >> 3)) * 8 + x; qb = ((j & 7) + k) & 7; return true; }
    const int u = bid + k * G; if (u >= 4096) return false; bh = u >> 3; qb = u & 7; return true;
}
}
#define LAS __attribute__((address_space(3)))
typedef unsigned short bf16;
typedef unsigned v4u __attribute__((ext_vector_type(4)));
typedef unsigned v2u __attribute__((ext_vector_type(2)));
typedef float f32x4 __attribute__((ext_vector_type(4)));
constexpr size_t MiB = 1u << 20;
constexpr size_t WS_MOD = 0;
constexpr size_t MOD_BYTES = 2 * 40 * 3072 * 4;
constexpr size_t WS_BAR = 1 * MiB - 16384;
constexpr size_t WS_CS = 1 * MiB;
constexpr size_t WS_G1 = 2 * MiB;
constexpr size_t WS_SW = 2 * MiB + 256 * 1024;
constexpr size_t WS_SSQ = 3 * MiB;
constexpr size_t WS_W_AIN = 4 * MiB, WS_W_AOUT = 12 * MiB, WS_W_BIN = 14 * MiB, WS_W_UQ = 18 * MiB, WS_W_UKV = 20 * MiB, WS_W_BOUT = 22 * MiB;
constexpr size_t WS_H = 24 * MiB;
constexpr size_t WS_CKV = 153 * MiB;
constexpr size_t WS_KR = 194 * MiB;
constexpr size_t WS_X = 200 * MiB;
constexpr size_t WS_QA = WS_X, WS_KA = WS_X + 129 * MiB, WS_VA = WS_X + 267 * MiB, WS_ZA = WS_X + 405 * MiB;
constexpr size_t WS_YG = WS_ZA;
constexpr size_t WS_ZB = WS_X, WS_RAW = WS_X + 129 * MiB, WS_QB = WS_RAW, WS_CQ = WS_X + 322 * MiB, WS_KN = WS_X + 371 * MiB, WS_VB = WS_X + 532 * MiB;
constexpr size_t WS_END = WS_X + 694 * MiB;
static_assert((size_t)M1 * 1024 * 2 <= 129 * MiB && (size_t)RA * 1024 * 2 <= 138 * MiB && (size_t)M1 * 768 * 4 <= 193 * MiB && (size_t)M1 * 384 * 2 <= 49 * MiB && (size_t)R2 * 1024 * 2 <= 161 * MiB, "ws map");
static_assert((size_t)R2 * 256 * 2 <= 41 * MiB && (size_t)R2 * 32 * 2 <= 6 * MiB && WS_ZA + 129 * MiB <= WS_END && WS_VB + 161 * MiB <= WS_END && WS_END <= 1024 * MiB, "ws map");
constexpr size_t O_YP = 0, O_YS = 67108864, O_AKP = 67371008, O_AVP = 84148224, O_AKS = 100925440, O_AVS = 101187584, O_CKVP = 101449728, O_KRP = 118226944, O_CKVS = 120324096, O_KRS = 120389632;
constexpr int LDS_TOTAL = 147456, LDS_MISC = 131072 + 320;
static_assert(at::LDS_BYTES <= LDS_TOTAL && pg8::STAGE_BYTES <= LDS_TOTAL, "LDS");

__device__ __forceinline__ float wave_sum(float v) {
#pragma unroll
    for (int o = 1; o < 64; o <<= 1) v += __shfl_xor(v, o);
    return v;
}
__device__ __forceinline__ unsigned pk2(float lo, float hi) { return pg8::pkbf(lo, hi); }
__device__ __forceinline__ int src_col(int gemm, int g) {
    const int lc = ((g >> 3) * 8 + (g & 3) * 2 + ((g >> 2) & 1)) * 32;
    switch (gemm) {
    case 2: if (lc < 1024) return 672 + lc; if (lc < 1408) return lc - 1024; if (lc < 1664) return 384 + (lc - 1408); if (lc < 1696) return 640 + (lc - 1664); return -1;
    case 3: if (lc < 1024) return (lc >> 6) * 96 + (lc & 63); return ((lc - 1024) >> 5) * 96 + 64;
    case 4: if (lc < 1024) return (lc >> 6) * 128 + (lc & 63); return ((lc - 1024) >> 6) * 128 + 64 + (lc & 63);
    default: return lc;
    }
}
__device__ __forceinline__ void transpose_item(const float* W, int K, int Nsrc, int sc, bf16* WT, int g, int k0, LAS float* scr, int lane) {
#pragma unroll 8
    for (int i = 0; i < 32; ++i) { const int kk = 2 * i + (lane >> 5); scr[kk * 33 + (lane & 31)] = sc >= 0 ? W[(size_t)(k0 + kk) * Nsrc + sc + (lane & 31)] : 0.f; }
    asm volatile("s_waitcnt lgkmcnt(0)" ::: "memory");
    const int c = lane & 7;
#pragma unroll
    for (int j = 0; j < 4; ++j) { const int n = (lane >> 3) + 8 * j; const LAS float* s = scr + (8 * c) * 33 + n;
        v4u o; o.x = pk2(s[0 * 33], s[1 * 33]); o.y = pk2(s[2 * 33], s[3 * 33]); o.z = pk2(s[4 * 33], s[5 * 33]); o.w = pk2(s[6 * 33], s[7 * 33]);
        *(v4u*)(WT + (size_t)(32 * g + n) * K + k0 + 8 * c) = o; }
    asm volatile("s_waitcnt lgkmcnt(0)" ::: "memory");
}
__device__ __forceinline__ void cvt8(const float* s, bf16* d) { const f32x4 a = *(const f32x4*)s, b = *(const f32x4*)(s + 4); v4u o; o.x = pk2(a[0], a[1]); o.y = pk2(a[2], a[3]); o.z = pk2(b[0], b[1]); o.w = pk2(b[2], b[3]); *(v4u*)d = o; }

#define GAS __attribute__((address_space(1)))
#define RLX_AGENT __ATOMIC_RELAXED, __HIP_MEMORY_SCOPE_AGENT
#define XB_TMO      128
#define XB_XCNT(j)  (256  + 64 * (j))
#define XB_XSUB(j)  (1280 + 64 * (j))
#define XB_XGEN(j)  (2304 + 64 * (j))
#define XB_TOP      3328
#define XB_TOPGEN   3392
#define XCD_BAR_WORDS 3456
#define XB_SPIN_CAP (1u << 18)

__device__ __forceinline__ unsigned xb_ld(unsigned* p)              { return __hip_atomic_load(p, __ATOMIC_RELAXED, __HIP_MEMORY_SCOPE_AGENT); }
__device__ __forceinline__ unsigned xb_add(unsigned* p, unsigned v) { return __hip_atomic_fetch_add(p, v, __ATOMIC_RELAXED, __HIP_MEMORY_SCOPE_AGENT); }
__device__ __forceinline__ unsigned xb_xcc_id() { return (unsigned)__builtin_amdgcn_s_getreg((3 << 11) | 20) & 0xFu; }
#define XB_SPIN(cond, bar) do { unsigned _sp = 0; while (cond) { __builtin_amdgcn_s_sleep(1); \
    if ((++_sp & 255u) == 0u) { if (xb_ld(&(bar)[XB_TMO])) break; if (_sp > XB_SPIN_CAP) { atomicAdd(&(bar)[XB_TMO], 1u); break; } } } } while (0)

struct XcdBarrier {
    unsigned* bar; unsigned x;
    volatile LAS unsigned* st;
};

__device__ __forceinline__ XcdBarrier xcd_barrier_post(unsigned* bar, volatile LAS unsigned* st) {
    XcdBarrier b; b.bar = bar; b.x = xb_xcc_id(); b.st = st;
    if (threadIdx.x == 0) (void)xb_add(&bar[XB_XCNT(b.x)], 1u);
    return b;
}
__device__ __forceinline__ void xcd_barrier_complete(unsigned* bar, unsigned x, unsigned& nloc, unsigned& nx) {
    const unsigned G = gridDim.x * gridDim.y * gridDim.z;
    unsigned sum, cnt, mine, sp = 0u;
    for (;;) {
        sum = 0u; cnt = 0u; mine = 0u;
#pragma unroll
        for (unsigned j = 0; j < 16; ++j) { const unsigned c = xb_ld(&bar[XB_XCNT(j)]); sum += c; cnt += (c > 0u) ? 1u : 0u; mine = (j == x) ? c : mine; }
        if (sum == G) break;
        __builtin_amdgcn_s_sleep(1);
        if ((++sp & 255u) == 0u) { if (xb_ld(&bar[XB_TMO])) break; if (sp > XB_SPIN_CAP) { atomicAdd(&bar[XB_TMO], 1u); break; } }
    }
    nloc = mine > 0u ? mine : 1u; nx = cnt > 0u ? cnt : 1u;
}

__device__ __forceinline__ void xcd_barrier(const XcdBarrier& b) {
    asm volatile("s_waitcnt vmcnt(0)" ::: "memory");
    __syncthreads();
    if (threadIdx.x == 0) {
        unsigned* bar = b.bar;
        __builtin_amdgcn_s_waitcnt(0);
        unsigned nloc = b.st[0], nx = b.st[1];
        if (nloc == 0u) { xcd_barrier_complete(bar, b.x, nloc, nx); b.st[0] = nloc; b.st[1] = nx; }
        const unsigned old = xb_add(&bar[XB_XSUB(b.x)], 1u);
        const unsigned gen = old / nloc;
        if (old + 1u == (gen + 1u) * nloc) {
            __builtin_amdgcn_fence(__ATOMIC_RELEASE, "agent");
            asm volatile("s_waitcnt vmcnt(0)" ::: "memory");
            const unsigned og = xb_add(&bar[XB_TOP], 1u);
            const unsigned tg = og / nx;
            if (og + 1u == (tg + 1u) * nx) xb_add(&bar[XB_TOPGEN], 1u);
            else XB_SPIN(xb_ld(&bar[XB_TOPGEN]) == tg, bar);
            __builtin_amdgcn_fence(__ATOMIC_ACQUIRE, "agent");
            xb_add(&bar[XB_XGEN(b.x)], 1u);
            asm volatile("s_waitcnt vmcnt(0)" ::: "memory");
        } else {
            XB_SPIN(xb_ld(&bar[XB_XGEN(b.x)]) == gen, bar);
            __builtin_amdgcn_fence(__ATOMIC_ACQUIRE, "agent");
            asm volatile("s_waitcnt vmcnt(0)" ::: "memory");
        }
    }
    __syncthreads();
}

struct Args { const float* in[26]; float* out; unsigned char* ws; int ph_lo, ph_hi; };

__device__ __forceinline__ void adanorm_rows(const float* xp, const float* xs, const float* g, const float* mod, bf16* H, int gw, int NGW, int lane) {
    for (int grp = gw; grp < M1 / 4; grp += NGW) {
        const int row0 = grp * 4;
        const float* xr; int bb;
        if (row0 < MP) { xr = xp + (size_t)row0 * 1024; bb = row0 >> 11; } else { xr = xs + (size_t)(row0 - MP) * 1024; bb = NBP + ((row0 - MP) >> 5); }
        const float* md = mod + (size_t)bb * 3072;
        f32x4 v[4][4]; float s[4];
#pragma unroll
        for (int q = 0; q < 4; ++q) { s[q] = 0.f;
#pragma unroll
            for (int j = 0; j < 4; ++j) v[q][j] = *(const f32x4*)(xr + (size_t)q * 1024 + 4 * lane + 256 * j); }
#pragma unroll
        for (int q = 0; q < 4; ++q)
#pragma unroll
            for (int j = 0; j < 4; ++j) s[q] += pg8::ssq4(v[q][j]);
#pragma unroll
        for (int o = 1; o < 64; o <<= 1) {
#pragma unroll
            for (int q = 0; q < 4; ++q) s[q] += __shfl_xor(s[q], o); }
#pragma unroll
        for (int q = 0; q < 4; ++q) s[q] = rsqrtf(s[q] * (1.f / 1024.f) + EPSN);
#pragma unroll
        for (int j = 0; j < 4; ++j) { const int c = 4 * lane + 256 * j;
            const f32x4 gg = *(const f32x4*)(g + c) * (*(const f32x4*)(md + 1024 + c) + 1.f), sh = *(const f32x4*)(md + c);
#pragma unroll
            for (int q = 0; q < 4; ++q) { const f32x4 h = v[q][j] * s[q] * gg + sh;
                v2u o; o.x = pk2(h[0], h[1]); o.y = pk2(h[2], h[3]); *(v2u*)(H + (size_t)(row0 + q) * 1024 + c) = o; } }
    }
}

__global__ void __launch_bounds__(512, 2) hybrid_fwd(Args args) {
    extern __shared__ __attribute__((aligned(16))) unsigned char lds_raw[];
    LAS unsigned char* lds = (LAS unsigned char*)lds_raw;
    const int tid = threadIdx.x, lane = tid & 63, wave = __builtin_amdgcn_readfirstlane(tid >> 6);
    const int G = gridDim.x, bid = blockIdx.x;
    const int gw = bid * 8 + wave, NGW = G * 8;
    const int gt = bid * 512 + tid, NGT = G * 512;
    const int lo = args.ph_lo, hi = args.ph_hi;
    volatile LAS unsigned* MISC = (volatile LAS unsigned*)(lds + LDS_MISC);
    if (tid < 16) MISC[tid] = 0u;
    __syncthreads();
    XcdBarrier bar; bar.bar = nullptr; bar.x = 0; bar.st = nullptr;
    if (hi - lo > 1) bar = xcd_barrier_post((unsigned*)(args.ws + WS_BAR), MISC + 8);
#ifndef PHMASK
#define PHMASK 0x7ff
#endif
#ifndef PROBE_SYNC
#define PROBE_SYNC 0
#endif
#ifndef PROBE_REP
#define PROBE_REP 0
#endif
#define REP(k) for (int rep_ = 0; rep_ < 1 + ((PROBE_REP >> (k)) & 1); ++rep_)
#define IN(k) (((PHMASK >> (k)) & 1) && lo <= (k) && (k) < hi)
typedef const __attribute__((address_space(4))) Args* KArgs;
#define PHASE_ARGS() KArgs A = (KArgs)__builtin_amdgcn_kernarg_segment_ptr(); asm volatile("" : "+s"(A)); unsigned char* ws = A->ws; float* out = A->out; (void)ws; (void)out
#define WSP(T, off) ((T*)(ws + (off)))
#define SEAM(k) do { if (IN(k) && IN((k) + 1)) { if ((k) == 0) cg::this_grid().sync(); else xcd_barrier(bar); } } while (0)

    if (IN(0)) REP(0) {
        PHASE_ARGS();
        float* mod = WSP(float, WS_MOD); float* CS = WSP(float, WS_CS);
        bf16 *W_AIN = WSP(bf16, WS_W_AIN), *W_AOUT = WSP(bf16, WS_W_AOUT), *W_BIN = WSP(bf16, WS_W_BIN), *W_UQ = WSP(bf16, WS_W_UQ), *W_UKV = WSP(bf16, WS_W_UKV), *W_BOUT = WSP(bf16, WS_W_BOUT);
        bf16 *KA = WSP(bf16, WS_KA), *VA = WSP(bf16, WS_VA), *CKV = WSP(bf16, WS_CKV), *KR = WSP(bf16, WS_KR);
        {
            LAS float* scr = (LAS float*)(lds + wave * 10240);
            constexpr int I0 = 16 * 128, I1 = 16 * 32, I2 = 16 * 56, I3 = 6 * 48, I4 = 4 * 64, I5 = 16 * 32;
            for (int it = gw; it < I0 + I1 + I2 + I3 + I4 + I5; it += NGW) {
                int r = it;
                if (r < I0) { const int g = r % 128; transpose_item(A->in[11], 1024, 4096, src_col(0, g), W_AIN, g, (r / 128) * 64, scr, lane); continue; } r -= I0;
                if (r < I1) { const int g = r % 32; transpose_item(A->in[15], 1024, 1024, src_col(1, g), W_AOUT, g, (r / 32) * 64, scr, lane); continue; } r -= I1;
                if (r < I2) { const int g = r % 56; transpose_item(A->in[16], 1024, 1696, src_col(2, g), W_BIN, g, (r / 56) * 64, scr, lane); continue; } r -= I2;
                if (r < I3) { const int g = r % 48; transpose_item(A->in[18], 384, 1536, src_col(3, g), W_UQ, g, (r / 48) * 64, scr, lane); continue; } r -= I3;
                if (r < I4) { const int g = r % 64; transpose_item(A->in[20], 256, 2048, src_col(4, g), W_UKV, g, (r / 64) * 64, scr, lane); continue; } r -= I4;
                { const int g = r % 32; transpose_item(A->in[25], 1024, 1024, src_col(5, g), W_BOUT, g, (r / 32) * 64, scr, lane); }
            }
        }
        for (int it = bid; it < 2 * 48; it += G) {
            const int l = it / 48, jb = it % 48;
            LAS float* sl = (LAS float*)(lds + wave * 10240);
            float acc[40];
#pragma unroll
            for (int b = 0; b < 40; ++b) acc[b] = 0.f;
            for (int pass = 0; pass < 2; ++pass) {
                const int k0 = (wave + 8 * pass) * 64;
                for (int e = lane; e < 40 * 64; e += 64) { const int bb = e >> 6, k = e & 63; const float c = bb < NBP ? A->in[6][(size_t)bb * 1024 + k0 + k] : A->in[7][(size_t)(bb - NBP) * 1024 + k0 + k]; sl[e] = c / (1.f + __expf(-c)); }
                asm volatile("s_waitcnt lgkmcnt(0)" ::: "memory");
                const float* W = A->in[9] + (size_t)l * 1024 * 3072 + (size_t)k0 * 3072 + jb * 64 + lane;
                for (int k = 0; k < 64; k += 4) {
                    const float w0 = W[(size_t)k * 3072], w1 = W[(size_t)(k + 1) * 3072], w2 = W[(size_t)(k + 2) * 3072], w3 = W[(size_t)(k + 3) * 3072];
#pragma unroll
                    for (int b = 0; b < 40; ++b) { const f32x4 sv = *(const LAS f32x4*)(sl + b * 64 + k); acc[b] += (sv[0] * w0 + sv[1] * w1) + (sv[2] * w2 + sv[3] * w3); }
                }
                asm volatile("s_waitcnt lgkmcnt(0)" ::: "memory");
            }
            __syncthreads();
            LAS float* red = (LAS float*)lds;
#pragma unroll
            for (int b = 0; b < 40; ++b) red[(wave * 40 + b) * 64 + lane] = acc[b];
            __syncthreads();
            for (int e = tid; e < 40 * 64; e += 512) { const int b = e >> 6, j = e & 63; float sum = A->in[10][(size_t)l * 3072 + jb * 64 + j];
#pragma unroll
                for (int w = 0; w < 8; ++w) sum += red[(w * 40 + b) * 64 + j];
                mod[((size_t)l * 40 + b) * 3072 + jb * 64 + j] = sum; }
            __syncthreads();
        }
        for (int i = gt; i < NBS * SA_STRIDE * 128; i += NGT) {
            const int c8 = i & 127, rr = (i >> 7) % SA_STRIDE, bs = (i >> 7) / SA_STRIDE;
            const size_t d = ((size_t)MP + (size_t)bs * SA_STRIDE + rr) * 1024 + c8 * 8;
            if (rr < 512) { const size_t s = ((size_t)bs * 512 + rr) * 1024 + c8 * 8; cvt8(A->in[2] + s, KA + d); cvt8(A->in[3] + s, VA + d); }
            else if (rr >= 544) { *(v4u*)(KA + d) = (v4u){0, 0, 0, 0}; *(v4u*)(VA + d) = (v4u){0, 0, 0, 0}; }
        }
        for (int i = gt; i < NBS * SB_STRIDE * 32; i += NGT) {
            const int c8 = i & 31, rr = (i >> 5) % SB_STRIDE, bs = (i >> 5) / SB_STRIDE;
            const size_t d = ((size_t)MP + (size_t)bs * SB_STRIDE + rr) * 256 + c8 * 8;
            if (rr < 2048) cvt8(A->in[4] + ((size_t)bs * 2048 + rr) * 256 + c8 * 8, CKV + d);
            else if (rr >= 2080) *(v4u*)(CKV + d) = (v4u){0, 0, 0, 0};
        }
        for (int i = gt; i < NBS * SB_STRIDE * 4; i += NGT) {
            const int c8 = i & 3, rr = (i >> 2) % SB_STRIDE, bs = (i >> 2) / SB_STRIDE;
            const size_t d = ((size_t)MP + (size_t)bs * SB_STRIDE + rr) * 32 + c8 * 8;
            if (rr < 2048) cvt8(A->in[5] + ((size_t)bs * 2048 + rr) * 32 + c8 * 8, KR + d);
            else if (rr >= 2080) *(v4u*)(KR + d) = (v4u){0, 0, 0, 0};
        }
        { float* SSQ = WSP(float, WS_SSQ); for (int i = gt; i < M1; i += NGT) SSQ[i] = 0.f; }
        for (int i = gt; i < 2112 * 16; i += NGT) {
            const int pos = i >> 4, k = i & 15;
            const float inv = exp2f(-(float)k * (13.287712379549449f / 16.f));
            const float ang = (float)pos * inv;
            const double tr = (double)ang * 0.15915494309189535;
            const float fr = (float)(tr - floor(tr + 0.5));
            CS[pos * 32 + k] = __builtin_amdgcn_cosf(fr); CS[pos * 32 + 16 + k] = __builtin_amdgcn_sinf(fr);
        }
    }
    SEAM(0);
    if (IN(1)) REP(1) { PHASE_ARGS();
        const float* mod1 = WSP(float, WS_MOD) + 40 * 3072;
        {
            float* G1 = WSP(float, WS_G1); const float* g1 = A->in[8] + 1024;
            for (int i = gt; i < 40 * 1024; i += NGT) { const int bb = i >> 10, c = i & 1023; G1[i] = g1[c] * (1.f + mod1[(size_t)bb * 3072 + 1024 + c]); }
            float* SW = WSP(float, WS_SW); const bf16* WB = WSP(bf16, WS_W_BIN);
            for (int lc = gw; lc < 1792; lc += NGW) {
                const int lg = lc >> 5, pn = lg >> 3, rem = lg & 7, crow_ = (pn * 8 + (rem & 1) * 4 + (rem >> 1)) * 32 + (lc & 31);
                const v4u w0 = *(const v4u*)(WB + (size_t)crow_ * 1024 + 16 * lane), w1 = *(const v4u*)(WB + (size_t)crow_ * 1024 + 16 * lane + 8);
                float wf[16];
#pragma unroll
                for (int e = 0; e < 4; ++e) { wf[2 * e] = __uint_as_float(w0[e] << 16); wf[2 * e + 1] = __uint_as_float(w0[e] & 0xffff0000u); wf[8 + 2 * e] = __uint_as_float(w1[e] << 16); wf[8 + 2 * e + 1] = __uint_as_float(w1[e] & 0xffff0000u); }
                for (int bb = 0; bb < 40; ++bb) { const float* sh = mod1 + (size_t)bb * 3072 + 16 * lane; float a = 0.f;
#pragma unroll
                    for (int e = 0; e < 4; ++e) { const f32x4 x = *(const f32x4*)(sh + 4 * e); a += (x[0] * wf[4 * e] + x[1] * wf[4 * e + 1]) + (x[2] * wf[4 * e + 2] + x[3] * wf[4 * e + 3]); }
                    a = wave_sum(a); if (lane == 0) SW[(size_t)bb * 1792 + lc] = a; }
            }
        }
        adanorm_rows(A->in[0], A->in[1], A->in[8], WSP(float, WS_MOD), WSP(bf16, WS_H), gw, NGW, lane); }
    SEAM(1);
    if (IN(2)) REP(2) {
        PHASE_ARGS();
        int Kop = 1024; asm volatile("" : "+s"(Kop)); pg8::Gemm g{WSP(bf16, WS_H), WSP(bf16, WS_W_AIN), M1, 4096, Kop}; pg8::StaticOrder S; S.init(M1, 4096, G, bid);
        pg8::EpiAin E{WSP(bf16, WS_QA), WSP(bf16, WS_KA), WSP(bf16, WS_VA), WSP(bf16, WS_ZA), A->in[12], A->in[13], out + O_AKP, out + O_AVP, out + O_AKS, out + O_AVS};
        pg8::gemm_phase<pg8::EpiAin, pg8::StaticOrder, true, true>(lds, g, S, E);
    }
    SEAM(2);
    if (IN(3)) REP(3) {
        PHASE_ARGS();
        bf16 *QA = WSP(bf16, WS_QA), *KA = WSP(bf16, WS_KA), *VA = WSP(bf16, WS_VA), *ZA = WSP(bf16, WS_ZA), *H = WSP(bf16, WS_H); const float* tblp = A->in[14];
        __syncthreads();
        { int bh, qb;
          for (int k = 0; at::prompt_unit(k, G, bid, bh, qb); ++k) {
            at::AttnUnit a; const int b = bh >> 4, c0 = 4 * qb, tf = c0 > 8 ? c0 - 8 : 0;
            a.qrow0 = b * SEQ + 256 * qb; a.nq = 256; a.krow0 = b * SEQ + 64 * tf; a.nt = c0 + 3 - tf + 1; a.lastvalid = 64; a.head = bh & 15; a.c0 = c0; a.tf = tf;
            at::attn_unit<false>(lds, a, QA, KA, nullptr, VA, ZA, H, tblp);
          } }
        for (int s = bid; s < 128; s += G) {
            at::AttnUnit a; const int bs = s >> 4;
            a.qrow0 = MP + bs * TS; a.nq = 32; a.krow0 = MP + bs * SA_STRIDE; a.nt = 9; a.lastvalid = 32; a.head = s & 15; a.c0 = 8; a.tf = 0;
            at::attn_unit<false>(lds, a, QA, KA, nullptr, VA, ZA, H, tblp);
        }
    }
    SEAM(3);
    if (IN(4)) REP(4) {
        PHASE_ARGS();
        int Kop = 1024; asm volatile("" : "+s"(Kop)); pg8::Gemm g{WSP(bf16, WS_H), WSP(bf16, WS_W_AOUT), M1, 1024, Kop}; pg8::StaticOrder S; S.init(M1, 1024, G, bid);
        pg8::EpiRes E{A->in[0], A->in[1], out + O_YP, out + O_YS, WSP(float, WS_MOD) + 2048, WSP(bf16, WS_YG), WSP(float, WS_G1), WSP(float, WS_SSQ)};
        pg8::gemm_phase<pg8::EpiRes, pg8::StaticOrder, true, true>(lds, g, S, E);
    }
    if (IN(4) && IN(6)) { xcd_barrier(bar); }
    if (IN(6)) REP(6) {
        PHASE_ARGS();
        int Kop = 1024; asm volatile("" : "+s"(Kop)); pg8::Gemm g{WSP(bf16, WS_YG), WSP(bf16, WS_W_BIN), M1, 1792, Kop}; pg8::StaticOrder S; S.init(M1, 1792, G, bid);
        pg8::EpiBin E{WSP(bf16, WS_ZB), WSP(float, WS_RAW), WSP(float, WS_SSQ), WSP(float, WS_SW)};
        pg8::gemm_phase<pg8::EpiBin, pg8::StaticOrder, true, true>(lds, g, S, E);
    }
    SEAM(6);
    if (IN(7)) REP(7) {
        PHASE_ARGS();
        const float* RAW = WSP(float, WS_RAW); const float* CS = WSP(float, WS_CS); bf16 *CQ = WSP(bf16, WS_CQ), *CKV = WSP(bf16, WS_CKV), *KR = WSP(bf16, WS_KR);
        const float *gcq = A->in[17], *gckv = A->in[19], *gkr = A->in[24];
        for (int row = gw; row < M1; row += NGW) {
            const float* rw = RAW + (size_t)row * 768;
            int pos; size_t drow, orow;
            if (row < MP) { pos = row & (SEQ - 1); drow = (size_t)row; orow = (size_t)row; }
            else { const int rs = row - MP; pos = SEQ + (rs & 31); drow = (size_t)MP + (size_t)(rs >> 5) * SB_STRIDE + 2048 + (rs & 31); orow = (size_t)rs; }
            float* ockv = (row < MP ? out + O_CKVP : out + O_CKVS) + orow * 256;
            float* okr = (row < MP ? out + O_KRP : out + O_KRS) + orow * 32;
            float q[6]; float s = 0.f;
#pragma unroll
            for (int j = 0; j < 6; ++j) { q[j] = rw[lane + 64 * j]; s += q[j] * q[j]; }
            float r = rsqrtf(wave_sum(s) * (1.f / 384.f) + EPSN);
#pragma unroll
            for (int j = 0; j < 6; ++j) { const float v = q[j] * r * gcq[lane + 64 * j]; const unsigned b = pk2(v, 0.f); CQ[(size_t)row * 384 + lane + 64 * j] = (bf16)(b & 0xffffu); }
            const f32x4 kv = *(const f32x4*)(rw + 384 + 4 * lane);
            r = rsqrtf(wave_sum(pg8::ssq4(kv)) * (1.f / 256.f) + EPSN);
            const f32x4 kvn = kv * r * *(const f32x4*)(gckv + 4 * lane);
            *(f32x4*)(ockv + 4 * lane) = kvn;
            { v2u o; o.x = pk2(kvn[0], kvn[1]); o.y = pk2(kvn[2], kvn[3]); *(v2u*)(CKV + drow * 256 + 4 * lane) = o; }
            const float kr = lane < 32 ? rw[640 + lane] : 0.f;
            r = rsqrtf(wave_sum(kr * kr) * (1.f / 32.f) + EPSN);
            const float kn = kr * r * (lane < 32 ? gkr[lane] : 0.f);
            const float pr = __shfl_xor(kn, 16);
            const float cs = CS[pos * 32 + (lane & 15)], sn = CS[pos * 32 + 16 + (lane & 15)];
            const float ro = (lane & 16) ? (kn * cs + pr * sn) : (kn * cs - pr * sn);
            if (lane < 32) { okr[lane] = ro; const unsigned b = pk2(ro, 0.f); KR[drow * 32 + lane] = (bf16)(b & 0xffffu); }
        }
    }
    SEAM(7);
    if (IN(8)) REP(8) {
        { PHASE_ARGS(); int Kop = 384; asm volatile("" : "+s"(Kop)); pg8::Gemm g{WSP(bf16, WS_CQ), WSP(bf16, WS_W_UQ), M1, 1536, Kop}; pg8::StaticOrder S; S.init(M1, 1536, G, bid);
          pg8::EpiUq E{WSP(bf16, WS_QB), A->in[21], A->in[22], WSP(float, WS_CS)};
          pg8::gemm_phase<pg8::EpiUq, pg8::StaticOrder, true, true>(lds, g, S, E); }
        __syncthreads();
        { PHASE_ARGS(); int Kop = 256; asm volatile("" : "+s"(Kop)); pg8::Gemm g{WSP(bf16, WS_CKV), WSP(bf16, WS_W_UKV), R2, 2048, Kop}; pg8::StaticOrder S; S.init(R2, 2048, G, bid);
          pg8::EpiUkv E{WSP(bf16, WS_KN), WSP(bf16, WS_VB), A->in[23]};
          pg8::gemm_phase<pg8::EpiUkv, pg8::StaticOrder, true, true>(lds, g, S, E); }
    }
    SEAM(8);
    if (IN(9)) REP(9) {
        PHASE_ARGS();
        bf16 *QB = WSP(bf16, WS_QB), *KN = WSP(bf16, WS_KN), *KR = WSP(bf16, WS_KR), *VB = WSP(bf16, WS_VB), *ZB = WSP(bf16, WS_ZB), *H = WSP(bf16, WS_H);
        __syncthreads();
        { int bh, qb;
          for (int k = 0; at::prompt_unit(k, G, bid, bh, qb); ++k) {
            at::AttnUnit a; const int b = bh >> 4;
            a.qrow0 = b * SEQ + 256 * qb; a.nq = 256; a.krow0 = b * SEQ; a.nt = 4 * qb + 4; a.lastvalid = 64; a.head = bh & 15; a.c0 = 4 * qb; a.tf = 0;
            at::attn_unit<true>(lds, a, QB, KN, KR, VB, ZB, H, nullptr);
          } }
        for (int s = bid; s < 128; s += G) {
            at::AttnUnit a; const int bs = s >> 4;
            a.qrow0 = MP + bs * TS; a.nq = 32; a.krow0 = MP + bs * SB_STRIDE; a.nt = 33; a.lastvalid = 32; a.head = s & 15; a.c0 = 32; a.tf = 0;
            at::attn_unit<true>(lds, a, QB, KN, KR, VB, ZB, H, nullptr);
        }
    }
    SEAM(9);
    if (IN(10)) REP(10) {
        PHASE_ARGS();
        int Kop = 1024; asm volatile("" : "+s"(Kop)); pg8::Gemm g{WSP(bf16, WS_H), WSP(bf16, WS_W_BOUT), M1, 1024, Kop}; pg8::StaticOrder S; S.init(M1, 1024, G, bid);
        pg8::EpiRes E{out + O_YP, out + O_YS, out + O_YP, out + O_YS, WSP(float, WS_MOD) + 40 * 3072 + 2048, nullptr, nullptr, nullptr};
        pg8::gemm_phase<pg8::EpiRes, pg8::StaticOrder, true, true>(lds, g, S, E);
    }
#if PROBE_SYNC
    if (hi - lo > 1) { for (int q = 0; q < 18; ++q) cg::this_grid().sync(); }
#endif
#undef IN
#undef SEAM
}

constexpr int N_PHASES = 11;
extern "C" void kernel_launch(void* const* d_in, const int* in_sizes, int n_in, void* d_out, int out_size, void* d_ws, size_t ws_size, hipStream_t stream) {
    static int grid = 0;
    if (grid == 0) {
        if (n_in != 26 || ws_size < WS_END) { fprintf(stderr, "kernel_launch: unexpected inputs (n_in %d, ws %zu, need %zu)\n", n_in, ws_size, (size_t)WS_END); grid = -1; return; }
        int dev = 0, cus = 0, per_cu = 0;
        hipGetDevice(&dev); hipDeviceGetAttribute(&cus, hipDeviceAttributeMultiprocessorCount, dev);
        hipFuncSetAttribute((const void*)hybrid_fwd, hipFuncAttributeMaxDynamicSharedMemorySize, LDS_TOTAL);
        hipOccupancyMaxActiveBlocksPerMultiprocessor(&per_cu, (const void*)hybrid_fwd, 512, LDS_TOTAL);
        if (per_cu < 1) { fprintf(stderr, "kernel_launch: occupancy query says %d blocks per CU\n", per_cu); per_cu = 1; }
        (void)hipGetLastError();
        grid = cus * per_cu;
    }
    if (grid < 0) return;
    hipMemsetAsync((char*)d_ws + WS_BAR, 0, 16384, stream);
    Args a{};
    for (int i = 0; i < 26; ++i) a.in[i] = (const float*)d_in[i];
    a.out = (float*)d_out; a.ws = (unsigned char*)d_ws;
#if MULTI_LAUNCH
    for (int p = 0; p < N_PHASES; ++p) { a.ph_lo = p; a.ph_hi = p + 1; hipLaunchKernelGGL(hybrid_fwd, dim3(grid), dim3(512), LDS_TOTAL, stream, a); }
#else
    a.ph_lo = 0; a.ph_hi = N_PHASES;
    void* kargs[] = {&a};
    hipError_t e = hipLaunchCooperativeKernel((const void*)hybrid_fwd, dim3(grid), dim3(512), kargs, LDS_TOTAL, stream);
    if (e != hipSuccess) fprintf(stderr, "cooperative launch failed: %s (grid %d)\n", hipGetErrorString(e), grid);
#endif
}
```

```cpp
#include <hip/hip_runtime.h>
#include <hip/hip_cooperative_groups.h>
#include <cstdio>
#include <cstdint>
namespace cg = cooperative_groups;
#ifndef MULTI_LAUNCH
#define MULTI_LAUNCH 0
#endif
constexpr int DMODEL = 1024, NBP = 32, SEQ = 2048, NBS = 8, TS = 32;
constexpr int MP = NBP * SEQ;
constexpr int M1 = MP + NBS * TS;
constexpr int SA_STRIDE = 576;
constexpr int RA = MP + NBS * SA_STRIDE;
constexpr int SB_STRIDE = 2112;
constexpr int R2 = MP + NBS * SB_STRIDE;
constexpr float EPSN = 1e-6f;
constexpr float LOG2E = 1.4426950408889634f;
constexpr float QSCALE_A = 0.125f * LOG2E;
constexpr float QSCALE_B = 0.10206207261596575f * LOG2E;
namespace pg8 {
#define PG8_LAS __attribute__((address_space(3)))
typedef unsigned short bf16_t;
typedef short bf16x8 __attribute__((ext_vector_type(8)));
typedef float f32x4 __attribute__((ext_vector_type(4)));
typedef unsigned u32x4 __attribute__((ext_vector_type(4)));
constexpr int BM = 256, BK = 64, HALF = 128, HTB = HALF * BK * 2  , STAGE_BYTES = 8 * HTB, NXCD = 8, WGM = 8;

__host__ __device__ __forceinline__ int lds_byte(int r, int c) { const int st = (r >> 4) * 2 + (c >> 5), rr = r & 15, cc = c & 31, ob = rr * 64 + cc * 2; return st * 1024 + (ob ^ (((ob >> 9) & 1) << 5)); }
__host__ __device__ __forceinline__ void stage_rc(int b, int& R, int& C) { const int st = b / 1024, sb = b % 1024, swz = sb ^ (((sb >> 9) & 1) << 5); R = (st >> 1) * 16 + swz / 64; C = (st & 1) * 32 + (swz % 64) / 2; }
__host__ __device__ __forceinline__ int perm32(int rho) { const int n = rho >> 4, i = rho & 15; return 8 * (i >> 2) + 4 * n + (i & 3); }

struct Unit { int pm, pn; };
struct Gemm { const bf16_t* A; const bf16_t* Bt; int M, N, K; };

struct StaticOrder {
    int nM, nN, nwg, G, c;
    __host__ __device__ void init(int M, int N, int G_, int c_) { nM = M / BM; nN = N / BM; nwg = nM * nN; G = G_; c = c_; }
    __host__ __device__ bool next(int i, Unit& u) const {
        const long L = (long)i * G + c; if (L >= nwg) return false;
        int wgid = (int)L; { const int q = nwg / NXCD, r = nwg % NXCD, xcd = wgid % NXCD, off = wgid / NXCD; wgid = (xcd < r ? xcd * (q + 1) : r * (q + 1) + (xcd - r) * q) + off; }
        const int nig = WGM * nN, gid = wgid / nig, fm = gid * WGM, gsz = (nM - fm) < WGM ? (nM - fm) : WGM;
        u.pm = fm + ((wgid % nig) % gsz); u.pn = (wgid % nig) / gsz; return true;
    }
    __device__ __forceinline__ void a_ready(const Unit&) const {}
    __device__ __forceinline__ void done(const Unit&) const {}
};

__device__ __forceinline__ unsigned cvt_pk_bf16(float lo, float hi) { unsigned r; asm volatile("v_cvt_pk_bf16_f32 %0, %1, %2" : "=v"(r) : "v"(lo), "v"(hi)); return r; }
template <class Epi, class Sched, bool ALIGN_EPI = false, bool SP2 = false>
__device__ __forceinline__ void gemm_phase(PG8_LAS unsigned char* lds, const Gemm g, const Sched& S, const Epi& E) {
    const int tid = threadIdx.x, wid = __builtin_amdgcn_readfirstlane(tid >> 6), lane = tid & 63, wr = wid >> 2, wc = wid & 3, fr = lane & 15, fq = lane >> 4;
    const int K = g.K, nt = K / BK;
    unsigned voffA[2], voffB[2];
#pragma unroll
    for (int i = 0; i < 2; ++i) { int R, C; stage_rc(tid * 16 + i * 8192, R, C); const int Rb = Epi::PERM ? ((R & ~31) + perm32(R & 31)) : R;
        voffA[i] = (unsigned)(R * K + C) * 2u; voffB[i] = (unsigned)(Rb * K + C) * 2u; }
    const size_t kstep = (size_t)(BK * 2);
    const size_t hstep = (size_t)HALF * K * 2;
    const size_t tstep = 2 * hstep;
    const unsigned ldsw = (unsigned)wid * 1024u;
    const int aoff = lds_byte(wr * 64 + fr, fq * 8), boff = lds_byte(wc * 32 + fr, fq * 8);
#define PG8_SA(b, h) (((b) * 2 + (h)) * HTB)
#define PG8_SB(b, h) ((4 + (b) * 2 + (h)) * HTB)
#define PG8_STAGE(bufoff, gbase, voff) do { _Pragma("unroll") for (int _i = 0; _i < 2; ++_i) \
        __builtin_amdgcn_global_load_lds((const unsigned*)((const char*)(gbase) + (voff)[_i]), (PG8_LAS unsigned*)(lds + (bufoff) + ldsw + _i * 8192), 16, 0, 0); } while (0)
#define PG8_LDA(dst, b, h) do { _Pragma("unroll") for (int m = 0; m < 4; ++m) _Pragma("unroll") for (int k = 0; k < 2; ++k) dst[m][k] = *(const PG8_LAS bf16x8*)(lds + PG8_SA(b, h) + aoff + m * 2048 + k * 1024); } while (0)
#define PG8_LDB(dst, b, h) do { _Pragma("unroll") for (int n = 0; n < 2; ++n) _Pragma("unroll") for (int k = 0; k < 2; ++k) dst[n][k] = *(const PG8_LAS bf16x8*)(lds + PG8_SB(b, h) + boff + n * 2048 + k * 1024); } while (0)
#define PG8_MMA(ai, bj, At, Bt) do { __builtin_amdgcn_s_setprio(1); _Pragma("unroll") for (int m = 0; m < 4; ++m) _Pragma("unroll") for (int n = 0; n < 2; ++n) _Pragma("unroll") for (int k = 0; k < 2; ++k) \
        acc[ai][bj][m][n] = __builtin_amdgcn_mfma_f32_16x16x32_bf16(Bt[n][k], At[m][k], acc[ai][bj][m][n], 0, 0, 0); __builtin_amdgcn_s_setprio(0); } while (0)
#define PG8_WAIT_V(n) asm volatile("s_waitcnt vmcnt(" #n ")" ::: "memory")
#define PG8_WAIT_L(n) asm volatile("s_waitcnt lgkmcnt(" #n ")" ::: "memory")
#define PG8_BAR __builtin_amdgcn_s_barrier()
#define PG8_SCHED __builtin_amdgcn_sched_barrier(0)
    Unit cur, nxt; int ui = 0;
    if (!S.next(0, cur)) return;
    f32x4 acc[2][2][4][2];
#pragma unroll
    for (int a = 0; a < 2; ++a)
#pragma unroll
        for (int b = 0; b < 2; ++b)
#pragma unroll
            for (int m = 0; m < 4; ++m)
#pragma unroll
                for (int n = 0; n < 2; ++n) acc[a][b][m][n] = (f32x4){0.f, 0.f, 0.f, 0.f};
    bf16x8 At[4][2], B0[2][2], B1[2][2];
    const char* cA = (const char*)g.A + (size_t)cur.pm * tstep; const char* cB = (const char*)g.Bt + (size_t)cur.pn * tstep;
    S.a_ready(cur);
    if constexpr (SP2) {
        PG8_STAGE(PG8_SB(0, 0), cB, voffB); PG8_STAGE(PG8_SB(0, 1), cB + hstep, voffB); PG8_STAGE(PG8_SA(0, 0), cA, voffA); PG8_STAGE(PG8_SA(0, 1), cA + hstep, voffA);
        if (wr == 1) PG8_BAR;
        PG8_WAIT_V(2); PG8_BAR;
        PG8_STAGE(PG8_SB(1, 0), cB + kstep, voffB); PG8_STAGE(PG8_SA(1, 0), cA + kstep, voffA); PG8_STAGE(PG8_SB(1, 1), cB + hstep + kstep, voffB);
        PG8_WAIT_V(6); PG8_BAR;
    } else {
        PG8_STAGE(PG8_SB(0, 0), cB, voffB); PG8_STAGE(PG8_SA(0, 0), cA, voffA); PG8_STAGE(PG8_SB(0, 1), cB + hstep, voffB); PG8_STAGE(PG8_SA(0, 1), cA + hstep, voffA);
        if (wr == 1) PG8_BAR;
        PG8_WAIT_V(4); PG8_BAR;
        PG8_STAGE(PG8_SB(1, 0), cB + kstep, voffB); PG8_STAGE(PG8_SA(1, 0), cA + kstep, voffA); PG8_STAGE(PG8_SB(1, 1), cB + hstep + kstep, voffB);
        PG8_WAIT_V(6); PG8_BAR;
    }
    for (;;) {
        const bool has_next = S.next(ui + 1, nxt);
        const char* nA = has_next ? (const char*)g.A + (size_t)nxt.pm * tstep : cA; const char* nB = has_next ? (const char*)g.Bt + (size_t)nxt.pn * tstep : cB;
        for (int t = 0; t < nt; t += 2) {
            const bool last = (t == nt - 2);
            const char* a1 = cA + (size_t)(t + 1) * kstep;
            const char* a2 = last ? nA : cA + (size_t)(t + 2) * kstep; const char* b2 = last ? nB : cB + (size_t)(t + 2) * kstep;
            const char* a3 = a2 + kstep; const char* b3 = b2 + kstep;
            if (last && has_next) S.a_ready(nxt);
            if constexpr (SP2) {
            PG8_LDB(B0, 0, 0); PG8_LDB(B1, 0, 1); PG8_SCHED; PG8_LDA(At, 0, 0); PG8_STAGE(PG8_SA(1, 1), a1 + hstep, voffA);
            PG8_WAIT_V(8); PG8_WAIT_L(0); PG8_BAR; PG8_MMA(0, 0, At, B0); PG8_MMA(0, 1, At, B1); PG8_BAR; PG8_SCHED;
            PG8_LDA(At, 0, 1); PG8_STAGE(PG8_SB(0, 0), b2, voffB); PG8_STAGE(PG8_SB(0, 1), b2 + hstep, voffB); PG8_STAGE(PG8_SA(0, 0), a2, voffA);
            PG8_WAIT_V(8); PG8_WAIT_L(0); PG8_BAR; PG8_MMA(1, 0, At, B0); PG8_MMA(1, 1, At, B1); PG8_BAR; PG8_SCHED;
            PG8_LDB(B0, 1, 0); PG8_LDB(B1, 1, 1); PG8_SCHED; PG8_LDA(At, 1, 0); PG8_STAGE(PG8_SA(0, 1), a2 + hstep, voffA);
            PG8_WAIT_V(8); PG8_WAIT_L(0); PG8_BAR; PG8_MMA(0, 0, At, B0); PG8_MMA(0, 1, At, B1); PG8_BAR; PG8_SCHED;
            PG8_LDA(At, 1, 1); PG8_STAGE(PG8_SB(1, 0), b3, voffB); PG8_STAGE(PG8_SB(1, 1), b3 + hstep, voffB); PG8_STAGE(PG8_SA(1, 0), a3, voffA);
            PG8_WAIT_V(8); PG8_WAIT_L(0); PG8_BAR; PG8_MMA(1, 0, At, B0); PG8_MMA(1, 1, At, B1); PG8_BAR; PG8_SCHED;
            } else {
            PG8_LDB(B0, 0, 0); PG8_SCHED; PG8_LDA(At, 0, 0); PG8_STAGE(PG8_SA(1, 1), a1 + hstep, voffA);
            PG8_WAIT_L(8); PG8_BAR; PG8_WAIT_L(0); PG8_MMA(0, 0, At, B0); PG8_BAR; PG8_SCHED;
            PG8_LDB(B1, 0, 1); PG8_STAGE(PG8_SB(0, 0), b2, voffB);
            PG8_BAR; PG8_WAIT_L(0); PG8_MMA(0, 1, At, B1); PG8_BAR;
            PG8_LDA(At, 0, 1); PG8_STAGE(PG8_SA(0, 0), a2, voffA);
            PG8_BAR; PG8_WAIT_L(0); PG8_MMA(1, 0, At, B0); PG8_BAR; PG8_SCHED;
            PG8_STAGE(PG8_SB(0, 1), b2 + hstep, voffB);
            PG8_WAIT_V(6); PG8_BAR; PG8_MMA(1, 1, At, B1); PG8_BAR;
            PG8_LDB(B0, 1, 0); PG8_SCHED; PG8_LDA(At, 1, 0); PG8_STAGE(PG8_SA(0, 1), a2 + hstep, voffA);
            PG8_WAIT_L(8); PG8_BAR; PG8_WAIT_L(0); PG8_MMA(0, 0, At, B0); PG8_BAR; PG8_SCHED;
            PG8_LDB(B1, 1, 1); PG8_STAGE(PG8_SB(1, 0), b3, voffB);
            PG8_BAR; PG8_WAIT_L(0); PG8_MMA(0, 1, At, B1); PG8_BAR;
            PG8_LDA(At, 1, 1); PG8_STAGE(PG8_SA(1, 0), a3, voffA);
            PG8_BAR; PG8_WAIT_L(0); PG8_MMA(1, 0, At, B0); PG8_BAR; PG8_SCHED;
            PG8_STAGE(PG8_SB(1, 1), b3 + hstep, voffB);
            PG8_WAIT_V(6); PG8_BAR; PG8_MMA(1, 1, At, B1); PG8_BAR;
            }
        }
        if constexpr (ALIGN_EPI) { if (wr == 0) PG8_BAR; }
        if constexpr (!Epi::AFTER_DRAIN) { E(acc, cur, wr, wc, fr, fq); S.done(cur); }
        if (!has_next) break;
#pragma unroll
        for (int a = 0; a < 2; ++a)
#pragma unroll
            for (int b = 0; b < 2; ++b)
#pragma unroll
                for (int m = 0; m < 4; ++m)
#pragma unroll
                    for (int n = 0; n < 2; ++n) acc[a][b][m][n] = (f32x4){0.f, 0.f, 0.f, 0.f};
        cur = nxt; cA = nA; cB = nB; ++ui;
        if constexpr (ALIGN_EPI) { if (wr == 1) PG8_BAR; }
    }
    PG8_WAIT_V(0);
    if constexpr (!ALIGN_EPI) { if (wr == 0) PG8_BAR; }
    PG8_BAR;
    if constexpr (Epi::AFTER_DRAIN) { E.fused(acc, cur, wr, wc, fr, fq, lds, wid, lane); S.done(cur); }
#undef PG8_SA
#undef PG8_SB
#undef PG8_STAGE
#undef PG8_LDA
#undef PG8_LDB
#undef PG8_MMA
#undef PG8_WAIT_V
#undef PG8_WAIT_L
#undef PG8_BAR
#undef PG8_SCHED
}
typedef unsigned u32x2 __attribute__((ext_vector_type(2)));
typedef float f32x2 __attribute__((ext_vector_type(2)));
typedef __bf16 bf16x2_t __attribute__((ext_vector_type(2)));
__device__ __forceinline__ unsigned pkbf(float lo, float hi) { f32x2 v = {lo, hi}; bf16x2_t b = __builtin_convertvector(v, bf16x2_t); return __builtin_bit_cast(unsigned, b); }
__device__ __forceinline__ u32x2 pk4(f32x4 v) { u32x2 r; r.x = pkbf(v[0], v[1]); r.y = pkbf(v[2], v[3]); return r; }
__device__ __forceinline__ float silu_f(float v) { return v * __builtin_amdgcn_rcpf(1.f + __expf(-v)); }
__device__ __forceinline__ f32x4 silu4(f32x4 v) { f32x4 o; o[0] = silu_f(v[0]); o[1] = silu_f(v[1]); o[2] = silu_f(v[2]); o[3] = silu_f(v[3]); return o; }
__device__ __forceinline__ float ssq4(f32x4 v) { return (v[0] * v[0] + v[1] * v[1]) + (v[2] * v[2] + v[3] * v[3]); }
__device__ __forceinline__ float red_fq(float s) { s += __shfl_xor(s, 16); s += __shfl_xor(s, 32); return s; }

struct EpiAin {
    static constexpr bool PERM = false, AFTER_DRAIN = false;
    bf16_t *Q, *K, *V, *Z; const float *gq, *gk; float *okp, *ovp, *oks, *ovs;
    __device__ __forceinline__ void operator()(const f32x4 (&acc)[2][2][4][2], const Unit& u, int wr, int wc, int fr, int fq) const {
        const int sec = u.pn >> 2, head = (u.pn & 3) * 4 + wc, cb = head * 64 + 4 * fq;
        f32x4 g[2][2];
#pragma unroll
        for (int bj = 0; bj < 2; ++bj)
#pragma unroll
            for (int n = 0; n < 2; ++n) g[bj][n] = (sec < 2) ? *(const f32x4*)((sec == 0 ? gq : gk) + 32 * bj + 16 * n + 4 * fq) : (f32x4){1.f, 1.f, 1.f, 1.f};
#pragma unroll
        for (int ai = 0; ai < 2; ++ai)
#pragma unroll
            for (int m = 0; m < 4; ++m) {
                const int row = u.pm * BM + ai * HALF + wr * 64 + m * 16 + fr;
                f32x4 v[2][2];
#pragma unroll
                for (int bj = 0; bj < 2; ++bj)
#pragma unroll
                    for (int n = 0; n < 2; ++n) v[bj][n] = acc[ai][bj][m][n];
                if (sec < 2) {
                    float s = (ssq4(v[0][0]) + ssq4(v[0][1])) + (ssq4(v[1][0]) + ssq4(v[1][1]));
                    s = red_fq(s);
                    const float r = rsqrtf(s * (1.f / 64.f) + EPSN) * (sec == 0 ? QSCALE_A : 1.f);
#pragma unroll
                    for (int bj = 0; bj < 2; ++bj)
#pragma unroll
                        for (int n = 0; n < 2; ++n) v[bj][n] = v[bj][n] * g[bj][n] * r;
                } else if (sec == 3) {
#pragma unroll
                    for (int bj = 0; bj < 2; ++bj)
#pragma unroll
                        for (int n = 0; n < 2; ++n) v[bj][n] = silu4(v[bj][n]);
                }
                if (sec == 0 || sec == 3) {
                    bf16_t* d = (sec == 0 ? Q : Z) + (size_t)row * 1024 + cb;
#pragma unroll
                    for (int bj = 0; bj < 2; ++bj)
#pragma unroll
                        for (int n = 0; n < 2; ++n) *(u32x2*)(d + 32 * bj + 16 * n) = pk4(v[bj][n]);
                } else {
                    size_t drow; float* of = nullptr;
                    if (row < MP) { drow = (size_t)row; const int pos = row & (SEQ - 1); if (pos >= SEQ - 512) of = (sec == 1 ? okp : ovp) + ((size_t)((row >> 11) * 512 + pos - (SEQ - 512))) * 1024; }
                    else { const int rs = row - MP; drow = (size_t)MP + (size_t)(rs >> 5) * SA_STRIDE + 512 + (rs & 31); of = (sec == 1 ? oks : ovs) + (size_t)rs * 1024; }
                    bf16_t* d = (sec == 1 ? K : V) + drow * 1024 + cb;
#pragma unroll
                    for (int bj = 0; bj < 2; ++bj)
#pragma unroll
                        for (int n = 0; n < 2; ++n) { *(u32x2*)(d + 32 * bj + 16 * n) = pk4(v[bj][n]); if (of) *(f32x4*)(of + cb + 32 * bj + 16 * n) = v[bj][n]; }
                }
                asm volatile("" ::: "memory");
            }
    }
};
struct EpiRes {
    static constexpr bool PERM = false, AFTER_DRAIN = false;
    const float *xp, *xs; float *yp, *ys; const float* gate;
    bf16_t* YG; const float* G1; float* ssq;
    __device__ __forceinline__ void operator()(const f32x4 (&acc)[2][2][4][2], const Unit& u, int wr, int wc, int fr, int fq) const {
        const int cb = u.pn * 256 + wc * 64 + 4 * fq;
#pragma unroll
        for (int ai = 0; ai < 2; ++ai)
#pragma unroll
            for (int m = 0; m < 4; ++m) {
                const int row = u.pm * BM + ai * HALF + wr * 64 + m * 16 + fr;
                const float* xi; float* yo; int bb;
                if (row < MP) { xi = xp + (size_t)row * 1024; yo = yp + (size_t)row * 1024; bb = row >> 11; }
                else { const int rs = row - MP; xi = xs + (size_t)rs * 1024; yo = ys + (size_t)rs * 1024; bb = NBP + (rs >> 5); }
                const float* gp = gate + (size_t)bb * 3072;
                float sq = 0.f;
#pragma unroll
                for (int bj = 0; bj < 2; ++bj)
#pragma unroll
                    for (int n = 0; n < 2; ++n) { const int c = cb + 32 * bj + 16 * n; const f32x4 o = *(const f32x4*)(xi + c) + *(const f32x4*)(gp + c) * acc[ai][bj][m][n]; *(f32x4*)(yo + c) = o;
                        if (YG) { sq += ssq4(o); *(u32x2*)(YG + (size_t)row * 1024 + c) = pk4(o * *(const f32x4*)(G1 + (size_t)bb * 1024 + c)); } }
                if (YG) { sq = red_fq(sq); if (fq == 0) atomicAdd(ssq + row, sq); }
                asm volatile("" ::: "memory");
            }
    }
};
struct EpiBin {
    static constexpr bool PERM = false, AFTER_DRAIN = false;
    bf16_t* Z; bf16_t* CQ; bf16_t* CKV; float* RAW2; const float* ssq; const float* SW; const float* gcq; const float* gckv; float* ssqq; float* ssqkv;
    __device__ __forceinline__ void operator()(const f32x4 (&acc)[2][2][4][2], const Unit& u, int wr, int wc, int fr, int fq) const {
        const int cb = u.pn * 256 + wc * 64 + 4 * fq;
        const int sidx = (u.pn - 4) * 4 + wc;
#pragma unroll
        for (int ai = 0; ai < 2; ++ai)
#pragma unroll
            for (int m = 0; m < 4; ++m) {
                const int row = u.pm * BM + ai * HALF + wr * 64 + m * 16 + fr;
                const int bb = row < MP ? (row >> 11) : NBP + ((row - MP) >> 5);
                const float r = rsqrtf(ssq[row] * (1.f / 1024.f) + EPSN);
                const float* sw = SW + (size_t)bb * 1792;
                f32x4 v[2][2];
#pragma unroll
                for (int bj = 0; bj < 2; ++bj)
#pragma unroll
                    for (int n = 0; n < 2; ++n) v[bj][n] = acc[ai][bj][m][n] * r + *(const f32x4*)(sw + cb + 32 * bj + 16 * n);
                if (u.pn < 4) {
#pragma unroll
                    for (int bj = 0; bj < 2; ++bj)
#pragma unroll
                        for (int n = 0; n < 2; ++n) *(u32x2*)(Z + (size_t)row * 1024 + cb + 32 * bj + 16 * n) = pk4(silu4(v[bj][n]));
                } else if (sidx < 10) {
                    float sq = (ssq4(v[0][0]) + ssq4(v[0][1])) + (ssq4(v[1][0]) + ssq4(v[1][1]));
                    sq = red_fq(sq);
                    if (sidx < 6) {
                        const int c0 = cb - 1024;
                        if (fq == 0) atomicAdd(ssqq + row, sq);
#pragma unroll
                        for (int bj = 0; bj < 2; ++bj)
#pragma unroll
                            for (int n = 0; n < 2; ++n) { const int c = c0 + 32 * bj + 16 * n; *(u32x2*)(CQ + (size_t)row * 384 + c) = pk4(v[bj][n] * *(const f32x4*)(gcq + c)); }
                    } else {
                        const int c0 = cb - 1408;
                        const size_t drow = row < MP ? (size_t)row : (size_t)MP + (size_t)((row - MP) >> 5) * SB_STRIDE + 2048 + ((row - MP) & 31);
                        if (fq == 0) atomicAdd(ssqkv + row, sq);
#pragma unroll
                        for (int bj = 0; bj < 2; ++bj)
#pragma unroll
                            for (int n = 0; n < 2; ++n) { const int c = c0 + 32 * bj + 16 * n; *(u32x2*)(CKV + drow * 256 + c) = pk4(v[bj][n] * *(const f32x4*)(gckv + c)); *(f32x4*)(RAW2 + (size_t)row * 288 + c) = v[bj][n]; }
                    }
                } else if (sidx == 10) {
#pragma unroll
                    for (int n = 0; n < 2; ++n) *(f32x4*)(RAW2 + (size_t)row * 288 + 256 + 4 * fq + 16 * n) = v[0][n];
                }
                asm volatile("" ::: "memory");
            }
    }
};
struct EpiUq {
    static constexpr bool PERM = false, AFTER_DRAIN = false;
    bf16_t* Q; const float *gqn, *gqr, *CS; const float* ssqq;
    __device__ __forceinline__ void operator()(const f32x4 (&acc)[2][2][4][2], const Unit& u, int wr, int wc, int fr, int fq) const {
        if (u.pn < 4) {
            const int head = u.pn * 4 + wc;
#pragma unroll
            for (int ai = 0; ai < 2; ++ai)
#pragma unroll
                for (int m = 0; m < 4; ++m) {
                    const int row = u.pm * BM + ai * HALF + wr * 64 + m * 16 + fr;
                    float s = (ssq4(acc[ai][0][m][0]) + ssq4(acc[ai][0][m][1])) + (ssq4(acc[ai][1][m][0]) + ssq4(acc[ai][1][m][1]));
                    s = red_fq(s);
                    const float rq = rsqrtf(ssqq[row] * (1.f / 384.f) + EPSN);
                    const float r = rsqrtf(s * rq * rq * (1.f / 64.f) + EPSN) * rq * QSCALE_B;
                    bf16_t* d = Q + (size_t)row * 1536 + head * 96 + 4 * fq;
#pragma unroll
                    for (int bj = 0; bj < 2; ++bj)
#pragma unroll
                        for (int n = 0; n < 2; ++n) *(u32x2*)(d + 32 * bj + 16 * n) = pk4(acc[ai][bj][m][n] * *(const f32x4*)(gqn + 32 * bj + 16 * n + 4 * fq) * r);
                    asm volatile("" ::: "memory");
                }
        } else {
#pragma unroll
            for (int ai = 0; ai < 2; ++ai)
#pragma unroll
                for (int m = 0; m < 4; ++m) {
                    const int row = u.pm * BM + ai * HALF + wr * 64 + m * 16 + fr;
                    const int pos = row < MP ? (row & (SEQ - 1)) : SEQ + ((row - MP) & 31);
                    const float rq = rsqrtf(ssqq[row] * (1.f / 384.f) + EPSN);
#pragma unroll
                    for (int bj = 0; bj < 2; ++bj) {
                        const int hr = (u.pn - 4) * 8 + wc * 2 + bj;
                        float s = ssq4(acc[ai][bj][m][0]) + ssq4(acc[ai][bj][m][1]);
                        s = red_fq(s);
                        const float r = rsqrtf(s * rq * rq * (1.f / 32.f) + EPSN) * rq;
                        const f32x4 x1 = acc[ai][bj][m][0] * *(const f32x4*)(gqr + 4 * fq) * r, x2 = acc[ai][bj][m][1] * *(const f32x4*)(gqr + 16 + 4 * fq) * r;
                        const f32x4 cs = *(const f32x4*)(CS + pos * 32 + 4 * fq), sn = *(const f32x4*)(CS + pos * 32 + 16 + 4 * fq);
                        bf16_t* d = Q + (size_t)row * 1536 + hr * 96 + 64 + 4 * fq;
                        *(u32x2*)d = pk4((x1 * cs - x2 * sn) * QSCALE_B); *(u32x2*)(d + 16) = pk4((x2 * cs + x1 * sn) * QSCALE_B);
                        asm volatile("" ::: "memory");
                    }
                }
        }
    }
};
struct EpiUkv {
    static constexpr bool PERM = false, AFTER_DRAIN = false;
    bf16_t *KN, *VB; const float* gkn; const float* ssqkv;
    __device__ __forceinline__ void operator()(const f32x4 (&acc)[2][2][4][2], const Unit& u, int wr, int wc, int fr, int fq) const {
        const bool isk = u.pn < 4; const int head = (u.pn & 3) * 4 + wc;
#pragma unroll
        for (int ai = 0; ai < 2; ++ai)
#pragma unroll
            for (int m = 0; m < 4; ++m) {
                const int row = u.pm * BM + ai * HALF + wr * 64 + m * 16 + fr;
                float rs = 1.f;
                if (u.pm < MP / BM) rs = rsqrtf(ssqkv[row] * (1.f / 256.f) + EPSN);
                else { const int q_ = row - MP, bs_ = q_ / SB_STRIDE, rr_ = q_ - bs_ * SB_STRIDE; if (rr_ >= 2048 && rr_ < 2080) rs = rsqrtf(ssqkv[MP + bs_ * TS + rr_ - 2048] * (1.f / 256.f) + EPSN); }
                float r = rs;
                if (isk) { float s = (ssq4(acc[ai][0][m][0]) + ssq4(acc[ai][0][m][1])) + (ssq4(acc[ai][1][m][0]) + ssq4(acc[ai][1][m][1])); s = red_fq(s); r = rsqrtf(s * rs * rs * (1.f / 64.f) + EPSN) * rs; }
                bf16_t* d = (isk ? KN : VB) + (size_t)row * 1024 + head * 64 + 4 * fq;
#pragma unroll
                for (int bj = 0; bj < 2; ++bj)
#pragma unroll
                    for (int n = 0; n < 2; ++n) { const f32x4 gg = isk ? *(const f32x4*)(gkn + 32 * bj + 16 * n + 4 * fq) : (f32x4){1.f, 1.f, 1.f, 1.f}; *(u32x2*)(d + 32 * bj + 16 * n) = pk4(acc[ai][bj][m][n] * gg * r); }
                asm volatile("" ::: "memory");
            }
    }
};
}
namespace at {
#define ALAS __attribute__((address_space(3)))
typedef unsigned short bf16_t;
typedef short bf16x8 __attribute__((ext_vector_type(8)));
typedef short s16x4 __attribute__((ext_vector_type(4)));
typedef float f32x16 __attribute__((ext_vector_type(16)));
typedef float f32x4 __attribute__((ext_vector_type(4)));
typedef unsigned u32x4 __attribute__((ext_vector_type(4)));
typedef unsigned u32x2 __attribute__((ext_vector_type(2)));
constexpr int KROW = 144, VROW = 144, RROW = 80;
constexpr int KBUF = 64 * KROW, VBUF = 64 * VROW, RBUF = 64 * RROW, STAGE = KBUF + VBUF + RBUF;
constexpr int NSTAGE = 2, TBL_OFF = NSTAGE * STAGE, LDS_BYTES = TBL_OFF + 1280;
struct AttnUnit { int qrow0, nq, krow0, nt, lastvalid, head, c0, tf; };
__device__ __forceinline__ int crow(int r, int hi) { return (r & 3) + 8 * (r >> 2) + 4 * hi; }

template <bool MLA>
__device__ __forceinline__ void attn_unit(ALAS unsigned char* lds, const AttnUnit u, const bf16_t* __restrict__ Q, const bf16_t* __restrict__ Kn, const bf16_t* __restrict__ Kr,
                                          const bf16_t* __restrict__ V, const bf16_t* __restrict__ Z, bf16_t* __restrict__ U, const float* __restrict__ tbl) {
    int tid_ = threadIdx.x; asm volatile("" : "+v"(tid_));
    const int tid = tid_, lane = tid & 63, wid = __builtin_amdgcn_readfirstlane(tid >> 6), l32 = lane & 31, hi = lane >> 5;
    const int ci = wid >> 1, qh = wid & 1;
    const bool active = ci * 64 + qh * 32 < u.nq;
    const int cq = u.c0 + ci;
    constexpr int QS = MLA ? 1536 : 1024, HS = MLA ? 96 : 64, ND0 = MLA ? 6 : 4;
    constexpr float THR = 8.f;
    ALAS float* tb = (ALAS float*)(lds + TBL_OFF);
    if (!MLA) { if (tid < 320) tb[tid] = tid < 257 ? (tbl[(size_t)u.head * 257 + tid] - tbl[(size_t)u.head * 257 + 256]) * LOG2E : 0.f; }
    const int qrow = u.qrow0 + (active ? ci * 64 + qh * 32 : 0) + l32;
    bf16x8 qf[ND0];
#pragma unroll
    for (int d0 = 0; d0 < ND0; ++d0) qf[d0] = *(const bf16x8*)(Q + (size_t)qrow * QS + u.head * HS + d0 * 16 + hi * 8);
    const char* kbase = (const char*)(Kn + (size_t)u.krow0 * 1024 + u.head * 64);
    const char* vbase = (const char*)(V + (size_t)u.krow0 * 1024 + u.head * 64);
    const char* rbase = MLA ? (const char*)(Kr + (size_t)u.krow0 * 32) : nullptr;
    const unsigned koff = (unsigned)(((tid >> 3) * 1024 + (tid & 7) * 8) * 2);
    const int vkvq = (tid & 3) + 4 * ((tid >> 6) & 3), vdq = (tid >> 2) & 15;
    const unsigned voff = (unsigned)(((vkvq * 4) * 1024 + vdq * 4) * 2);
    const int vpos8 = (vkvq & ~3) + ((vkvq & 1) << 1) + ((vkvq >> 1) & 1);
    const unsigned roff = (unsigned)(((((tid - 256) >> 2) & 63) * 32 + (tid & 3) * 8) * 2);
    u32x4 kreg[1]; u32x2 vreg[1][4]; u32x4 rreg[1];
#define AT_GLOAD(ti, sx) do { const int tl_ = (ti) < u.nt ? (ti) : u.nt - 1; \
        kreg[sx] = *(const u32x4*)(kbase + (size_t)tl_ * 131072 + koff); \
        if (tid < 256) { const char* vb_ = vbase + (size_t)tl_ * 131072; \
            vreg[sx][0] = *(const u32x2*)(vb_ + voff); vreg[sx][1] = *(const u32x2*)(vb_ + voff + 2048); vreg[sx][2] = *(const u32x2*)(vb_ + 4096 + voff); vreg[sx][3] = *(const u32x2*)(vb_ + 4096 + voff + 2048); } \
        else if (MLA) { rreg[sx] = *(const u32x4*)(rbase + (size_t)tl_ * 4096 + roff); } } while (0)
#define AT_SWRITE(st, sx) do { ALAS unsigned char* sb_ = lds + (st) * STAGE; \
        *(ALAS u32x4*)(sb_ + (tid >> 3) * KROW + (tid & 7) * 16) = kreg[sx]; \
        if (tid < 256) { \
            _Pragma("unroll") for (int jj_ = 0; jj_ < 4; ++jj_) { const int d_ = 4 * vdq + jj_; u32x2 o_; \
                const unsigned sel_ = (jj_ & 1) ? 0x07060302u : 0x05040100u; \
                if (jj_ < 2) { o_.x = __builtin_amdgcn_perm(vreg[sx][1].x, vreg[sx][0].x, sel_); o_.y = __builtin_amdgcn_perm(vreg[sx][3].x, vreg[sx][2].x, sel_); } \
                else         { o_.x = __builtin_amdgcn_perm(vreg[sx][1].y, vreg[sx][0].y, sel_); o_.y = __builtin_amdgcn_perm(vreg[sx][3].y, vreg[sx][2].y, sel_); } \
                *(ALAS u32x2*)(sb_ + KBUF + d_ * VROW + vpos8 * 8) = o_; } } \
        else if (MLA) { const int t2_ = tid - 256; *(ALAS u32x4*)(sb_ + KBUF + VBUF + (t2_ >> 2) * RROW + (t2_ & 3) * 16) = rreg[sx]; } } while (0)
    float mref = 0.f;
    bool first = true;
    f32x16 negm = f32x16{}; asm volatile("" : "+v"(negm));
    f32x16 o0 = f32x16{}, o1 = f32x16{}; float lrun = 0.f;
    f32x16 p[2];
    const int tgl = (qh * 32 + l32 + 128 - 4 * hi) * 4;
#define AT_QK(t, sg) do { const int kc_ = u.tf + (t); ALAS unsigned char* sb_ = lds + (sg) * STAGE; ALAS unsigned char* kb_ = sb_ + l32 * KROW + hi * 16; \
        bool near_ = false; \
        if (!MLA) { near_ = cq - kc_ < 3; \
            if (near_) { ALAS unsigned char* tp_ = (ALAS unsigned char*)tb + tgl + 256 * (cq - kc_); \
                _Pragma("unroll") for (int blk = 0; blk < 2; ++blk) _Pragma("unroll") for (int r = 0; r < 16; ++r) p[blk][r] = *(const ALAS float*)(tp_ - 4 * (32 * blk + (r & 3) + 8 * (r >> 2))) - mref; } } \
        bf16x8 ka_[4], kb2_[4]; ALAS unsigned char* rb_ = sb_ + KBUF + VBUF + l32 * RROW + hi * 16; \
        _Pragma("unroll") for (int d0 = 0; d0 < 4; ++d0) ka_[d0] = *(const ALAS bf16x8*)(kb_ + d0 * 32); \
        _Pragma("unroll") for (int d0 = 0; d0 < 4; ++d0) kb2_[d0] = *(const ALAS bf16x8*)(kb_ + 32 * KROW + d0 * 32); \
        __builtin_amdgcn_sched_barrier(0); \
        if (near_) { p[0] = __builtin_amdgcn_mfma_f32_32x32x16_bf16(ka_[0], qf[0], p[0], 0, 0, 0); p[1] = __builtin_amdgcn_mfma_f32_32x32x16_bf16(kb2_[0], qf[0], p[1], 0, 0, 0); } \
        else       { p[0] = __builtin_amdgcn_mfma_f32_32x32x16_bf16(ka_[0], qf[0], negm, 0, 0, 0); p[1] = __builtin_amdgcn_mfma_f32_32x32x16_bf16(kb2_[0], qf[0], negm, 0, 0, 0); } \
        _Pragma("unroll") for (int d0 = 1; d0 < 4; ++d0) { p[0] = __builtin_amdgcn_mfma_f32_32x32x16_bf16(ka_[d0], qf[d0], p[0], 0, 0, 0); p[1] = __builtin_amdgcn_mfma_f32_32x32x16_bf16(kb2_[d0], qf[d0], p[1], 0, 0, 0); \
            if (MLA && d0 == 1) { ka_[0] = *(const ALAS bf16x8*)(rb_); kb2_[0] = *(const ALAS bf16x8*)(rb_ + 32 * RROW); ka_[1] = *(const ALAS bf16x8*)(rb_ + 32); kb2_[1] = *(const ALAS bf16x8*)(rb_ + 32 * RROW + 32); } } \
        if (MLA) { p[0] = __builtin_amdgcn_mfma_f32_32x32x16_bf16(ka_[0], qf[4], p[0], 0, 0, 0); p[1] = __builtin_amdgcn_mfma_f32_32x32x16_bf16(kb2_[0], qf[4], p[1], 0, 0, 0); \
                   p[0] = __builtin_amdgcn_mfma_f32_32x32x16_bf16(ka_[1], qf[ND0 - 1], p[0], 0, 0, 0); p[1] = __builtin_amdgcn_mfma_f32_32x32x16_bf16(kb2_[1], qf[ND0 - 1], p[1], 0, 0, 0); } \
        if ((t) == u.nt - 1 && u.lastvalid < 64) { _Pragma("unroll") for (int r = 0; r < 16; ++r) p[1][r] = -__builtin_inff(); } } while (0)
#define AT_SMPV(t, sg) do { ALAS unsigned char* vb_ = lds + (sg) * STAGE + KBUF + l32 * VROW + hi * 16; \
        bf16x8 vf_[2][4]; \
        _Pragma("unroll") for (int dblk = 0; dblk < 2; ++dblk) _Pragma("unroll") for (int j = 0; j < 4; ++j) vf_[dblk][j] = *(const ALAS bf16x8*)(vb_ + dblk * 32 * VROW + j * 32); \
        __builtin_amdgcn_sched_barrier(0); \
        float rm = p[0][0]; \
        _Pragma("unroll") for (int r = 1; r < 16; ++r) rm = fmaxf(rm, p[0][r]); \
        _Pragma("unroll") for (int r = 0; r < 16; ++r) rm = fmaxf(rm, p[1][r]); \
        rm = fmaxf(rm, __shfl_xor(rm, 32)); \
        if (first || __any(rm > THR)) { \
            const float dl = first ? rm : fmaxf(rm, 0.f); mref += dl; \
            _Pragma("unroll") for (int r = 0; r < 16; ++r) { p[0][r] -= dl; p[1][r] -= dl; } \
            _Pragma("unroll") for (int r = 0; r < 16; ++r) negm[r] = -mref; \
            asm volatile("" : "+v"(negm)); \
            if (!first) { const float al = __builtin_amdgcn_exp2f(-dl); lrun *= al; \
                _Pragma("unroll") for (int r = 0; r < 16; ++r) { o0[r] *= al; o1[r] *= al; } } \
            first = false; } \
        _Pragma("unroll") for (int blk = 0; blk < 2; ++blk) _Pragma("unroll") for (int r = 0; r < 16; ++r) p[blk][r] = __builtin_amdgcn_exp2f(p[blk][r]); \
        { float ls0 = 0.f, ls1 = 0.f; _Pragma("unroll") for (int r = 0; r < 16; ++r) { ls0 += p[0][r]; ls1 += p[1][r]; } lrun += ls0 + ls1; } \
        bf16x8 pk[4]; \
        _Pragma("unroll") for (int j = 0; j < 4; ++j) { u32x4 w; const int b = j >> 1, r0 = 8 * (j & 1); \
            w.x = pg8::pkbf(p[b][r0 + 0], p[b][r0 + 1]); w.y = pg8::pkbf(p[b][r0 + 2], p[b][r0 + 3]); w.z = pg8::pkbf(p[b][r0 + 4], p[b][r0 + 5]); w.w = pg8::pkbf(p[b][r0 + 6], p[b][r0 + 7]); \
            pk[j] = __builtin_bit_cast(bf16x8, w); } \
        _Pragma("unroll") for (int j = 0; j < 4; ++j) { \
            o0 = __builtin_amdgcn_mfma_f32_32x32x16_bf16(vf_[0][j], pk[j], o0, 0, 0, 0); \
            o1 = __builtin_amdgcn_mfma_f32_32x32x16_bf16(vf_[1][j], pk[j], o1, 0, 0, 0); \
            } } while (0)
#define AT_TAKE(t) (active && (u.tf + (t)) <= cq && (MLA || (u.tf + (t)) >= cq - 8))
    AT_GLOAD(0, 0); AT_SWRITE(0, 0);
    __syncthreads();
    for (int ti = 0; ti < u.nt; ++ti) {
        const bool more = ti + 1 < u.nt;
        if (more) AT_GLOAD(ti + 1, 0);
        if (AT_TAKE(ti)) { AT_QK(ti, ti & 1); AT_SMPV(ti, ti & 1); }
        if (more) AT_SWRITE((ti + 1) & 1, 0);
        __syncthreads();
    }
#undef AT_QK
#undef AT_SMPV
#undef AT_TAKE
    if (active) {
        const float inv = 1.f / (lrun + __shfl_xor(lrun, 32));
        const size_t ob = (size_t)qrow * 1024 + u.head * 64 + 4 * hi;
#pragma unroll
        for (int dblk = 0; dblk < 2; ++dblk)
#pragma unroll
            for (int g = 0; g < 4; ++g) {
                const u32x2 zz = *(const u32x2*)(Z + ob + 32 * dblk + 8 * g);
                const float z0 = __uint_as_float(zz.x << 16), z1 = __uint_as_float(zz.x & 0xffff0000u), z2 = __uint_as_float(zz.y << 16), z3 = __uint_as_float(zz.y & 0xffff0000u);
                const f32x16& o = dblk == 0 ? o0 : o1;
                u32x2 w; w.x = pg8::pkbf(o[4 * g + 0] * inv * z0, o[4 * g + 1] * inv * z1); w.y = pg8::pkbf(o[4 * g + 2] * inv * z2, o[4 * g + 3] * inv * z3);
                *(u32x2*)(U + ob + 32 * dblk + 8 * g) = w;
            }
    }
#undef AT_GLOAD
#undef AT_SWRITE
}
__device__ __forceinline__ bool prompt_unit(int k, int G, int bid, int& bh, int& qb) {
    if (G == 256) { if (k >= 16) return false; const int x = bid & 7, j = bid >> 3; bh = (4 * k + (j >> 3)) * 8 + x; qb = ((j & 7) + k) & 7; return true; }
    const int u = bid + k * G; if (u >= 4096) return false; bh = u >> 3; qb = u & 7; return true;
}
}
#define LAS __attribute__((address_space(3)))
typedef unsigned short bf16;
typedef unsigned v4u __attribute__((ext_vector_type(4)));
typedef unsigned v2u __attribute__((ext_vector_type(2)));
typedef float f32x4 __attribute__((ext_vector_type(4)));
constexpr size_t MiB = 1u << 20;
constexpr size_t WS_MOD = 0;
constexpr size_t MOD_BYTES = 2 * 40 * 3072 * 4;
constexpr size_t WS_BAR = 1 * MiB - 16384;
constexpr size_t WS_CS = 1 * MiB;
constexpr size_t WS_G1 = 2 * MiB;
constexpr size_t WS_SW = 2 * MiB + 256 * 1024;
constexpr size_t WS_SSQ = 3 * MiB;
constexpr size_t WS_SSQQ = 3 * MiB + 320 * 1024, WS_SSQKV = 3 * MiB + 640 * 1024;
constexpr size_t WS_RAW2 = 24 * MiB;
constexpr size_t WS_W_AIN = 4 * MiB, WS_W_AOUT = 12 * MiB, WS_W_BIN = 14 * MiB, WS_W_UQ = 18 * MiB, WS_W_UKV = 20 * MiB, WS_W_BOUT = 22 * MiB;
constexpr size_t WS_H = 24 * MiB;
constexpr size_t WS_CKV = 153 * MiB;
constexpr size_t WS_KR = 194 * MiB;
constexpr size_t WS_X = 200 * MiB;
constexpr size_t WS_QA = WS_X, WS_KA = WS_X + 129 * MiB, WS_VA = WS_X + 267 * MiB, WS_ZA = WS_X + 405 * MiB;
constexpr size_t WS_YG = WS_ZA;
constexpr size_t WS_ZB = WS_X, WS_RAW = WS_X + 129 * MiB, WS_QB = WS_RAW, WS_CQ = WS_X + 322 * MiB, WS_KN = WS_X + 371 * MiB, WS_VB = WS_X + 532 * MiB;
constexpr size_t WS_END = WS_X + 694 * MiB;
static_assert((size_t)M1 * 1024 * 2 <= 129 * MiB && (size_t)RA * 1024 * 2 <= 138 * MiB && (size_t)M1 * 768 * 4 <= 193 * MiB && (size_t)M1 * 384 * 2 <= 49 * MiB && (size_t)R2 * 1024 * 2 <= 161 * MiB, "ws map");
static_assert((size_t)R2 * 256 * 2 <= 41 * MiB && (size_t)R2 * 32 * 2 <= 6 * MiB && WS_ZA + 129 * MiB <= WS_END && WS_VB + 161 * MiB <= WS_END && WS_END <= 1024 * MiB, "ws map");
constexpr size_t O_YP = 0, O_YS = 67108864, O_AKP = 67371008, O_AVP = 84148224, O_AKS = 100925440, O_AVS = 101187584, O_CKVP = 101449728, O_KRP = 118226944, O_CKVS = 120324096, O_KRS = 120389632;
constexpr int LDS_TOTAL = 147456, LDS_MISC = 131072 + 320;
static_assert(at::LDS_BYTES <= LDS_TOTAL && pg8::STAGE_BYTES <= LDS_TOTAL, "LDS");

__device__ __forceinline__ float wave_sum(float v) {
#pragma unroll
    for (int o = 1; o < 64; o <<= 1) v += __shfl_xor(v, o);
    return v;
}
__device__ __forceinline__ unsigned pk2(float lo, float hi) { return pg8::pkbf(lo, hi); }
__device__ __forceinline__ int src_col(int gemm, int g) {
    const int lc = ((g >> 3) * 8 + (g & 3) * 2 + ((g >> 2) & 1)) * 32;
    switch (gemm) {
    case 2: if (lc < 1024) return 672 + lc; if (lc < 1408) return lc - 1024; if (lc < 1664) return 384 + (lc - 1408); if (lc < 1696) return 640 + (lc - 1664); return -1;
    case 3: if (lc < 1024) return (lc >> 6) * 96 + (lc & 63); return ((lc - 1024) >> 5) * 96 + 64;
    case 4: if (lc < 1024) return (lc >> 6) * 128 + (lc & 63); return ((lc - 1024) >> 6) * 128 + 64 + (lc & 63);
    default: return lc;
    }
}
__device__ __forceinline__ void transpose_item(const float* W, int K, int Nsrc, int sc, bf16* WT, int g, int k0, LAS float* scr, int lane) {
#pragma unroll 8
    for (int i = 0; i < 32; ++i) { const int kk = 2 * i + (lane >> 5); scr[kk * 33 + (lane & 31)] = sc >= 0 ? W[(size_t)(k0 + kk) * Nsrc + sc + (lane & 31)] : 0.f; }
    asm volatile("s_waitcnt lgkmcnt(0)" ::: "memory");
    const int c = lane & 7;
#pragma unroll
    for (int j = 0; j < 4; ++j) { const int n = (lane >> 3) + 8 * j; const LAS float* s = scr + (8 * c) * 33 + n;
        v4u o; o.x = pk2(s[0 * 33], s[1 * 33]); o.y = pk2(s[2 * 33], s[3 * 33]); o.z = pk2(s[4 * 33], s[5 * 33]); o.w = pk2(s[6 * 33], s[7 * 33]);
        *(v4u*)(WT + (size_t)(32 * g + n) * K + k0 + 8 * c) = o; }
    asm volatile("s_waitcnt lgkmcnt(0)" ::: "memory");
}
__device__ __forceinline__ void cvt8(const float* s, bf16* d) { const f32x4 a = *(const f32x4*)s, b = *(const f32x4*)(s + 4); v4u o; o.x = pk2(a[0], a[1]); o.y = pk2(a[2], a[3]); o.z = pk2(b[0], b[1]); o.w = pk2(b[2], b[3]); *(v4u*)d = o; }

#define GAS __attribute__((address_space(1)))
#define RLX_AGENT __ATOMIC_RELAXED, __HIP_MEMORY_SCOPE_AGENT
#define XB_TMO      128
#define XB_XCNT(j)  (256  + 64 * (j))
#define XB_XSUB(j)  (1280 + 64 * (j))
#define XB_XGEN(j)  (2304 + 64 * (j))
#define XB_TOP      3328
#define XB_TOPGEN   3392
#define XCD_BAR_WORDS 3456
#define XB_SPIN_CAP (1u << 18)

__device__ __forceinline__ unsigned xb_ld(unsigned* p)              { return __hip_atomic_load(p, __ATOMIC_RELAXED, __HIP_MEMORY_SCOPE_AGENT); }
__device__ __forceinline__ unsigned xb_add(unsigned* p, unsigned v) { return __hip_atomic_fetch_add(p, v, __ATOMIC_RELAXED, __HIP_MEMORY_SCOPE_AGENT); }
__device__ __forceinline__ unsigned xb_xcc_id() { return (unsigned)__builtin_amdgcn_s_getreg((3 << 11) | 20) & 0xFu; }
#define XB_SPIN(cond, bar) do { unsigned _sp = 0; while (cond) { __builtin_amdgcn_s_sleep(1); \
    if ((++_sp & 255u) == 0u) { if (xb_ld(&(bar)[XB_TMO])) break; if (_sp > XB_SPIN_CAP) { atomicAdd(&(bar)[XB_TMO], 1u); break; } } } } while (0)

struct XcdBarrier {
    unsigned* bar; unsigned x;
    volatile LAS unsigned* st;
};

__device__ __forceinline__ XcdBarrier xcd_barrier_post(unsigned* bar, volatile LAS unsigned* st) {
    XcdBarrier b; b.bar = bar; b.x = xb_xcc_id(); b.st = st;
    if (threadIdx.x == 0) (void)xb_add(&bar[XB_XCNT(b.x)], 1u);
    return b;
}
__device__ __forceinline__ void xcd_barrier_complete(unsigned* bar, unsigned x, unsigned& nloc, unsigned& nx) {
    const unsigned G = gridDim.x * gridDim.y * gridDim.z;
    unsigned sum, cnt, mine, sp = 0u;
    for (;;) {
        sum = 0u; cnt = 0u; mine = 0u;
#pragma unroll
        for (unsigned j = 0; j < 16; ++j) { const unsigned c = xb_ld(&bar[XB_XCNT(j)]); sum += c; cnt += (c > 0u) ? 1u : 0u; mine = (j == x) ? c : mine; }
        if (sum == G) break;
        __builtin_amdgcn_s_sleep(1);
        if ((++sp & 255u) == 0u) { if (xb_ld(&bar[XB_TMO])) break; if (sp > XB_SPIN_CAP) { atomicAdd(&bar[XB_TMO], 1u); break; } }
    }
    nloc = mine > 0u ? mine : 1u; nx = cnt > 0u ? cnt : 1u;
}

__device__ __forceinline__ void xcd_barrier(const XcdBarrier& b) {
    asm volatile("s_waitcnt vmcnt(0)" ::: "memory");
    __syncthreads();
    if (threadIdx.x == 0) {
        unsigned* bar = b.bar;
        __builtin_amdgcn_s_waitcnt(0);
        unsigned nloc = b.st[0], nx = b.st[1];
        if (nloc == 0u) { xcd_barrier_complete(bar, b.x, nloc, nx); b.st[0] = nloc; b.st[1] = nx; }
        const unsigned old = xb_add(&bar[XB_XSUB(b.x)], 1u);
        const unsigned gen = old / nloc;
        if (old + 1u == (gen + 1u) * nloc) {
            __builtin_amdgcn_fence(__ATOMIC_RELEASE, "agent");
            asm volatile("s_waitcnt vmcnt(0)" ::: "memory");
            const unsigned og = xb_add(&bar[XB_TOP], 1u);
            const unsigned tg = og / nx;
            if (og + 1u == (tg + 1u) * nx) xb_add(&bar[XB_TOPGEN], 1u);
            else XB_SPIN(xb_ld(&bar[XB_TOPGEN]) == tg, bar);
            __builtin_amdgcn_fence(__ATOMIC_ACQUIRE, "agent");
            xb_add(&bar[XB_XGEN(b.x)], 1u);
            asm volatile("s_waitcnt vmcnt(0)" ::: "memory");
        } else {
            XB_SPIN(xb_ld(&bar[XB_XGEN(b.x)]) == gen, bar);
            __builtin_amdgcn_fence(__ATOMIC_ACQUIRE, "agent");
            asm volatile("s_waitcnt vmcnt(0)" ::: "memory");
        }
    }
    __syncthreads();
}

struct Args { const float* in[26]; float* out; unsigned char* ws; int ph_lo, ph_hi; };

__device__ __forceinline__ void adanorm_rows(const float* xp, const float* xs, const float* g, const float* mod, bf16* H, int gw, int NGW, int lane) {
    for (int grp = gw; grp < M1 / 4; grp += NGW) {
        const int row0 = grp * 4;
        const float* xr; int bb;
        if (row0 < MP) { xr = xp + (size_t)row0 * 1024; bb = row0 >> 11; } else { xr = xs + (size_t)(row0 - MP) * 1024; bb = NBP + ((row0 - MP) >> 5); }
        const float* md = mod + (size_t)bb * 3072;
        f32x4 v[4][4]; float s[4];
#pragma unroll
        for (int q = 0; q < 4; ++q) { s[q] = 0.f;
#pragma unroll
            for (int j = 0; j < 4; ++j) v[q][j] = *(const f32x4*)(xr + (size_t)q * 1024 + 4 * lane + 256 * j); }
#pragma unroll
        for (int q = 0; q < 4; ++q)
#pragma unroll
            for (int j = 0; j < 4; ++j) s[q] += pg8::ssq4(v[q][j]);
#pragma unroll
        for (int o = 1; o < 64; o <<= 1) {
#pragma unroll
            for (int q = 0; q < 4; ++q) s[q] += __shfl_xor(s[q], o); }
#pragma unroll
        for (int q = 0; q < 4; ++q) s[q] = rsqrtf(s[q] * (1.f / 1024.f) + EPSN);
#pragma unroll
        for (int j = 0; j < 4; ++j) { const int c = 4 * lane + 256 * j;
            const f32x4 gg = *(const f32x4*)(g + c) * (*(const f32x4*)(md + 1024 + c) + 1.f), sh = *(const f32x4*)(md + c);
#pragma unroll
            for (int q = 0; q < 4; ++q) { const f32x4 h = v[q][j] * s[q] * gg + sh;
                v2u o; o.x = pk2(h[0], h[1]); o.y = pk2(h[2], h[3]); *(v2u*)(H + (size_t)(row0 + q) * 1024 + c) = o; } }
    }
}

__global__ void __launch_bounds__(512, 2) hybrid_fwd(Args args) {
    extern __shared__ __attribute__((aligned(16))) unsigned char lds_raw[];
    LAS unsigned char* lds = (LAS unsigned char*)lds_raw;
    const int tid = threadIdx.x, lane = tid & 63, wave = __builtin_amdgcn_readfirstlane(tid >> 6);
    const int G = gridDim.x, bid = blockIdx.x;
    const int gw = bid * 8 + wave, NGW = G * 8;
    const int gt = bid * 512 + tid, NGT = G * 512;
    const int lo = args.ph_lo, hi = args.ph_hi;
    volatile LAS unsigned* MISC = (volatile LAS unsigned*)(lds + LDS_MISC);
    if (tid < 16) MISC[tid] = 0u;
    __syncthreads();
    XcdBarrier bar; bar.bar = nullptr; bar.x = 0; bar.st = nullptr;
    if (hi - lo > 1) { bar = xcd_barrier_post((unsigned*)(args.ws + WS_BAR), MISC + 8); cg::this_grid().sync(); }
#ifndef PHMASK
#define PHMASK 0x7ff
#endif
#ifndef PROBE_SYNC
#define PROBE_SYNC 0
#endif
#ifndef PROBE_REP
#define PROBE_REP 0
#endif
#define REP(k) for (int rep_ = 0; rep_ < 1 + ((PROBE_REP >> (k)) & 1); ++rep_)
#define IN(k) (((PHMASK >> (k)) & 1) && lo <= (k) && (k) < hi)
typedef const __attribute__((address_space(4))) Args* KArgs;
#define PHASE_ARGS() KArgs A = (KArgs)__builtin_amdgcn_kernarg_segment_ptr(); asm volatile("" : "+s"(A)); unsigned char* ws = A->ws; float* out = A->out; (void)ws; (void)out
#define WSP(T, off) ((T*)(ws + (off)))
#define SEAM(k) do { if (IN(k) && IN((k) + 1)) { xcd_barrier(bar); } } while (0)

    if (IN(0)) REP(0) {
        PHASE_ARGS();
        float* mod = WSP(float, WS_MOD); float* CS = WSP(float, WS_CS);
        bf16 *W_AIN = WSP(bf16, WS_W_AIN), *W_AOUT = WSP(bf16, WS_W_AOUT), *W_BIN = WSP(bf16, WS_W_BIN), *W_UQ = WSP(bf16, WS_W_UQ), *W_UKV = WSP(bf16, WS_W_UKV), *W_BOUT = WSP(bf16, WS_W_BOUT);
        bf16 *KA = WSP(bf16, WS_KA), *VA = WSP(bf16, WS_VA), *CKV = WSP(bf16, WS_CKV), *KR = WSP(bf16, WS_KR);
        {
            LAS float* scr = (LAS float*)(lds + wave * 10240);
            constexpr int I0 = 16 * 128, I1 = 16 * 32, I2 = 16 * 56, I3 = 6 * 48, I4 = 4 * 64, I5 = 16 * 32;
            for (int it = gw; it < I0 + I1 + I2 + I3 + I4 + I5; it += NGW) {
                int r = it;
                if (r < I0) { const int g = r % 128; transpose_item(A->in[11], 1024, 4096, src_col(0, g), W_AIN, g, (r / 128) * 64, scr, lane); continue; } r -= I0;
                if (r < I1) { const int g = r % 32; transpose_item(A->in[15], 1024, 1024, src_col(1, g), W_AOUT, g, (r / 32) * 64, scr, lane); continue; } r -= I1;
                if (r < I2) { const int g = r % 56; transpose_item(A->in[16], 1024, 1696, src_col(2, g), W_BIN, g, (r / 56) * 64, scr, lane); continue; } r -= I2;
                if (r < I3) { const int g = r % 48; transpose_item(A->in[18], 384, 1536, src_col(3, g), W_UQ, g, (r / 48) * 64, scr, lane); continue; } r -= I3;
                if (r < I4) { const int g = r % 64; transpose_item(A->in[20], 256, 2048, src_col(4, g), W_UKV, g, (r / 64) * 64, scr, lane); continue; } r -= I4;
                { const int g = r % 32; transpose_item(A->in[25], 1024, 1024, src_col(5, g), W_BOUT, g, (r / 32) * 64, scr, lane); }
            }
        }
        for (int it = bid; it < 2 * 48; it += G) {
            const int l = it / 48, jb = it % 48;
            LAS float* sl = (LAS float*)(lds + wave * 10240);
            float acc[40];
#pragma unroll
            for (int b = 0; b < 40; ++b) acc[b] = 0.f;
            for (int pass = 0; pass < 2; ++pass) {
                const int k0 = (wave + 8 * pass) * 64;
                for (int e = lane; e < 40 * 64; e += 64) { const int bb = e >> 6, k = e & 63; const float c = bb < NBP ? A->in[6][(size_t)bb * 1024 + k0 + k] : A->in[7][(size_t)(bb - NBP) * 1024 + k0 + k]; sl[e] = c / (1.f + __expf(-c)); }
                asm volatile("s_waitcnt lgkmcnt(0)" ::: "memory");
                const float* W = A->in[9] + (size_t)l * 1024 * 3072 + (size_t)k0 * 3072 + jb * 64 + lane;
                for (int k = 0; k < 64; k += 4) {
                    const float w0 = W[(size_t)k * 3072], w1 = W[(size_t)(k + 1) * 3072], w2 = W[(size_t)(k + 2) * 3072], w3 = W[(size_t)(k + 3) * 3072];
#pragma unroll
                    for (int b = 0; b < 40; ++b) { const f32x4 sv = *(const LAS f32x4*)(sl + b * 64 + k); acc[b] += (sv[0] * w0 + sv[1] * w1) + (sv[2] * w2 + sv[3] * w3); }
                }
                asm volatile("s_waitcnt lgkmcnt(0)" ::: "memory");
            }
            __syncthreads();
            LAS float* red = (LAS float*)lds;
#pragma unroll
            for (int b = 0; b < 40; ++b) red[(wave * 40 + b) * 64 + lane] = acc[b];
            __syncthreads();
            for (int e = tid; e < 40 * 64; e += 512) { const int b = e >> 6, j = e & 63; float sum = A->in[10][(size_t)l * 3072 + jb * 64 + j];
#pragma unroll
                for (int w = 0; w < 8; ++w) sum += red[(w * 40 + b) * 64 + j];
                mod[((size_t)l * 40 + b) * 3072 + jb * 64 + j] = sum; }
            __syncthreads();
        }
        for (int i = gt; i < NBS * SA_STRIDE * 128; i += NGT) {
            const int c8 = i & 127, rr = (i >> 7) % SA_STRIDE, bs = (i >> 7) / SA_STRIDE;
            const size_t d = ((size_t)MP + (size_t)bs * SA_STRIDE + rr) * 1024 + c8 * 8;
            if (rr < 512) { const size_t s = ((size_t)bs * 512 + rr) * 1024 + c8 * 8; cvt8(A->in[2] + s, KA + d); cvt8(A->in[3] + s, VA + d); }
            else if (rr >= 544) { *(v4u*)(KA + d) = (v4u){0, 0, 0, 0}; *(v4u*)(VA + d) = (v4u){0, 0, 0, 0}; }
        }
        for (int i = gt; i < NBS * SB_STRIDE * 32; i += NGT) {
            const int c8 = i & 31, rr = (i >> 5) % SB_STRIDE, bs = (i >> 5) / SB_STRIDE;
            const size_t d = ((size_t)MP + (size_t)bs * SB_STRIDE + rr) * 256 + c8 * 8;
            if (rr < 2048) cvt8(A->in[4] + ((size_t)bs * 2048 + rr) * 256 + c8 * 8, CKV + d);
            else if (rr >= 2080) *(v4u*)(CKV + d) = (v4u){0, 0, 0, 0};
        }
        for (int i = gt; i < NBS * SB_STRIDE * 4; i += NGT) {
            const int c8 = i & 3, rr = (i >> 2) % SB_STRIDE, bs = (i >> 2) / SB_STRIDE;
            const size_t d = ((size_t)MP + (size_t)bs * SB_STRIDE + rr) * 32 + c8 * 8;
            if (rr < 2048) cvt8(A->in[5] + ((size_t)bs * 2048 + rr) * 32 + c8 * 8, KR + d);
            else if (rr >= 2080) *(v4u*)(KR + d) = (v4u){0, 0, 0, 0};
        }
        { float* SSQ = WSP(float, WS_SSQ); float* SQ2 = WSP(float, WS_SSQQ); float* SQ3 = WSP(float, WS_SSQKV); for (int i = gt; i < M1; i += NGT) { SSQ[i] = 0.f; SQ2[i] = 0.f; SQ3[i] = 0.f; } }
        for (int i = gt; i < 2112 * 16; i += NGT) {
            const int pos = i >> 4, k = i & 15;
            const float inv = exp2f(-(float)k * (13.287712379549449f / 16.f));
            const float ang = (float)pos * inv;
            const double tr = (double)ang * 0.15915494309189535;
            const float fr = (float)(tr - floor(tr + 0.5));
            CS[pos * 32 + k] = __builtin_amdgcn_cosf(fr); CS[pos * 32 + 16 + k] = __builtin_amdgcn_sinf(fr);
        }
    }
    SEAM(0);
    if (IN(1)) REP(1) { PHASE_ARGS();
        const float* mod1 = WSP(float, WS_MOD) + 40 * 3072;
        {
            float* G1 = WSP(float, WS_G1); const float* g1 = A->in[8] + 1024;
            for (int i = gt; i < 40 * 1024; i += NGT) { const int bb = i >> 10, c = i & 1023; G1[i] = g1[c] * (1.f + mod1[(size_t)bb * 3072 + 1024 + c]); }
            float* SW = WSP(float, WS_SW); const bf16* WB = WSP(bf16, WS_W_BIN);
            for (int lc = gw; lc < 1792; lc += NGW) {
                const int lg = lc >> 5, pn = lg >> 3, rem = lg & 7, crow_ = (pn * 8 + (rem & 1) * 4 + (rem >> 1)) * 32 + (lc & 31);
                const v4u w0 = *(const v4u*)(WB + (size_t)crow_ * 1024 + 16 * lane), w1 = *(const v4u*)(WB + (size_t)crow_ * 1024 + 16 * lane + 8);
                float wf[16];
#pragma unroll
                for (int e = 0; e < 4; ++e) { wf[2 * e] = __uint_as_float(w0[e] << 16); wf[2 * e + 1] = __uint_as_float(w0[e] & 0xffff0000u); wf[8 + 2 * e] = __uint_as_float(w1[e] << 16); wf[8 + 2 * e + 1] = __uint_as_float(w1[e] & 0xffff0000u); }
                for (int bb = 0; bb < 40; ++bb) { const float* sh = mod1 + (size_t)bb * 3072 + 16 * lane; float a = 0.f;
#pragma unroll
                    for (int e = 0; e < 4; ++e) { const f32x4 x = *(const f32x4*)(sh + 4 * e); a += (x[0] * wf[4 * e] + x[1] * wf[4 * e + 1]) + (x[2] * wf[4 * e + 2] + x[3] * wf[4 * e + 3]); }
                    a = wave_sum(a); if (lane == 0) SW[(size_t)bb * 1792 + lc] = a; }
            }
        }
        adanorm_rows(A->in[0], A->in[1], A->in[8], WSP(float, WS_MOD), WSP(bf16, WS_H), gw, NGW, lane); }
    SEAM(1);
    if (IN(2)) REP(2) {
        PHASE_ARGS();
        int Kop = 1024; asm volatile("" : "+s"(Kop)); pg8::Gemm g{WSP(bf16, WS_H), WSP(bf16, WS_W_AIN), M1, 4096, Kop}; pg8::StaticOrder S; S.init(M1, 4096, G, bid);
        pg8::EpiAin E{WSP(bf16, WS_QA), WSP(bf16, WS_KA), WSP(bf16, WS_VA), WSP(bf16, WS_ZA), A->in[12], A->in[13], out + O_AKP, out + O_AVP, out + O_AKS, out + O_AVS};
        pg8::gemm_phase<pg8::EpiAin, pg8::StaticOrder, true, true>(lds, g, S, E);
    }
    SEAM(2);
    if (IN(3)) REP(3) {
        PHASE_ARGS();
        bf16 *QA = WSP(bf16, WS_QA), *KA = WSP(bf16, WS_KA), *VA = WSP(bf16, WS_VA), *ZA = WSP(bf16, WS_ZA), *H = WSP(bf16, WS_H); const float* tblp = A->in[14];
        __syncthreads();
        { int bh, qb;
          for (int k = 0; at::prompt_unit(k, G, bid, bh, qb); ++k) {
            at::AttnUnit a; const int b = bh >> 4, c0 = 4 * qb, tf = c0 > 8 ? c0 - 8 : 0;
            a.qrow0 = b * SEQ + 256 * qb; a.nq = 256; a.krow0 = b * SEQ + 64 * tf; a.nt = c0 + 3 - tf + 1; a.lastvalid = 64; a.head = bh & 15; a.c0 = c0; a.tf = tf;
            at::attn_unit<false>(lds, a, QA, KA, nullptr, VA, ZA, H, tblp);
          } }
        for (int s = bid; s < 128; s += G) {
            at::AttnUnit a; const int bs = s >> 4;
            a.qrow0 = MP + bs * TS; a.nq = 32; a.krow0 = MP + bs * SA_STRIDE; a.nt = 9; a.lastvalid = 32; a.head = s & 15; a.c0 = 8; a.tf = 0;
            at::attn_unit<false>(lds, a, QA, KA, nullptr, VA, ZA, H, tblp);
        }
    }
    SEAM(3);
    if (IN(4)) REP(4) {
        PHASE_ARGS();
        int Kop = 1024; asm volatile("" : "+s"(Kop)); pg8::Gemm g{WSP(bf16, WS_H), WSP(bf16, WS_W_AOUT), M1, 1024, Kop}; pg8::StaticOrder S; S.init(M1, 1024, G, bid);
        pg8::EpiRes E{A->in[0], A->in[1], out + O_YP, out + O_YS, WSP(float, WS_MOD) + 2048, WSP(bf16, WS_YG), WSP(float, WS_G1), WSP(float, WS_SSQ)};
        pg8::gemm_phase<pg8::EpiRes, pg8::StaticOrder, true, true>(lds, g, S, E);
    }
    if (IN(4) && IN(6)) { xcd_barrier(bar); }
    if (IN(6)) REP(6) {
        PHASE_ARGS();
        int Kop = 1024; asm volatile("" : "+s"(Kop)); pg8::Gemm g{WSP(bf16, WS_YG), WSP(bf16, WS_W_BIN), M1, 1792, Kop}; pg8::StaticOrder S; S.init(M1, 1792, G, bid);
        pg8::EpiBin E{WSP(bf16, WS_ZB), WSP(bf16, WS_CQ), WSP(bf16, WS_CKV), WSP(float, WS_RAW2), WSP(float, WS_SSQ), WSP(float, WS_SW), A->in[17], A->in[19], WSP(float, WS_SSQQ), WSP(float, WS_SSQKV)};
        pg8::gemm_phase<pg8::EpiBin, pg8::StaticOrder, true, true>(lds, g, S, E);
    }
    if (IN(6) && IN(8)) { xcd_barrier(bar); }
    if (IN(8)) REP(8) {
        { PHASE_ARGS(); int Kop = 384; asm volatile("" : "+s"(Kop)); pg8::Gemm g{WSP(bf16, WS_CQ), WSP(bf16, WS_W_UQ), M1, 1536, Kop}; pg8::StaticOrder S; S.init(M1, 1536, G, bid);
          pg8::EpiUq E{WSP(bf16, WS_QB), A->in[21], A->in[22], WSP(float, WS_CS), WSP(float, WS_SSQQ)};
          pg8::gemm_phase<pg8::EpiUq, pg8::StaticOrder, true, true>(lds, g, S, E); }
        __syncthreads();
        { PHASE_ARGS(); int Kop = 256; asm volatile("" : "+s"(Kop)); pg8::Gemm g{WSP(bf16, WS_CKV), WSP(bf16, WS_W_UKV), R2, 2048, Kop}; pg8::StaticOrder S; S.init(R2, 2048, G, G - 1 - bid);
          pg8::EpiUkv E{WSP(bf16, WS_KN), WSP(bf16, WS_VB), A->in[23], WSP(float, WS_SSQKV)};
          pg8::gemm_phase<pg8::EpiUkv, pg8::StaticOrder, true, true>(lds, g, S, E); }
        __syncthreads();
        {
            PHASE_ARGS();
            const float* RAW2 = WSP(float, WS_RAW2); const float* CS = WSP(float, WS_CS); const float* SQ3 = WSP(float, WS_SSQKV); bf16* KR = WSP(bf16, WS_KR);
            const float *gckv = A->in[19], *gkr = A->in[24];
            unsigned* wq = (unsigned*)(ws + WS_BAR) + 3600;
            volatile LAS unsigned* slot = (volatile LAS unsigned*)(lds + LDS_MISC + 16);
            for (;;) {
                if (tid == 0) slot[0] = atomicAdd(wq, 1u);
                __syncthreads();
                const unsigned ch = slot[0];
                __syncthreads();
                if (ch >= (unsigned)(M1 / 128)) break;
              for (int rix = 0; rix < 16; ++rix) { const int row = (int)ch * 128 + rix * 8 + wave;
                const float* rw = RAW2 + (size_t)row * 288;
                int pos; size_t drow, orow;
                if (row < MP) { pos = row & (SEQ - 1); drow = (size_t)row; orow = (size_t)row; }
                else { const int rs = row - MP; pos = SEQ + (rs & 31); drow = (size_t)MP + (size_t)(rs >> 5) * SB_STRIDE + 2048 + (rs & 31); orow = (size_t)rs; }
                float* ockv = (row < MP ? out + O_CKVP : out + O_CKVS) + orow * 256;
                float* okr = (row < MP ? out + O_KRP : out + O_KRS) + orow * 32;
                const f32x4 kv = *(const f32x4*)(rw + 4 * lane);
                const float kr = lane < 32 ? rw[256 + lane] : 0.f;
                float r = rsqrtf(SQ3[row] * (1.f / 256.f) + EPSN);
                *(f32x4*)(ockv + 4 * lane) = kv * r * *(const f32x4*)(gckv + 4 * lane);
                r = rsqrtf(wave_sum(kr * kr) * (1.f / 32.f) + EPSN);
                const float kn = kr * r * (lane < 32 ? gkr[lane] : 0.f);
                const float pr = __shfl_xor(kn, 16);
                const float cs = CS[pos * 32 + (lane & 15)], sn = CS[pos * 32 + 16 + (lane & 15)];
                const float ro = (lane & 16) ? (kn * cs + pr * sn) : (kn * cs - pr * sn);
                if (lane < 32) { okr[lane] = ro; const unsigned b = pk2(ro, 0.f); KR[drow * 32 + lane] = (bf16)(b & 0xffffu); }
              }
            }
        }
    }
    SEAM(8);
    if (IN(9)) REP(9) {
        PHASE_ARGS();
        bf16 *QB = WSP(bf16, WS_QB), *KN = WSP(bf16, WS_KN), *KR = WSP(bf16, WS_KR), *VB = WSP(bf16, WS_VB), *ZB = WSP(bf16, WS_ZB), *H = WSP(bf16, WS_H);
        __syncthreads();
        { int bh, qb;
          for (int k = 0; at::prompt_unit(k, G, bid, bh, qb); ++k) {
            at::AttnUnit a; const int b = bh >> 4;
            a.qrow0 = b * SEQ + 256 * qb; a.nq = 256; a.krow0 = b * SEQ; a.nt = 4 * qb + 4; a.lastvalid = 64; a.head = bh & 15; a.c0 = 4 * qb; a.tf = 0;
            at::attn_unit<true>(lds, a, QB, KN, KR, VB, ZB, H, nullptr);
          } }
        for (int s = bid; s < 128; s += G) {
            at::AttnUnit a; const int bs = s >> 4;
            a.qrow0 = MP + bs * TS; a.nq = 32; a.krow0 = MP + bs * SB_STRIDE; a.nt = 33; a.lastvalid = 32; a.head = s & 15; a.c0 = 32; a.tf = 0;
            at::attn_unit<true>(lds, a, QB, KN, KR, VB, ZB, H, nullptr);
        }
    }
    SEAM(9);
    if (IN(10)) REP(10) {
        PHASE_ARGS();
        int Kop = 1024; asm volatile("" : "+s"(Kop)); pg8::Gemm g{WSP(bf16, WS_H), WSP(bf16, WS_W_BOUT), M1, 1024, Kop}; pg8::StaticOrder S; S.init(M1, 1024, G, bid);
        pg8::EpiRes E{out + O_YP, out + O_YS, out + O_YP, out + O_YS, WSP(float, WS_MOD) + 40 * 3072 + 2048, nullptr, nullptr, nullptr};
        pg8::gemm_phase<pg8::EpiRes, pg8::StaticOrder, true, true>(lds, g, S, E);
    }
#if PROBE_SYNC
    if (hi - lo > 1) { for (int q = 0; q < 18; ++q) cg::this_grid().sync(); }
#endif
#undef IN
#undef SEAM
}

constexpr int N_PHASES = 11;
extern "C" void kernel_launch(void* const* d_in, const int* in_sizes, int n_in, void* d_out, int out_size, void* d_ws, size_t ws_size, hipStream_t stream) {
    static int grid = 0;
    if (grid == 0) {
        if (n_in != 26 || ws_size < WS_END) { fprintf(stderr, "kernel_launch: unexpected inputs (n_in %d, ws %zu, need %zu)\n", n_in, ws_size, (size_t)WS_END); grid = -1; return; }
        int dev = 0, cus = 0, per_cu = 0;
        hipGetDevice(&dev); hipDeviceGetAttribute(&cus, hipDeviceAttributeMultiprocessorCount, dev);
        hipFuncSetAttribute((const void*)hybrid_fwd, hipFuncAttributeMaxDynamicSharedMemorySize, LDS_TOTAL);
        hipOccupancyMaxActiveBlocksPerMultiprocessor(&per_cu, (const void*)hybrid_fwd, 512, LDS_TOTAL);
        if (per_cu < 1) { fprintf(stderr, "kernel_launch: occupancy query says %d blocks per CU\n", per_cu); per_cu = 1; }
        (void)hipGetLastError();
        grid = cus * per_cu;
    }
    if (grid < 0) return;
    hipMemsetAsync((char*)d_ws + WS_BAR, 0, 16384, stream);
    Args a{};
    for (int i = 0; i < 26; ++i) a.in[i] = (const float*)d_in[i];
    a.out = (float*)d_out; a.ws = (unsigned char*)d_ws;
#if MULTI_LAUNCH
    for (int p = 0; p < N_PHASES; ++p) { a.ph_lo = p; a.ph_hi = p + 1; hipLaunchKernelGGL(hybrid_fwd, dim3(grid), dim3(512), LDS_TOTAL, stream, a); }
#else
    a.ph_lo = 0; a.ph_hi = N_PHASES;
    void* kargs[] = {&a};
    hipError_t e = hipLaunchCooperativeKernel((const void*)hybrid_fwd, dim3(grid), dim3(512), kargs, LDS_TOTAL, stream);
    if (e != hipSuccess) fprintf(stderr, "cooperative launch failed: %s (grid %d)\n", hipGetErrorString(e), grid);
#endif
}
```

```cpp
#include <hip/hip_runtime.h>
#include <hip/hip_cooperative_groups.h>
#include <cstdio>
#include <cstdint>
namespace cg = cooperative_groups;
#ifndef MULTI_LAUNCH
#define MULTI_LAUNCH 0
#endif
constexpr int DMODEL = 1024, NBP = 32, SEQ = 2048, NBS = 8, TS = 32;
constexpr int MP = NBP * SEQ;
constexpr int M1 = MP + NBS * TS;
constexpr int SA_STRIDE = 576;
constexpr int RA = MP + NBS * SA_STRIDE;
constexpr int SB_STRIDE = 2112;
constexpr int R2 = MP + NBS * SB_STRIDE;
constexpr float EPSN = 1e-6f;
constexpr float LOG2E = 1.4426950408889634f;
constexpr float QSCALE_A = 0.125f * LOG2E;
constexpr float QSCALE_B = 0.10206207261596575f * LOG2E;
namespace pg8 {
#define PG8_LAS __attribute__((address_space(3)))
typedef unsigned short bf16_t;
typedef short bf16x8 __attribute__((ext_vector_type(8)));
typedef float f32x4 __attribute__((ext_vector_type(4)));
typedef unsigned u32x4 __attribute__((ext_vector_type(4)));
constexpr int BM = 256, BK = 64, HALF = 128, HTB = HALF * BK * 2  , STAGE_BYTES = 8 * HTB, NXCD = 8, WGM = 8;

__host__ __device__ __forceinline__ int lds_byte(int r, int c) { const int st = (r >> 4) * 2 + (c >> 5), rr = r & 15, cc = c & 31, ob = rr * 64 + cc * 2; return st * 1024 + (ob ^ (((ob >> 9) & 1) << 5)); }
__host__ __device__ __forceinline__ void stage_rc(int b, int& R, int& C) { const int st = b / 1024, sb = b % 1024, swz = sb ^ (((sb >> 9) & 1) << 5); R = (st >> 1) * 16 + swz / 64; C = (st & 1) * 32 + (swz % 64) / 2; }
__host__ __device__ __forceinline__ int perm32(int rho) { const int n = rho >> 4, i = rho & 15; return 8 * (i >> 2) + 4 * n + (i & 3); }

struct Unit { int pm, pn; };
struct Gemm { const bf16_t* A; const bf16_t* Bt; int M, N, K; };

struct StaticOrder {
    int nM, nN, nwg, G, c;
    __host__ __device__ void init(int M, int N, int G_, int c_) { nM = M / BM; nN = N / BM; nwg = nM * nN; G = G_; c = c_; }
    __host__ __device__ bool next(int i, Unit& u) const {
        const long L = (long)i * G + c; if (L >= nwg) return false;
        int wgid = (int)L; { const int q = nwg / NXCD, r = nwg % NXCD, xcd = wgid % NXCD, off = wgid / NXCD; wgid = (xcd < r ? xcd * (q + 1) : r * (q + 1) + (xcd - r) * q) + off; }
        const int nig = WGM * nN, gid = wgid / nig, fm = gid * WGM, gsz = (nM - fm) < WGM ? (nM - fm) : WGM;
        u.pm = fm + ((wgid % nig) % gsz); u.pn = (wgid % nig) / gsz; return true;
    }
    __device__ __forceinline__ void a_ready(const Unit&) const {}
    __device__ __forceinline__ void done(const Unit&) const {}
};

__device__ __forceinline__ unsigned cvt_pk_bf16(float lo, float hi) { unsigned r; asm volatile("v_cvt_pk_bf16_f32 %0, %1, %2" : "=v"(r) : "v"(lo), "v"(hi)); return r; }
template <class Epi, class Sched, bool ALIGN_EPI = false, bool SP2 = false>
__device__ __forceinline__ void gemm_phase(PG8_LAS unsigned char* lds, const Gemm g, const Sched& S, const Epi& E) {
    const int tid = threadIdx.x, wid = __builtin_amdgcn_readfirstlane(tid >> 6), lane = tid & 63, wr = wid >> 2, wc = wid & 3, fr = lane & 15, fq = lane >> 4;
    const int K = g.K, nt = K / BK;
    unsigned voffA[2], voffB[2];
#pragma unroll
    for (int i = 0; i < 2; ++i) { int R, C; stage_rc(tid * 16 + i * 8192, R, C); const int Rb = Epi::PERM ? ((R & ~31) + perm32(R & 31)) : R;
        voffA[i] = (unsigned)(R * K + C) * 2u; voffB[i] = (unsigned)(Rb * K + C) * 2u; }
    const size_t kstep = (size_t)(BK * 2);
    const size_t hstep = (size_t)HALF * K * 2;
    const size_t tstep = 2 * hstep;
    const unsigned ldsw = (unsigned)wid * 1024u;
    const int aoff = lds_byte(wr * 64 + fr, fq * 8), boff = lds_byte(wc * 32 + fr, fq * 8);
#define PG8_SA(b, h) (((b) * 2 + (h)) * HTB)
#define PG8_SB(b, h) ((4 + (b) * 2 + (h)) * HTB)
#define PG8_STAGE(bufoff, gbase, voff) do { _Pragma("unroll") for (int _i = 0; _i < 2; ++_i) \
        __builtin_amdgcn_global_load_lds((const unsigned*)((const char*)(gbase) + (voff)[_i]), (PG8_LAS unsigned*)(lds + (bufoff) + ldsw + _i * 8192), 16, 0, 0); } while (0)
#define PG8_LDA(dst, b, h) do { _Pragma("unroll") for (int m = 0; m < 4; ++m) _Pragma("unroll") for (int k = 0; k < 2; ++k) dst[m][k] = *(const PG8_LAS bf16x8*)(lds + PG8_SA(b, h) + aoff + m * 2048 + k * 1024); } while (0)
#define PG8_LDB(dst, b, h) do { _Pragma("unroll") for (int n = 0; n < 2; ++n) _Pragma("unroll") for (int k = 0; k < 2; ++k) dst[n][k] = *(const PG8_LAS bf16x8*)(lds + PG8_SB(b, h) + boff + n * 2048 + k * 1024); } while (0)
#define PG8_MMA(ai, bj, At, Bt) do { __builtin_amdgcn_s_setprio(1); _Pragma("unroll") for (int m = 0; m < 4; ++m) _Pragma("unroll") for (int n = 0; n < 2; ++n) _Pragma("unroll") for (int k = 0; k < 2; ++k) \
        acc[ai][bj][m][n] = __builtin_amdgcn_mfma_f32_16x16x32_bf16(Bt[n][k], At[m][k], acc[ai][bj][m][n], 0, 0, 0); __builtin_amdgcn_s_setprio(0); } while (0)
#define PG8_WAIT_V(n) asm volatile("s_waitcnt vmcnt(" #n ")" ::: "memory")
#define PG8_WAIT_L(n) asm volatile("s_waitcnt lgkmcnt(" #n ")" ::: "memory")
#define PG8_BAR __builtin_amdgcn_s_barrier()
#define PG8_SCHED __builtin_amdgcn_sched_barrier(0)
    Unit cur, nxt; int ui = 0;
    if (!S.next(0, cur)) return;
    f32x4 acc[2][2][4][2];
#pragma unroll
    for (int a = 0; a < 2; ++a)
#pragma unroll
        for (int b = 0; b < 2; ++b)
#pragma unroll
            for (int m = 0; m < 4; ++m)
#pragma unroll
                for (int n = 0; n < 2; ++n) acc[a][b][m][n] = (f32x4){0.f, 0.f, 0.f, 0.f};
    bf16x8 At[4][2], B0[2][2], B1[2][2];
    const char* cA = (const char*)g.A + (size_t)cur.pm * tstep; const char* cB = (const char*)g.Bt + (size_t)cur.pn * tstep;
    S.a_ready(cur);
    if constexpr (SP2) {
        PG8_STAGE(PG8_SB(0, 0), cB, voffB); PG8_STAGE(PG8_SB(0, 1), cB + hstep, voffB); PG8_STAGE(PG8_SA(0, 0), cA, voffA); PG8_STAGE(PG8_SA(0, 1), cA + hstep, voffA);
        if (wr == 1) PG8_BAR;
        PG8_WAIT_V(2); PG8_BAR;
        PG8_STAGE(PG8_SB(1, 0), cB + kstep, voffB); PG8_STAGE(PG8_SA(1, 0), cA + kstep, voffA); PG8_STAGE(PG8_SB(1, 1), cB + hstep + kstep, voffB);
        PG8_WAIT_V(6); PG8_BAR;
    } else {
        PG8_STAGE(PG8_SB(0, 0), cB, voffB); PG8_STAGE(PG8_SA(0, 0), cA, voffA); PG8_STAGE(PG8_SB(0, 1), cB + hstep, voffB); PG8_STAGE(PG8_SA(0, 1), cA + hstep, voffA);
        if (wr == 1) PG8_BAR;
        PG8_WAIT_V(4); PG8_BAR;
        PG8_STAGE(PG8_SB(1, 0), cB + kstep, voffB); PG8_STAGE(PG8_SA(1, 0), cA + kstep, voffA); PG8_STAGE(PG8_SB(1, 1), cB + hstep + kstep, voffB);
        PG8_WAIT_V(6); PG8_BAR;
    }
    for (;;) {
        const bool has_next = S.next(ui + 1, nxt);
        const char* nA = has_next ? (const char*)g.A + (size_t)nxt.pm * tstep : cA; const char* nB = has_next ? (const char*)g.Bt + (size_t)nxt.pn * tstep : cB;
        for (int t = 0; t < nt; t += 2) {
            const bool last = (t == nt - 2);
            const char* a1 = cA + (size_t)(t + 1) * kstep;
            const char* a2 = last ? nA : cA + (size_t)(t + 2) * kstep; const char* b2 = last ? nB : cB + (size_t)(t + 2) * kstep;
            const char* a3 = a2 + kstep; const char* b3 = b2 + kstep;
            if (last && has_next) S.a_ready(nxt);
            if constexpr (SP2) {
            PG8_LDB(B0, 0, 0); PG8_LDB(B1, 0, 1); PG8_SCHED; PG8_LDA(At, 0, 0); PG8_STAGE(PG8_SA(1, 1), a1 + hstep, voffA);
            PG8_WAIT_V(8); PG8_WAIT_L(0); PG8_BAR; PG8_MMA(0, 0, At, B0); PG8_MMA(0, 1, At, B1); PG8_BAR; PG8_SCHED;
            PG8_LDA(At, 0, 1); PG8_STAGE(PG8_SB(0, 0), b2, voffB); PG8_STAGE(PG8_SB(0, 1), b2 + hstep, voffB); PG8_STAGE(PG8_SA(0, 0), a2, voffA);
            PG8_WAIT_V(8); PG8_WAIT_L(0); PG8_BAR; PG8_MMA(1, 0, At, B0); PG8_MMA(1, 1, At, B1); PG8_BAR; PG8_SCHED;
            PG8_LDB(B0, 1, 0); PG8_LDB(B1, 1, 1); PG8_SCHED; PG8_LDA(At, 1, 0); PG8_STAGE(PG8_SA(0, 1), a2 + hstep, voffA);
            PG8_WAIT_V(8); PG8_WAIT_L(0); PG8_BAR; PG8_MMA(0, 0, At, B0); PG8_MMA(0, 1, At, B1); PG8_BAR; PG8_SCHED;
            PG8_LDA(At, 1, 1); PG8_STAGE(PG8_SB(1, 0), b3, voffB); PG8_STAGE(PG8_SB(1, 1), b3 + hstep, voffB); PG8_STAGE(PG8_SA(1, 0), a3, voffA);
            PG8_WAIT_V(8); PG8_WAIT_L(0); PG8_BAR; PG8_MMA(1, 0, At, B0); PG8_MMA(1, 1, At, B1); PG8_BAR; PG8_SCHED;
            } else {
            PG8_LDB(B0, 0, 0); PG8_SCHED; PG8_LDA(At, 0, 0); PG8_STAGE(PG8_SA(1, 1), a1 + hstep, voffA);
            PG8_WAIT_L(8); PG8_BAR; PG8_WAIT_L(0); PG8_MMA(0, 0, At, B0); PG8_BAR; PG8_SCHED;
            PG8_LDB(B1, 0, 1); PG8_STAGE(PG8_SB(0, 0), b2, voffB);
            PG8_BAR; PG8_WAIT_L(0); PG8_MMA(0, 1, At, B1); PG8_BAR;
            PG8_LDA(At, 0, 1); PG8_STAGE(PG8_SA(0, 0), a2, voffA);
            PG8_BAR; PG8_WAIT_L(0); PG8_MMA(1, 0, At, B0); PG8_BAR; PG8_SCHED;
            PG8_STAGE(PG8_SB(0, 1), b2 + hstep, voffB);
            PG8_WAIT_V(6); PG8_BAR; PG8_MMA(1, 1, At, B1); PG8_BAR;
            PG8_LDB(B0, 1, 0); PG8_SCHED; PG8_LDA(At, 1, 0); PG8_STAGE(PG8_SA(0, 1), a2 + hstep, voffA);
            PG8_WAIT_L(8); PG8_BAR; PG8_WAIT_L(0); PG8_MMA(0, 0, At, B0); PG8_BAR; PG8_SCHED;
            PG8_LDB(B1, 1, 1); PG8_STAGE(PG8_SB(1, 0), b3, voffB);
            PG8_BAR; PG8_WAIT_L(0); PG8_MMA(0, 1, At, B1); PG8_BAR;
            PG8_LDA(At, 1, 1); PG8_STAGE(PG8_SA(1, 0), a3, voffA);
            PG8_BAR; PG8_WAIT_L(0); PG8_MMA(1, 0, At, B0); PG8_BAR; PG8_SCHED;
            PG8_STAGE(PG8_SB(1, 1), b3 + hstep, voffB);
            PG8_WAIT_V(6); PG8_BAR; PG8_MMA(1, 1, At, B1); PG8_BAR;
            }
        }
        if constexpr (ALIGN_EPI) { if (wr == 0) PG8_BAR; }
        if constexpr (!Epi::AFTER_DRAIN) { E(acc, cur, wr, wc, fr, fq); S.done(cur); }
        if (!has_next) break;
#pragma unroll
        for (int a = 0; a < 2; ++a)
#pragma unroll
            for (int b = 0; b < 2; ++b)
#pragma unroll
                for (int m = 0; m < 4; ++m)
#pragma unroll
                    for (int n = 0; n < 2; ++n) acc[a][b][m][n] = (f32x4){0.f, 0.f, 0.f, 0.f};
        cur = nxt; cA = nA; cB = nB; ++ui;
        if constexpr (ALIGN_EPI) { if (wr == 1) PG8_BAR; }
    }
    PG8_WAIT_V(0);
    if constexpr (!ALIGN_EPI) { if (wr == 0) PG8_BAR; }
    PG8_BAR;
    if constexpr (Epi::AFTER_DRAIN) { E.fused(acc, cur, wr, wc, fr, fq, lds, wid, lane); S.done(cur); }
#undef PG8_SA
#undef PG8_SB
#undef PG8_STAGE
#undef PG8_LDA
#undef PG8_LDB
#undef PG8_MMA
#undef PG8_WAIT_V
#undef PG8_WAIT_L
#undef PG8_BAR
#undef PG8_SCHED
}
typedef unsigned u32x2 __attribute__((ext_vector_type(2)));
typedef float f32x2 __attribute__((ext_vector_type(2)));
typedef __bf16 bf16x2_t __attribute__((ext_vector_type(2)));
__device__ __forceinline__ unsigned pkbf(float lo, float hi) { f32x2 v = {lo, hi}; bf16x2_t b = __builtin_convertvector(v, bf16x2_t); return __builtin_bit_cast(unsigned, b); }
__device__ __forceinline__ u32x2 pk4(f32x4 v) { u32x2 r; r.x = pkbf(v[0], v[1]); r.y = pkbf(v[2], v[3]); return r; }
__device__ __forceinline__ float silu_f(float v) { return v * __builtin_amdgcn_rcpf(1.f + __expf(-v)); }
__device__ __forceinline__ f32x4 silu4(f32x4 v) { f32x4 o; o[0] = silu_f(v[0]); o[1] = silu_f(v[1]); o[2] = silu_f(v[2]); o[3] = silu_f(v[3]); return o; }
__device__ __forceinline__ float ssq4(f32x4 v) { return (v[0] * v[0] + v[1] * v[1]) + (v[2] * v[2] + v[3] * v[3]); }
__device__ __forceinline__ float red_fq(float s) { s += __shfl_xor(s, 16); s += __shfl_xor(s, 32); return s; }

struct EpiAin {
    static constexpr bool PERM = false, AFTER_DRAIN = false;
    bf16_t *Q, *K, *V, *Z; const float *gq, *gk; float *okp, *ovp, *oks, *ovs;
    __device__ __forceinline__ void operator()(const f32x4 (&acc)[2][2][4][2], const Unit& u, int wr, int wc, int fr, int fq) const {
        const int sec = u.pn >> 2, head = (u.pn & 3) * 4 + wc, cb = head * 64 + 4 * fq;
        f32x4 g[2][2];
#pragma unroll
        for (int bj = 0; bj < 2; ++bj)
#pragma unroll
            for (int n = 0; n < 2; ++n) g[bj][n] = (sec < 2) ? *(const f32x4*)((sec == 0 ? gq : gk) + 32 * bj + 16 * n + 4 * fq) : (f32x4){1.f, 1.f, 1.f, 1.f};
#pragma unroll
        for (int ai = 0; ai < 2; ++ai)
#pragma unroll
            for (int m = 0; m < 4; ++m) {
                const int row = u.pm * BM + ai * HALF + wr * 64 + m * 16 + fr;
                f32x4 v[2][2];
#pragma unroll
                for (int bj = 0; bj < 2; ++bj)
#pragma unroll
                    for (int n = 0; n < 2; ++n) v[bj][n] = acc[ai][bj][m][n];
                if (sec < 2) {
                    float s = (ssq4(v[0][0]) + ssq4(v[0][1])) + (ssq4(v[1][0]) + ssq4(v[1][1]));
                    s = red_fq(s);
                    const float r = rsqrtf(s * (1.f / 64.f) + EPSN) * (sec == 0 ? QSCALE_A : 1.f);
#pragma unroll
                    for (int bj = 0; bj < 2; ++bj)
#pragma unroll
                        for (int n = 0; n < 2; ++n) v[bj][n] = v[bj][n] * g[bj][n] * r;
                } else if (sec == 3) {
#pragma unroll
                    for (int bj = 0; bj < 2; ++bj)
#pragma unroll
                        for (int n = 0; n < 2; ++n) v[bj][n] = silu4(v[bj][n]);
                }
                if (sec == 0 || sec == 3) {
                    bf16_t* d = (sec == 0 ? Q : Z) + (size_t)row * 1024 + cb;
#pragma unroll
                    for (int bj = 0; bj < 2; ++bj)
#pragma unroll
                        for (int n = 0; n < 2; ++n) *(u32x2*)(d + 32 * bj + 16 * n) = pk4(v[bj][n]);
                } else {
                    size_t drow; float* of = nullptr;
                    if (row < MP) { drow = (size_t)row; const int pos = row & (SEQ - 1); if (pos >= SEQ - 512) of = (sec == 1 ? okp : ovp) + ((size_t)((row >> 11) * 512 + pos - (SEQ - 512))) * 1024; }
                    else { const int rs = row - MP; drow = (size_t)MP + (size_t)(rs >> 5) * SA_STRIDE + 512 + (rs & 31); of = (sec == 1 ? oks : ovs) + (size_t)rs * 1024; }
                    bf16_t* d = (sec == 1 ? K : V) + drow * 1024 + cb;
#pragma unroll
                    for (int bj = 0; bj < 2; ++bj)
#pragma unroll
                        for (int n = 0; n < 2; ++n) { *(u32x2*)(d + 32 * bj + 16 * n) = pk4(v[bj][n]); if (of) *(f32x4*)(of + cb + 32 * bj + 16 * n) = v[bj][n]; }
                }
                asm volatile("" ::: "memory");
            }
    }
};
struct EpiRes {
    static constexpr bool PERM = false, AFTER_DRAIN = false;
    const float *xp, *xs; float *yp, *ys; const float* gate;
    bf16_t* YG; const float* G1; float* ssq;
    const bf16_t* xb; bf16_t* yb;
    __device__ __forceinline__ void operator()(const f32x4 (&acc)[2][2][4][2], const Unit& u, int wr, int wc, int fr, int fq) const {
        const int cb = u.pn * 256 + wc * 64 + 4 * fq;
#pragma unroll
        for (int ai = 0; ai < 2; ++ai)
#pragma unroll
            for (int m = 0; m < 4; ++m) {
                const int row = u.pm * BM + ai * HALF + wr * 64 + m * 16 + fr;
                const float* xi; float* yo; int bb;
                if (row < MP) { xi = xp + (size_t)row * 1024; yo = yp + (size_t)row * 1024; bb = row >> 11; }
                else { const int rs = row - MP; xi = xs + (size_t)rs * 1024; yo = ys + (size_t)rs * 1024; bb = NBP + (rs >> 5); }
                const float* gp = gate + (size_t)bb * 3072;
                float sq = 0.f;
#pragma unroll
                for (int bj = 0; bj < 2; ++bj)
#pragma unroll
                    for (int n = 0; n < 2; ++n) { const int c = cb + 32 * bj + 16 * n;
                        f32x4 xv;
                        if (xb) { const u32x2 w = *(const u32x2*)(xb + (size_t)row * 1024 + c); xv = (f32x4){__uint_as_float(w.x << 16), __uint_as_float(w.x & 0xffff0000u), __uint_as_float(w.y << 16), __uint_as_float(w.y & 0xffff0000u)}; }
                        else xv = *(const f32x4*)(xi + c);
                        const f32x4 o = xv + *(const f32x4*)(gp + c) * acc[ai][bj][m][n];
                        if (yb) *(u32x2*)(yb + (size_t)row * 1024 + c) = pk4(o); else *(f32x4*)(yo + c) = o;
                        if (YG) { sq += ssq4(o); *(u32x2*)(YG + (size_t)row * 1024 + c) = pk4(o * *(const f32x4*)(G1 + (size_t)bb * 1024 + c)); } }
                if (YG) { sq = red_fq(sq); if (fq == 0) atomicAdd(ssq + row, sq); }
                asm volatile("" ::: "memory");
            }
    }
};
struct EpiBin {
    static constexpr bool PERM = false, AFTER_DRAIN = false;
    bf16_t* Z; bf16_t* CQ; bf16_t* CKV; float* RAW2; const float* ssq; const float* SW; const float* gcq; const float* gckv; float* ssqq; float* ssqkv;
    __device__ __forceinline__ void operator()(const f32x4 (&acc)[2][2][4][2], const Unit& u, int wr, int wc, int fr, int fq) const {
        const int cb = u.pn * 256 + wc * 64 + 4 * fq;
        const int sidx = (u.pn - 4) * 4 + wc;
#pragma unroll
        for (int ai = 0; ai < 2; ++ai)
#pragma unroll
            for (int m = 0; m < 4; ++m) {
                const int row = u.pm * BM + ai * HALF + wr * 64 + m * 16 + fr;
                const int bb = row < MP ? (row >> 11) : NBP + ((row - MP) >> 5);
                const float r = rsqrtf(ssq[row] * (1.f / 1024.f) + EPSN);
                const float* sw = SW + (size_t)bb * 1792;
                f32x4 v[2][2];
#pragma unroll
                for (int bj = 0; bj < 2; ++bj)
#pragma unroll
                    for (int n = 0; n < 2; ++n) v[bj][n] = acc[ai][bj][m][n] * r + *(const f32x4*)(sw + cb + 32 * bj + 16 * n);
                if (u.pn < 4) {
#pragma unroll
                    for (int bj = 0; bj < 2; ++bj)
#pragma unroll
                        for (int n = 0; n < 2; ++n) *(u32x2*)(Z + (size_t)row * 1024 + cb + 32 * bj + 16 * n) = pk4(silu4(v[bj][n]));
                } else if (sidx < 10) {
                    float sq = (ssq4(v[0][0]) + ssq4(v[0][1])) + (ssq4(v[1][0]) + ssq4(v[1][1]));
                    sq = red_fq(sq);
                    if (sidx < 6) {
                        const int c0 = cb - 1024;
                        if (fq == 0) atomicAdd(ssqq + row, sq);
#pragma unroll
                        for (int bj = 0; bj < 2; ++bj)
#pragma unroll
                            for (int n = 0; n < 2; ++n) { const int c = c0 + 32 * bj + 16 * n; *(u32x2*)(CQ + (size_t)row * 384 + c) = pk4(v[bj][n] * *(const f32x4*)(gcq + c)); }
                    } else {
                        const int c0 = cb - 1408;
                        const size_t drow = row < MP ? (size_t)row : (size_t)MP + (size_t)((row - MP) >> 5) * SB_STRIDE + 2048 + ((row - MP) & 31);
                        if (fq == 0) atomicAdd(ssqkv + row, sq);
#pragma unroll
                        for (int bj = 0; bj < 2; ++bj)
#pragma unroll
                            for (int n = 0; n < 2; ++n) { const int c = c0 + 32 * bj + 16 * n; *(u32x2*)(CKV + drow * 256 + c) = pk4(v[bj][n] * *(const f32x4*)(gckv + c)); }
                    }
                } else if (sidx == 10) {
#pragma unroll
                    for (int n = 0; n < 2; ++n) *(f32x4*)(RAW2 + (size_t)row * 32 + 4 * fq + 16 * n) = v[0][n];
                }
                asm volatile("" ::: "memory");
            }
    }
};
struct EpiUq {
    static constexpr bool PERM = false, AFTER_DRAIN = false;
    bf16_t* Q; const float *gqn, *gqr, *CS; const float* ssqq;
    __device__ __forceinline__ void operator()(const f32x4 (&acc)[2][2][4][2], const Unit& u, int wr, int wc, int fr, int fq) const {
        if (u.pn < 4) {
            const int head = u.pn * 4 + wc;
#pragma unroll
            for (int ai = 0; ai < 2; ++ai)
#pragma unroll
                for (int m = 0; m < 4; ++m) {
                    const int row = u.pm * BM + ai * HALF + wr * 64 + m * 16 + fr;
                    float s = (ssq4(acc[ai][0][m][0]) + ssq4(acc[ai][0][m][1])) + (ssq4(acc[ai][1][m][0]) + ssq4(acc[ai][1][m][1]));
                    s = red_fq(s);
                    const float rq = rsqrtf(ssqq[row] * (1.f / 384.f) + EPSN);
                    const float r = rsqrtf(s * rq * rq * (1.f / 64.f) + EPSN) * rq * QSCALE_B;
                    bf16_t* d = Q + (size_t)row * 1536 + head * 96 + 4 * fq;
#pragma unroll
                    for (int bj = 0; bj < 2; ++bj)
#pragma unroll
                        for (int n = 0; n < 2; ++n) *(u32x2*)(d + 32 * bj + 16 * n) = pk4(acc[ai][bj][m][n] * *(const f32x4*)(gqn + 32 * bj + 16 * n + 4 * fq) * r);
                    asm volatile("" ::: "memory");
                }
        } else {
#pragma unroll
            for (int ai = 0; ai < 2; ++ai)
#pragma unroll
                for (int m = 0; m < 4; ++m) {
                    const int row = u.pm * BM + ai * HALF + wr * 64 + m * 16 + fr;
                    const int pos = row < MP ? (row & (SEQ - 1)) : SEQ + ((row - MP) & 31);
                    const float rq = rsqrtf(ssqq[row] * (1.f / 384.f) + EPSN);
#pragma unroll
                    for (int bj = 0; bj < 2; ++bj) {
                        const int hr = (u.pn - 4) * 8 + wc * 2 + bj;
                        float s = ssq4(acc[ai][bj][m][0]) + ssq4(acc[ai][bj][m][1]);
                        s = red_fq(s);
                        const float r = rsqrtf(s * rq * rq * (1.f / 32.f) + EPSN) * rq;
                        const f32x4 x1 = acc[ai][bj][m][0] * *(const f32x4*)(gqr + 4 * fq) * r, x2 = acc[ai][bj][m][1] * *(const f32x4*)(gqr + 16 + 4 * fq) * r;
                        const f32x4 cs = *(const f32x4*)(CS + pos * 32 + 4 * fq), sn = *(const f32x4*)(CS + pos * 32 + 16 + 4 * fq);
                        bf16_t* d = Q + (size_t)row * 1536 + hr * 96 + 64 + 4 * fq;
                        *(u32x2*)d = pk4((x1 * cs - x2 * sn) * QSCALE_B); *(u32x2*)(d + 16) = pk4((x2 * cs + x1 * sn) * QSCALE_B);
                        asm volatile("" ::: "memory");
                    }
                }
        }
    }
};
struct EpiUkv {
    static constexpr bool PERM = false, AFTER_DRAIN = false;
    bf16_t *KN, *VB; const float* gkn; const float* ssqkv;
    __device__ __forceinline__ void operator()(const f32x4 (&acc)[2][2][4][2], const Unit& u, int wr, int wc, int fr, int fq) const {
        const bool isk = u.pn < 4; const int head = (u.pn & 3) * 4 + wc;
#pragma unroll
        for (int ai = 0; ai < 2; ++ai)
#pragma unroll
            for (int m = 0; m < 4; ++m) {
                const int row = u.pm * BM + ai * HALF + wr * 64 + m * 16 + fr;
                float rs = 1.f;
                if (u.pm < MP / BM) rs = rsqrtf(ssqkv[row] * (1.f / 256.f) + EPSN);
                else { const int q_ = row - MP, bs_ = q_ / SB_STRIDE, rr_ = q_ - bs_ * SB_STRIDE; if (rr_ >= 2048 && rr_ < 2080) rs = rsqrtf(ssqkv[MP + bs_ * TS + rr_ - 2048] * (1.f / 256.f) + EPSN); }
                float r = rs;
                if (isk) { float s = (ssq4(acc[ai][0][m][0]) + ssq4(acc[ai][0][m][1])) + (ssq4(acc[ai][1][m][0]) + ssq4(acc[ai][1][m][1])); s = red_fq(s); r = rsqrtf(s * rs * rs * (1.f / 64.f) + EPSN) * rs; }
                bf16_t* d = (isk ? KN : VB) + (size_t)row * 1024 + head * 64 + 4 * fq;
#pragma unroll
                for (int bj = 0; bj < 2; ++bj)
#pragma unroll
                    for (int n = 0; n < 2; ++n) { const f32x4 gg = isk ? *(const f32x4*)(gkn + 32 * bj + 16 * n + 4 * fq) : (f32x4){1.f, 1.f, 1.f, 1.f}; *(u32x2*)(d + 32 * bj + 16 * n) = pk4(acc[ai][bj][m][n] * gg * r); }
                asm volatile("" ::: "memory");
            }
    }
};
}
namespace at {
#define ALAS __attribute__((address_space(3)))
typedef unsigned short bf16_t;
typedef short bf16x8 __attribute__((ext_vector_type(8)));
typedef short s16x4 __attribute__((ext_vector_type(4)));
typedef float f32x16 __attribute__((ext_vector_type(16)));
typedef float f32x4 __attribute__((ext_vector_type(4)));
typedef unsigned u32x4 __attribute__((ext_vector_type(4)));
typedef unsigned u32x2 __attribute__((ext_vector_type(2)));
constexpr int KROW = 144, VROW = 144, RROW = 80;
constexpr int KBUF = 64 * KROW, VBUF = 64 * VROW, RBUF = 64 * RROW, STAGE = KBUF + VBUF + RBUF;
constexpr int NSTAGE = 2, TBL_OFF = NSTAGE * STAGE, LDS_BYTES = TBL_OFF + 1280;
struct AttnUnit { int qrow0, nq, krow0, nt, lastvalid, head, c0, tf; };
__device__ __forceinline__ int crow(int r, int hi) { return (r & 3) + 8 * (r >> 2) + 4 * hi; }

template <bool MLA>
__device__ __forceinline__ void attn_unit(ALAS unsigned char* lds, const AttnUnit u, const bf16_t* __restrict__ Q, const bf16_t* __restrict__ Kn, const bf16_t* __restrict__ Kr,
                                          const bf16_t* __restrict__ V, const bf16_t* __restrict__ Z, bf16_t* __restrict__ U, const float* __restrict__ tbl) {
    int tid_ = threadIdx.x; asm volatile("" : "+v"(tid_));
    const int tid = tid_, lane = tid & 63, wid = __builtin_amdgcn_readfirstlane(tid >> 6), l32 = lane & 31, hi = lane >> 5;
    const int ci = wid >> 1, qh = wid & 1;
    const bool active = ci * 64 + qh * 32 < u.nq;
    const int cq = u.c0 + ci;
    constexpr int QS = MLA ? 1536 : 1024, HS = MLA ? 96 : 64, ND0 = MLA ? 6 : 4;
    constexpr float THR = 8.f;
    ALAS float* tb = (ALAS float*)(lds + TBL_OFF);
    if (!MLA) { if (tid < 320) tb[tid] = tid < 257 ? (tbl[(size_t)u.head * 257 + tid] - tbl[(size_t)u.head * 257 + 256]) * LOG2E : 0.f; }
    const int qrow = u.qrow0 + (active ? ci * 64 + qh * 32 : 0) + l32;
    bf16x8 qf[ND0];
#pragma unroll
    for (int d0 = 0; d0 < ND0; ++d0) qf[d0] = *(const bf16x8*)(Q + (size_t)qrow * QS + u.head * HS + d0 * 16 + hi * 8);
    const char* kbase = (const char*)(Kn + (size_t)u.krow0 * 1024 + u.head * 64);
    const char* vbase = (const char*)(V + (size_t)u.krow0 * 1024 + u.head * 64);
    const char* rbase = MLA ? (const char*)(Kr + (size_t)u.krow0 * 32) : nullptr;
    const unsigned koff = (unsigned)(((tid >> 3) * 1024 + (tid & 7) * 8) * 2);
    const int vkvq = (tid & 3) + 4 * ((tid >> 6) & 3), vdq = (tid >> 2) & 15;
    const unsigned voff = (unsigned)(((vkvq * 4) * 1024 + vdq * 4) * 2);
    const int vpos8 = (vkvq & ~3) + ((vkvq & 1) << 1) + ((vkvq >> 1) & 1);
    const unsigned roff = (unsigned)(((((tid - 256) >> 2) & 63) * 32 + (tid & 3) * 8) * 2);
    u32x4 kreg[1]; u32x2 vreg[1][4]; u32x4 rreg[1];
#define AT_GLOAD(ti, sx) do { const int tl_ = (ti) < u.nt ? (ti) : u.nt - 1; \
        kreg[sx] = *(const u32x4*)(kbase + (size_t)tl_ * 131072 + koff); \
        if (tid < 256) { const char* vb_ = vbase + (size_t)tl_ * 131072; \
            vreg[sx][0] = *(const u32x2*)(vb_ + voff); vreg[sx][1] = *(const u32x2*)(vb_ + voff + 2048); vreg[sx][2] = *(const u32x2*)(vb_ + 4096 + voff); vreg[sx][3] = *(const u32x2*)(vb_ + 4096 + voff + 2048); } \
        else if (MLA) { rreg[sx] = *(const u32x4*)(rbase + (size_t)tl_ * 4096 + roff); } } while (0)
#define AT_SWRITE(st, sx) do { ALAS unsigned char* sb_ = lds + (st) * STAGE; \
        *(ALAS u32x4*)(sb_ + (tid >> 3) * KROW + (tid & 7) * 16) = kreg[sx]; \
        if (tid < 256) { \
            _Pragma("unroll") for (int jj_ = 0; jj_ < 4; ++jj_) { const int d_ = 4 * vdq + jj_; u32x2 o_; \
                const unsigned sel_ = (jj_ & 1) ? 0x07060302u : 0x05040100u; \
                if (jj_ < 2) { o_.x = __builtin_amdgcn_perm(vreg[sx][1].x, vreg[sx][0].x, sel_); o_.y = __builtin_amdgcn_perm(vreg[sx][3].x, vreg[sx][2].x, sel_); } \
                else         { o_.x = __builtin_amdgcn_perm(vreg[sx][1].y, vreg[sx][0].y, sel_); o_.y = __builtin_amdgcn_perm(vreg[sx][3].y, vreg[sx][2].y, sel_); } \
                *(ALAS u32x2*)(sb_ + KBUF + d_ * VROW + vpos8 * 8) = o_; } } \
        else if (MLA) { const int t2_ = tid - 256; *(ALAS u32x4*)(sb_ + KBUF + VBUF + (t2_ >> 2) * RROW + (t2_ & 3) * 16) = rreg[sx]; } } while (0)
    float mref = 0.f;
    bool first = true;
    f32x16 negm = f32x16{}; asm volatile("" : "+v"(negm));
    f32x16 o0 = f32x16{}, o1 = f32x16{}; float lrun = 0.f;
    f32x16 p[2];
    const int tgl = (qh * 32 + l32 + 128 - 4 * hi) * 4;
#define AT_QK(t, sg) do { const int kc_ = u.tf + (t); ALAS unsigned char* sb_ = lds + (sg) * STAGE; ALAS unsigned char* kb_ = sb_ + l32 * KROW + hi * 16; \
        bool near_ = false; \
        if (!MLA) { near_ = cq - kc_ < 3; \
            if (near_) { ALAS unsigned char* tp_ = (ALAS unsigned char*)tb + tgl + 256 * (cq - kc_); \
                _Pragma("unroll") for (int blk = 0; blk < 2; ++blk) _Pragma("unroll") for (int r = 0; r < 16; ++r) p[blk][r] = *(const ALAS float*)(tp_ - 4 * (32 * blk + (r & 3) + 8 * (r >> 2))) - mref; } } \
        bf16x8 ka_[4], kb2_[4]; ALAS unsigned char* rb_ = sb_ + KBUF + VBUF + l32 * RROW + hi * 16; \
        _Pragma("unroll") for (int d0 = 0; d0 < 4; ++d0) ka_[d0] = *(const ALAS bf16x8*)(kb_ + d0 * 32); \
        _Pragma("unroll") for (int d0 = 0; d0 < 4; ++d0) kb2_[d0] = *(const ALAS bf16x8*)(kb_ + 32 * KROW + d0 * 32); \
        __builtin_amdgcn_sched_barrier(0); \
        if (near_) { p[0] = __builtin_amdgcn_mfma_f32_32x32x16_bf16(ka_[0], qf[0], p[0], 0, 0, 0); p[1] = __builtin_amdgcn_mfma_f32_32x32x16_bf16(kb2_[0], qf[0], p[1], 0, 0, 0); } \
        else       { p[0] = __builtin_amdgcn_mfma_f32_32x32x16_bf16(ka_[0], qf[0], negm, 0, 0, 0); p[1] = __builtin_amdgcn_mfma_f32_32x32x16_bf16(kb2_[0], qf[0], negm, 0, 0, 0); } \
        _Pragma("unroll") for (int d0 = 1; d0 < 4; ++d0) { p[0] = __builtin_amdgcn_mfma_f32_32x32x16_bf16(ka_[d0], qf[d0], p[0], 0, 0, 0); p[1] = __builtin_amdgcn_mfma_f32_32x32x16_bf16(kb2_[d0], qf[d0], p[1], 0, 0, 0); \
            if (MLA && d0 == 1) { ka_[0] = *(const ALAS bf16x8*)(rb_); kb2_[0] = *(const ALAS bf16x8*)(rb_ + 32 * RROW); ka_[1] = *(const ALAS bf16x8*)(rb_ + 32); kb2_[1] = *(const ALAS bf16x8*)(rb_ + 32 * RROW + 32); } } \
        if (MLA) { p[0] = __builtin_amdgcn_mfma_f32_32x32x16_bf16(ka_[0], qf[4], p[0], 0, 0, 0); p[1] = __builtin_amdgcn_mfma_f32_32x32x16_bf16(kb2_[0], qf[4], p[1], 0, 0, 0); \
                   p[0] = __builtin_amdgcn_mfma_f32_32x32x16_bf16(ka_[1], qf[ND0 - 1], p[0], 0, 0, 0); p[1] = __builtin_amdgcn_mfma_f32_32x32x16_bf16(kb2_[1], qf[ND0 - 1], p[1], 0, 0, 0); } \
        if ((t) == u.nt - 1 && u.lastvalid < 64) { _Pragma("unroll") for (int r = 0; r < 16; ++r) p[1][r] = -__builtin_inff(); } } while (0)
#define AT_SMPV(t, sg) do { ALAS unsigned char* vb_ = lds + (sg) * STAGE + KBUF + l32 * VROW + hi * 16; \
        bf16x8 vf_[2][4]; \
        _Pragma("unroll") for (int dblk = 0; dblk < 2; ++dblk) _Pragma("unroll") for (int j = 0; j < 4; ++j) vf_[dblk][j] = *(const ALAS bf16x8*)(vb_ + dblk * 32 * VROW + j * 32); \
        __builtin_amdgcn_sched_barrier(0); \
        float rm = p[0][0]; \
        _Pragma("unroll") for (int r = 1; r < 16; ++r) rm = fmaxf(rm, p[0][r]); \
        _Pragma("unroll") for (int r = 0; r < 16; ++r) rm = fmaxf(rm, p[1][r]); \
        rm = fmaxf(rm, __shfl_xor(rm, 32)); \
        if (first || __any(rm > THR)) { \
            const float dl = first ? rm : fmaxf(rm, 0.f); mref += dl; \
            _Pragma("unroll") for (int r = 0; r < 16; ++r) { p[0][r] -= dl; p[1][r] -= dl; } \
            _Pragma("unroll") for (int r = 0; r < 16; ++r) negm[r] = -mref; \
            asm volatile("" : "+v"(negm)); \
            if (!first) { const float al = __builtin_amdgcn_exp2f(-dl); lrun *= al; \
                _Pragma("unroll") for (int r = 0; r < 16; ++r) { o0[r] *= al; o1[r] *= al; } } \
            first = false; } \
        _Pragma("unroll") for (int blk = 0; blk < 2; ++blk) _Pragma("unroll") for (int r = 0; r < 16; ++r) p[blk][r] = __builtin_amdgcn_exp2f(p[blk][r]); \
        { float ls0 = 0.f, ls1 = 0.f; _Pragma("unroll") for (int r = 0; r < 16; ++r) { ls0 += p[0][r]; ls1 += p[1][r]; } lrun += ls0 + ls1; } \
        bf16x8 pk[4]; \
        _Pragma("unroll") for (int j = 0; j < 4; ++j) { u32x4 w; const int b = j >> 1, r0 = 8 * (j & 1); \
            w.x = pg8::pkbf(p[b][r0 + 0], p[b][r0 + 1]); w.y = pg8::pkbf(p[b][r0 + 2], p[b][r0 + 3]); w.z = pg8::pkbf(p[b][r0 + 4], p[b][r0 + 5]); w.w = pg8::pkbf(p[b][r0 + 6], p[b][r0 + 7]); \
            pk[j] = __builtin_bit_cast(bf16x8, w); } \
        _Pragma("unroll") for (int j = 0; j < 4; ++j) { \
            o0 = __builtin_amdgcn_mfma_f32_32x32x16_bf16(vf_[0][j], pk[j], o0, 0, 0, 0); \
            o1 = __builtin_amdgcn_mfma_f32_32x32x16_bf16(vf_[1][j], pk[j], o1, 0, 0, 0); \
            } } while (0)
#define AT_TAKE(t) (active && (u.tf + (t)) <= cq && (MLA || (u.tf + (t)) >= cq - 8))
    AT_GLOAD(0, 0); AT_SWRITE(0, 0);
    __syncthreads();
    for (int ti = 0; ti < u.nt; ++ti) {
        const bool more = ti + 1 < u.nt;
        if (more) AT_GLOAD(ti + 1, 0);
        if (AT_TAKE(ti)) { AT_QK(ti, ti & 1); AT_SMPV(ti, ti & 1); }
        if (more) AT_SWRITE((ti + 1) & 1, 0);
        __syncthreads();
    }
#undef AT_QK
#undef AT_SMPV
#undef AT_TAKE
    if (active) {
        const float inv = 1.f / (lrun + __shfl_xor(lrun, 32));
        const size_t ob = (size_t)qrow * 1024 + u.head * 64 + 4 * hi;
#pragma unroll
        for (int dblk = 0; dblk < 2; ++dblk)
#pragma unroll
            for (int g = 0; g < 4; ++g) {
                const u32x2 zz = *(const u32x2*)(Z + ob + 32 * dblk + 8 * g);
                const float z0 = __uint_as_float(zz.x << 16), z1 = __uint_as_float(zz.x & 0xffff0000u), z2 = __uint_as_float(zz.y << 16), z3 = __uint_as_float(zz.y & 0xffff0000u);
                const f32x16& o = dblk == 0 ? o0 : o1;
                u32x2 w; w.x = pg8::pkbf(o[4 * g + 0] * inv * z0, o[4 * g + 1] * inv * z1); w.y = pg8::pkbf(o[4 * g + 2] * inv * z2, o[4 * g + 3] * inv * z3);
                *(u32x2*)(U + ob + 32 * dblk + 8 * g) = w;
            }
    }
#undef AT_GLOAD
#undef AT_SWRITE
}
__device__ __forceinline__ bool prompt_unit(int k, int G, int bid, int& bh, int& qb) {
    if (G == 256) { if (k >= 16) return false; const int x = bid & 7, j = bid >> 3; bh = (4 * k + (j >> 3)) * 8 + x; qb = ((j & 7) + k) & 7; return true; }
    const int u = bid + k * G; if (u >= 4096) return false; bh = u >> 3; qb = u & 7; return true;
}
}
#define LAS __attribute__((address_space(3)))
typedef unsigned short bf16;
typedef unsigned v4u __attribute__((ext_vector_type(4)));
typedef unsigned v2u __attribute__((ext_vector_type(2)));
typedef float f32x4 __attribute__((ext_vector_type(4)));
constexpr size_t MiB = 1u << 20;
constexpr size_t WS_MOD = 0;
constexpr size_t MOD_BYTES = 2 * 40 * 3072 * 4;
constexpr size_t WS_BAR = 1 * MiB - 16384;
constexpr size_t WS_CS = 1 * MiB;
constexpr size_t WS_G1 = 2 * MiB;
constexpr size_t WS_SW = 2 * MiB + 256 * 1024;
constexpr size_t WS_SSQ = 3 * MiB;
constexpr size_t WS_SSQQ = 3 * MiB + 320 * 1024, WS_SSQKV = 3 * MiB + 640 * 1024;
constexpr size_t WS_RAW2 = 24 * MiB;
constexpr size_t WS_W_AIN = 4 * MiB, WS_W_AOUT = 12 * MiB, WS_W_BIN = 14 * MiB, WS_W_UQ = 18 * MiB, WS_W_UKV = 20 * MiB, WS_W_BOUT = 22 * MiB;
constexpr size_t WS_H = 24 * MiB;
constexpr size_t WS_CKV = 153 * MiB;
constexpr size_t WS_KR = 194 * MiB;
constexpr size_t WS_X = 200 * MiB;
constexpr size_t WS_QA = WS_X, WS_KA = WS_X + 129 * MiB, WS_VA = WS_X + 267 * MiB, WS_ZA = WS_X + 405 * MiB;
constexpr size_t WS_YG = WS_ZA;
constexpr size_t WS_ZB = WS_X, WS_RAW = WS_X + 129 * MiB, WS_QB = WS_RAW, WS_CQ = WS_X + 322 * MiB, WS_KN = WS_X + 371 * MiB, WS_VB = WS_X + 532 * MiB;
constexpr size_t WS_Y1B = WS_X + 694 * MiB;
constexpr size_t WS_END = WS_Y1B + 129 * MiB;
static_assert((size_t)M1 * 1024 * 2 <= 129 * MiB && (size_t)RA * 1024 * 2 <= 138 * MiB && (size_t)M1 * 768 * 4 <= 193 * MiB && (size_t)M1 * 384 * 2 <= 49 * MiB && (size_t)R2 * 1024 * 2 <= 161 * MiB, "ws map");
static_assert((size_t)R2 * 256 * 2 <= 41 * MiB && (size_t)R2 * 32 * 2 <= 6 * MiB && WS_ZA + 129 * MiB <= WS_END && WS_VB + 161 * MiB <= WS_END && WS_END <= 1024 * MiB, "ws map");
constexpr size_t O_YP = 0, O_YS = 67108864, O_AKP = 67371008, O_AVP = 84148224, O_AKS = 100925440, O_AVS = 101187584, O_CKVP = 101449728, O_KRP = 118226944, O_CKVS = 120324096, O_KRS = 120389632;
constexpr int LDS_TOTAL = 147456, LDS_MISC = 131072 + 320;
static_assert(at::LDS_BYTES <= LDS_TOTAL && pg8::STAGE_BYTES <= LDS_TOTAL, "LDS");

__device__ __forceinline__ float wave_sum(float v) {
#pragma unroll
    for (int o = 1; o < 64; o <<= 1) v += __shfl_xor(v, o);
    return v;
}
__device__ __forceinline__ unsigned pk2(float lo, float hi) { return pg8::pkbf(lo, hi); }
__device__ __forceinline__ int src_col(int gemm, int g) {
    const int lc = ((g >> 3) * 8 + (g & 3) * 2 + ((g >> 2) & 1)) * 32;
    switch (gemm) {
    case 2: if (lc < 1024) return 672 + lc; if (lc < 1408) return lc - 1024; if (lc < 1664) return 384 + (lc - 1408); if (lc < 1696) return 640 + (lc - 1664); return -1;
    case 3: if (lc < 1024) return (lc >> 6) * 96 + (lc & 63); return ((lc - 1024) >> 5) * 96 + 64;
    case 4: if (lc < 1024) return (lc >> 6) * 128 + (lc & 63); return ((lc - 1024) >> 6) * 128 + 64 + (lc & 63);
    default: return lc;
    }
}
__device__ __forceinline__ void transpose_item(const float* W, int K, int Nsrc, int sc, bf16* WT, int g, int k0, LAS float* scr, int lane) {
#pragma unroll 8
    for (int i = 0; i < 32; ++i) { const int kk = 2 * i + (lane >> 5); scr[kk * 33 + (lane & 31)] = sc >= 0 ? W[(size_t)(k0 + kk) * Nsrc + sc + (lane & 31)] : 0.f; }
    asm volatile("s_waitcnt lgkmcnt(0)" ::: "memory");
    const int c = lane & 7;
#pragma unroll
    for (int j = 0; j < 4; ++j) { const int n = (lane >> 3) + 8 * j; const LAS float* s = scr + (8 * c) * 33 + n;
        v4u o; o.x = pk2(s[0 * 33], s[1 * 33]); o.y = pk2(s[2 * 33], s[3 * 33]); o.z = pk2(s[4 * 33], s[5 * 33]); o.w = pk2(s[6 * 33], s[7 * 33]);
        *(v4u*)(WT + (size_t)(32 * g + n) * K + k0 + 8 * c) = o; }
    asm volatile("s_waitcnt lgkmcnt(0)" ::: "memory");
}
__device__ __forceinline__ void cvt8(const float* s, bf16* d) { const f32x4 a = *(const f32x4*)s, b = *(const f32x4*)(s + 4); v4u o; o.x = pk2(a[0], a[1]); o.y = pk2(a[2], a[3]); o.z = pk2(b[0], b[1]); o.w = pk2(b[2], b[3]); *(v4u*)d = o; }

#define GAS __attribute__((address_space(1)))
#define RLX_AGENT __ATOMIC_RELAXED, __HIP_MEMORY_SCOPE_AGENT
#define XB_TMO      128
#define XB_XCNT(j)  (256  + 64 * (j))
#define XB_XSUB(j)  (1280 + 64 * (j))
#define XB_XGEN(j)  (2304 + 64 * (j))
#define XB_TOP      3328
#define XB_TOPGEN   3392
#define XCD_BAR_WORDS 3456
#define XB_SPIN_CAP (1u << 18)

__device__ __forceinline__ unsigned xb_ld(unsigned* p)              { return __hip_atomic_load(p, __ATOMIC_RELAXED, __HIP_MEMORY_SCOPE_AGENT); }
__device__ __forceinline__ unsigned xb_add(unsigned* p, unsigned v) { return __hip_atomic_fetch_add(p, v, __ATOMIC_RELAXED, __HIP_MEMORY_SCOPE_AGENT); }
__device__ __forceinline__ unsigned xb_xcc_id() { return (unsigned)__builtin_amdgcn_s_getreg((3 << 11) | 20) & 0xFu; }
#define XB_SPIN(cond, bar) do { unsigned _sp = 0; while (cond) { __builtin_amdgcn_s_sleep(1); \
    if ((++_sp & 255u) == 0u) { if (xb_ld(&(bar)[XB_TMO])) break; if (_sp > XB_SPIN_CAP) { atomicAdd(&(bar)[XB_TMO], 1u); break; } } } } while (0)

struct XcdBarrier {
    unsigned* bar; unsigned x;
    volatile LAS unsigned* st;
};

__device__ __forceinline__ XcdBarrier xcd_barrier_post(unsigned* bar, volatile LAS unsigned* st) {
    XcdBarrier b; b.bar = bar; b.x = xb_xcc_id(); b.st = st;
    if (threadIdx.x == 0) (void)xb_add(&bar[XB_XCNT(b.x)], 1u);
    return b;
}
__device__ __forceinline__ void xcd_barrier_complete(unsigned* bar, unsigned x, unsigned& nloc, unsigned& nx) {
    const unsigned G = gridDim.x * gridDim.y * gridDim.z;
    unsigned sum, cnt, mine, sp = 0u;
    for (;;) {
        sum = 0u; cnt = 0u; mine = 0u;
#pragma unroll
        for (unsigned j = 0; j < 16; ++j) { const unsigned c = xb_ld(&bar[XB_XCNT(j)]); sum += c; cnt += (c > 0u) ? 1u : 0u; mine = (j == x) ? c : mine; }
        if (sum == G) break;
        __builtin_amdgcn_s_sleep(1);
        if ((++sp & 255u) == 0u) { if (xb_ld(&bar[XB_TMO])) break; if (sp > XB_SPIN_CAP) { atomicAdd(&bar[XB_TMO], 1u); break; } }
    }
    nloc = mine > 0u ? mine : 1u; nx = cnt > 0u ? cnt : 1u;
}

__device__ __forceinline__ void xcd_barrier(const XcdBarrier& b) {
    asm volatile("s_waitcnt vmcnt(0)" ::: "memory");
    __syncthreads();
    if (threadIdx.x == 0) {
        unsigned* bar = b.bar;
        __builtin_amdgcn_s_waitcnt(0);
        unsigned nloc = b.st[0], nx = b.st[1];
        if (nloc == 0u) { xcd_barrier_complete(bar, b.x, nloc, nx); b.st[0] = nloc; b.st[1] = nx; }
        const unsigned old = xb_add(&bar[XB_XSUB(b.x)], 1u);
        const unsigned gen = old / nloc;
        if (old + 1u == (gen + 1u) * nloc) {
            __builtin_amdgcn_fence(__ATOMIC_RELEASE, "agent");
            asm volatile("s_waitcnt vmcnt(0)" ::: "memory");
            const unsigned og = xb_add(&bar[XB_TOP], 1u);
            const unsigned tg = og / nx;
            if (og + 1u == (tg + 1u) * nx) xb_add(&bar[XB_TOPGEN], 1u);
            else XB_SPIN(xb_ld(&bar[XB_TOPGEN]) == tg, bar);
            __builtin_amdgcn_fence(__ATOMIC_ACQUIRE, "agent");
            xb_add(&bar[XB_XGEN(b.x)], 1u);
            asm volatile("s_waitcnt vmcnt(0)" ::: "memory");
        } else {
            XB_SPIN(xb_ld(&bar[XB_XGEN(b.x)]) == gen, bar);
            __builtin_amdgcn_fence(__ATOMIC_ACQUIRE, "agent");
            asm volatile("s_waitcnt vmcnt(0)" ::: "memory");
        }
    }
    __syncthreads();
}

struct Args { const float* in[26]; float* out; unsigned char* ws; int ph_lo, ph_hi; };

__device__ __forceinline__ void adanorm_rows(const float* xp, const float* xs, const float* g, const float* mod, bf16* H, int gw, int NGW, int lane) {
    for (int grp = gw; grp < M1 / 4; grp += NGW) {
        const int row0 = grp * 4;
        const float* xr; int bb;
        if (row0 < MP) { xr = xp + (size_t)row0 * 1024; bb = row0 >> 11; } else { xr = xs + (size_t)(row0 - MP) * 1024; bb = NBP + ((row0 - MP) >> 5); }
        const float* md = mod + (size_t)bb * 3072;
        f32x4 v[4][4]; float s[4];
#pragma unroll
        for (int q = 0; q < 4; ++q) { s[q] = 0.f;
#pragma unroll
            for (int j = 0; j < 4; ++j) v[q][j] = *(const f32x4*)(xr + (size_t)q * 1024 + 4 * lane + 256 * j); }
#pragma unroll
        for (int q = 0; q < 4; ++q)
#pragma unroll
            for (int j = 0; j < 4; ++j) s[q] += pg8::ssq4(v[q][j]);
#pragma unroll
        for (int o = 1; o < 64; o <<= 1) {
#pragma unroll
            for (int q = 0; q < 4; ++q) s[q] += __shfl_xor(s[q], o); }
#pragma unroll
        for (int q = 0; q < 4; ++q) s[q] = rsqrtf(s[q] * (1.f / 1024.f) + EPSN);
#pragma unroll
        for (int j = 0; j < 4; ++j) { const int c = 4 * lane + 256 * j;
            const f32x4 gg = *(const f32x4*)(g + c) * (*(const f32x4*)(md + 1024 + c) + 1.f), sh = *(const f32x4*)(md + c);
#pragma unroll
            for (int q = 0; q < 4; ++q) { const f32x4 h = v[q][j] * s[q] * gg + sh;
                v2u o; o.x = pk2(h[0], h[1]); o.y = pk2(h[2], h[3]); *(v2u*)(H + (size_t)(row0 + q) * 1024 + c) = o; } }
    }
}

__global__ void __launch_bounds__(512, 2) hybrid_fwd(Args args) {
    extern __shared__ __attribute__((aligned(16))) unsigned char lds_raw[];
    LAS unsigned char* lds = (LAS unsigned char*)lds_raw;
    const int tid = threadIdx.x, lane = tid & 63, wave = __builtin_amdgcn_readfirstlane(tid >> 6);
    const int G = gridDim.x, bid = blockIdx.x;
    const int gw = bid * 8 + wave, NGW = G * 8;
    const int gt = bid * 512 + tid, NGT = G * 512;
    const int lo = args.ph_lo, hi = args.ph_hi;
    volatile LAS unsigned* MISC = (volatile LAS unsigned*)(lds + LDS_MISC);
    if (tid < 16) MISC[tid] = 0u;
    __syncthreads();
    XcdBarrier bar; bar.bar = nullptr; bar.x = 0; bar.st = nullptr;
    if (hi - lo > 1) { bar = xcd_barrier_post((unsigned*)(args.ws + WS_BAR), MISC + 8); cg::this_grid().sync(); }
#ifndef PHMASK
#define PHMASK 0x7ff
#endif
#ifndef PROBE_SYNC
#define PROBE_SYNC 0
#endif
#ifndef PROBE_REP
#define PROBE_REP 0
#endif
#define REP(k) for (int rep_ = 0; rep_ < 1 + ((PROBE_REP >> (k)) & 1); ++rep_)
#define IN(k) (((PHMASK >> (k)) & 1) && lo <= (k) && (k) < hi)
typedef const __attribute__((address_space(4))) Args* KArgs;
#define PHASE_ARGS() KArgs A = (KArgs)__builtin_amdgcn_kernarg_segment_ptr(); asm volatile("" : "+s"(A)); unsigned char* ws = A->ws; float* out = A->out; (void)ws; (void)out
#define WSP(T, off) ((T*)(ws + (off)))
#define SEAM(k) do { if (IN(k) && IN((k) + 1)) { xcd_barrier(bar); } } while (0)

    if (IN(0)) REP(0) {
        PHASE_ARGS();
        float* mod = WSP(float, WS_MOD); float* CS = WSP(float, WS_CS);
        bf16 *W_AIN = WSP(bf16, WS_W_AIN), *W_AOUT = WSP(bf16, WS_W_AOUT), *W_BIN = WSP(bf16, WS_W_BIN), *W_UQ = WSP(bf16, WS_W_UQ), *W_UKV = WSP(bf16, WS_W_UKV), *W_BOUT = WSP(bf16, WS_W_BOUT);
        bf16 *KA = WSP(bf16, WS_KA), *VA = WSP(bf16, WS_VA), *CKV = WSP(bf16, WS_CKV), *KR = WSP(bf16, WS_KR);
        {
            LAS float* scr = (LAS float*)(lds + wave * 10240);
            constexpr int I0 = 16 * 128, I1 = 16 * 32, I2 = 16 * 56, I3 = 6 * 48, I4 = 4 * 64, I5 = 16 * 32;
            for (int it = gw; it < I0 + I1 + I2 + I3 + I4 + I5; it += NGW) {
                int r = it;
                if (r < I0) { const int g = r % 128; transpose_item(A->in[11], 1024, 4096, src_col(0, g), W_AIN, g, (r / 128) * 64, scr, lane); continue; } r -= I0;
                if (r < I1) { const int g = r % 32; transpose_item(A->in[15], 1024, 1024, src_col(1, g), W_AOUT, g, (r / 32) * 64, scr, lane); continue; } r -= I1;
                if (r < I2) { const int g = r % 56; transpose_item(A->in[16], 1024, 1696, src_col(2, g), W_BIN, g, (r / 56) * 64, scr, lane); continue; } r -= I2;
                if (r < I3) { const int g = r % 48; transpose_item(A->in[18], 384, 1536, src_col(3, g), W_UQ, g, (r / 48) * 64, scr, lane); continue; } r -= I3;
                if (r < I4) { const int g = r % 64; transpose_item(A->in[20], 256, 2048, src_col(4, g), W_UKV, g, (r / 64) * 64, scr, lane); continue; } r -= I4;
                { const int g = r % 32; transpose_item(A->in[25], 1024, 1024, src_col(5, g), W_BOUT, g, (r / 32) * 64, scr, lane); }
            }
        }
        for (int it = bid; it < 2 * 48; it += G) {
            const int l = it / 48, jb = it % 48;
            LAS float* sl = (LAS float*)(lds + wave * 10240);
            float acc[40];
#pragma unroll
            for (int b = 0; b < 40; ++b) acc[b] = 0.f;
            for (int pass = 0; pass < 2; ++pass) {
                const int k0 = (wave + 8 * pass) * 64;
                for (int e = lane; e < 40 * 64; e += 64) { const int bb = e >> 6, k = e & 63; const float c = bb < NBP ? A->in[6][(size_t)bb * 1024 + k0 + k] : A->in[7][(size_t)(bb - NBP) * 1024 + k0 + k]; sl[e] = c / (1.f + __expf(-c)); }
                asm volatile("s_waitcnt lgkmcnt(0)" ::: "memory");
                const float* W = A->in[9] + (size_t)l * 1024 * 3072 + (size_t)k0 * 3072 + jb * 64 + lane;
                for (int k = 0; k < 64; k += 4) {
                    const float w0 = W[(size_t)k * 3072], w1 = W[(size_t)(k + 1) * 3072], w2 = W[(size_t)(k + 2) * 3072], w3 = W[(size_t)(k + 3) * 3072];
#pragma unroll
                    for (int b = 0; b < 40; ++b) { const f32x4 sv = *(const LAS f32x4*)(sl + b * 64 + k); acc[b] += (sv[0] * w0 + sv[1] * w1) + (sv[2] * w2 + sv[3] * w3); }
                }
                asm volatile("s_waitcnt lgkmcnt(0)" ::: "memory");
            }
            __syncthreads();
            LAS float* red = (LAS float*)lds;
#pragma unroll
            for (int b = 0; b < 40; ++b) red[(wave * 40 + b) * 64 + lane] = acc[b];
            __syncthreads();
            for (int e = tid; e < 40 * 64; e += 512) { const int b = e >> 6, j = e & 63; float sum = A->in[10][(size_t)l * 3072 + jb * 64 + j];
#pragma unroll
                for (int w = 0; w < 8; ++w) sum += red[(w * 40 + b) * 64 + j];
                mod[((size_t)l * 40 + b) * 3072 + jb * 64 + j] = sum; }
            __syncthreads();
        }
        for (int i = gt; i < NBS * SA_STRIDE * 128; i += NGT) {
            const int c8 = i & 127, rr = (i >> 7) % SA_STRIDE, bs = (i >> 7) / SA_STRIDE;
            const size_t d = ((size_t)MP + (size_t)bs * SA_STRIDE + rr) * 1024 + c8 * 8;
            if (rr < 512) { const size_t s = ((size_t)bs * 512 + rr) * 1024 + c8 * 8; cvt8(A->in[2] + s, KA + d); cvt8(A->in[3] + s, VA + d); }
            else if (rr >= 544) { *(v4u*)(KA + d) = (v4u){0, 0, 0, 0}; *(v4u*)(VA + d) = (v4u){0, 0, 0, 0}; }
        }
        for (int i = gt; i < NBS * SB_STRIDE * 32; i += NGT) {
            const int c8 = i & 31, rr = (i >> 5) % SB_STRIDE, bs = (i >> 5) / SB_STRIDE;
            const size_t d = ((size_t)MP + (size_t)bs * SB_STRIDE + rr) * 256 + c8 * 8;
            if (rr < 2048) cvt8(A->in[4] + ((size_t)bs * 2048 + rr) * 256 + c8 * 8, CKV + d);
            else if (rr >= 2080) *(v4u*)(CKV + d) = (v4u){0, 0, 0, 0};
        }
        for (int i = gt; i < NBS * SB_STRIDE * 4; i += NGT) {
            const int c8 = i & 3, rr = (i >> 2) % SB_STRIDE, bs = (i >> 2) / SB_STRIDE;
            const size_t d = ((size_t)MP + (size_t)bs * SB_STRIDE + rr) * 32 + c8 * 8;
            if (rr < 2048) cvt8(A->in[5] + ((size_t)bs * 2048 + rr) * 32 + c8 * 8, KR + d);
            else if (rr >= 2080) *(v4u*)(KR + d) = (v4u){0, 0, 0, 0};
        }
        { float* SSQ = WSP(float, WS_SSQ); float* SQ2 = WSP(float, WS_SSQQ); float* SQ3 = WSP(float, WS_SSQKV); for (int i = gt; i < M1; i += NGT) { SSQ[i] = 0.f; SQ2[i] = 0.f; SQ3[i] = 0.f; } }
        for (int i = gt; i < 2112 * 16; i += NGT) {
            const int pos = i >> 4, k = i & 15;
            const float inv = exp2f(-(float)k * (13.287712379549449f / 16.f));
            const float ang = (float)pos * inv;
            const double tr = (double)ang * 0.15915494309189535;
            const float fr = (float)(tr - floor(tr + 0.5));
            CS[pos * 32 + k] = __builtin_amdgcn_cosf(fr); CS[pos * 32 + 16 + k] = __builtin_amdgcn_sinf(fr);
        }
    }
    SEAM(0);
    if (IN(1)) REP(1) { PHASE_ARGS();
        const float* mod1 = WSP(float, WS_MOD) + 40 * 3072;
        {
            float* G1 = WSP(float, WS_G1); const float* g1 = A->in[8] + 1024;
            for (int i = gt; i < 40 * 1024; i += NGT) { const int bb = i >> 10, c = i & 1023; G1[i] = g1[c] * (1.f + mod1[(size_t)bb * 3072 + 1024 + c]); }
            float* SW = WSP(float, WS_SW); const bf16* WB = WSP(bf16, WS_W_BIN);
            for (int lc = gw; lc < 1792; lc += NGW) {
                const int lg = lc >> 5, pn = lg >> 3, rem = lg & 7, crow_ = (pn * 8 + (rem & 1) * 4 + (rem >> 1)) * 32 + (lc & 31);
                const v4u w0 = *(const v4u*)(WB + (size_t)crow_ * 1024 + 16 * lane), w1 = *(const v4u*)(WB + (size_t)crow_ * 1024 + 16 * lane + 8);
                float wf[16];
#pragma unroll
                for (int e = 0; e < 4; ++e) { wf[2 * e] = __uint_as_float(w0[e] << 16); wf[2 * e + 1] = __uint_as_float(w0[e] & 0xffff0000u); wf[8 + 2 * e] = __uint_as_float(w1[e] << 16); wf[8 + 2 * e + 1] = __uint_as_float(w1[e] & 0xffff0000u); }
                for (int bb = 0; bb < 40; ++bb) { const float* sh = mod1 + (size_t)bb * 3072 + 16 * lane; float a = 0.f;
#pragma unroll
                    for (int e = 0; e < 4; ++e) { const f32x4 x = *(const f32x4*)(sh + 4 * e); a += (x[0] * wf[4 * e] + x[1] * wf[4 * e + 1]) + (x[2] * wf[4 * e + 2] + x[3] * wf[4 * e + 3]); }
                    a = wave_sum(a); if (lane == 0) SW[(size_t)bb * 1792 + lc] = a; }
            }
        }
        adanorm_rows(A->in[0], A->in[1], A->in[8], WSP(float, WS_MOD), WSP(bf16, WS_H), gw, NGW, lane); }
    SEAM(1);
    if (IN(2)) REP(2) {
        PHASE_ARGS();
        int Kop = 1024; asm volatile("" : "+s"(Kop)); pg8::Gemm g{WSP(bf16, WS_H), WSP(bf16, WS_W_AIN), M1, 4096, Kop}; pg8::StaticOrder S; S.init(M1, 4096, G, bid);
        pg8::EpiAin E{WSP(bf16, WS_QA), WSP(bf16, WS_KA), WSP(bf16, WS_VA), WSP(bf16, WS_ZA), A->in[12], A->in[13], out + O_AKP, out + O_AVP, out + O_AKS, out + O_AVS};
        pg8::gemm_phase<pg8::EpiAin, pg8::StaticOrder, true, true>(lds, g, S, E);
    }
    SEAM(2);
    if (IN(3)) REP(3) {
        PHASE_ARGS();
        bf16 *QA = WSP(bf16, WS_QA), *KA = WSP(bf16, WS_KA), *VA = WSP(bf16, WS_VA), *ZA = WSP(bf16, WS_ZA), *H = WSP(bf16, WS_H); const float* tblp = A->in[14];
        __syncthreads();
        { int bh, qb;
          for (int k = 0; at::prompt_unit(k, G, bid, bh, qb); ++k) {
            at::AttnUnit a; const int b = bh >> 4, c0 = 4 * qb, tf = c0 > 8 ? c0 - 8 : 0;
            a.qrow0 = b * SEQ + 256 * qb; a.nq = 256; a.krow0 = b * SEQ + 64 * tf; a.nt = c0 + 3 - tf + 1; a.lastvalid = 64; a.head = bh & 15; a.c0 = c0; a.tf = tf;
            at::attn_unit<false>(lds, a, QA, KA, nullptr, VA, ZA, H, tblp);
          } }
        for (int s = bid; s < 128; s += G) {
            at::AttnUnit a; const int bs = s >> 4;
            a.qrow0 = MP + bs * TS; a.nq = 32; a.krow0 = MP + bs * SA_STRIDE; a.nt = 9; a.lastvalid = 32; a.head = s & 15; a.c0 = 8; a.tf = 0;
            at::attn_unit<false>(lds, a, QA, KA, nullptr, VA, ZA, H, tblp);
        }
    }
    SEAM(3);
    if (IN(4)) REP(4) {
        PHASE_ARGS();
        int Kop = 1024; asm volatile("" : "+s"(Kop)); pg8::Gemm g{WSP(bf16, WS_H), WSP(bf16, WS_W_AOUT), M1, 1024, Kop}; pg8::StaticOrder S; S.init(M1, 1024, G, bid);
        pg8::EpiRes E{A->in[0], A->in[1], out + O_YP, out + O_YS, WSP(float, WS_MOD) + 2048, WSP(bf16, WS_YG), WSP(float, WS_G1), WSP(float, WS_SSQ), nullptr, WSP(bf16, WS_Y1B)};
        pg8::gemm_phase<pg8::EpiRes, pg8::StaticOrder, true, true>(lds, g, S, E);
    }
    if (IN(4) && IN(6)) { xcd_barrier(bar); }
    if (IN(6)) REP(6) {
        PHASE_ARGS();
        int Kop = 1024; asm volatile("" : "+s"(Kop)); pg8::Gemm g{WSP(bf16, WS_YG), WSP(bf16, WS_W_BIN), M1, 1792, Kop}; pg8::StaticOrder S; S.init(M1, 1792, G, bid);
        pg8::EpiBin E{WSP(bf16, WS_ZB), WSP(bf16, WS_CQ), WSP(bf16, WS_CKV), WSP(float, WS_RAW2), WSP(float, WS_SSQ), WSP(float, WS_SW), A->in[17], A->in[19], WSP(float, WS_SSQQ), WSP(float, WS_SSQKV)};
        pg8::gemm_phase<pg8::EpiBin, pg8::StaticOrder, true, true>(lds, g, S, E);
    }
    if (IN(6) && IN(8)) { xcd_barrier(bar); }
    if (IN(8)) REP(8) {
        { PHASE_ARGS(); int Kop = 384; asm volatile("" : "+s"(Kop)); pg8::Gemm g{WSP(bf16, WS_CQ), WSP(bf16, WS_W_UQ), M1, 1536, Kop}; pg8::StaticOrder S; S.init(M1, 1536, G, bid);
          pg8::EpiUq E{WSP(bf16, WS_QB), A->in[21], A->in[22], WSP(float, WS_CS), WSP(float, WS_SSQQ)};
          pg8::gemm_phase<pg8::EpiUq, pg8::StaticOrder, true, true>(lds, g, S, E); }
        __syncthreads();
        { PHASE_ARGS(); int Kop = 256; asm volatile("" : "+s"(Kop)); pg8::Gemm g{WSP(bf16, WS_CKV), WSP(bf16, WS_W_UKV), R2, 2048, Kop}; pg8::StaticOrder S; S.init(R2, 2048, G, G - 1 - bid);
          pg8::EpiUkv E{WSP(bf16, WS_KN), WSP(bf16, WS_VB), A->in[23], WSP(float, WS_SSQKV)};
          pg8::gemm_phase<pg8::EpiUkv, pg8::StaticOrder, true, true>(lds, g, S, E); }
        __syncthreads();
        {
            PHASE_ARGS();
            const float* RAW2 = WSP(float, WS_RAW2); const float* CS = WSP(float, WS_CS); const float* SQ3 = WSP(float, WS_SSQKV); bf16* KR = WSP(bf16, WS_KR); const bf16* CKVb = WSP(bf16, WS_CKV);
            const float* gkr = A->in[24];
            unsigned* wq = (unsigned*)(ws + WS_BAR) + 3600;
            volatile LAS unsigned* slot = (volatile LAS unsigned*)(lds + LDS_MISC + 16);
            for (;;) {
                if (tid == 0) slot[0] = atomicAdd(wq, 1u);
                __syncthreads();
                const unsigned ch = slot[0];
                __syncthreads();
                if (ch >= (unsigned)(M1 / 128)) break;
              for (int rix = 0; rix < 16; ++rix) { const int row = (int)ch * 128 + rix * 8 + wave;
                const float* rw = RAW2 + (size_t)row * 32;
                int pos; size_t drow, orow;
                if (row < MP) { pos = row & (SEQ - 1); drow = (size_t)row; orow = (size_t)row; }
                else { const int rs = row - MP; pos = SEQ + (rs & 31); drow = (size_t)MP + (size_t)(rs >> 5) * SB_STRIDE + 2048 + (rs & 31); orow = (size_t)rs; }
                float* ockv = (row < MP ? out + O_CKVP : out + O_CKVS) + orow * 256;
                float* okr = (row < MP ? out + O_KRP : out + O_KRS) + orow * 32;
                const v2u kw = *(const v2u*)(CKVb + drow * 256 + 4 * lane);
                const f32x4 kv = (f32x4){__uint_as_float(kw.x << 16), __uint_as_float(kw.x & 0xffff0000u), __uint_as_float(kw.y << 16), __uint_as_float(kw.y & 0xffff0000u)};
                const float kr = lane < 32 ? rw[lane] : 0.f;
                float r = rsqrtf(SQ3[row] * (1.f / 256.f) + EPSN);
                *(f32x4*)(ockv + 4 * lane) = kv * r;
                r = rsqrtf(wave_sum(kr * kr) * (1.f / 32.f) + EPSN);
                const float kn = kr * r * (lane < 32 ? gkr[lane] : 0.f);
                const float pr = __shfl_xor(kn, 16);
                const float cs = CS[pos * 32 + (lane & 15)], sn = CS[pos * 32 + 16 + (lane & 15)];
                const float ro = (lane & 16) ? (kn * cs + pr * sn) : (kn * cs - pr * sn);
                if (lane < 32) { okr[lane] = ro; const unsigned b = pk2(ro, 0.f); KR[drow * 32 + lane] = (bf16)(b & 0xffffu); }
              }
            }
        }
    }
    SEAM(8);
    if (IN(9)) REP(9) {
        PHASE_ARGS();
        bf16 *QB = WSP(bf16, WS_QB), *KN = WSP(bf16, WS_KN), *KR = WSP(bf16, WS_KR), *VB = WSP(bf16, WS_VB), *ZB = WSP(bf16, WS_ZB), *H = WSP(bf16, WS_H);
        __syncthreads();
        const bool shed = (G == 256);
        { int bh, qb;
          for (int k = 0; at::prompt_unit(k, G, bid, bh, qb); ++k) {
            if (shed && bid < 128 && k < 8 && qb == 3) continue;
            at::AttnUnit a; const int b = bh >> 4;
            a.qrow0 = b * SEQ + 256 * qb; a.nq = 256; a.krow0 = b * SEQ; a.nt = 4 * qb + 4; a.lastvalid = 64; a.head = bh & 15; a.c0 = 4 * qb; a.tf = 0;
            at::attn_unit<true>(lds, a, QB, KN, KR, VB, ZB, H, nullptr);
          }
          if (shed && bid >= 128) {
            for (int k = 0; k < 8 && at::prompt_unit(k, G, bid - 128, bh, qb); ++k) { if (qb != 3) continue;
              at::AttnUnit a; const int b = bh >> 4;
              a.qrow0 = b * SEQ + 256 * qb; a.nq = 256; a.krow0 = b * SEQ; a.nt = 4 * qb + 4; a.lastvalid = 64; a.head = bh & 15; a.c0 = 4 * qb; a.tf = 0;
              at::attn_unit<true>(lds, a, QB, KN, KR, VB, ZB, H, nullptr); }
          } }
        for (int s = bid; s < 128; s += G) {
            at::AttnUnit a; const int bs = s >> 4;
            a.qrow0 = MP + bs * TS; a.nq = 32; a.krow0 = MP + bs * SB_STRIDE; a.nt = 33; a.lastvalid = 32; a.head = s & 15; a.c0 = 32; a.tf = 0;
            at::attn_unit<true>(lds, a, QB, KN, KR, VB, ZB, H, nullptr);
        }
    }
    SEAM(9);
    if (IN(10)) REP(10) {
        PHASE_ARGS();
        int Kop = 1024; asm volatile("" : "+s"(Kop)); pg8::Gemm g{WSP(bf16, WS_H), WSP(bf16, WS_W_BOUT), M1, 1024, Kop}; pg8::StaticOrder S; S.init(M1, 1024, G, bid);
        pg8::EpiRes E{out + O_YP, out + O_YS, out + O_YP, out + O_YS, WSP(float, WS_MOD) + 40 * 3072 + 2048, nullptr, nullptr, nullptr, WSP(bf16, WS_Y1B), nullptr};
        pg8::gemm_phase<pg8::EpiRes, pg8::StaticOrder, true, true>(lds, g, S, E);
    }
#if PROBE_SYNC
    if (hi - lo > 1) { for (int q = 0; q < 18; ++q) cg::this_grid().sync(); }
#endif
#undef IN
#undef SEAM
}

constexpr int N_PHASES = 11;
extern "C" void kernel_launch(void* const* d_in, const int* in_sizes, int n_in, void* d_out, int out_size, void* d_ws, size_t ws_size, hipStream_t stream) {
    static int grid = 0;
    if (grid == 0) {
        if (n_in != 26 || ws_size < WS_END) { fprintf(stderr, "kernel_launch: unexpected inputs (n_in %d, ws %zu, need %zu)\n", n_in, ws_size, (size_t)WS_END); grid = -1; return; }
        int dev = 0, cus = 0, per_cu = 0;
        hipGetDevice(&dev); hipDeviceGetAttribute(&cus, hipDeviceAttributeMultiprocessorCount, dev);
        hipFuncSetAttribute((const void*)hybrid_fwd, hipFuncAttributeMaxDynamicSharedMemorySize, LDS_TOTAL);
        hipOccupancyMaxActiveBlocksPerMultiprocessor(&per_cu, (const void*)hybrid_fwd, 512, LDS_TOTAL);
        if (per_cu < 1) { fprintf(stderr, "kernel_launch: occupancy query says %d blocks per CU\n", per_cu); per_cu = 1; }
        (void)hipGetLastError();
        grid = cus * per_cu;
    }
    if (grid < 0) return;
    hipMemsetAsync((char*)d_ws + WS_BAR, 0, 16384, stream);
    Args a{};
    for (int i = 0; i < 26; ++i) a.in[i] = (const float*)d_in[i];
    a.out = (float*)d_out; a.ws = (unsigned char*)d_ws;
#if MULTI_LAUNCH
    for (int p = 0; p < N_PHASES; ++p) { a.ph_lo = p; a.ph_hi = p + 1; hipLaunchKernelGGL(hybrid_fwd, dim3(grid), dim3(512), LDS_TOTAL, stream, a); }
#else
    a.ph_lo = 0; a.ph_hi = N_PHASES;
    void* kargs[] = {&a};
    hipError_t e = hipLaunchCooperativeKernel((const void*)hybrid_fwd, dim3(grid), dim3(512), kargs, LDS_TOTAL, stream);
    if (e != hipSuccess) fprintf(stderr, "cooperative launch failed: %s (grid %d)\n", hipGetErrorString(e), grid);
#endif
}
```

```cpp
#include <hip/hip_runtime.h>
#include <hip/hip_cooperative_groups.h>
#include <cstdio>
#include <cstdint>
namespace cg = cooperative_groups;
#ifndef MULTI_LAUNCH
#define MULTI_LAUNCH 0
#endif
constexpr int DMODEL = 1024, NBP = 32, SEQ = 2048, NBS = 8, TS = 32;
constexpr int MP = NBP * SEQ;
constexpr int M1 = MP + NBS * TS;
constexpr int SA_STRIDE = 576;
constexpr int RA = MP + NBS * SA_STRIDE;
constexpr int SB_STRIDE = 2112;
constexpr int R2 = MP + NBS * SB_STRIDE;
constexpr float EPSN = 1e-6f;
constexpr float LOG2E = 1.4426950408889634f;
constexpr float QSCALE_A = 0.125f * LOG2E;
constexpr float QSCALE_B = 0.10206207261596575f * LOG2E;
namespace pg8 {
#define PG8_LAS __attribute__((address_space(3)))
typedef unsigned short bf16_t;
typedef short bf16x8 __attribute__((ext_vector_type(8)));
typedef float f32x4 __attribute__((ext_vector_type(4)));
typedef unsigned u32x4 __attribute__((ext_vector_type(4)));
constexpr int BM = 256, BK = 64, HALF = 128, HTB = HALF * BK * 2  , STAGE_BYTES = 8 * HTB, NXCD = 8, WGM = 8;

__host__ __device__ __forceinline__ int lds_byte(int r, int c) { const int st = (r >> 4) * 2 + (c >> 5), rr = r & 15, cc = c & 31, ob = rr * 64 + cc * 2; return st * 1024 + (ob ^ (((ob >> 9) & 1) << 5)); }
__host__ __device__ __forceinline__ void stage_rc(int b, int& R, int& C) { const int st = b / 1024, sb = b % 1024, swz = sb ^ (((sb >> 9) & 1) << 5); R = (st >> 1) * 16 + swz / 64; C = (st & 1) * 32 + (swz % 64) / 2; }
__host__ __device__ __forceinline__ int perm32(int rho) { const int n = rho >> 4, i = rho & 15; return 8 * (i >> 2) + 4 * n + (i & 3); }

struct Unit { int pm, pn; };
struct Gemm { const bf16_t* A; const bf16_t* Bt; int M, N, K; };

struct StaticOrder {
    int nM, nN, nwg, G, c;
    __host__ __device__ void init(int M, int N, int G_, int c_) { nM = M / BM; nN = N / BM; nwg = nM * nN; G = G_; c = c_; }
    __host__ __device__ bool next(int i, Unit& u) const {
        const long L = (long)i * G + c; if (L >= nwg) return false;
        int wgid = (int)L; { const int q = nwg / NXCD, r = nwg % NXCD, xcd = wgid % NXCD, off = wgid / NXCD; wgid = (xcd < r ? xcd * (q + 1) : r * (q + 1) + (xcd - r) * q) + off; }
        const int nig = WGM * nN, gid = wgid / nig, fm = gid * WGM, gsz = (nM - fm) < WGM ? (nM - fm) : WGM;
        u.pm = fm + ((wgid % nig) % gsz); u.pn = (wgid % nig) / gsz; return true;
    }
    __device__ __forceinline__ void a_ready(const Unit&) const {}
    __device__ __forceinline__ void done(const Unit&) const {}
};

__device__ __forceinline__ unsigned cvt_pk_bf16(float lo, float hi) { unsigned r; asm volatile("v_cvt_pk_bf16_f32 %0, %1, %2" : "=v"(r) : "v"(lo), "v"(hi)); return r; }
template <class Epi, class Sched, bool ALIGN_EPI = false, bool SP2 = false>
__device__ __forceinline__ void gemm_phase(PG8_LAS unsigned char* lds, const Gemm g, const Sched& S, const Epi& E) {
    const int tid = threadIdx.x, wid = __builtin_amdgcn_readfirstlane(tid >> 6), lane = tid & 63, wr = wid >> 2, wc = wid & 3, fr = lane & 15, fq = lane >> 4;
    const int K = g.K, nt = K / BK;
    unsigned voffA[2], voffB[2];
#pragma unroll
    for (int i = 0; i < 2; ++i) { int R, C; stage_rc(tid * 16 + i * 8192, R, C); const int Rb = Epi::PERM ? ((R & ~31) + perm32(R & 31)) : R;
        voffA[i] = (unsigned)(R * K + C) * 2u; voffB[i] = (unsigned)(Rb * K + C) * 2u; }
    const size_t kstep = (size_t)(BK * 2);
    const size_t hstep = (size_t)HALF * K * 2;
    const size_t tstep = 2 * hstep;
    const unsigned ldsw = (unsigned)wid * 1024u;
    const int aoff = lds_byte(wr * 64 + fr, fq * 8), boff = lds_byte(wc * 32 + fr, fq * 8);
#define PG8_SA(b, h) (((b) * 2 + (h)) * HTB)
#define PG8_SB(b, h) ((4 + (b) * 2 + (h)) * HTB)
#define PG8_STAGE(bufoff, gbase, voff) do { _Pragma("unroll") for (int _i = 0; _i < 2; ++_i) \
        __builtin_amdgcn_global_load_lds((const unsigned*)((const char*)(gbase) + (voff)[_i]), (PG8_LAS unsigned*)(lds + (bufoff) + ldsw + _i * 8192), 16, 0, 0); } while (0)
#define PG8_LDA(dst, b, h) do { _Pragma("unroll") for (int m = 0; m < 4; ++m) _Pragma("unroll") for (int k = 0; k < 2; ++k) dst[m][k] = *(const PG8_LAS bf16x8*)(lds + PG8_SA(b, h) + aoff + m * 2048 + k * 1024); } while (0)
#define PG8_LDB(dst, b, h) do { _Pragma("unroll") for (int n = 0; n < 2; ++n) _Pragma("unroll") for (int k = 0; k < 2; ++k) dst[n][k] = *(const PG8_LAS bf16x8*)(lds + PG8_SB(b, h) + boff + n * 2048 + k * 1024); } while (0)
#define PG8_MMA(ai, bj, At, Bt) do { __builtin_amdgcn_s_setprio(1); _Pragma("unroll") for (int m = 0; m < 4; ++m) _Pragma("unroll") for (int n = 0; n < 2; ++n) _Pragma("unroll") for (int k = 0; k < 2; ++k) \
        acc[ai][bj][m][n] = __builtin_amdgcn_mfma_f32_16x16x32_bf16(Bt[n][k], At[m][k], acc[ai][bj][m][n], 0, 0, 0); __builtin_amdgcn_s_setprio(0); } while (0)
#define PG8_WAIT_V(n) asm volatile("s_waitcnt vmcnt(" #n ")" ::: "memory")
#define PG8_WAIT_L(n) asm volatile("s_waitcnt lgkmcnt(" #n ")" ::: "memory")
#define PG8_BAR __builtin_amdgcn_s_barrier()
#define PG8_SCHED __builtin_amdgcn_sched_barrier(0)
    Unit cur, nxt; int ui = 0;
    if (!S.next(0, cur)) return;
    f32x4 acc[2][2][4][2];
#pragma unroll
    for (int a = 0; a < 2; ++a)
#pragma unroll
        for (int b = 0; b < 2; ++b)
#pragma unroll
            for (int m = 0; m < 4; ++m)
#pragma unroll
                for (int n = 0; n < 2; ++n) acc[a][b][m][n] = (f32x4){0.f, 0.f, 0.f, 0.f};
    bf16x8 At[4][2], B0[2][2], B1[2][2];
    const char* cA = (const char*)g.A + (size_t)cur.pm * tstep; const char* cB = (const char*)g.Bt + (size_t)cur.pn * tstep;
    S.a_ready(cur);
    if constexpr (SP2) {
        PG8_STAGE(PG8_SB(0, 0), cB, voffB); PG8_STAGE(PG8_SB(0, 1), cB + hstep, voffB); PG8_STAGE(PG8_SA(0, 0), cA, voffA); PG8_STAGE(PG8_SA(0, 1), cA + hstep, voffA);
        if (wr == 1) PG8_BAR;
        PG8_WAIT_V(2); PG8_BAR;
        PG8_STAGE(PG8_SB(1, 0), cB + kstep, voffB); PG8_STAGE(PG8_SA(1, 0), cA + kstep, voffA); PG8_STAGE(PG8_SB(1, 1), cB + hstep + kstep, voffB);
        PG8_WAIT_V(6); PG8_BAR;
    } else {
        PG8_STAGE(PG8_SB(0, 0), cB, voffB); PG8_STAGE(PG8_SA(0, 0), cA, voffA); PG8_STAGE(PG8_SB(0, 1), cB + hstep, voffB); PG8_STAGE(PG8_SA(0, 1), cA + hstep, voffA);
        if (wr == 1) PG8_BAR;
        PG8_WAIT_V(4); PG8_BAR;
        PG8_STAGE(PG8_SB(1, 0), cB + kstep, voffB); PG8_STAGE(PG8_SA(1, 0), cA + kstep, voffA); PG8_STAGE(PG8_SB(1, 1), cB + hstep + kstep, voffB);
        PG8_WAIT_V(6); PG8_BAR;
    }
    for (;;) {
        const bool has_next = S.next(ui + 1, nxt);
        const char* nA = has_next ? (const char*)g.A + (size_t)nxt.pm * tstep : cA; const char* nB = has_next ? (const char*)g.Bt + (size_t)nxt.pn * tstep : cB;
        for (int t = 0; t < nt; t += 2) {
            const bool last = (t == nt - 2);
            const char* a1 = cA + (size_t)(t + 1) * kstep;
            const char* a2 = last ? nA : cA + (size_t)(t + 2) * kstep; const char* b2 = last ? nB : cB + (size_t)(t + 2) * kstep;
            const char* a3 = a2 + kstep; const char* b3 = b2 + kstep;
            if (last && has_next) S.a_ready(nxt);
            if constexpr (SP2) {
            PG8_LDB(B0, 0, 0); PG8_LDB(B1, 0, 1); PG8_SCHED; PG8_LDA(At, 0, 0); PG8_STAGE(PG8_SA(1, 1), a1 + hstep, voffA);
            PG8_WAIT_V(8); PG8_WAIT_L(0); PG8_BAR; PG8_MMA(0, 0, At, B0); PG8_MMA(0, 1, At, B1); PG8_BAR; PG8_SCHED;
            PG8_LDA(At, 0, 1); PG8_STAGE(PG8_SB(0, 0), b2, voffB); PG8_STAGE(PG8_SB(0, 1), b2 + hstep, voffB); PG8_STAGE(PG8_SA(0, 0), a2, voffA);
            PG8_WAIT_V(8); PG8_WAIT_L(0); PG8_BAR; PG8_MMA(1, 0, At, B0); PG8_MMA(1, 1, At, B1); PG8_BAR; PG8_SCHED;
            PG8_LDB(B0, 1, 0); PG8_LDB(B1, 1, 1); PG8_SCHED; PG8_LDA(At, 1, 0); PG8_STAGE(PG8_SA(0, 1), a2 + hstep, voffA);
            PG8_WAIT_V(8); PG8_WAIT_L(0); PG8_BAR; PG8_MMA(0, 0, At, B0); PG8_MMA(0, 1, At, B1); PG8_BAR; PG8_SCHED;
            PG8_LDA(At, 1, 1); PG8_STAGE(PG8_SB(1, 0), b3, voffB); PG8_STAGE(PG8_SB(1, 1), b3 + hstep, voffB); PG8_STAGE(PG8_SA(1, 0), a3, voffA);
            PG8_WAIT_V(8); PG8_WAIT_L(0); PG8_BAR; PG8_MMA(1, 0, At, B0); PG8_MMA(1, 1, At, B1); PG8_BAR; PG8_SCHED;
            } else {
            PG8_LDB(B0, 0, 0); PG8_SCHED; PG8_LDA(At, 0, 0); PG8_STAGE(PG8_SA(1, 1), a1 + hstep, voffA);
            PG8_WAIT_L(8); PG8_BAR; PG8_WAIT_L(0); PG8_MMA(0, 0, At, B0); PG8_BAR; PG8_SCHED;
            PG8_LDB(B1, 0, 1); PG8_STAGE(PG8_SB(0, 0), b2, voffB);
            PG8_BAR; PG8_WAIT_L(0); PG8_MMA(0, 1, At, B1); PG8_BAR;
            PG8_LDA(At, 0, 1); PG8_STAGE(PG8_SA(0, 0), a2, voffA);
            PG8_BAR; PG8_WAIT_L(0); PG8_MMA(1, 0, At, B0); PG8_BAR; PG8_SCHED;
            PG8_STAGE(PG8_SB(0, 1), b2 + hstep, voffB);
            PG8_WAIT_V(6); PG8_BAR; PG8_MMA(1, 1, At, B1); PG8_BAR;
            PG8_LDB(B0, 1, 0); PG8_SCHED; PG8_LDA(At, 1, 0); PG8_STAGE(PG8_SA(0, 1), a2 + hstep, voffA);
            PG8_WAIT_L(8); PG8_BAR; PG8_WAIT_L(0); PG8_MMA(0, 0, At, B0); PG8_BAR; PG8_SCHED;
            PG8_LDB(B1, 1, 1); PG8_STAGE(PG8_SB(1, 0), b3, voffB);
            PG8_BAR; PG8_WAIT_L(0); PG8_MMA(0, 1, At, B1); PG8_BAR;
            PG8_LDA(At, 1, 1); PG8_STAGE(PG8_SA(1, 0), a3, voffA);
            PG8_BAR; PG8_WAIT_L(0); PG8_MMA(1, 0, At, B0); PG8_BAR; PG8_SCHED;
            PG8_STAGE(PG8_SB(1, 1), b3 + hstep, voffB);
            PG8_WAIT_V(6); PG8_BAR; PG8_MMA(1, 1, At, B1); PG8_BAR;
            }
        }
        if constexpr (ALIGN_EPI) { if (wr == 0) PG8_BAR; }
        if constexpr (!Epi::AFTER_DRAIN) { E(acc, cur, wr, wc, fr, fq); S.done(cur); }
        if (!has_next) break;
#pragma unroll
        for (int a = 0; a < 2; ++a)
#pragma unroll
            for (int b = 0; b < 2; ++b)
#pragma unroll
                for (int m = 0; m < 4; ++m)
#pragma unroll
                    for (int n = 0; n < 2; ++n) acc[a][b][m][n] = (f32x4){0.f, 0.f, 0.f, 0.f};
        cur = nxt; cA = nA; cB = nB; ++ui;
        if constexpr (ALIGN_EPI) { if (wr == 1) PG8_BAR; }
    }
    PG8_WAIT_V(0);
    if constexpr (!ALIGN_EPI) { if (wr == 0) PG8_BAR; }
    PG8_BAR;
    if constexpr (Epi::AFTER_DRAIN) { E.fused(acc, cur, wr, wc, fr, fq, lds, wid, lane); S.done(cur); }
#undef PG8_SA
#undef PG8_SB
#undef PG8_STAGE
#undef PG8_LDA
#undef PG8_LDB
#undef PG8_MMA
#undef PG8_WAIT_V
#undef PG8_WAIT_L
#undef PG8_BAR
#undef PG8_SCHED
}
typedef unsigned u32x2 __attribute__((ext_vector_type(2)));
typedef float f32x2 __attribute__((ext_vector_type(2)));
typedef __bf16 bf16x2_t __attribute__((ext_vector_type(2)));
__device__ __forceinline__ unsigned pkbf(float lo, float hi) { f32x2 v = {lo, hi}; bf16x2_t b = __builtin_convertvector(v, bf16x2_t); return __builtin_bit_cast(unsigned, b); }
__device__ __forceinline__ u32x2 pk4(f32x4 v) { u32x2 r; r.x = pkbf(v[0], v[1]); r.y = pkbf(v[2], v[3]); return r; }
__device__ __forceinline__ void st8(bf16_t* d, f32x4 a, f32x4 b) { u32x4 w; w.x = pkbf(a[0], a[1]); w.y = pkbf(a[2], a[3]); w.z = pkbf(b[0], b[1]); w.w = pkbf(b[2], b[3]); *(u32x4*)d = w; }
__device__ __forceinline__ float silu_f(float v) { return v * __builtin_amdgcn_rcpf(1.f + __expf(-v)); }
__device__ __forceinline__ f32x4 silu4(f32x4 v) { f32x4 o; o[0] = silu_f(v[0]); o[1] = silu_f(v[1]); o[2] = silu_f(v[2]); o[3] = silu_f(v[3]); return o; }
__device__ __forceinline__ float ssq4(f32x4 v) { return (v[0] * v[0] + v[1] * v[1]) + (v[2] * v[2] + v[3] * v[3]); }
__device__ __forceinline__ float red_fq(float s) { s += __shfl_xor(s, 16); s += __shfl_xor(s, 32); return s; }

struct EpiAin {
    static constexpr bool PERM = true, AFTER_DRAIN = false;
    bf16_t *Q, *K, *V, *Z; const float *gq, *gk; float *okp, *ovp, *oks, *ovs;
    __device__ __forceinline__ void operator()(const f32x4 (&acc)[2][2][4][2], const Unit& u, int wr, int wc, int fr, int fq) const {
        const int sec = u.pn >> 2, head = (u.pn & 3) * 4 + wc, cb = head * 64 + 8 * fq;
        f32x4 g[2][2];
#pragma unroll
        for (int bj = 0; bj < 2; ++bj)
#pragma unroll
            for (int n = 0; n < 2; ++n) g[bj][n] = (sec < 2) ? *(const f32x4*)((sec == 0 ? gq : gk) + 32 * bj + 4 * n + 8 * fq) : (f32x4){1.f, 1.f, 1.f, 1.f};
#pragma unroll
        for (int ai = 0; ai < 2; ++ai)
#pragma unroll
            for (int m = 0; m < 4; ++m) {
                const int row = u.pm * BM + ai * HALF + wr * 64 + m * 16 + fr;
                f32x4 v[2][2];
#pragma unroll
                for (int bj = 0; bj < 2; ++bj)
#pragma unroll
                    for (int n = 0; n < 2; ++n) v[bj][n] = acc[ai][bj][m][n];
                if (sec < 2) {
                    float s = (ssq4(v[0][0]) + ssq4(v[0][1])) + (ssq4(v[1][0]) + ssq4(v[1][1]));
                    s = red_fq(s);
                    const float r = rsqrtf(s * (1.f / 64.f) + EPSN) * (sec == 0 ? QSCALE_A : 1.f);
#pragma unroll
                    for (int bj = 0; bj < 2; ++bj)
#pragma unroll
                        for (int n = 0; n < 2; ++n) v[bj][n] = v[bj][n] * g[bj][n] * r;
                } else if (sec == 3) {
#pragma unroll
                    for (int bj = 0; bj < 2; ++bj)
#pragma unroll
                        for (int n = 0; n < 2; ++n) v[bj][n] = silu4(v[bj][n]);
                }
                if (sec == 0 || sec == 3) {
                    bf16_t* d = (sec == 0 ? Q : Z) + (size_t)row * 1024 + cb;
#pragma unroll
                    for (int bj = 0; bj < 2; ++bj) st8(d + 32 * bj, v[bj][0], v[bj][1]);
                } else {
                    size_t drow; float* of = nullptr;
                    if (row < MP) { drow = (size_t)row; const int pos = row & (SEQ - 1); if (pos >= SEQ - 512) of = (sec == 1 ? okp : ovp) + ((size_t)((row >> 11) * 512 + pos - (SEQ - 512))) * 1024; }
                    else { const int rs = row - MP; drow = (size_t)MP + (size_t)(rs >> 5) * SA_STRIDE + 512 + (rs & 31); of = (sec == 1 ? oks : ovs) + (size_t)rs * 1024; }
                    bf16_t* d = (sec == 1 ? K : V) + drow * 1024 + cb;
#pragma unroll
                    for (int bj = 0; bj < 2; ++bj) { st8(d + 32 * bj, v[bj][0], v[bj][1]); if (of) { *(f32x4*)(of + cb + 32 * bj) = v[bj][0]; *(f32x4*)(of + cb + 32 * bj + 4) = v[bj][1]; } }
                }
                asm volatile("" ::: "memory");
            }
    }
};
struct EpiRes {
    static constexpr bool PERM = true, AFTER_DRAIN = false;
    const float *xp, *xs; float *yp, *ys; const float* gate;
    bf16_t* YG; const float* G1; float* ssq;
    const bf16_t* xb; bf16_t* yb;
    __device__ __forceinline__ void operator()(const f32x4 (&acc)[2][2][4][2], const Unit& u, int wr, int wc, int fr, int fq) const {
        const int cb = u.pn * 256 + wc * 64 + 8 * fq;
#pragma unroll
        for (int ai = 0; ai < 2; ++ai)
#pragma unroll
            for (int m = 0; m < 4; ++m) {
                const int row = u.pm * BM + ai * HALF + wr * 64 + m * 16 + fr;
                const float* xi; float* yo; int bb;
                if (row < MP) { xi = xp + (size_t)row * 1024; yo = yp + (size_t)row * 1024; bb = row >> 11; }
                else { const int rs = row - MP; xi = xs + (size_t)rs * 1024; yo = ys + (size_t)rs * 1024; bb = NBP + (rs >> 5); }
                const float* gp = gate + (size_t)bb * 3072;
                float sq = 0.f;
#pragma unroll
                for (int bj = 0; bj < 2; ++bj) { const int c = cb + 32 * bj;
                    f32x4 x0, x1;
                    if (xb) { const u32x4 w = *(const u32x4*)(xb + (size_t)row * 1024 + c);
                        x0 = (f32x4){__uint_as_float(w.x << 16), __uint_as_float(w.x & 0xffff0000u), __uint_as_float(w.y << 16), __uint_as_float(w.y & 0xffff0000u)};
                        x1 = (f32x4){__uint_as_float(w.z << 16), __uint_as_float(w.z & 0xffff0000u), __uint_as_float(w.w << 16), __uint_as_float(w.w & 0xffff0000u)}; }
                    else { x0 = *(const f32x4*)(xi + c); x1 = *(const f32x4*)(xi + c + 4); }
                    const f32x4 o0 = x0 + *(const f32x4*)(gp + c) * acc[ai][bj][m][0], o1 = x1 + *(const f32x4*)(gp + c + 4) * acc[ai][bj][m][1];
                    if (yb) st8(yb + (size_t)row * 1024 + c, o0, o1); else { *(f32x4*)(yo + c) = o0; *(f32x4*)(yo + c + 4) = o1; }
                    if (YG) { sq += ssq4(o0) + ssq4(o1); const float* gg = G1 + (size_t)bb * 1024 + c; st8(YG + (size_t)row * 1024 + c, o0 * *(const f32x4*)gg, o1 * *(const f32x4*)(gg + 4)); } }
                if (YG) { sq = red_fq(sq); if (fq == 0) atomicAdd(ssq + row, sq); }
                asm volatile("" ::: "memory");
            }
    }
};
struct EpiBin {
    static constexpr bool PERM = true, AFTER_DRAIN = false;
    bf16_t* Z; bf16_t* CQ; bf16_t* CKV; float* RAW2; const float* ssq; const float* SW; const float* gcq; const float* gckv; float* ssqq; float* ssqkv;
    __device__ __forceinline__ void operator()(const f32x4 (&acc)[2][2][4][2], const Unit& u, int wr, int wc, int fr, int fq) const {
        const int cb = u.pn * 256 + wc * 64 + 8 * fq;
        const int sidx = (u.pn - 4) * 4 + wc;
#pragma unroll
        for (int ai = 0; ai < 2; ++ai)
#pragma unroll
            for (int m = 0; m < 4; ++m) {
                const int row = u.pm * BM + ai * HALF + wr * 64 + m * 16 + fr;
                const int bb = row < MP ? (row >> 11) : NBP + ((row - MP) >> 5);
                const float r = rsqrtf(ssq[row] * (1.f / 1024.f) + EPSN);
                const float* sw = SW + (size_t)bb * 1792;
                f32x4 v[2][2];
#pragma unroll
                for (int bj = 0; bj < 2; ++bj)
#pragma unroll
                    for (int n = 0; n < 2; ++n) v[bj][n] = acc[ai][bj][m][n] * r + *(const f32x4*)(sw + cb + 32 * bj + 4 * n);
                if (u.pn < 4) {
#pragma unroll
                    for (int bj = 0; bj < 2; ++bj) st8(Z + (size_t)row * 1024 + cb + 32 * bj, silu4(v[bj][0]), silu4(v[bj][1]));
                } else if (sidx < 10) {
                    float sq = (ssq4(v[0][0]) + ssq4(v[0][1])) + (ssq4(v[1][0]) + ssq4(v[1][1]));
                    sq = red_fq(sq);
                    if (sidx < 6) {
                        const int c0 = cb - 1024;
                        if (fq == 0) atomicAdd(ssqq + row, sq);
#pragma unroll
                        for (int bj = 0; bj < 2; ++bj) { const int c = c0 + 32 * bj; st8(CQ + (size_t)row * 384 + c, v[bj][0] * *(const f32x4*)(gcq + c), v[bj][1] * *(const f32x4*)(gcq + c + 4)); }
                    } else {
                        const int c0 = cb - 1408;
                        const size_t drow = row < MP ? (size_t)row : (size_t)MP + (size_t)((row - MP) >> 5) * SB_STRIDE + 2048 + ((row - MP) & 31);
                        if (fq == 0) atomicAdd(ssqkv + row, sq);
#pragma unroll
                        for (int bj = 0; bj < 2; ++bj) { const int c = c0 + 32 * bj; st8(CKV + drow * 256 + c, v[bj][0] * *(const f32x4*)(gckv + c), v[bj][1] * *(const f32x4*)(gckv + c + 4)); }
                    }
                } else if (sidx == 10) {
#pragma unroll
                    for (int n = 0; n < 2; ++n) *(f32x4*)(RAW2 + (size_t)row * 32 + 8 * fq + 4 * n) = v[0][n];
                }
                asm volatile("" ::: "memory");
            }
    }
};
struct EpiUq {
    static constexpr bool PERM = true, AFTER_DRAIN = false;
    bf16_t* Q; const float *gqn, *gqr, *CS; const float* ssqq;
    __device__ __forceinline__ void operator()(const f32x4 (&acc)[2][2][4][2], const Unit& u, int wr, int wc, int fr, int fq) const {
        if (u.pn < 4) {
            const int head = u.pn * 4 + wc;
#pragma unroll
            for (int ai = 0; ai < 2; ++ai)
#pragma unroll
                for (int m = 0; m < 4; ++m) {
                    const int row = u.pm * BM + ai * HALF + wr * 64 + m * 16 + fr;
                    float s = (ssq4(acc[ai][0][m][0]) + ssq4(acc[ai][0][m][1])) + (ssq4(acc[ai][1][m][0]) + ssq4(acc[ai][1][m][1]));
                    s = red_fq(s);
                    const float rq = rsqrtf(ssqq[row] * (1.f / 384.f) + EPSN);
                    const float r = rsqrtf(s * rq * rq * (1.f / 64.f) + EPSN) * rq * QSCALE_B;
                    bf16_t* d = Q + (size_t)row * 1536 + head * 96 + 8 * fq;
#pragma unroll
                    for (int bj = 0; bj < 2; ++bj) st8(d + 32 * bj, acc[ai][bj][m][0] * *(const f32x4*)(gqn + 32 * bj + 8 * fq) * r, acc[ai][bj][m][1] * *(const f32x4*)(gqn + 32 * bj + 4 + 8 * fq) * r);
                    asm volatile("" ::: "memory");
                }
        } else {
#pragma unroll
            for (int ai = 0; ai < 2; ++ai)
#pragma unroll
                for (int m = 0; m < 4; ++m) {
                    const int row = u.pm * BM + ai * HALF + wr * 64 + m * 16 + fr;
                    const int pos = row < MP ? (row & (SEQ - 1)) : SEQ + ((row - MP) & 31);
                    const float rq = rsqrtf(ssqq[row] * (1.f / 384.f) + EPSN);
#pragma unroll
                    for (int bj = 0; bj < 2; ++bj) {
                        const int hr = (u.pn - 4) * 8 + wc * 2 + bj;
                        float s = ssq4(acc[ai][bj][m][0]) + ssq4(acc[ai][bj][m][1]);
                        s = red_fq(s);
                        const float r = rsqrtf(s * rq * rq * (1.f / 32.f) + EPSN) * rq;
                        const f32x4 x1 = acc[ai][bj][m][0] * *(const f32x4*)(gqr + 4 * fq) * r, x2 = acc[ai][bj][m][1] * *(const f32x4*)(gqr + 16 + 4 * fq) * r;
                        const f32x4 cs = *(const f32x4*)(CS + pos * 32 + 4 * fq), sn = *(const f32x4*)(CS + pos * 32 + 16 + 4 * fq);
                        bf16_t* d = Q + (size_t)row * 1536 + hr * 96 + 64 + 4 * fq;
                        *(u32x2*)d = pk4((x1 * cs - x2 * sn) * QSCALE_B); *(u32x2*)(d + 16) = pk4((x2 * cs + x1 * sn) * QSCALE_B);
                        asm volatile("" ::: "memory");
                    }
                }
        }
    }
};
struct EpiUkv {
    static constexpr bool PERM = true, AFTER_DRAIN = false;
    bf16_t *KN, *VB; const float* gkn; const float* ssqkv;
    __device__ __forceinline__ void operator()(const f32x4 (&acc)[2][2][4][2], const Unit& u, int wr, int wc, int fr, int fq) const {
        const bool isk = u.pn < 4; const int head = (u.pn & 3) * 4 + wc;
#pragma unroll
        for (int ai = 0; ai < 2; ++ai)
#pragma unroll
            for (int m = 0; m < 4; ++m) {
                const int row = u.pm * BM + ai * HALF + wr * 64 + m * 16 + fr;
                float rs = 1.f;
                if (u.pm < MP / BM) rs = rsqrtf(ssqkv[row] * (1.f / 256.f) + EPSN);
                else { const int q_ = row - MP, bs_ = q_ / SB_STRIDE, rr_ = q_ - bs_ * SB_STRIDE; if (rr_ >= 2048 && rr_ < 2080) rs = rsqrtf(ssqkv[MP + bs_ * TS + rr_ - 2048] * (1.f / 256.f) + EPSN); }
                float r = rs;
                if (isk) { float s = (ssq4(acc[ai][0][m][0]) + ssq4(acc[ai][0][m][1])) + (ssq4(acc[ai][1][m][0]) + ssq4(acc[ai][1][m][1])); s = red_fq(s); r = rsqrtf(s * rs * rs * (1.f / 64.f) + EPSN) * rs; }
                bf16_t* d = (isk ? KN : VB) + (size_t)row * 1024 + head * 64 + 8 * fq;
#pragma unroll
                for (int bj = 0; bj < 2; ++bj) { const f32x4 g0 = isk ? *(const f32x4*)(gkn + 32 * bj + 8 * fq) : (f32x4){1.f, 1.f, 1.f, 1.f}, g1 = isk ? *(const f32x4*)(gkn + 32 * bj + 4 + 8 * fq) : (f32x4){1.f, 1.f, 1.f, 1.f};
                    st8(d + 32 * bj, acc[ai][bj][m][0] * g0 * r, acc[ai][bj][m][1] * g1 * r); }
                asm volatile("" ::: "memory");
            }
    }
};
}
namespace at {
#define ALAS __attribute__((address_space(3)))
typedef unsigned short bf16_t;
typedef short bf16x8 __attribute__((ext_vector_type(8)));
typedef short s16x4 __attribute__((ext_vector_type(4)));
typedef float f32x16 __attribute__((ext_vector_type(16)));
typedef float f32x4 __attribute__((ext_vector_type(4)));
typedef unsigned u32x4 __attribute__((ext_vector_type(4)));
typedef unsigned u32x2 __attribute__((ext_vector_type(2)));
constexpr int KROW = 144, VROW = 144, RROW = 80;
constexpr int KBUF = 64 * KROW, VBUF = 64 * VROW, RBUF = 64 * RROW, STAGE = KBUF + VBUF + RBUF;
constexpr int NSTAGE = 2, TBL_OFF = NSTAGE * STAGE, OSTG_OFF = 49152, OSTG_WAVE = 32 * 272, LDS_BYTES = OSTG_OFF + 8 * OSTG_WAVE;
static_assert(TBL_OFF + 1280 <= OSTG_OFF, "attention LDS map");
struct AttnUnit { int qrow0, nq, krow0, nt, lastvalid, head, c0, tf; };
__device__ __forceinline__ int crow(int r, int hi) { return (r & 3) + 8 * (r >> 2) + 4 * hi; }

template <bool MLA>
__device__ __forceinline__ void attn_unit(ALAS unsigned char* lds, const AttnUnit u, const bf16_t* __restrict__ Q, const bf16_t* __restrict__ Kn, const bf16_t* __restrict__ Kr,
                                          const bf16_t* __restrict__ V, const bf16_t* __restrict__ Z, bf16_t* __restrict__ U, const float* __restrict__ tbl) {
    int tid_ = threadIdx.x; asm volatile("" : "+v"(tid_));
    const int tid = tid_, lane = tid & 63, wid = __builtin_amdgcn_readfirstlane(tid >> 6), l32 = lane & 31, hi = lane >> 5;
    const int ci = wid >> 1, qh = wid & 1;
    const bool active = ci * 64 + qh * 32 < u.nq;
    const int cq = u.c0 + ci;
    constexpr int QS = MLA ? 1536 : 1024, HS = MLA ? 96 : 64, ND0 = MLA ? 6 : 4;
    constexpr float THR = 8.f;
    ALAS float* tb = (ALAS float*)(lds + TBL_OFF);
    if (!MLA) { if (tid < 320) tb[tid] = tid < 257 ? (tbl[(size_t)u.head * 257 + tid] - tbl[(size_t)u.head * 257 + 256]) * LOG2E : 0.f; }
    const int qrow = u.qrow0 + (active ? ci * 64 + qh * 32 : 0) + l32;
    bf16x8 qf[ND0];
#pragma unroll
    for (int d0 = 0; d0 < ND0; ++d0) qf[d0] = *(const bf16x8*)(Q + (size_t)qrow * QS + u.head * HS + d0 * 16 + hi * 8);
    const char* kbase = (const char*)(Kn + (size_t)u.krow0 * 1024 + u.head * 64);
    const char* vbase = (const char*)(V + (size_t)u.krow0 * 1024 + u.head * 64);
    const char* rbase = MLA ? (const char*)(Kr + (size_t)u.krow0 * 32) : nullptr;
    const unsigned koff = (unsigned)(((tid >> 3) * 1024 + (tid & 7) * 8) * 2);
    const int vkvq = (tid & 3) + 4 * ((tid >> 6) & 3), vdq = (tid >> 2) & 15;
    const unsigned voff = (unsigned)(((vkvq * 4) * 1024 + vdq * 4) * 2);
    const int vpos8 = (vkvq & ~3) + ((vkvq & 1) << 1) + ((vkvq >> 1) & 1);
    const unsigned roff = (unsigned)(((((tid - 256) >> 2) & 63) * 32 + (tid & 3) * 8) * 2);
    u32x4 kreg[1]; u32x2 vreg[1][4]; u32x4 rreg[1];
#define AT_GLOAD(ti, sx) do { const int tl_ = (ti) < u.nt ? (ti) : u.nt - 1; \
        kreg[sx] = *(const u32x4*)(kbase + (size_t)tl_ * 131072 + koff); \
        if (tid < 256) { const char* vb_ = vbase + (size_t)tl_ * 131072; \
            vreg[sx][0] = *(const u32x2*)(vb_ + voff); vreg[sx][1] = *(const u32x2*)(vb_ + voff + 2048); vreg[sx][2] = *(const u32x2*)(vb_ + 4096 + voff); vreg[sx][3] = *(const u32x2*)(vb_ + 4096 + voff + 2048); } \
        else if (MLA) { rreg[sx] = *(const u32x4*)(rbase + (size_t)tl_ * 4096 + roff); } } while (0)
#define AT_SWRITE(st, sx) do { ALAS unsigned char* sb_ = lds + (st) * STAGE; \
        *(ALAS u32x4*)(sb_ + (tid >> 3) * KROW + (tid & 7) * 16) = kreg[sx]; \
        if (tid < 256) { \
            _Pragma("unroll") for (int jj_ = 0; jj_ < 4; ++jj_) { const int d_ = 4 * vdq + jj_; u32x2 o_; \
                const unsigned sel_ = (jj_ & 1) ? 0x07060302u : 0x05040100u; \
                if (jj_ < 2) { o_.x = __builtin_amdgcn_perm(vreg[sx][1].x, vreg[sx][0].x, sel_); o_.y = __builtin_amdgcn_perm(vreg[sx][3].x, vreg[sx][2].x, sel_); } \
                else         { o_.x = __builtin_amdgcn_perm(vreg[sx][1].y, vreg[sx][0].y, sel_); o_.y = __builtin_amdgcn_perm(vreg[sx][3].y, vreg[sx][2].y, sel_); } \
                *(ALAS u32x2*)(sb_ + KBUF + d_ * VROW + vpos8 * 8) = o_; } } \
        else if (MLA) { const int t2_ = tid - 256; *(ALAS u32x4*)(sb_ + KBUF + VBUF + (t2_ >> 2) * RROW + (t2_ & 3) * 16) = rreg[sx]; } } while (0)
    float mref = 0.f;
    bool first = true;
    f32x16 negm = f32x16{}; asm volatile("" : "+v"(negm));
    f32x16 o0 = f32x16{}, o1 = f32x16{}; float lrun = 0.f;
    f32x16 p[2];
    const int tgl = (qh * 32 + l32 + 128 - 4 * hi) * 4;
#define AT_QK(t, sg) do { const int kc_ = u.tf + (t); ALAS unsigned char* sb_ = lds + (sg) * STAGE; ALAS unsigned char* kb_ = sb_ + l32 * KROW + hi * 16; \
        bool near_ = false; \
        if (!MLA) { near_ = cq - kc_ < 3; \
            if (near_) { ALAS unsigned char* tp_ = (ALAS unsigned char*)tb + tgl + 256 * (cq - kc_); \
                _Pragma("unroll") for (int blk = 0; blk < 2; ++blk) _Pragma("unroll") for (int r = 0; r < 16; ++r) p[blk][r] = *(const ALAS float*)(tp_ - 4 * (32 * blk + (r & 3) + 8 * (r >> 2))) - mref; } } \
        bf16x8 ka_[4], kb2_[4]; ALAS unsigned char* rb_ = sb_ + KBUF + VBUF + l32 * RROW + hi * 16; \
        _Pragma("unroll") for (int d0 = 0; d0 < 4; ++d0) ka_[d0] = *(const ALAS bf16x8*)(kb_ + d0 * 32); \
        _Pragma("unroll") for (int d0 = 0; d0 < 4; ++d0) kb2_[d0] = *(const ALAS bf16x8*)(kb_ + 32 * KROW + d0 * 32); \
        __builtin_amdgcn_sched_barrier(0); \
        if (near_) { p[0] = __builtin_amdgcn_mfma_f32_32x32x16_bf16(ka_[0], qf[0], p[0], 0, 0, 0); p[1] = __builtin_amdgcn_mfma_f32_32x32x16_bf16(kb2_[0], qf[0], p[1], 0, 0, 0); } \
        else       { p[0] = __builtin_amdgcn_mfma_f32_32x32x16_bf16(ka_[0], qf[0], negm, 0, 0, 0); p[1] = __builtin_amdgcn_mfma_f32_32x32x16_bf16(kb2_[0], qf[0], negm, 0, 0, 0); } \
        _Pragma("unroll") for (int d0 = 1; d0 < 4; ++d0) { p[0] = __builtin_amdgcn_mfma_f32_32x32x16_bf16(ka_[d0], qf[d0], p[0], 0, 0, 0); p[1] = __builtin_amdgcn_mfma_f32_32x32x16_bf16(kb2_[d0], qf[d0], p[1], 0, 0, 0); \
            if (MLA && d0 == 1) { ka_[0] = *(const ALAS bf16x8*)(rb_); kb2_[0] = *(const ALAS bf16x8*)(rb_ + 32 * RROW); ka_[1] = *(const ALAS bf16x8*)(rb_ + 32); kb2_[1] = *(const ALAS bf16x8*)(rb_ + 32 * RROW + 32); } } \
        if (MLA) { p[0] = __builtin_amdgcn_mfma_f32_32x32x16_bf16(ka_[0], qf[4], p[0], 0, 0, 0); p[1] = __builtin_amdgcn_mfma_f32_32x32x16_bf16(kb2_[0], qf[4], p[1], 0, 0, 0); \
                   p[0] = __builtin_amdgcn_mfma_f32_32x32x16_bf16(ka_[1], qf[ND0 - 1], p[0], 0, 0, 0); p[1] = __builtin_amdgcn_mfma_f32_32x32x16_bf16(kb2_[1], qf[ND0 - 1], p[1], 0, 0, 0); } \
        if ((t) == u.nt - 1 && u.lastvalid < 64) { _Pragma("unroll") for (int r = 0; r < 16; ++r) p[1][r] = -__builtin_inff(); } } while (0)
#define AT_SMPV(t, sg) do { ALAS unsigned char* vb_ = lds + (sg) * STAGE + KBUF + l32 * VROW + hi * 16; \
        bf16x8 vf_[2][4]; \
        _Pragma("unroll") for (int dblk = 0; dblk < 2; ++dblk) _Pragma("unroll") for (int j = 0; j < 4; ++j) vf_[dblk][j] = *(const ALAS bf16x8*)(vb_ + dblk * 32 * VROW + j * 32); \
        __builtin_amdgcn_sched_barrier(0); \
        float rm = p[0][0]; \
        _Pragma("unroll") for (int r = 1; r < 16; ++r) rm = fmaxf(rm, p[0][r]); \
        _Pragma("unroll") for (int r = 0; r < 16; ++r) rm = fmaxf(rm, p[1][r]); \
        rm = fmaxf(rm, __shfl_xor(rm, 32)); \
        if (first || __any(rm > THR)) { \
            const float dl = first ? rm : fmaxf(rm, 0.f); mref += dl; \
            _Pragma("unroll") for (int r = 0; r < 16; ++r) { p[0][r] -= dl; p[1][r] -= dl; } \
            _Pragma("unroll") for (int r = 0; r < 16; ++r) negm[r] = -mref; \
            asm volatile("" : "+v"(negm)); \
            if (!first) { const float al = __builtin_amdgcn_exp2f(-dl); lrun *= al; \
                _Pragma("unroll") for (int r = 0; r < 16; ++r) { o0[r] *= al; o1[r] *= al; } } \
            first = false; } \
        _Pragma("unroll") for (int blk = 0; blk < 2; ++blk) _Pragma("unroll") for (int r = 0; r < 16; ++r) p[blk][r] = __builtin_amdgcn_exp2f(p[blk][r]); \
        { float ls0 = 0.f, ls1 = 0.f; _Pragma("unroll") for (int r = 0; r < 16; ++r) { ls0 += p[0][r]; ls1 += p[1][r]; } lrun += ls0 + ls1; } \
        bf16x8 pk[4]; \
        _Pragma("unroll") for (int j = 0; j < 4; ++j) { u32x4 w; const int b = j >> 1, r0 = 8 * (j & 1); \
            w.x = pg8::pkbf(p[b][r0 + 0], p[b][r0 + 1]); w.y = pg8::pkbf(p[b][r0 + 2], p[b][r0 + 3]); w.z = pg8::pkbf(p[b][r0 + 4], p[b][r0 + 5]); w.w = pg8::pkbf(p[b][r0 + 6], p[b][r0 + 7]); \
            pk[j] = __builtin_bit_cast(bf16x8, w); } \
        _Pragma("unroll") for (int j = 0; j < 4; ++j) { \
            o0 = __builtin_amdgcn_mfma_f32_32x32x16_bf16(vf_[0][j], pk[j], o0, 0, 0, 0); \
            o1 = __builtin_amdgcn_mfma_f32_32x32x16_bf16(vf_[1][j], pk[j], o1, 0, 0, 0); \
            } } while (0)
#define AT_TAKE(t) (active && (u.tf + (t)) <= cq && (MLA || (u.tf + (t)) >= cq - 8))
    AT_GLOAD(0, 0); AT_SWRITE(0, 0);
    __syncthreads();
    for (int ti = 0; ti < u.nt; ++ti) {
        const bool more = ti + 1 < u.nt;
        if (more) AT_GLOAD(ti + 1, 0);
        if (AT_TAKE(ti)) { AT_QK(ti, ti & 1); AT_SMPV(ti, ti & 1); }
        if (more) AT_SWRITE((ti + 1) & 1, 0);
        __syncthreads();
    }
#undef AT_QK
#undef AT_SMPV
#undef AT_TAKE
    if (active) {
        const float inv = 1.f / (lrun + __shfl_xor(lrun, 32));
        ALAS unsigned char* ot = lds + OSTG_OFF + wid * OSTG_WAVE;
#pragma unroll
        for (int dblk = 0; dblk < 2; ++dblk)
#pragma unroll
            for (int g = 0; g < 4; ++g) { const f32x16& o = dblk == 0 ? o0 : o1;
                *(ALAS f32x4*)(ot + l32 * 272 + (32 * dblk + 8 * g + 4 * hi) * 4) = (f32x4){o[4 * g + 0] * inv, o[4 * g + 1] * inv, o[4 * g + 2] * inv, o[4 * g + 3] * inv}; }
        asm volatile("s_waitcnt lgkmcnt(0)" ::: "memory");
        const size_t rb = (size_t)(qrow - l32) * 1024 + u.head * 64 + (lane & 7) * 8;
#pragma unroll
        for (int i = 0; i < 4; ++i) { const int r = i * 8 + (lane >> 3);
            const f32x4 a0 = *(const ALAS f32x4*)(ot + r * 272 + (lane & 7) * 32), a1 = *(const ALAS f32x4*)(ot + r * 272 + (lane & 7) * 32 + 16);
            const u32x4 zz = *(const u32x4*)(Z + rb + (size_t)r * 1024);
            u32x4 w;
            w.x = pg8::pkbf(a0[0] * __uint_as_float(zz.x << 16), a0[1] * __uint_as_float(zz.x & 0xffff0000u)); w.y = pg8::pkbf(a0[2] * __uint_as_float(zz.y << 16), a0[3] * __uint_as_float(zz.y & 0xffff0000u));
            w.z = pg8::pkbf(a1[0] * __uint_as_float(zz.z << 16), a1[1] * __uint_as_float(zz.z & 0xffff0000u)); w.w = pg8::pkbf(a1[2] * __uint_as_float(zz.w << 16), a1[3] * __uint_as_float(zz.w & 0xffff0000u));
            *(u32x4*)(U + rb + (size_t)r * 1024) = w; }
        asm volatile("s_waitcnt lgkmcnt(0)" ::: "memory");
    }
#undef AT_GLOAD
#undef AT_SWRITE
}
__device__ __forceinline__ bool prompt_unit(int k, int G, int bid, int& bh, int& qb) {
    if (G == 256) { if (k >= 16) return false; const int x = bid & 7, j = bid >> 3; bh = (4 * k + (j >> 3)) * 8 + x; qb = ((j & 7) + k) & 7; return true; }
    const int u = bid + k * G; if (u >= 4096) return false; bh = u >> 3; qb = u & 7; return true;
}
}
#define LAS __attribute__((address_space(3)))
typedef unsigned short bf16;
typedef unsigned v4u __attribute__((ext_vector_type(4)));
typedef unsigned v2u __attribute__((ext_vector_type(2)));
typedef float f32x4 __attribute__((ext_vector_type(4)));
constexpr size_t MiB = 1u << 20;
constexpr size_t WS_MOD = 0;
constexpr size_t MOD_BYTES = 2 * 40 * 3072 * 4;
constexpr size_t WS_BAR = 1 * MiB - 16384;
constexpr size_t WS_CS = 1 * MiB;
constexpr size_t WS_G1 = 2 * MiB;
constexpr size_t WS_SW = 2 * MiB + 256 * 1024;
constexpr size_t WS_SSQ = 3 * MiB;
constexpr size_t WS_SSQQ = 3 * MiB + 320 * 1024, WS_SSQKV = 3 * MiB + 640 * 1024;
constexpr size_t WS_RAW2 = 24 * MiB;
constexpr size_t WS_W_AIN = 4 * MiB, WS_W_AOUT = 12 * MiB, WS_W_BIN = 14 * MiB, WS_W_UQ = 18 * MiB, WS_W_UKV = 20 * MiB, WS_W_BOUT = 22 * MiB;
constexpr size_t WS_H = 24 * MiB;
constexpr size_t WS_CKV = 153 * MiB;
constexpr size_t WS_KR = 194 * MiB;
constexpr size_t WS_X = 200 * MiB;
constexpr size_t WS_QA = WS_X, WS_KA = WS_X + 129 * MiB, WS_VA = WS_X + 267 * MiB, WS_ZA = WS_X + 405 * MiB;
constexpr size_t WS_YG = WS_ZA;
constexpr size_t WS_ZB = WS_X, WS_RAW = WS_X + 129 * MiB, WS_QB = WS_RAW, WS_CQ = WS_X + 322 * MiB, WS_KN = WS_X + 371 * MiB, WS_VB = WS_X + 532 * MiB;
constexpr size_t WS_Y1B = WS_X + 694 * MiB;
constexpr size_t WS_END = WS_Y1B + 129 * MiB;
static_assert((size_t)M1 * 1024 * 2 <= 129 * MiB && (size_t)RA * 1024 * 2 <= 138 * MiB && (size_t)M1 * 768 * 4 <= 193 * MiB && (size_t)M1 * 384 * 2 <= 49 * MiB && (size_t)R2 * 1024 * 2 <= 161 * MiB, "ws map");
static_assert((size_t)R2 * 256 * 2 <= 41 * MiB && (size_t)R2 * 32 * 2 <= 6 * MiB && WS_ZA + 129 * MiB <= WS_END && WS_VB + 161 * MiB <= WS_END && WS_END <= 1024 * MiB, "ws map");
constexpr size_t O_YP = 0, O_YS = 67108864, O_AKP = 67371008, O_AVP = 84148224, O_AKS = 100925440, O_AVS = 101187584, O_CKVP = 101449728, O_KRP = 118226944, O_CKVS = 120324096, O_KRS = 120389632;
constexpr int LDS_TOTAL = 147456, LDS_MISC = 131072 + 320;
static_assert(at::LDS_BYTES <= LDS_TOTAL && pg8::STAGE_BYTES <= LDS_TOTAL, "LDS");

__device__ __forceinline__ float wave_sum(float v) {
#pragma unroll
    for (int o = 1; o < 64; o <<= 1) v += __shfl_xor(v, o);
    return v;
}
__device__ __forceinline__ unsigned pk2(float lo, float hi) { return pg8::pkbf(lo, hi); }
__device__ __forceinline__ int src_col(int gemm, int g) {
    const int lc = ((g >> 3) * 8 + (g & 3) * 2 + ((g >> 2) & 1)) * 32;
    switch (gemm) {
    case 2: if (lc < 1024) return 672 + lc; if (lc < 1408) return lc - 1024; if (lc < 1664) return 384 + (lc - 1408); if (lc < 1696) return 640 + (lc - 1664); return -1;
    case 3: if (lc < 1024) return (lc >> 6) * 96 + (lc & 63); return ((lc - 1024) >> 5) * 96 + 64;
    case 4: if (lc < 1024) return (lc >> 6) * 128 + (lc & 63); return ((lc - 1024) >> 6) * 128 + 64 + (lc & 63);
    default: return lc;
    }
}
__device__ __forceinline__ void transpose_item(const float* W, int K, int Nsrc, int sc, bf16* WT, int g, int k0, LAS float* scr, int lane, bool cperm = false) {
    const int jl = lane & 31, sj = cperm ? 16 * ((jl >> 2) & 1) + 4 * (jl >> 3) + (jl & 3) : jl;
#pragma unroll 8
    for (int i = 0; i < 32; ++i) { const int kk = 2 * i + (lane >> 5); scr[kk * 33 + (lane & 31)] = sc >= 0 ? W[(size_t)(k0 + kk) * Nsrc + sc + sj] : 0.f; }
    asm volatile("s_waitcnt lgkmcnt(0)" ::: "memory");
    const int c = lane & 7;
#pragma unroll
    for (int j = 0; j < 4; ++j) { const int n = (lane >> 3) + 8 * j; const LAS float* s = scr + (8 * c) * 33 + n;
        v4u o; o.x = pk2(s[0 * 33], s[1 * 33]); o.y = pk2(s[2 * 33], s[3 * 33]); o.z = pk2(s[4 * 33], s[5 * 33]); o.w = pk2(s[6 * 33], s[7 * 33]);
        *(v4u*)(WT + (size_t)(32 * g + n) * K + k0 + 8 * c) = o; }
    asm volatile("s_waitcnt lgkmcnt(0)" ::: "memory");
}
__device__ __forceinline__ void cvt8(const float* s, bf16* d) { const f32x4 a = *(const f32x4*)s, b = *(const f32x4*)(s + 4); v4u o; o.x = pk2(a[0], a[1]); o.y = pk2(a[2], a[3]); o.z = pk2(b[0], b[1]); o.w = pk2(b[2], b[3]); *(v4u*)d = o; }

#define GAS __attribute__((address_space(1)))
#define RLX_AGENT __ATOMIC_RELAXED, __HIP_MEMORY_SCOPE_AGENT
#define XB_TMO      128
#define XB_XCNT(j)  (256  + 64 * (j))
#define XB_XSUB(j)  (1280 + 64 * (j))
#define XB_XGEN(j)  (2304 + 64 * (j))
#define XB_TOP      3328
#define XB_TOPGEN   3392
#define XCD_BAR_WORDS 3456
#define XB_SPIN_CAP (1u << 18)

__device__ __forceinline__ unsigned xb_ld(unsigned* p)              { return __hip_atomic_load(p, __ATOMIC_RELAXED, __HIP_MEMORY_SCOPE_AGENT); }
__device__ __forceinline__ unsigned xb_add(unsigned* p, unsigned v) { return __hip_atomic_fetch_add(p, v, __ATOMIC_RELAXED, __HIP_MEMORY_SCOPE_AGENT); }
__device__ __forceinline__ unsigned xb_xcc_id() { return (unsigned)__builtin_amdgcn_s_getreg((3 << 11) | 20) & 0xFu; }
#define XB_SPIN(cond, bar) do { unsigned _sp = 0; while (cond) { __builtin_amdgcn_s_sleep(1); \
    if ((++_sp & 255u) == 0u) { if (xb_ld(&(bar)[XB_TMO])) break; if (_sp > XB_SPIN_CAP) { atomicAdd(&(bar)[XB_TMO], 1u); break; } } } } while (0)

struct XcdBarrier {
    unsigned* bar; unsigned x;
    volatile LAS unsigned* st;
};

__device__ __forceinline__ XcdBarrier xcd_barrier_post(unsigned* bar, volatile LAS unsigned* st) {
    XcdBarrier b; b.bar = bar; b.x = xb_xcc_id(); b.st = st;
    if (threadIdx.x == 0) (void)xb_add(&bar[XB_XCNT(b.x)], 1u);
    return b;
}
__device__ __forceinline__ void xcd_barrier_complete(unsigned* bar, unsigned x, unsigned& nloc, unsigned& nx) {
    const unsigned G = gridDim.x * gridDim.y * gridDim.z;
    unsigned sum, cnt, mine, sp = 0u;
    for (;;) {
        sum = 0u; cnt = 0u; mine = 0u;
#pragma unroll
        for (unsigned j = 0; j < 16; ++j) { const unsigned c = xb_ld(&bar[XB_XCNT(j)]); sum += c; cnt += (c > 0u) ? 1u : 0u; mine = (j == x) ? c : mine; }
        if (sum == G) break;
        __builtin_amdgcn_s_sleep(1);
        if ((++sp & 255u) == 0u) { if (xb_ld(&bar[XB_TMO])) break; if (sp > XB_SPIN_CAP) { atomicAdd(&bar[XB_TMO], 1u); break; } }
    }
    nloc = mine > 0u ? mine : 1u; nx = cnt > 0u ? cnt : 1u;
}

__device__ __forceinline__ void xcd_barrier(const XcdBarrier& b) {
    asm volatile("s_waitcnt vmcnt(0)" ::: "memory");
    __syncthreads();
    if (threadIdx.x == 0) {
        unsigned* bar = b.bar;
        __builtin_amdgcn_s_waitcnt(0);
        unsigned nloc = b.st[0], nx = b.st[1];
        if (nloc == 0u) { xcd_barrier_complete(bar, b.x, nloc, nx); b.st[0] = nloc; b.st[1] = nx; }
        const unsigned old = xb_add(&bar[XB_XSUB(b.x)], 1u);
        const unsigned gen = old / nloc;
        if (old + 1u == (gen + 1u) * nloc) {
            __builtin_amdgcn_fence(__ATOMIC_RELEASE, "agent");
            asm volatile("s_waitcnt vmcnt(0)" ::: "memory");
            const unsigned og = xb_add(&bar[XB_TOP], 1u);
            const unsigned tg = og / nx;
            if (og + 1u == (tg + 1u) * nx) xb_add(&bar[XB_TOPGEN], 1u);
            else XB_SPIN(xb_ld(&bar[XB_TOPGEN]) == tg, bar);
            __builtin_amdgcn_fence(__ATOMIC_ACQUIRE, "agent");
            xb_add(&bar[XB_XGEN(b.x)], 1u);
            asm volatile("s_waitcnt vmcnt(0)" ::: "memory");
        } else {
            XB_SPIN(xb_ld(&bar[XB_XGEN(b.x)]) == gen, bar);
            __builtin_amdgcn_fence(__ATOMIC_ACQUIRE, "agent");
            asm volatile("s_waitcnt vmcnt(0)" ::: "memory");
        }
    }
    __syncthreads();
}

struct Args { const float* in[26]; float* out; unsigned char* ws; int ph_lo, ph_hi; };

__device__ __forceinline__ void adanorm_rows(const float* xp, const float* xs, const float* g, const float* mod, bf16* H, int gw, int NGW, int lane) {
    for (int grp = gw; grp < M1 / 4; grp += NGW) {
        const int row0 = grp * 4;
        const float* xr; int bb;
        if (row0 < MP) { xr = xp + (size_t)row0 * 1024; bb = row0 >> 11; } else { xr = xs + (size_t)(row0 - MP) * 1024; bb = NBP + ((row0 - MP) >> 5); }
        const float* md = mod + (size_t)bb * 3072;
        f32x4 v[4][4]; float s[4];
#pragma unroll
        for (int q = 0; q < 4; ++q) { s[q] = 0.f;
#pragma unroll
            for (int j = 0; j < 4; ++j) v[q][j] = *(const f32x4*)(xr + (size_t)q * 1024 + 4 * lane + 256 * j); }
#pragma unroll
        for (int q = 0; q < 4; ++q)
#pragma unroll
            for (int j = 0; j < 4; ++j) s[q] += pg8::ssq4(v[q][j]);
#pragma unroll
        for (int o = 1; o < 64; o <<= 1) {
#pragma unroll
            for (int q = 0; q < 4; ++q) s[q] += __shfl_xor(s[q], o); }
#pragma unroll
        for (int q = 0; q < 4; ++q) s[q] = rsqrtf(s[q] * (1.f / 1024.f) + EPSN);
#pragma unroll
        for (int j = 0; j < 4; ++j) { const int c = 4 * lane + 256 * j;
            const f32x4 gg = *(const f32x4*)(g + c) * (*(const f32x4*)(md + 1024 + c) + 1.f), sh = *(const f32x4*)(md + c);
#pragma unroll
            for (int q = 0; q < 4; ++q) { const f32x4 h = v[q][j] * s[q] * gg + sh;
                v2u o; o.x = pk2(h[0], h[1]); o.y = pk2(h[2], h[3]); *(v2u*)(H + (size_t)(row0 + q) * 1024 + c) = o; } }
    }
}

__global__ void __launch_bounds__(512, 2) hybrid_fwd(Args args) {
    extern __shared__ __attribute__((aligned(16))) unsigned char lds_raw[];
    LAS unsigned char* lds = (LAS unsigned char*)lds_raw;
    const int tid = threadIdx.x, lane = tid & 63, wave = __builtin_amdgcn_readfirstlane(tid >> 6);
    const int G = gridDim.x, bid = blockIdx.x;
    const int gw = bid * 8 + wave, NGW = G * 8;
    const int gt = bid * 512 + tid, NGT = G * 512;
    const int lo = args.ph_lo, hi = args.ph_hi;
    volatile LAS unsigned* MISC = (volatile LAS unsigned*)(lds + LDS_MISC);
    if (tid < 16) MISC[tid] = 0u;
    __syncthreads();
    XcdBarrier bar; bar.bar = nullptr; bar.x = 0; bar.st = nullptr;
    if (hi - lo > 1) { bar = xcd_barrier_post((unsigned*)(args.ws + WS_BAR), MISC + 8); cg::this_grid().sync(); }
#ifndef PHMASK
#define PHMASK 0x7ff
#endif
#ifndef PROBE_SYNC
#define PROBE_SYNC 0
#endif
#ifndef PROBE_REP
#define PROBE_REP 0
#endif
#define REP(k) for (int rep_ = 0; rep_ < 1 + ((PROBE_REP >> (k)) & 1); ++rep_)
#define IN(k) (((PHMASK >> (k)) & 1) && lo <= (k) && (k) < hi)
typedef const __attribute__((address_space(4))) Args* KArgs;
#define PHASE_ARGS() KArgs A = (KArgs)__builtin_amdgcn_kernarg_segment_ptr(); asm volatile("" : "+s"(A)); unsigned char* ws = A->ws; float* out = A->out; (void)ws; (void)out
#define WSP(T, off) ((T*)(ws + (off)))
#define SEAM(k) do { if (IN(k) && IN((k) + 1)) { xcd_barrier(bar); } } while (0)

    if (IN(0)) REP(0) {
        PHASE_ARGS();
        float* mod = WSP(float, WS_MOD); float* CS = WSP(float, WS_CS);
        bf16 *W_AIN = WSP(bf16, WS_W_AIN), *W_AOUT = WSP(bf16, WS_W_AOUT), *W_BIN = WSP(bf16, WS_W_BIN), *W_UQ = WSP(bf16, WS_W_UQ), *W_UKV = WSP(bf16, WS_W_UKV), *W_BOUT = WSP(bf16, WS_W_BOUT);
        bf16 *KA = WSP(bf16, WS_KA), *VA = WSP(bf16, WS_VA), *CKV = WSP(bf16, WS_CKV), *KR = WSP(bf16, WS_KR);
        {
            LAS float* scr = (LAS float*)(lds + wave * 10240);
            constexpr int I0 = 16 * 128, I1 = 16 * 32, I2 = 16 * 56, I3 = 6 * 48, I4 = 4 * 64, I5 = 16 * 32;
            for (int it = gw; it < I0 + I1 + I2 + I3 + I4 + I5; it += NGW) {
                int r = it;
                if (r < I0) { const int g = r % 128; transpose_item(A->in[11], 1024, 4096, src_col(0, g), W_AIN, g, (r / 128) * 64, scr, lane); continue; } r -= I0;
                if (r < I1) { const int g = r % 32; transpose_item(A->in[15], 1024, 1024, src_col(1, g), W_AOUT, g, (r / 32) * 64, scr, lane); continue; } r -= I1;
                if (r < I2) { const int g = r % 56; transpose_item(A->in[16], 1024, 1696, src_col(2, g), W_BIN, g, (r / 56) * 64, scr, lane); continue; } r -= I2;
                if (r < I3) { const int g = r % 48; transpose_item(A->in[18], 384, 1536, src_col(3, g), W_UQ, g, (r / 48) * 64, scr, lane, g >= 32); continue; } r -= I3;
                if (r < I4) { const int g = r % 64; transpose_item(A->in[20], 256, 2048, src_col(4, g), W_UKV, g, (r / 64) * 64, scr, lane); continue; } r -= I4;
                { const int g = r % 32; transpose_item(A->in[25], 1024, 1024, src_col(5, g), W_BOUT, g, (r / 32) * 64, scr, lane); }
            }
        }
        for (int it = bid; it < 2 * 48; it += G) {
            const int l = it / 48, jb = it % 48;
            LAS float* sl = (LAS float*)(lds + wave * 10240);
            float acc[40];
#pragma unroll
            for (int b = 0; b < 40; ++b) acc[b] = 0.f;
            for (int pass = 0; pass < 2; ++pass) {
                const int k0 = (wave + 8 * pass) * 64;
                for (int e = lane; e < 40 * 64; e += 64) { const int bb = e >> 6, k = e & 63; const float c = bb < NBP ? A->in[6][(size_t)bb * 1024 + k0 + k] : A->in[7][(size_t)(bb - NBP) * 1024 + k0 + k]; sl[e] = c / (1.f + __expf(-c)); }
                asm volatile("s_waitcnt lgkmcnt(0)" ::: "memory");
                const float* W = A->in[9] + (size_t)l * 1024 * 3072 + (size_t)k0 * 3072 + jb * 64 + lane;
                for (int k = 0; k < 64; k += 4) {
                    const float w0 = W[(size_t)k * 3072], w1 = W[(size_t)(k + 1) * 3072], w2 = W[(size_t)(k + 2) * 3072], w3 = W[(size_t)(k + 3) * 3072];
#pragma unroll
                    for (int b = 0; b < 40; ++b) { const f32x4 sv = *(const LAS f32x4*)(sl + b * 64 + k); acc[b] += (sv[0] * w0 + sv[1] * w1) + (sv[2] * w2 + sv[3] * w3); }
                }
                asm volatile("s_waitcnt lgkmcnt(0)" ::: "memory");
            }
            __syncthreads();
            LAS float* red = (LAS float*)lds;
#pragma unroll
            for (int b = 0; b < 40; ++b) red[(wave * 40 + b) * 64 + lane] = acc[b];
            __syncthreads();
            for (int e = tid; e < 40 * 64; e += 512) { const int b = e >> 6, j = e & 63; float sum = A->in[10][(size_t)l * 3072 + jb * 64 + j];
#pragma unroll
                for (int w = 0; w < 8; ++w) sum += red[(w * 40 + b) * 64 + j];
                mod[((size_t)l * 40 + b) * 3072 + jb * 64 + j] = sum; }
            __syncthreads();
        }
        for (int i = gt; i < NBS * SA_STRIDE * 128; i += NGT) {
            const int c8 = i & 127, rr = (i >> 7) % SA_STRIDE, bs = (i >> 7) / SA_STRIDE;
            const size_t d = ((size_t)MP + (size_t)bs * SA_STRIDE + rr) * 1024 + c8 * 8;
            if (rr < 512) { const size_t s = ((size_t)bs * 512 + rr) * 1024 + c8 * 8; cvt8(A->in[2] + s, KA + d); cvt8(A->in[3] + s, VA + d); }
            else if (rr >= 544) { *(v4u*)(KA + d) = (v4u){0, 0, 0, 0}; *(v4u*)(VA + d) = (v4u){0, 0, 0, 0}; }
        }
        for (int i = gt; i < NBS * SB_STRIDE * 32; i += NGT) {
            const int c8 = i & 31, rr = (i >> 5) % SB_STRIDE, bs = (i >> 5) / SB_STRIDE;
            const size_t d = ((size_t)MP + (size_t)bs * SB_STRIDE + rr) * 256 + c8 * 8;
            if (rr < 2048) cvt8(A->in[4] + ((size_t)bs * 2048 + rr) * 256 + c8 * 8, CKV + d);
            else if (rr >= 2080) *(v4u*)(CKV + d) = (v4u){0, 0, 0, 0};
        }
        for (int i = gt; i < NBS * SB_STRIDE * 4; i += NGT) {
            const int c8 = i & 3, rr = (i >> 2) % SB_STRIDE, bs = (i >> 2) / SB_STRIDE;
            const size_t d = ((size_t)MP + (size_t)bs * SB_STRIDE + rr) * 32 + c8 * 8;
            if (rr < 2048) cvt8(A->in[5] + ((size_t)bs * 2048 + rr) * 32 + c8 * 8, KR + d);
            else if (rr >= 2080) *(v4u*)(KR + d) = (v4u){0, 0, 0, 0};
        }
        { float* SSQ = WSP(float, WS_SSQ); float* SQ2 = WSP(float, WS_SSQQ); float* SQ3 = WSP(float, WS_SSQKV); for (int i = gt; i < M1; i += NGT) { SSQ[i] = 0.f; SQ2[i] = 0.f; SQ3[i] = 0.f; } }
        for (int i = gt; i < 2112 * 16; i += NGT) {
            const int pos = i >> 4, k = i & 15;
            const float inv = exp2f(-(float)k * (13.287712379549449f / 16.f));
            const float ang = (float)pos * inv;
            const double tr = (double)ang * 0.15915494309189535;
            const float fr = (float)(tr - floor(tr + 0.5));
            CS[pos * 32 + k] = __builtin_amdgcn_cosf(fr); CS[pos * 32 + 16 + k] = __builtin_amdgcn_sinf(fr);
        }
    }
    SEAM(0);
    if (IN(1)) REP(1) { PHASE_ARGS();
        const float* mod1 = WSP(float, WS_MOD) + 40 * 3072;
        {
            float* G1 = WSP(float, WS_G1); const float* g1 = A->in[8] + 1024;
            for (int i = gt; i < 40 * 1024; i += NGT) { const int bb = i >> 10, c = i & 1023; G1[i] = g1[c] * (1.f + mod1[(size_t)bb * 3072 + 1024 + c]); }
            float* SW = WSP(float, WS_SW); const bf16* WB = WSP(bf16, WS_W_BIN);
            for (int lc = gw; lc < 1792; lc += NGW) {
                const int lg = lc >> 5, pn = lg >> 3, rem = lg & 7, crow_ = (pn * 8 + (rem & 1) * 4 + (rem >> 1)) * 32 + (lc & 31);
                const v4u w0 = *(const v4u*)(WB + (size_t)crow_ * 1024 + 16 * lane), w1 = *(const v4u*)(WB + (size_t)crow_ * 1024 + 16 * lane + 8);
                float wf[16];
#pragma unroll
                for (int e = 0; e < 4; ++e) { wf[2 * e] = __uint_as_float(w0[e] << 16); wf[2 * e + 1] = __uint_as_float(w0[e] & 0xffff0000u); wf[8 + 2 * e] = __uint_as_float(w1[e] << 16); wf[8 + 2 * e + 1] = __uint_as_float(w1[e] & 0xffff0000u); }
                for (int bb = 0; bb < 40; ++bb) { const float* sh = mod1 + (size_t)bb * 3072 + 16 * lane; float a = 0.f;
#pragma unroll
                    for (int e = 0; e < 4; ++e) { const f32x4 x = *(const f32x4*)(sh + 4 * e); a += (x[0] * wf[4 * e] + x[1] * wf[4 * e + 1]) + (x[2] * wf[4 * e + 2] + x[3] * wf[4 * e + 3]); }
                    a = wave_sum(a); if (lane == 0) SW[(size_t)bb * 1792 + lc] = a; }
            }
        }
        adanorm_rows(A->in[0], A->in[1], A->in[8], WSP(float, WS_MOD), WSP(bf16, WS_H), gw, NGW, lane); }
    SEAM(1);
    if (IN(2)) REP(2) {
        PHASE_ARGS();
        int Kop = 1024; asm volatile("" : "+s"(Kop)); pg8::Gemm g{WSP(bf16, WS_H), WSP(bf16, WS_W_AIN), M1, 4096, Kop}; pg8::StaticOrder S; S.init(M1, 4096, G, bid);
        pg8::EpiAin E{WSP(bf16, WS_QA), WSP(bf16, WS_KA), WSP(bf16, WS_VA), WSP(bf16, WS_ZA), A->in[12], A->in[13], out + O_AKP, out + O_AVP, out + O_AKS, out + O_AVS};
        pg8::gemm_phase<pg8::EpiAin, pg8::StaticOrder, true, true>(lds, g, S, E);
    }
    SEAM(2);
    if (IN(3)) REP(3) {
        PHASE_ARGS();
        bf16 *QA = WSP(bf16, WS_QA), *KA = WSP(bf16, WS_KA), *VA = WSP(bf16, WS_VA), *ZA = WSP(bf16, WS_ZA), *H = WSP(bf16, WS_H); const float* tblp = A->in[14];
        __syncthreads();
        { int bh, qb;
          for (int k = 0; at::prompt_unit(k, G, bid, bh, qb); ++k) {
            at::AttnUnit a; const int b = bh >> 4, c0 = 4 * qb, tf = c0 > 8 ? c0 - 8 : 0;
            a.qrow0 = b * SEQ + 256 * qb; a.nq = 256; a.krow0 = b * SEQ + 64 * tf; a.nt = c0 + 3 - tf + 1; a.lastvalid = 64; a.head = bh & 15; a.c0 = c0; a.tf = tf;
            at::attn_unit<false>(lds, a, QA, KA, nullptr, VA, ZA, H, tblp);
          } }
        for (int s = bid; s < 128; s += G) {
            at::AttnUnit a; const int bs = s >> 4;
            a.qrow0 = MP + bs * TS; a.nq = 32; a.krow0 = MP + bs * SA_STRIDE; a.nt = 9; a.lastvalid = 32; a.head = s & 15; a.c0 = 8; a.tf = 0;
            at::attn_unit<false>(lds, a, QA, KA, nullptr, VA, ZA, H, tblp);
        }
    }
    SEAM(3);
    if (IN(4)) REP(4) {
        PHASE_ARGS();
        int Kop = 1024; asm volatile("" : "+s"(Kop)); pg8::Gemm g{WSP(bf16, WS_H), WSP(bf16, WS_W_AOUT), M1, 1024, Kop}; pg8::StaticOrder S; S.init(M1, 1024, G, bid);
        pg8::EpiRes E{A->in[0], A->in[1], out + O_YP, out + O_YS, WSP(float, WS_MOD) + 2048, WSP(bf16, WS_YG), WSP(float, WS_G1), WSP(float, WS_SSQ), nullptr, WSP(bf16, WS_Y1B)};
        pg8::gemm_phase<pg8::EpiRes, pg8::StaticOrder, true, true>(lds, g, S, E);
    }
    if (IN(4) && IN(6)) { xcd_barrier(bar); }
    if (IN(6)) REP(6) {
        PHASE_ARGS();
        int Kop = 1024; asm volatile("" : "+s"(Kop)); pg8::Gemm g{WSP(bf16, WS_YG), WSP(bf16, WS_W_BIN), M1, 1792, Kop}; pg8::StaticOrder S; S.init(M1, 1792, G, bid);
        pg8::EpiBin E{WSP(bf16, WS_ZB), WSP(bf16, WS_CQ), WSP(bf16, WS_CKV), WSP(float, WS_RAW2), WSP(float, WS_SSQ), WSP(float, WS_SW), A->in[17], A->in[19], WSP(float, WS_SSQQ), WSP(float, WS_SSQKV)};
        pg8::gemm_phase<pg8::EpiBin, pg8::StaticOrder, true, true>(lds, g, S, E);
    }
    if (IN(6) && IN(8)) { xcd_barrier(bar); }
    if (IN(8)) REP(8) {
        { PHASE_ARGS(); int Kop = 384; asm volatile("" : "+s"(Kop)); pg8::Gemm g{WSP(bf16, WS_CQ), WSP(bf16, WS_W_UQ), M1, 1536, Kop}; pg8::StaticOrder S; S.init(M1, 1536, G, bid);
          pg8::EpiUq E{WSP(bf16, WS_QB), A->in[21], A->in[22], WSP(float, WS_CS), WSP(float, WS_SSQQ)};
          pg8::gemm_phase<pg8::EpiUq, pg8::StaticOrder, true, true>(lds, g, S, E); }
        __syncthreads();
        { PHASE_ARGS(); int Kop = 256; asm volatile("" : "+s"(Kop)); pg8::Gemm g{WSP(bf16, WS_CKV), WSP(bf16, WS_W_UKV), R2, 2048, Kop}; pg8::StaticOrder S; S.init(R2, 2048, G, G - 1 - bid);
          pg8::EpiUkv E{WSP(bf16, WS_KN), WSP(bf16, WS_VB), A->in[23], WSP(float, WS_SSQKV)};
          pg8::gemm_phase<pg8::EpiUkv, pg8::StaticOrder, true, true>(lds, g, S, E); }
        __syncthreads();
        {
            PHASE_ARGS();
            const float* RAW2 = WSP(float, WS_RAW2); const float* CS = WSP(float, WS_CS); const float* SQ3 = WSP(float, WS_SSQKV); bf16* KR = WSP(bf16, WS_KR); const bf16* CKVb = WSP(bf16, WS_CKV);
            const float* gkr = A->in[24];
            unsigned* wq = (unsigned*)(ws + WS_BAR) + 3600;
            volatile LAS unsigned* slot = (volatile LAS unsigned*)(lds + LDS_MISC + 16);
            for (;;) {
                if (tid == 0) slot[0] = atomicAdd(wq, 1u);
                __syncthreads();
                const unsigned ch = slot[0];
                __syncthreads();
                if (ch >= (unsigned)(M1 / 128)) break;
              for (int rix = 0; rix < 16; ++rix) { const int row = (int)ch * 128 + rix * 8 + wave;
                const float* rw = RAW2 + (size_t)row * 32;
                int pos; size_t drow, orow;
                if (row < MP) { pos = row & (SEQ - 1); drow = (size_t)row; orow = (size_t)row; }
                else { const int rs = row - MP; pos = SEQ + (rs & 31); drow = (size_t)MP + (size_t)(rs >> 5) * SB_STRIDE + 2048 + (rs & 31); orow = (size_t)rs; }
                float* ockv = (row < MP ? out + O_CKVP : out + O_CKVS) + orow * 256;
                float* okr = (row < MP ? out + O_KRP : out + O_KRS) + orow * 32;
                const v2u kw = *(const v2u*)(CKVb + drow * 256 + 4 * lane);
                const f32x4 kv = (f32x4){__uint_as_float(kw.x << 16), __uint_as_float(kw.x & 0xffff0000u), __uint_as_float(kw.y << 16), __uint_as_float(kw.y & 0xffff0000u)};
                const float kr = lane < 32 ? rw[lane] : 0.f;
                float r = rsqrtf(SQ3[row] * (1.f / 256.f) + EPSN);
                *(f32x4*)(ockv + 4 * lane) = kv * r;
                r = rsqrtf(wave_sum(kr * kr) * (1.f / 32.f) + EPSN);
                const float kn = kr * r * (lane < 32 ? gkr[lane] : 0.f);
                const float pr = __shfl_xor(kn, 16);
                const float cs = CS[pos * 32 + (lane & 15)], sn = CS[pos * 32 + 16 + (lane & 15)];
                const float ro = (lane & 16) ? (kn * cs + pr * sn) : (kn * cs - pr * sn);
                if (lane < 32) { okr[lane] = ro; const unsigned b = pk2(ro, 0.f); KR[drow * 32 + lane] = (bf16)(b & 0xffffu); }
              }
            }
        }
    }
    SEAM(8);
    if (IN(9)) REP(9) {
        PHASE_ARGS();
        bf16 *QB = WSP(bf16, WS_QB), *KN = WSP(bf16, WS_KN), *KR = WSP(bf16, WS_KR), *VB = WSP(bf16, WS_VB), *ZB = WSP(bf16, WS_ZB), *H = WSP(bf16, WS_H);
        __syncthreads();
        const bool shed = (G == 256);
        { int bh, qb;
          for (int k = 0; at::prompt_unit(k, G, bid, bh, qb); ++k) {
            if (shed && bid < 128 && k < 8 && qb == 3) continue;
            at::AttnUnit a; const int b = bh >> 4;
            a.qrow0 = b * SEQ + 256 * qb; a.nq = 256; a.krow0 = b * SEQ; a.nt = 4 * qb + 4; a.lastvalid = 64; a.head = bh & 15; a.c0 = 4 * qb; a.tf = 0;
            at::attn_unit<true>(lds, a, QB, KN, KR, VB, ZB, H, nullptr);
          }
          if (shed && bid >= 128) {
            for (int k = 0; k < 8 && at::prompt_unit(k, G, bid - 128, bh, qb); ++k) { if (qb != 3) continue;
              at::AttnUnit a; const int b = bh >> 4;
              a.qrow0 = b * SEQ + 256 * qb; a.nq = 256; a.krow0 = b * SEQ; a.nt = 4 * qb + 4; a.lastvalid = 64; a.head = bh & 15; a.c0 = 4 * qb; a.tf = 0;
              at::attn_unit<true>(lds, a, QB, KN, KR, VB, ZB, H, nullptr); }
          } }
        for (int s = bid; s < 128; s += G) {
            at::AttnUnit a; const int bs = s >> 4;
            a.qrow0 = MP + bs * TS; a.nq = 32; a.krow0 = MP + bs * SB_STRIDE; a.nt = 33; a.lastvalid = 32; a.head = s & 15; a.c0 = 32; a.tf = 0;
            at::attn_unit<true>(lds, a, QB, KN, KR, VB, ZB, H, nullptr);
        }
    }
    SEAM(9);
    if (IN(10)) REP(10) {
        PHASE_ARGS();
        int Kop = 1024; asm volatile("" : "+s"(Kop)); pg8::Gemm g{WSP(bf16, WS_H), WSP(bf16, WS_W_BOUT), M1, 1024, Kop}; pg8::StaticOrder S; S.init(M1, 1024, G, bid);
        pg8::EpiRes E{out + O_YP, out + O_YS, out + O_YP, out + O_YS, WSP(float, WS_MOD) + 40 * 3072 + 2048, nullptr, nullptr, nullptr, WSP(bf16, WS_Y1B), nullptr};
        pg8::gemm_phase<pg8::EpiRes, pg8::StaticOrder, true, true>(lds, g, S, E);
    }
#if PROBE_SYNC
    if (hi - lo > 1) { for (int q = 0; q < 18; ++q) cg::this_grid().sync(); }
#endif
#undef IN
#undef SEAM
}

constexpr int N_PHASES = 11;
extern "C" void kernel_launch(void* const* d_in, const int* in_sizes, int n_in, void* d_out, int out_size, void* d_ws, size_t ws_size, hipStream_t stream) {
    static int grid = 0;
    if (grid == 0) {
        if (n_in != 26 || ws_size < WS_END) { fprintf(stderr, "kernel_launch: unexpected inputs (n_in %d, ws %zu, need %zu)\n", n_in, ws_size, (size_t)WS_END); grid = -1; return; }
        int dev = 0, cus = 0, per_cu = 0;
        hipGetDevice(&dev); hipDeviceGetAttribute(&cus, hipDeviceAttributeMultiprocessorCount, dev);
        hipFuncSetAttribute((const void*)hybrid_fwd, hipFuncAttributeMaxDynamicSharedMemorySize, LDS_TOTAL);
        hipOccupancyMaxActiveBlocksPerMultiprocessor(&per_cu, (const void*)hybrid_fwd, 512, LDS_TOTAL);
        if (per_cu < 1) { fprintf(stderr, "kernel_launch: occupancy query says %d blocks per CU\n", per_cu); per_cu = 1; }
        (void)hipGetLastError();
        grid = cus * per_cu;
    }
    if (grid < 0) return;
    hipMemsetAsync((char*)d_ws + WS_BAR, 0, 16384, stream);
    Args a{};
    for (int i = 0; i < 26; ++i) a.in[i] = (const float*)d_in[i];
    a.out = (float*)d_out; a.ws = (unsigned char*)d_ws;
#if MULTI_LAUNCH
    for (int p = 0; p < N_PHASES; ++p) { a.ph_lo = p; a.ph_hi = p + 1; hipLaunchKernelGGL(hybrid_fwd, dim3(grid), dim3(512), LDS_TOTAL, stream, a); }
#else
    a.ph_lo = 0; a.ph_hi = N_PHASES;
    void* kargs[] = {&a};
    hipError_t e = hipLaunchCooperativeKernel((const void*)hybrid_fwd, dim3(grid), dim3(512), kargs, LDS_TOTAL, stream);
    if (e != hipSuccess) fprintf(stderr, "cooperative launch failed: %s (grid %d)\n", hipGetErrorString(e), grid);
#endif
}
```

```cpp
#include <hip/hip_runtime.h>
#include <hip/hip_cooperative_groups.h>
#include <cstdio>
#include <cstdint>
namespace cg = cooperative_groups;
#ifndef MULTI_LAUNCH
#define MULTI_LAUNCH 0
#endif
constexpr int DMODEL = 1024, NBP = 32, SEQ = 2048, NBS = 8, TS = 32;
constexpr int MP = NBP * SEQ;
constexpr int M1 = MP + NBS * TS;
constexpr int SA_STRIDE = 576;
constexpr int RA = MP + NBS * SA_STRIDE;
constexpr int SB_STRIDE = 2112;
constexpr int R2 = MP + NBS * SB_STRIDE;
constexpr float EPSN = 1e-6f;
constexpr float LOG2E = 1.4426950408889634f;
constexpr float QSCALE_A = 0.125f * LOG2E;
constexpr float QSCALE_B = 0.10206207261596575f * LOG2E;
namespace pg8 {
#define PG8_LAS __attribute__((address_space(3)))
typedef unsigned short bf16_t;
typedef short bf16x8 __attribute__((ext_vector_type(8)));
typedef float f32x4 __attribute__((ext_vector_type(4)));
typedef unsigned u32x4 __attribute__((ext_vector_type(4)));
constexpr int BM = 256, BK = 64, HALF = 128, HTB = HALF * BK * 2  , STAGE_BYTES = 8 * HTB, NXCD = 8, WGM = 8;

__host__ __device__ __forceinline__ int lds_byte(int r, int c) { const int st = (r >> 4) * 2 + (c >> 5), rr = r & 15, cc = c & 31, ob = rr * 64 + cc * 2; return st * 1024 + (ob ^ (((ob >> 9) & 1) << 5)); }
__host__ __device__ __forceinline__ void stage_rc(int b, int& R, int& C) { const int st = b / 1024, sb = b % 1024, swz = sb ^ (((sb >> 9) & 1) << 5); R = (st >> 1) * 16 + swz / 64; C = (st & 1) * 32 + (swz % 64) / 2; }
__host__ __device__ __forceinline__ int perm32(int rho) { const int n = rho >> 4, i = rho & 15; return 8 * (i >> 2) + 4 * n + (i & 3); }

struct Unit { int pm, pn; };
struct Gemm { const bf16_t* A; const bf16_t* Bt; int M, N, K; };

struct StaticOrder {
    int nM, nN, nwg, G, c;
    __host__ __device__ void init(int M, int N, int G_, int c_) { nM = M / BM; nN = N / BM; nwg = nM * nN; G = G_; c = c_; }
    __host__ __device__ bool next(int i, Unit& u) const {
        const long L = (long)i * G + c; if (L >= nwg) return false;
        int wgid = (int)L; { const int q = nwg / NXCD, r = nwg % NXCD, xcd = wgid % NXCD, off = wgid / NXCD; wgid = (xcd < r ? xcd * (q + 1) : r * (q + 1) + (xcd - r) * q) + off; }
        const int nig = WGM * nN, gid = wgid / nig, fm = gid * WGM, gsz = (nM - fm) < WGM ? (nM - fm) : WGM;
        u.pm = fm + ((wgid % nig) % gsz); u.pn = (wgid % nig) / gsz; return true;
    }
    __device__ __forceinline__ void a_ready(const Unit&) const {}
    __device__ __forceinline__ void done(const Unit&) const {}
};

__device__ __forceinline__ unsigned cvt_pk_bf16(float lo, float hi) { unsigned r; asm volatile("v_cvt_pk_bf16_f32 %0, %1, %2" : "=v"(r) : "v"(lo), "v"(hi)); return r; }
template <class Epi, class Sched, bool ALIGN_EPI = false, bool SP2 = false>
__device__ __forceinline__ void gemm_phase(PG8_LAS unsigned char* lds, const Gemm g, const Sched& S, const Epi& E) {
    int tid_ = threadIdx.x; asm volatile("" : "+v"(tid_));
    const int tid = tid_, wid = __builtin_amdgcn_readfirstlane(tid >> 6), lane = tid & 63, wr = wid >> 2, wc = wid & 3, fr = lane & 15, fq = lane >> 4;
    const int K = g.K, nt = K / BK;
    unsigned voffA[2], voffB[2];
#pragma unroll
    for (int i = 0; i < 2; ++i) { int R, C; stage_rc(tid * 16 + i * 8192, R, C); const int Rb = Epi::PERM ? ((R & ~31) + perm32(R & 31)) : R;
        voffA[i] = (unsigned)(R * K + C) * 2u; voffB[i] = (unsigned)(Rb * K + C) * 2u; }
    const size_t kstep = (size_t)(BK * 2);
    const size_t hstep = (size_t)HALF * K * 2;
    const size_t tstep = 2 * hstep;
    const unsigned ldsw = (unsigned)wid * 1024u;
    const int aoff = lds_byte(wr * 64 + fr, fq * 8), boff = lds_byte(wc * 32 + fr, fq * 8);
#define PG8_SA(b, h) (((b) * 2 + (h)) * HTB)
#define PG8_SB(b, h) ((4 + (b) * 2 + (h)) * HTB)
#define PG8_STAGE(bufoff, gbase, voff) do { _Pragma("unroll") for (int _i = 0; _i < 2; ++_i) \
        __builtin_amdgcn_global_load_lds((const unsigned*)((const char*)(gbase) + (voff)[_i]), (PG8_LAS unsigned*)(lds + (bufoff) + ldsw + _i * 8192), 16, 0, 0); } while (0)
#define PG8_LDA(dst, b, h) do { _Pragma("unroll") for (int m = 0; m < 4; ++m) _Pragma("unroll") for (int k = 0; k < 2; ++k) dst[m][k] = *(const PG8_LAS bf16x8*)(lds + PG8_SA(b, h) + aoff + m * 2048 + k * 1024); } while (0)
#define PG8_LDB(dst, b, h) do { _Pragma("unroll") for (int n = 0; n < 2; ++n) _Pragma("unroll") for (int k = 0; k < 2; ++k) dst[n][k] = *(const PG8_LAS bf16x8*)(lds + PG8_SB(b, h) + boff + n * 2048 + k * 1024); } while (0)
#define PG8_MMA(ai, bj, At, Bt) do { __builtin_amdgcn_s_setprio(1); _Pragma("unroll") for (int m = 0; m < 4; ++m) _Pragma("unroll") for (int n = 0; n < 2; ++n) _Pragma("unroll") for (int k = 0; k < 2; ++k) \
        acc[ai][bj][m][n] = __builtin_amdgcn_mfma_f32_16x16x32_bf16(Bt[n][k], At[m][k], acc[ai][bj][m][n], 0, 0, 0); __builtin_amdgcn_s_setprio(0); } while (0)
#define PG8_WAIT_V(n) asm volatile("s_waitcnt vmcnt(" #n ")" ::: "memory")
#define PG8_WAIT_L(n) asm volatile("s_waitcnt lgkmcnt(" #n ")" ::: "memory")
#define PG8_BAR __builtin_amdgcn_s_barrier()
#define PG8_SCHED __builtin_amdgcn_sched_barrier(0)
    Unit cur, nxt; int ui = 0;
    if (!S.next(0, cur)) return;
    f32x4 acc[2][2][4][2];
#pragma unroll
    for (int a = 0; a < 2; ++a)
#pragma unroll
        for (int b = 0; b < 2; ++b)
#pragma unroll
            for (int m = 0; m < 4; ++m)
#pragma unroll
                for (int n = 0; n < 2; ++n) acc[a][b][m][n] = (f32x4){0.f, 0.f, 0.f, 0.f};
    bf16x8 At[4][2], B0[2][2], B1[2][2];
    const char* cA = (const char*)g.A + (size_t)cur.pm * tstep; const char* cB = (const char*)g.Bt + (size_t)cur.pn * tstep;
    S.a_ready(cur);
    if constexpr (SP2) {
        PG8_STAGE(PG8_SB(0, 0), cB, voffB); PG8_STAGE(PG8_SB(0, 1), cB + hstep, voffB); PG8_STAGE(PG8_SA(0, 0), cA, voffA); PG8_STAGE(PG8_SA(0, 1), cA + hstep, voffA);
        if (wr == 1) PG8_BAR;
        PG8_WAIT_V(2); PG8_BAR;
        PG8_STAGE(PG8_SB(1, 0), cB + kstep, voffB); PG8_STAGE(PG8_SA(1, 0), cA + kstep, voffA); PG8_STAGE(PG8_SB(1, 1), cB + hstep + kstep, voffB);
        PG8_WAIT_V(6); PG8_BAR;
    } else {
        PG8_STAGE(PG8_SB(0, 0), cB, voffB); PG8_STAGE(PG8_SA(0, 0), cA, voffA); PG8_STAGE(PG8_SB(0, 1), cB + hstep, voffB); PG8_STAGE(PG8_SA(0, 1), cA + hstep, voffA);
        if (wr == 1) PG8_BAR;
        PG8_WAIT_V(4); PG8_BAR;
        PG8_STAGE(PG8_SB(1, 0), cB + kstep, voffB); PG8_STAGE(PG8_SA(1, 0), cA + kstep, voffA); PG8_STAGE(PG8_SB(1, 1), cB + hstep + kstep, voffB);
        PG8_WAIT_V(6); PG8_BAR;
    }
    for (;;) {
        const bool has_next = S.next(ui + 1, nxt);
        const char* nA = has_next ? (const char*)g.A + (size_t)nxt.pm * tstep : cA; const char* nB = has_next ? (const char*)g.Bt + (size_t)nxt.pn * tstep : cB;
        for (int t = 0; t < nt; t += 2) {
            const bool last = (t == nt - 2);
            const char* a1 = cA + (size_t)(t + 1) * kstep;
            const char* a2 = last ? nA : cA + (size_t)(t + 2) * kstep; const char* b2 = last ? nB : cB + (size_t)(t + 2) * kstep;
            const char* a3 = a2 + kstep; const char* b3 = b2 + kstep;
            if (last && has_next) S.a_ready(nxt);
            if constexpr (SP2) {
            PG8_LDB(B0, 0, 0); PG8_LDB(B1, 0, 1); PG8_SCHED; PG8_LDA(At, 0, 0); PG8_STAGE(PG8_SA(1, 1), a1 + hstep, voffA);
            PG8_WAIT_V(8); PG8_WAIT_L(0); PG8_BAR; PG8_MMA(0, 0, At, B0); PG8_MMA(0, 1, At, B1); PG8_BAR; PG8_SCHED;
            PG8_LDA(At, 0, 1); PG8_STAGE(PG8_SB(0, 0), b2, voffB); PG8_STAGE(PG8_SB(0, 1), b2 + hstep, voffB); PG8_STAGE(PG8_SA(0, 0), a2, voffA);
            PG8_WAIT_V(8); PG8_WAIT_L(0); PG8_BAR; PG8_MMA(1, 0, At, B0); PG8_MMA(1, 1, At, B1); PG8_BAR; PG8_SCHED;
            PG8_LDB(B0, 1, 0); PG8_LDB(B1, 1, 1); PG8_SCHED; PG8_LDA(At, 1, 0); PG8_STAGE(PG8_SA(0, 1), a2 + hstep, voffA);
            PG8_WAIT_V(8); PG8_WAIT_L(0); PG8_BAR; PG8_MMA(0, 0, At, B0); PG8_MMA(0, 1, At, B1); PG8_BAR; PG8_SCHED;
            PG8_LDA(At, 1, 1); PG8_STAGE(PG8_SB(1, 0), b3, voffB); PG8_STAGE(PG8_SB(1, 1), b3 + hstep, voffB); PG8_STAGE(PG8_SA(1, 0), a3, voffA);
            PG8_WAIT_V(8); PG8_WAIT_L(0); PG8_BAR; PG8_MMA(1, 0, At, B0); PG8_MMA(1, 1, At, B1); PG8_BAR; PG8_SCHED;
            } else {
            PG8_LDB(B0, 0, 0); PG8_SCHED; PG8_LDA(At, 0, 0); PG8_STAGE(PG8_SA(1, 1), a1 + hstep, voffA);
            PG8_WAIT_L(8); PG8_BAR; PG8_WAIT_L(0); PG8_MMA(0, 0, At, B0); PG8_BAR; PG8_SCHED;
            PG8_LDB(B1, 0, 1); PG8_STAGE(PG8_SB(0, 0), b2, voffB);
            PG8_BAR; PG8_WAIT_L(0); PG8_MMA(0, 1, At, B1); PG8_BAR;
            PG8_LDA(At, 0, 1); PG8_STAGE(PG8_SA(0, 0), a2, voffA);
            PG8_BAR; PG8_WAIT_L(0); PG8_MMA(1, 0, At, B0); PG8_BAR; PG8_SCHED;
            PG8_STAGE(PG8_SB(0, 1), b2 + hstep, voffB);
            PG8_WAIT_V(6); PG8_BAR; PG8_MMA(1, 1, At, B1); PG8_BAR;
            PG8_LDB(B0, 1, 0); PG8_SCHED; PG8_LDA(At, 1, 0); PG8_STAGE(PG8_SA(0, 1), a2 + hstep, voffA);
            PG8_WAIT_L(8); PG8_BAR; PG8_WAIT_L(0); PG8_MMA(0, 0, At, B0); PG8_BAR; PG8_SCHED;
            PG8_LDB(B1, 1, 1); PG8_STAGE(PG8_SB(1, 0), b3, voffB);
            PG8_BAR; PG8_WAIT_L(0); PG8_MMA(0, 1, At, B1); PG8_BAR;
            PG8_LDA(At, 1, 1); PG8_STAGE(PG8_SA(1, 0), a3, voffA);
            PG8_BAR; PG8_WAIT_L(0); PG8_MMA(1, 0, At, B0); PG8_BAR; PG8_SCHED;
            PG8_STAGE(PG8_SB(1, 1), b3 + hstep, voffB);
            PG8_WAIT_V(6); PG8_BAR; PG8_MMA(1, 1, At, B1); PG8_BAR;
            }
        }
        if constexpr (ALIGN_EPI) { if (wr == 0) PG8_BAR; }
        if constexpr (!Epi::AFTER_DRAIN) { E(acc, cur, wr, wc, fr, fq); S.done(cur); }
        if (!has_next) break;
#pragma unroll
        for (int a = 0; a < 2; ++a)
#pragma unroll
            for (int b = 0; b < 2; ++b)
#pragma unroll
                for (int m = 0; m < 4; ++m)
#pragma unroll
                    for (int n = 0; n < 2; ++n) acc[a][b][m][n] = (f32x4){0.f, 0.f, 0.f, 0.f};
        cur = nxt; cA = nA; cB = nB; ++ui;
        if constexpr (ALIGN_EPI) { if (wr == 1) PG8_BAR; }
    }
    PG8_WAIT_V(0);
    if constexpr (!ALIGN_EPI) { if (wr == 0) PG8_BAR; }
    PG8_BAR;
    if constexpr (Epi::AFTER_DRAIN) { E.fused(acc, cur, wr, wc, fr, fq, lds, wid, lane); S.done(cur); }
#undef PG8_SA
#undef PG8_SB
#undef PG8_STAGE
#undef PG8_LDA
#undef PG8_LDB
#undef PG8_MMA
#undef PG8_WAIT_V
#undef PG8_WAIT_L
#undef PG8_BAR
#undef PG8_SCHED
}
typedef unsigned u32x2 __attribute__((ext_vector_type(2)));
typedef float f32x2 __attribute__((ext_vector_type(2)));
typedef __bf16 bf16x2_t __attribute__((ext_vector_type(2)));
__device__ __forceinline__ unsigned pkbf(float lo, float hi) { f32x2 v = {lo, hi}; bf16x2_t b = __builtin_convertvector(v, bf16x2_t); return __builtin_bit_cast(unsigned, b); }
__device__ __forceinline__ u32x2 pk4(f32x4 v) { u32x2 r; r.x = pkbf(v[0], v[1]); r.y = pkbf(v[2], v[3]); return r; }
__device__ __forceinline__ void st8(bf16_t* d, f32x4 a, f32x4 b) { u32x4 w; w.x = pkbf(a[0], a[1]); w.y = pkbf(a[2], a[3]); w.z = pkbf(b[0], b[1]); w.w = pkbf(b[2], b[3]); *(u32x4*)d = w; }
constexpr int STG_OFF = 131072 + 1024, STG_WAVE = 16 * 144;
__device__ __forceinline__ void stg_put(PG8_LAS unsigned char* stg, int fr, int fq, int bj, f32x4 a, f32x4 b) {
    u32x4 w; w.x = pkbf(a[0], a[1]); w.y = pkbf(a[2], a[3]); w.z = pkbf(b[0], b[1]); w.w = pkbf(b[2], b[3]);
    *(PG8_LAS u32x4*)(stg + fr * 144 + 64 * bj + 16 * fq) = w;
}
__device__ __forceinline__ void stg_flush(PG8_LAS unsigned char* stg, int fr, int fq, bf16_t* seg, int stride) {
    const int lane = fr + 16 * fq, r0 = lane >> 3, ch = lane & 7;
    bf16_t* p0 = seg + (r0 - fr) * stride + 8 * ch;
    asm volatile("s_waitcnt lgkmcnt(0)" ::: "memory");
    const u32x4 x0 = *(const PG8_LAS u32x4*)(stg + r0 * 144 + 16 * ch), x1 = *(const PG8_LAS u32x4*)(stg + (r0 + 8) * 144 + 16 * ch);
    *(u32x4*)p0 = x0; *(u32x4*)(p0 + 8 * stride) = x1;
    asm volatile("s_waitcnt lgkmcnt(0)" ::: "memory");
}
__device__ __forceinline__ void st_rows(PG8_LAS unsigned char* stg, int fr, int fq, bf16_t* seg, int stride, f32x4 a0, f32x4 a1, f32x4 b0, f32x4 b1) {
    stg_put(stg, fr, fq, 0, a0, a1); stg_put(stg, fr, fq, 1, b0, b1); stg_flush(stg, fr, fq, seg, stride);
}
__device__ __forceinline__ float silu_f(float v) { return v * __builtin_amdgcn_rcpf(1.f + __expf(-v)); }
__device__ __forceinline__ f32x4 silu4(f32x4 v) { f32x4 o; o[0] = silu_f(v[0]); o[1] = silu_f(v[1]); o[2] = silu_f(v[2]); o[3] = silu_f(v[3]); return o; }
__device__ __forceinline__ float ssq4(f32x4 v) { return (v[0] * v[0] + v[1] * v[1]) + (v[2] * v[2] + v[3] * v[3]); }
__device__ __forceinline__ float red_fq(float s) { s += __shfl_xor(s, 16); s += __shfl_xor(s, 32); return s; }

struct EpiAin {
    static constexpr bool PERM = true, AFTER_DRAIN = false;
    bf16_t *Q, *K, *V, *Z; const float *gq, *gk; float *okp, *ovp, *oks, *ovs; PG8_LAS unsigned char* stg0;
    __device__ __forceinline__ void operator()(const f32x4 (&acc)[2][2][4][2], const Unit& u, int wr, int wc, int fr, int fq) const {
        const int sec = u.pn >> 2, head = (u.pn & 3) * 4 + wc, cb = head * 64 + 8 * fq;
        f32x4 g[2][2];
#pragma unroll
        for (int bj = 0; bj < 2; ++bj)
#pragma unroll
            for (int n = 0; n < 2; ++n) g[bj][n] = (sec < 2) ? *(const f32x4*)((sec == 0 ? gq : gk) + 32 * bj + 4 * n + 8 * fq) : (f32x4){1.f, 1.f, 1.f, 1.f};
#pragma unroll
        for (int ai = 0; ai < 2; ++ai)
#pragma unroll
            for (int m = 0; m < 4; ++m) {
                const int row = u.pm * BM + ai * HALF + wr * 64 + m * 16 + fr;
                f32x4 v[2][2];
#pragma unroll
                for (int bj = 0; bj < 2; ++bj)
#pragma unroll
                    for (int n = 0; n < 2; ++n) v[bj][n] = acc[ai][bj][m][n];
                if (sec < 2) {
                    float s = (ssq4(v[0][0]) + ssq4(v[0][1])) + (ssq4(v[1][0]) + ssq4(v[1][1]));
                    s = red_fq(s);
                    const float r = rsqrtf(s * (1.f / 64.f) + EPSN) * (sec == 0 ? QSCALE_A : 1.f);
#pragma unroll
                    for (int bj = 0; bj < 2; ++bj)
#pragma unroll
                        for (int n = 0; n < 2; ++n) v[bj][n] = v[bj][n] * g[bj][n] * r;
                } else if (sec == 3) {
#pragma unroll
                    for (int bj = 0; bj < 2; ++bj)
#pragma unroll
                        for (int n = 0; n < 2; ++n) v[bj][n] = silu4(v[bj][n]);
                }
                if (sec == 0 || sec == 3) {
                    bf16_t* d = (sec == 0 ? Q : Z) + (size_t)row * 1024 + cb;
                    st_rows(stg0 + (wr * 4 + wc) * STG_WAVE, fr, fq, d - 8 * fq, 1024, v[0][0], v[0][1], v[1][0], v[1][1]);
                } else {
                    size_t drow; float* of = nullptr;
                    if (row < MP) { drow = (size_t)row; const int pos = row & (SEQ - 1); if (pos >= SEQ - 512) of = (sec == 1 ? okp : ovp) + ((size_t)((row >> 11) * 512 + pos - (SEQ - 512))) * 1024; }
                    else { const int rs = row - MP; drow = (size_t)MP + (size_t)(rs >> 5) * SA_STRIDE + 512 + (rs & 31); of = (sec == 1 ? oks : ovs) + (size_t)rs * 1024; }
                    bf16_t* d = (sec == 1 ? K : V) + drow * 1024 + cb;
                    st_rows(stg0 + (wr * 4 + wc) * STG_WAVE, fr, fq, d - 8 * fq, 1024, v[0][0], v[0][1], v[1][0], v[1][1]);
#pragma unroll
                    for (int bj = 0; bj < 2; ++bj) { if (of) { *(f32x4*)(of + cb + 32 * bj) = v[bj][0]; *(f32x4*)(of + cb + 32 * bj + 4) = v[bj][1]; } }
                }
                asm volatile("" ::: "memory");
            }
    }
};
struct EpiRes {
    static constexpr bool PERM = true, AFTER_DRAIN = false;
    const float *xp, *xs; float *yp, *ys; const float* gate;
    bf16_t* YG; const float* G1; float* ssq;
    PG8_LAS unsigned char* stg0; const bf16_t* xb; bf16_t* yb;
    __device__ __forceinline__ void operator()(const f32x4 (&acc)[2][2][4][2], const Unit& u, int wr, int wc, int fr, int fq) const {
        const int cb = u.pn * 256 + wc * 64 + 8 * fq;
#pragma unroll
        for (int ai = 0; ai < 2; ++ai)
#pragma unroll
            for (int m = 0; m < 4; ++m) {
                const int row = u.pm * BM + ai * HALF + wr * 64 + m * 16 + fr;
                const float* xi; float* yo; int bb;
                if (row < MP) { xi = xp + (size_t)row * 1024; yo = yp + (size_t)row * 1024; bb = row >> 11; }
                else { const int rs = row - MP; xi = xs + (size_t)rs * 1024; yo = ys + (size_t)rs * 1024; bb = NBP + (rs >> 5); }
                const float* gp = gate + (size_t)bb * 3072;
                float sq = 0.f;
                f32x4 ov[2][2];
#pragma unroll
                for (int bj = 0; bj < 2; ++bj) { const int c = cb + 32 * bj;
                    f32x4 x0, x1;
                    if (xb) { const u32x4 w = *(const u32x4*)(xb + (size_t)row * 1024 + c);
                        x0 = (f32x4){__uint_as_float(w.x << 16), __uint_as_float(w.x & 0xffff0000u), __uint_as_float(w.y << 16), __uint_as_float(w.y & 0xffff0000u)};
                        x1 = (f32x4){__uint_as_float(w.z << 16), __uint_as_float(w.z & 0xffff0000u), __uint_as_float(w.w << 16), __uint_as_float(w.w & 0xffff0000u)}; }
                    else { x0 = *(const f32x4*)(xi + c); x1 = *(const f32x4*)(xi + c + 4); }
                    ov[bj][0] = x0 + *(const f32x4*)(gp + c) * acc[ai][bj][m][0]; ov[bj][1] = x1 + *(const f32x4*)(gp + c + 4) * acc[ai][bj][m][1];
                    if (!yb) { *(f32x4*)(yo + c) = ov[bj][0]; *(f32x4*)(yo + c + 4) = ov[bj][1]; } }
                if (yb) st_rows(stg0 + (wr * 4 + wc) * STG_WAVE, fr, fq, yb + (size_t)row * 1024 + cb - 8 * fq, 1024, ov[0][0], ov[0][1], ov[1][0], ov[1][1]);
                if (YG) { sq = (ssq4(ov[0][0]) + ssq4(ov[0][1])) + (ssq4(ov[1][0]) + ssq4(ov[1][1])); const float* gg = G1 + (size_t)bb * 1024 + cb;
                    st_rows(stg0 + (wr * 4 + wc) * STG_WAVE, fr, fq, YG + (size_t)row * 1024 + cb - 8 * fq, 1024, ov[0][0] * *(const f32x4*)gg, ov[0][1] * *(const f32x4*)(gg + 4), ov[1][0] * *(const f32x4*)(gg + 32), ov[1][1] * *(const f32x4*)(gg + 36)); }
                if (YG) { sq = red_fq(sq); if (fq == 0) atomicAdd(ssq + row, sq); }
                asm volatile("" ::: "memory");
            }
    }
};
struct EpiBin {
    static constexpr bool PERM = true, AFTER_DRAIN = false;
    bf16_t* Z; bf16_t* CQ; bf16_t* CKV; float* RAW2; const float* ssq; const float* SW; const float* gcq; const float* gckv; float* ssqq; float* ssqkv; PG8_LAS unsigned char* stg0;
    __device__ __forceinline__ void operator()(const f32x4 (&acc)[2][2][4][2], const Unit& u, int wr, int wc, int fr, int fq) const {
        const int cb = u.pn * 256 + wc * 64 + 8 * fq;
        const int sidx = (u.pn - 4) * 4 + wc;
#pragma unroll
        for (int ai = 0; ai < 2; ++ai)
#pragma unroll
            for (int m = 0; m < 4; ++m) {
                const int row = u.pm * BM + ai * HALF + wr * 64 + m * 16 + fr;
                const int bb = row < MP ? (row >> 11) : NBP + ((row - MP) >> 5);
                const float r = rsqrtf(ssq[row] * (1.f / 1024.f) + EPSN);
                const float* sw = SW + (size_t)bb * 1792;
                f32x4 v[2][2];
#pragma unroll
                for (int bj = 0; bj < 2; ++bj)
#pragma unroll
                    for (int n = 0; n < 2; ++n) v[bj][n] = acc[ai][bj][m][n] * r + *(const f32x4*)(sw + cb + 32 * bj + 4 * n);
                if (u.pn < 4) {
                    st_rows(stg0 + (wr * 4 + wc) * STG_WAVE, fr, fq, Z + (size_t)row * 1024 + cb - 8 * fq, 1024, silu4(v[0][0]), silu4(v[0][1]), silu4(v[1][0]), silu4(v[1][1]));
                } else if (sidx < 10) {
                    float sq = (ssq4(v[0][0]) + ssq4(v[0][1])) + (ssq4(v[1][0]) + ssq4(v[1][1]));
                    sq = red_fq(sq);
                    if (sidx < 6) {
                        const int c0 = cb - 1024;
                        if (fq == 0) atomicAdd(ssqq + row, sq);
                        st_rows(stg0 + (wr * 4 + wc) * STG_WAVE, fr, fq, CQ + (size_t)row * 384 + c0 - 8 * fq, 384, v[0][0] * *(const f32x4*)(gcq + c0), v[0][1] * *(const f32x4*)(gcq + c0 + 4), v[1][0] * *(const f32x4*)(gcq + c0 + 32), v[1][1] * *(const f32x4*)(gcq + c0 + 36));
                    } else {
                        const int c0 = cb - 1408;
                        const size_t drow = row < MP ? (size_t)row : (size_t)MP + (size_t)((row - MP) >> 5) * SB_STRIDE + 2048 + ((row - MP) & 31);
                        if (fq == 0) atomicAdd(ssqkv + row, sq);
                        st_rows(stg0 + (wr * 4 + wc) * STG_WAVE, fr, fq, CKV + drow * 256 + c0 - 8 * fq, 256, v[0][0] * *(const f32x4*)(gckv + c0), v[0][1] * *(const f32x4*)(gckv + c0 + 4), v[1][0] * *(const f32x4*)(gckv + c0 + 32), v[1][1] * *(const f32x4*)(gckv + c0 + 36));
                    }
                } else if (sidx == 10) {
#pragma unroll
                    for (int n = 0; n < 2; ++n) *(f32x4*)(RAW2 + (size_t)row * 32 + 8 * fq + 4 * n) = v[0][n];
                }
                asm volatile("" ::: "memory");
            }
    }
};
struct EpiUq {
    static constexpr bool PERM = true, AFTER_DRAIN = false;
    bf16_t* Q; const float *gqn, *gqr, *CS; const float* ssqq; PG8_LAS unsigned char* stg0;
    __device__ __forceinline__ void operator()(const f32x4 (&acc)[2][2][4][2], const Unit& u, int wr, int wc, int fr, int fq) const {
        if (u.pn < 4) {
            const int head = u.pn * 4 + wc;
#pragma unroll
            for (int ai = 0; ai < 2; ++ai)
#pragma unroll
                for (int m = 0; m < 4; ++m) {
                    const int row = u.pm * BM + ai * HALF + wr * 64 + m * 16 + fr;
                    float s = (ssq4(acc[ai][0][m][0]) + ssq4(acc[ai][0][m][1])) + (ssq4(acc[ai][1][m][0]) + ssq4(acc[ai][1][m][1]));
                    s = red_fq(s);
                    const float rq = rsqrtf(ssqq[row] * (1.f / 384.f) + EPSN);
                    const float r = rsqrtf(s * rq * rq * (1.f / 64.f) + EPSN) * rq * QSCALE_B;
                    bf16_t* d = Q + (size_t)row * 1536 + head * 96 + 8 * fq;
                    { PG8_LAS unsigned char* sg_ = stg0 + (wr * 4 + wc) * STG_WAVE;
#pragma unroll
                      for (int bj = 0; bj < 2; ++bj) stg_put(sg_, fr, fq, bj, acc[ai][bj][m][0] * *(const f32x4*)(gqn + 32 * bj + 8 * fq) * r, acc[ai][bj][m][1] * *(const f32x4*)(gqn + 32 * bj + 4 + 8 * fq) * r);
                      stg_flush(sg_, fr, fq, d - 8 * fq, 1536); }
                    asm volatile("" ::: "memory");
                }
        } else {
#pragma unroll
            for (int ai = 0; ai < 2; ++ai)
#pragma unroll
                for (int m = 0; m < 4; ++m) {
                    const int row = u.pm * BM + ai * HALF + wr * 64 + m * 16 + fr;
                    const int pos = row < MP ? (row & (SEQ - 1)) : SEQ + ((row - MP) & 31);
                    const float rq = rsqrtf(ssqq[row] * (1.f / 384.f) + EPSN);
#pragma unroll
                    for (int bj = 0; bj < 2; ++bj) {
                        const int hr = (u.pn - 4) * 8 + wc * 2 + bj;
                        float s = ssq4(acc[ai][bj][m][0]) + ssq4(acc[ai][bj][m][1]);
                        s = red_fq(s);
                        const float r = rsqrtf(s * rq * rq * (1.f / 32.f) + EPSN) * rq;
                        const f32x4 x1 = acc[ai][bj][m][0] * *(const f32x4*)(gqr + 4 * fq) * r, x2 = acc[ai][bj][m][1] * *(const f32x4*)(gqr + 16 + 4 * fq) * r;
                        const f32x4 cs = *(const f32x4*)(CS + pos * 32 + 4 * fq), sn = *(const f32x4*)(CS + pos * 32 + 16 + 4 * fq);
                        bf16_t* d = Q + (size_t)row * 1536 + hr * 96 + 64 + 4 * fq;
                        *(u32x2*)d = pk4((x1 * cs - x2 * sn) * QSCALE_B); *(u32x2*)(d + 16) = pk4((x2 * cs + x1 * sn) * QSCALE_B);
                        asm volatile("" ::: "memory");
                    }
                }
        }
    }
};
struct EpiUkv {
    static constexpr bool PERM = true, AFTER_DRAIN = false;
    bf16_t *KN, *VB; const float* gkn; const float* ssqkv; PG8_LAS unsigned char* stg0;
    __device__ __forceinline__ void operator()(const f32x4 (&acc)[2][2][4][2], const Unit& u, int wr, int wc, int fr, int fq) const {
        const bool isk = u.pn < 4; const int head = (u.pn & 3) * 4 + wc;
#pragma unroll
        for (int ai = 0; ai < 2; ++ai)
#pragma unroll
            for (int m = 0; m < 4; ++m) {
                const int row = u.pm * BM + ai * HALF + wr * 64 + m * 16 + fr;
                float rs = 1.f;
                if (u.pm < MP / BM) rs = rsqrtf(ssqkv[row] * (1.f / 256.f) + EPSN);
                else { const int q_ = row - MP, bs_ = q_ / SB_STRIDE, rr_ = q_ - bs_ * SB_STRIDE; if (rr_ >= 2048 && rr_ < 2080) rs = rsqrtf(ssqkv[MP + bs_ * TS + rr_ - 2048] * (1.f / 256.f) + EPSN); }
                float r = rs;
                if (isk) { float s = (ssq4(acc[ai][0][m][0]) + ssq4(acc[ai][0][m][1])) + (ssq4(acc[ai][1][m][0]) + ssq4(acc[ai][1][m][1])); s = red_fq(s); r = rsqrtf(s * rs * rs * (1.f / 64.f) + EPSN) * rs; }
                bf16_t* d = (isk ? KN : VB) + (size_t)row * 1024 + head * 64 + 8 * fq;
                { PG8_LAS unsigned char* sg_ = stg0 + (wr * 4 + wc) * STG_WAVE;
#pragma unroll
                  for (int bj = 0; bj < 2; ++bj) { const f32x4 g0 = isk ? *(const f32x4*)(gkn + 32 * bj + 8 * fq) : (f32x4){1.f, 1.f, 1.f, 1.f}, g1 = isk ? *(const f32x4*)(gkn + 32 * bj + 4 + 8 * fq) : (f32x4){1.f, 1.f, 1.f, 1.f};
                      stg_put(sg_, fr, fq, bj, acc[ai][bj][m][0] * g0 * r, acc[ai][bj][m][1] * g1 * r); }
                  stg_flush(sg_, fr, fq, d - 8 * fq, 1024); }
                asm volatile("" ::: "memory");
            }
    }
};
}
namespace at {
#define ALAS __attribute__((address_space(3)))
typedef unsigned short bf16_t;
typedef short bf16x8 __attribute__((ext_vector_type(8)));
typedef short s16x4 __attribute__((ext_vector_type(4)));
typedef float f32x16 __attribute__((ext_vector_type(16)));
typedef float f32x4 __attribute__((ext_vector_type(4)));
typedef unsigned u32x4 __attribute__((ext_vector_type(4)));
typedef unsigned u32x2 __attribute__((ext_vector_type(2)));
constexpr int KROW = 144, VROW = 144, RROW = 80;
constexpr int KBUF = 64 * KROW, VBUF = 64 * VROW, RBUF = 64 * RROW, STAGE = KBUF + VBUF + RBUF;
constexpr int NSTAGE = 2, TBL_OFF = NSTAGE * STAGE, OSTG_OFF = 49152, OSTG_WAVE = 32 * 272, LDS_BYTES = OSTG_OFF + 8 * OSTG_WAVE;
static_assert(TBL_OFF + 1280 <= OSTG_OFF, "attention LDS map");
struct AttnUnit { int qrow0, nq, krow0, nt, lastvalid, head, c0, tf; };
__device__ __forceinline__ int crow(int r, int hi) { return (r & 3) + 8 * (r >> 2) + 4 * hi; }

template <bool MLA>
__device__ __forceinline__ void attn_unit(ALAS unsigned char* lds, const AttnUnit u, const bf16_t* __restrict__ Q, const bf16_t* __restrict__ Kn, const bf16_t* __restrict__ Kr,
                                          const bf16_t* __restrict__ V, const bf16_t* __restrict__ Z, bf16_t* __restrict__ U, const float* __restrict__ tbl) {
    int tid_ = threadIdx.x; asm volatile("" : "+v"(tid_));
    const int tid = tid_, lane = tid & 63, wid = __builtin_amdgcn_readfirstlane(tid >> 6), l32 = lane & 31, hi = lane >> 5;
    const int ci = wid >> 1, qh = wid & 1;
    const bool active = ci * 64 + qh * 32 < u.nq;
    const int cq = u.c0 + ci;
    constexpr int QS = MLA ? 1536 : 1024, HS = MLA ? 96 : 64, ND0 = MLA ? 6 : 4;
    constexpr float THR = 8.f;
    ALAS float* tb = (ALAS float*)(lds + TBL_OFF);
    if (!MLA) { if (tid < 320) tb[tid] = tid < 257 ? (tbl[(size_t)u.head * 257 + tid] - tbl[(size_t)u.head * 257 + 256]) * LOG2E : 0.f; }
    const int qrow = u.qrow0 + (active ? ci * 64 + qh * 32 : 0) + l32;
    bf16x8 qf[ND0];
#pragma unroll
    for (int d0 = 0; d0 < ND0; ++d0) qf[d0] = *(const bf16x8*)(Q + (size_t)qrow * QS + u.head * HS + d0 * 16 + hi * 8);
    const char* kbase = (const char*)(Kn + (size_t)u.krow0 * 1024 + u.head * 64);
    const char* vbase = (const char*)(V + (size_t)u.krow0 * 1024 + u.head * 64);
    const char* rbase = MLA ? (const char*)(Kr + (size_t)u.krow0 * 32) : nullptr;
    const unsigned koff = (unsigned)(((tid >> 3) * 1024 + (tid & 7) * 8) * 2);
    const int vkvq = (tid & 3) + 4 * ((tid >> 6) & 3), vdq = (tid >> 2) & 15;
    const unsigned voff = (unsigned)(((vkvq * 4) * 1024 + vdq * 4) * 2);
    const int vpos8 = (vkvq & ~3) + ((vkvq & 1) << 1) + ((vkvq >> 1) & 1);
    const unsigned roff = (unsigned)(((((tid - 256) >> 2) & 63) * 32 + (tid & 3) * 8) * 2);
    u32x4 kreg[1]; u32x2 vreg[1][4]; u32x4 rreg[1];
#define AT_GLOAD(ti, sx) do { const int tl_ = (ti) < u.nt ? (ti) : u.nt - 1; \
        kreg[sx] = *(const u32x4*)(kbase + (size_t)tl_ * 131072 + koff); \
        if (tid < 256) { const char* vb_ = vbase + (size_t)tl_ * 131072; \
            vreg[sx][0] = *(const u32x2*)(vb_ + voff); vreg[sx][1] = *(const u32x2*)(vb_ + voff + 2048); vreg[sx][2] = *(const u32x2*)(vb_ + 4096 + voff); vreg[sx][3] = *(const u32x2*)(vb_ + 4096 + voff + 2048); } \
        else if (MLA) { rreg[sx] = *(const u32x4*)(rbase + (size_t)tl_ * 4096 + roff); } } while (0)
#define AT_SWRITE(st, sx) do { ALAS unsigned char* sb_ = lds + (st) * STAGE; \
        *(ALAS u32x4*)(sb_ + (tid >> 3) * KROW + (tid & 7) * 16) = kreg[sx]; \
        if (tid < 256) { \
            _Pragma("unroll") for (int jj_ = 0; jj_ < 4; ++jj_) { const int d_ = 4 * vdq + jj_; u32x2 o_; \
                const unsigned sel_ = (jj_ & 1) ? 0x07060302u : 0x05040100u; \
                if (jj_ < 2) { o_.x = __builtin_amdgcn_perm(vreg[sx][1].x, vreg[sx][0].x, sel_); o_.y = __builtin_amdgcn_perm(vreg[sx][3].x, vreg[sx][2].x, sel_); } \
                else         { o_.x = __builtin_amdgcn_perm(vreg[sx][1].y, vreg[sx][0].y, sel_); o_.y = __builtin_amdgcn_perm(vreg[sx][3].y, vreg[sx][2].y, sel_); } \
                *(ALAS u32x2*)(sb_ + KBUF + d_ * VROW + vpos8 * 8) = o_; } } \
        else if (MLA) { const int t2_ = tid - 256; *(ALAS u32x4*)(sb_ + KBUF + VBUF + (t2_ >> 2) * RROW + (t2_ & 3) * 16) = rreg[sx]; } } while (0)
    float mref = 0.f;
    bool first = true;
    f32x16 negm = f32x16{}; asm volatile("" : "+v"(negm));
    f32x16 o0 = f32x16{}, o1 = f32x16{}; float lrun = 0.f;
    f32x16 p[2];
    const int tgl = (qh * 32 + l32 + 128 - 4 * hi) * 4;
#define AT_QK(t, sg) do { const int kc_ = u.tf + (t); ALAS unsigned char* sb_ = lds + (sg) * STAGE; ALAS unsigned char* kb_ = sb_ + l32 * KROW + hi * 16; \
        bool near_ = false; \
        if (!MLA) { near_ = cq - kc_ < 3; \
            if (near_) { ALAS unsigned char* tp_ = (ALAS unsigned char*)tb + tgl + 256 * (cq - kc_); \
                _Pragma("unroll") for (int blk = 0; blk < 2; ++blk) _Pragma("unroll") for (int r = 0; r < 16; ++r) p[blk][r] = *(const ALAS float*)(tp_ - 4 * (32 * blk + (r & 3) + 8 * (r >> 2))) - mref; } } \
        bf16x8 ka_[4], kb2_[4]; ALAS unsigned char* rb_ = sb_ + KBUF + VBUF + l32 * RROW + hi * 16; \
        _Pragma("unroll") for (int d0 = 0; d0 < 4; ++d0) ka_[d0] = *(const ALAS bf16x8*)(kb_ + d0 * 32); \
        _Pragma("unroll") for (int d0 = 0; d0 < 4; ++d0) kb2_[d0] = *(const ALAS bf16x8*)(kb_ + 32 * KROW + d0 * 32); \
        __builtin_amdgcn_sched_barrier(0); \
        if (near_) { p[0] = __builtin_amdgcn_mfma_f32_32x32x16_bf16(ka_[0], qf[0], p[0], 0, 0, 0); p[1] = __builtin_amdgcn_mfma_f32_32x32x16_bf16(kb2_[0], qf[0], p[1], 0, 0, 0); } \
        else       { p[0] = __builtin_amdgcn_mfma_f32_32x32x16_bf16(ka_[0], qf[0], negm, 0, 0, 0); p[1] = __builtin_amdgcn_mfma_f32_32x32x16_bf16(kb2_[0], qf[0], negm, 0, 0, 0); } \
        _Pragma("unroll") for (int d0 = 1; d0 < 4; ++d0) { p[0] = __builtin_amdgcn_mfma_f32_32x32x16_bf16(ka_[d0], qf[d0], p[0], 0, 0, 0); p[1] = __builtin_amdgcn_mfma_f32_32x32x16_bf16(kb2_[d0], qf[d0], p[1], 0, 0, 0); \
            if (MLA && d0 == 1) { ka_[0] = *(const ALAS bf16x8*)(rb_); kb2_[0] = *(const ALAS bf16x8*)(rb_ + 32 * RROW); ka_[1] = *(const ALAS bf16x8*)(rb_ + 32); kb2_[1] = *(const ALAS bf16x8*)(rb_ + 32 * RROW + 32); } } \
        if (MLA) { p[0] = __builtin_amdgcn_mfma_f32_32x32x16_bf16(ka_[0], qf[4], p[0], 0, 0, 0); p[1] = __builtin_amdgcn_mfma_f32_32x32x16_bf16(kb2_[0], qf[4], p[1], 0, 0, 0); \
                   p[0] = __builtin_amdgcn_mfma_f32_32x32x16_bf16(ka_[1], qf[ND0 - 1], p[0], 0, 0, 0); p[1] = __builtin_amdgcn_mfma_f32_32x32x16_bf16(kb2_[1], qf[ND0 - 1], p[1], 0, 0, 0); } \
        if ((t) == u.nt - 1 && u.lastvalid < 64) { _Pragma("unroll") for (int r = 0; r < 16; ++r) p[1][r] = -__builtin_inff(); } } while (0)
#define AT_SMPV(t, sg) do { ALAS unsigned char* vb_ = lds + (sg) * STAGE + KBUF + l32 * VROW + hi * 16; \
        bf16x8 vf_[2][4]; \
        _Pragma("unroll") for (int dblk = 0; dblk < 2; ++dblk) _Pragma("unroll") for (int j = 0; j < 4; ++j) vf_[dblk][j] = *(const ALAS bf16x8*)(vb_ + dblk * 32 * VROW + j * 32); \
        __builtin_amdgcn_sched_barrier(0); \
        float rm = p[0][0]; \
        _Pragma("unroll") for (int r = 1; r < 16; ++r) rm = fmaxf(rm, p[0][r]); \
        _Pragma("unroll") for (int r = 0; r < 16; ++r) rm = fmaxf(rm, p[1][r]); \
        rm = fmaxf(rm, __shfl_xor(rm, 32)); \
        if (first || __any(rm > THR)) { \
            const float dl = first ? rm : fmaxf(rm, 0.f); mref += dl; \
            _Pragma("unroll") for (int r = 0; r < 16; ++r) { p[0][r] -= dl; p[1][r] -= dl; } \
            _Pragma("unroll") for (int r = 0; r < 16; ++r) negm[r] = -mref; \
            asm volatile("" : "+v"(negm)); \
            if (!first) { const float al = __builtin_amdgcn_exp2f(-dl); lrun *= al; \
                _Pragma("unroll") for (int r = 0; r < 16; ++r) { o0[r] *= al; o1[r] *= al; } } \
            first = false; } \
        _Pragma("unroll") for (int blk = 0; blk < 2; ++blk) _Pragma("unroll") for (int r = 0; r < 16; ++r) p[blk][r] = __builtin_amdgcn_exp2f(p[blk][r]); \
        { float ls0 = 0.f, ls1 = 0.f; _Pragma("unroll") for (int r = 0; r < 16; ++r) { ls0 += p[0][r]; ls1 += p[1][r]; } lrun += ls0 + ls1; } \
        bf16x8 pk[4]; \
        _Pragma("unroll") for (int j = 0; j < 4; ++j) { u32x4 w; const int b = j >> 1, r0 = 8 * (j & 1); \
            w.x = pg8::pkbf(p[b][r0 + 0], p[b][r0 + 1]); w.y = pg8::pkbf(p[b][r0 + 2], p[b][r0 + 3]); w.z = pg8::pkbf(p[b][r0 + 4], p[b][r0 + 5]); w.w = pg8::pkbf(p[b][r0 + 6], p[b][r0 + 7]); \
            pk[j] = __builtin_bit_cast(bf16x8, w); } \
        _Pragma("unroll") for (int j = 0; j < 4; ++j) { \
            o0 = __builtin_amdgcn_mfma_f32_32x32x16_bf16(vf_[0][j], pk[j], o0, 0, 0, 0); \
            o1 = __builtin_amdgcn_mfma_f32_32x32x16_bf16(vf_[1][j], pk[j], o1, 0, 0, 0); \
            } } while (0)
#define AT_TAKE(t) (active && (u.tf + (t)) <= cq && (MLA || (u.tf + (t)) >= cq - 8))
    AT_GLOAD(0, 0); AT_SWRITE(0, 0);
    __syncthreads();
    for (int ti = 0; ti < u.nt; ++ti) {
        const bool more = ti + 1 < u.nt;
        if (more) AT_GLOAD(ti + 1, 0);
        if (AT_TAKE(ti)) { AT_QK(ti, ti & 1); AT_SMPV(ti, ti & 1); }
        if (more) AT_SWRITE((ti + 1) & 1, 0);
        __syncthreads();
    }
#undef AT_QK
#undef AT_SMPV
#undef AT_TAKE
    if (active) {
        const float inv = 1.f / (lrun + __shfl_xor(lrun, 32));
        ALAS unsigned char* ot = lds + OSTG_OFF + wid * OSTG_WAVE;
#pragma unroll
        for (int dblk = 0; dblk < 2; ++dblk)
#pragma unroll
            for (int g = 0; g < 4; ++g) { const f32x16& o = dblk == 0 ? o0 : o1;
                *(ALAS f32x4*)(ot + l32 * 272 + (32 * dblk + 8 * g + 4 * hi) * 4) = (f32x4){o[4 * g + 0] * inv, o[4 * g + 1] * inv, o[4 * g + 2] * inv, o[4 * g + 3] * inv}; }
        asm volatile("s_waitcnt lgkmcnt(0)" ::: "memory");
        const size_t rb = (size_t)(qrow - l32) * 1024 + u.head * 64 + (lane & 7) * 8;
#pragma unroll
        for (int i = 0; i < 4; ++i) { const int r = i * 8 + (lane >> 3);
            const f32x4 a0 = *(const ALAS f32x4*)(ot + r * 272 + (lane & 7) * 32), a1 = *(const ALAS f32x4*)(ot + r * 272 + (lane & 7) * 32 + 16);
            const u32x4 zz = *(const u32x4*)(Z + rb + (size_t)r * 1024);
            u32x4 w;
            w.x = pg8::pkbf(a0[0] * __uint_as_float(zz.x << 16), a0[1] * __uint_as_float(zz.x & 0xffff0000u)); w.y = pg8::pkbf(a0[2] * __uint_as_float(zz.y << 16), a0[3] * __uint_as_float(zz.y & 0xffff0000u));
            w.z = pg8::pkbf(a1[0] * __uint_as_float(zz.z << 16), a1[1] * __uint_as_float(zz.z & 0xffff0000u)); w.w = pg8::pkbf(a1[2] * __uint_as_float(zz.w << 16), a1[3] * __uint_as_float(zz.w & 0xffff0000u));
            *(u32x4*)(U + rb + (size_t)r * 1024) = w; }
        asm volatile("s_waitcnt lgkmcnt(0)" ::: "memory");
    }
#undef AT_GLOAD
#undef AT_SWRITE
}
__device__ __forceinline__ bool prompt_unit(int k, int G, int bid, int& bh, int& qb) {
    if (G == 256) { if (k >= 16) return false; const int x = bid & 7, j = bid >> 3; bh = (4 * k + (j >> 3)) * 8 + x; qb = ((j & 7) + k) & 7; return true; }
    const int u = bid + k * G; if (u >= 4096) return false; bh = u >> 3; qb = u & 7; return true;
}
}
#define LAS __attribute__((address_space(3)))
typedef unsigned short bf16;
typedef unsigned v4u __attribute__((ext_vector_type(4)));
typedef unsigned v2u __attribute__((ext_vector_type(2)));
typedef float f32x4 __attribute__((ext_vector_type(4)));
constexpr size_t MiB = 1u << 20;
constexpr size_t WS_MOD = 0;
constexpr size_t MOD_BYTES = 2 * 40 * 3072 * 4;
constexpr size_t WS_BAR = 1 * MiB - 16384;
constexpr size_t WS_CS = 1 * MiB;
constexpr size_t WS_G1 = 2 * MiB;
constexpr size_t WS_SW = 2 * MiB + 256 * 1024;
constexpr size_t WS_SSQ = 3 * MiB;
constexpr size_t WS_SSQQ = 3 * MiB + 320 * 1024, WS_SSQKV = 3 * MiB + 640 * 1024;
constexpr size_t WS_RAW2 = 24 * MiB;
constexpr size_t WS_W_AIN = 4 * MiB, WS_W_AOUT = 12 * MiB, WS_W_BIN = 14 * MiB, WS_W_UQ = 18 * MiB, WS_W_UKV = 20 * MiB, WS_W_BOUT = 22 * MiB;
constexpr size_t WS_H = 24 * MiB;
constexpr size_t WS_CKV = 153 * MiB;
constexpr size_t WS_KR = 194 * MiB;
constexpr size_t WS_X = 200 * MiB;
constexpr size_t WS_QA = WS_X, WS_KA = WS_X + 129 * MiB, WS_VA = WS_X + 267 * MiB, WS_ZA = WS_X + 405 * MiB;
constexpr size_t WS_YG = WS_ZA;
constexpr size_t WS_ZB = WS_X, WS_RAW = WS_X + 129 * MiB, WS_QB = WS_RAW, WS_CQ = WS_X + 322 * MiB, WS_KN = WS_X + 371 * MiB, WS_VB = WS_X + 532 * MiB;
constexpr size_t WS_Y1B = WS_X + 694 * MiB;
constexpr size_t WS_END = WS_Y1B + 129 * MiB;
static_assert((size_t)M1 * 1024 * 2 <= 129 * MiB && (size_t)RA * 1024 * 2 <= 138 * MiB && (size_t)M1 * 768 * 4 <= 193 * MiB && (size_t)M1 * 384 * 2 <= 49 * MiB && (size_t)R2 * 1024 * 2 <= 161 * MiB, "ws map");
static_assert((size_t)R2 * 256 * 2 <= 41 * MiB && (size_t)R2 * 32 * 2 <= 6 * MiB && WS_ZA + 129 * MiB <= WS_END && WS_VB + 161 * MiB <= WS_END && WS_END <= 1024 * MiB, "ws map");
constexpr size_t O_YP = 0, O_YS = 67108864, O_AKP = 67371008, O_AVP = 84148224, O_AKS = 100925440, O_AVS = 101187584, O_CKVP = 101449728, O_KRP = 118226944, O_CKVS = 120324096, O_KRS = 120389632;
constexpr int LDS_TOTAL = 151552, LDS_MISC = 131072 + 320;
static_assert(at::LDS_BYTES <= LDS_TOTAL && pg8::STAGE_BYTES <= LDS_TOTAL && pg8::STG_OFF + 8 * pg8::STG_WAVE <= LDS_TOTAL, "LDS");

__device__ __forceinline__ float wave_sum(float v) {
#pragma unroll
    for (int o = 1; o < 64; o <<= 1) v += __shfl_xor(v, o);
    return v;
}
__device__ __forceinline__ unsigned pk2(float lo, float hi) { return pg8::pkbf(lo, hi); }
__device__ __forceinline__ int src_col(int gemm, int g) {
    const int lc = ((g >> 3) * 8 + (g & 3) * 2 + ((g >> 2) & 1)) * 32;
    switch (gemm) {
    case 2: if (lc < 1024) return 672 + lc; if (lc < 1408) return lc - 1024; if (lc < 1664) return 384 + (lc - 1408); if (lc < 1696) return 640 + (lc - 1664); return -1;
    case 3: if (lc < 1024) return (lc >> 6) * 96 + (lc & 63); return ((lc - 1024) >> 5) * 96 + 64;
    case 4: if (lc < 1024) return (lc >> 6) * 128 + (lc & 63); return ((lc - 1024) >> 6) * 128 + 64 + (lc & 63);
    default: return lc;
    }
}
__device__ __forceinline__ void transpose_item(const float* W, int K, int Nsrc, int sc, bf16* WT, int g, int k0, LAS float* scr, int lane, bool cperm = false) {
    const int jl = lane & 31, sj = cperm ? 16 * ((jl >> 2) & 1) + 4 * (jl >> 3) + (jl & 3) : jl;
#pragma unroll 8
    for (int i = 0; i < 32; ++i) { const int kk = 2 * i + (lane >> 5); scr[kk * 33 + (lane & 31)] = sc >= 0 ? W[(size_t)(k0 + kk) * Nsrc + sc + sj] : 0.f; }
    asm volatile("s_waitcnt lgkmcnt(0)" ::: "memory");
    const int c = lane & 7;
#pragma unroll
    for (int j = 0; j < 4; ++j) { const int n = (lane >> 3) + 8 * j; const LAS float* s = scr + (8 * c) * 33 + n;
        v4u o; o.x = pk2(s[0 * 33], s[1 * 33]); o.y = pk2(s[2 * 33], s[3 * 33]); o.z = pk2(s[4 * 33], s[5 * 33]); o.w = pk2(s[6 * 33], s[7 * 33]);
        *(v4u*)(WT + (size_t)(32 * g + n) * K + k0 + 8 * c) = o; }
    asm volatile("s_waitcnt lgkmcnt(0)" ::: "memory");
}
__device__ __forceinline__ void cvt8(const float* s, bf16* d) { const f32x4 a = *(const f32x4*)s, b = *(const f32x4*)(s + 4); v4u o; o.x = pk2(a[0], a[1]); o.y = pk2(a[2], a[3]); o.z = pk2(b[0], b[1]); o.w = pk2(b[2], b[3]); *(v4u*)d = o; }

#define GAS __attribute__((address_space(1)))
#define RLX_AGENT __ATOMIC_RELAXED, __HIP_MEMORY_SCOPE_AGENT
#define XB_TMO      128
#define XB_XCNT(j)  (256  + 64 * (j))
#define XB_XSUB(j)  (1280 + 64 * (j))
#define XB_XGEN(j)  (2304 + 64 * (j))
#define XB_TOP      3328
#define XB_TOPGEN   3392
#define XCD_BAR_WORDS 3456
#define XB_SPIN_CAP (1u << 18)

__device__ __forceinline__ unsigned xb_ld(unsigned* p)              { return __hip_atomic_load(p, __ATOMIC_RELAXED, __HIP_MEMORY_SCOPE_AGENT); }
__device__ __forceinline__ unsigned xb_add(unsigned* p, unsigned v) { return __hip_atomic_fetch_add(p, v, __ATOMIC_RELAXED, __HIP_MEMORY_SCOPE_AGENT); }
__device__ __forceinline__ unsigned xb_xcc_id() { return (unsigned)__builtin_amdgcn_s_getreg((3 << 11) | 20) & 0xFu; }
#define XB_SPIN(cond, bar) do { unsigned _sp = 0; while (cond) { __builtin_amdgcn_s_sleep(1); \
    if ((++_sp & 255u) == 0u) { if (xb_ld(&(bar)[XB_TMO])) break; if (_sp > XB_SPIN_CAP) { atomicAdd(&(bar)[XB_TMO], 1u); break; } } } } while (0)

struct XcdBarrier {
    unsigned* bar; unsigned x;
    volatile LAS unsigned* st;
};

__device__ __forceinline__ XcdBarrier xcd_barrier_post(unsigned* bar, volatile LAS unsigned* st) {
    XcdBarrier b; b.bar = bar; b.x = xb_xcc_id(); b.st = st;
    if (threadIdx.x == 0) (void)xb_add(&bar[XB_XCNT(b.x)], 1u);
    return b;
}
__device__ __forceinline__ void xcd_barrier_complete(unsigned* bar, unsigned x, unsigned& nloc, unsigned& nx) {
    const unsigned G = gridDim.x * gridDim.y * gridDim.z;
    unsigned sum, cnt, mine, sp = 0u;
    for (;;) {
        sum = 0u; cnt = 0u; mine = 0u;
#pragma unroll
        for (unsigned j = 0; j < 16; ++j) { const unsigned c = xb_ld(&bar[XB_XCNT(j)]); sum += c; cnt += (c > 0u) ? 1u : 0u; mine = (j == x) ? c : mine; }
        if (sum == G) break;
        __builtin_amdgcn_s_sleep(1);
        if ((++sp & 255u) == 0u) { if (xb_ld(&bar[XB_TMO])) break; if (sp > XB_SPIN_CAP) { atomicAdd(&bar[XB_TMO], 1u); break; } }
    }
    nloc = mine > 0u ? mine : 1u; nx = cnt > 0u ? cnt : 1u;
}

__device__ __forceinline__ void xcd_barrier(const XcdBarrier& b) {
    asm volatile("s_waitcnt vmcnt(0)" ::: "memory");
    __syncthreads();
    if (threadIdx.x == 0) {
        unsigned* bar = b.bar;
        __builtin_amdgcn_s_waitcnt(0);
        unsigned nloc = b.st[0], nx = b.st[1];
        if (nloc == 0u) { xcd_barrier_complete(bar, b.x, nloc, nx); b.st[0] = nloc; b.st[1] = nx; }
        const unsigned old = xb_add(&bar[XB_XSUB(b.x)], 1u);
        const unsigned gen = old / nloc;
        if (old + 1u == (gen + 1u) * nloc) {
            __builtin_amdgcn_fence(__ATOMIC_RELEASE, "agent");
            asm volatile("s_waitcnt vmcnt(0)" ::: "memory");
            const unsigned og = xb_add(&bar[XB_TOP], 1u);
            const unsigned tg = og / nx;
            if (og + 1u == (tg + 1u) * nx) xb_add(&bar[XB_TOPGEN], 1u);
            else XB_SPIN(xb_ld(&bar[XB_TOPGEN]) == tg, bar);
            __builtin_amdgcn_fence(__ATOMIC_ACQUIRE, "agent");
            xb_add(&bar[XB_XGEN(b.x)], 1u);
            asm volatile("s_waitcnt vmcnt(0)" ::: "memory");
        } else {
            XB_SPIN(xb_ld(&bar[XB_XGEN(b.x)]) == gen, bar);
            __builtin_amdgcn_fence(__ATOMIC_ACQUIRE, "agent");
            asm volatile("s_waitcnt vmcnt(0)" ::: "memory");
        }
    }
    __syncthreads();
}

struct Args { const float* in[26]; float* out; unsigned char* ws; int ph_lo, ph_hi; };

__device__ __forceinline__ void adanorm_rows(const float* xp, const float* xs, const float* g, const float* mod, bf16* H, int gw, int NGW, int lane) {
    for (int grp = gw; grp < M1 / 4; grp += NGW) {
        const int row0 = grp * 4;
        const float* xr; int bb;
        if (row0 < MP) { xr = xp + (size_t)row0 * 1024; bb = row0 >> 11; } else { xr = xs + (size_t)(row0 - MP) * 1024; bb = NBP + ((row0 - MP) >> 5); }
        const float* md = mod + (size_t)bb * 3072;
        f32x4 v[4][4]; float s[4];
#pragma unroll
        for (int q = 0; q < 4; ++q) { s[q] = 0.f;
#pragma unroll
            for (int j = 0; j < 4; ++j) v[q][j] = *(const f32x4*)(xr + (size_t)q * 1024 + 4 * lane + 256 * j); }
#pragma unroll
        for (int q = 0; q < 4; ++q)
#pragma unroll
            for (int j = 0; j < 4; ++j) s[q] += pg8::ssq4(v[q][j]);
#pragma unroll
        for (int o = 1; o < 64; o <<= 1) {
#pragma unroll
            for (int q = 0; q < 4; ++q) s[q] += __shfl_xor(s[q], o); }
#pragma unroll
        for (int q = 0; q < 4; ++q) s[q] = rsqrtf(s[q] * (1.f / 1024.f) + EPSN);
#pragma unroll
        for (int j = 0; j < 4; ++j) { const int c = 4 * lane + 256 * j;
            const f32x4 gg = *(const f32x4*)(g + c) * (*(const f32x4*)(md + 1024 + c) + 1.f), sh = *(const f32x4*)(md + c);
#pragma unroll
            for (int q = 0; q < 4; ++q) { const f32x4 h = v[q][j] * s[q] * gg + sh;
                v2u o; o.x = pk2(h[0], h[1]); o.y = pk2(h[2], h[3]); *(v2u*)(H + (size_t)(row0 + q) * 1024 + c) = o; } }
    }
}

__global__ void __launch_bounds__(512, 2) hybrid_fwd(Args args) {
    extern __shared__ __attribute__((aligned(16))) unsigned char lds_raw[];
    LAS unsigned char* lds = (LAS unsigned char*)lds_raw;
    const int tid = threadIdx.x, lane = tid & 63, wave = __builtin_amdgcn_readfirstlane(tid >> 6);
    const int G = gridDim.x, bid = blockIdx.x;
    const int gw = bid * 8 + wave, NGW = G * 8;
    const int gt = bid * 512 + tid, NGT = G * 512;
    const int lo = args.ph_lo, hi = args.ph_hi;
    volatile LAS unsigned* MISC = (volatile LAS unsigned*)(lds + LDS_MISC);
    if (tid < 16) MISC[tid] = 0u;
    __syncthreads();
    XcdBarrier bar; bar.bar = nullptr; bar.x = 0; bar.st = nullptr;
    if (hi - lo > 1) { bar = xcd_barrier_post((unsigned*)(args.ws + WS_BAR), MISC + 8); cg::this_grid().sync(); }
#ifndef PHMASK
#define PHMASK 0x7ff
#endif
#ifndef PROBE_SYNC
#define PROBE_SYNC 0
#endif
#ifndef PROBE_REP
#define PROBE_REP 0
#endif
#define REP(k) for (int rep_ = 0; rep_ < 1 + ((PROBE_REP >> (k)) & 1); ++rep_)
#define IN(k) (((PHMASK >> (k)) & 1) && lo <= (k) && (k) < hi)
typedef const __attribute__((address_space(4))) Args* KArgs;
#define PHASE_ARGS() KArgs A = (KArgs)__builtin_amdgcn_kernarg_segment_ptr(); asm volatile("" : "+s"(A)); unsigned char* ws = A->ws; float* out = A->out; (void)ws; (void)out
#define WSP(T, off) ((T*)(ws + (off)))
#define SEAM(k) do { if (IN(k) && IN((k) + 1)) { xcd_barrier(bar); } } while (0)

    if (IN(0)) REP(0) {
        PHASE_ARGS();
        float* mod = WSP(float, WS_MOD); float* CS = WSP(float, WS_CS);
        bf16 *W_AIN = WSP(bf16, WS_W_AIN), *W_AOUT = WSP(bf16, WS_W_AOUT), *W_BIN = WSP(bf16, WS_W_BIN), *W_UQ = WSP(bf16, WS_W_UQ), *W_UKV = WSP(bf16, WS_W_UKV), *W_BOUT = WSP(bf16, WS_W_BOUT);
        bf16 *KA = WSP(bf16, WS_KA), *VA = WSP(bf16, WS_VA), *CKV = WSP(bf16, WS_CKV), *KR = WSP(bf16, WS_KR);
        {
            LAS float* scr = (LAS float*)(lds + wave * 10240);
            constexpr int I0 = 16 * 128, I1 = 16 * 32, I2 = 16 * 56, I3 = 6 * 48, I4 = 4 * 64, I5 = 16 * 32;
            for (int it = gw; it < I0 + I1 + I2 + I3 + I4 + I5; it += NGW) {
                int r = it;
                if (r < I0) { const int g = r % 128; transpose_item(A->in[11], 1024, 4096, src_col(0, g), W_AIN, g, (r / 128) * 64, scr, lane); continue; } r -= I0;
                if (r < I1) { const int g = r % 32; transpose_item(A->in[15], 1024, 1024, src_col(1, g), W_AOUT, g, (r / 32) * 64, scr, lane); continue; } r -= I1;
                if (r < I2) { const int g = r % 56; transpose_item(A->in[16], 1024, 1696, src_col(2, g), W_BIN, g, (r / 56) * 64, scr, lane); continue; } r -= I2;
                if (r < I3) { const int g = r % 48; transpose_item(A->in[18], 384, 1536, src_col(3, g), W_UQ, g, (r / 48) * 64, scr, lane, g >= 32); continue; } r -= I3;
                if (r < I4) { const int g = r % 64; transpose_item(A->in[20], 256, 2048, src_col(4, g), W_UKV, g, (r / 64) * 64, scr, lane); continue; } r -= I4;
                { const int g = r % 32; transpose_item(A->in[25], 1024, 1024, src_col(5, g), W_BOUT, g, (r / 32) * 64, scr, lane); }
            }
        }
        for (int it = bid; it < 2 * 48; it += G) {
            const int l = it / 48, jb = it % 48;
            LAS float* sl = (LAS float*)(lds + wave * 10240);
            float acc[40];
#pragma unroll
            for (int b = 0; b < 40; ++b) acc[b] = 0.f;
            for (int pass = 0; pass < 2; ++pass) {
                const int k0 = (wave + 8 * pass) * 64;
                for (int e = lane; e < 40 * 64; e += 64) { const int bb = e >> 6, k = e & 63; const float c = bb < NBP ? A->in[6][(size_t)bb * 1024 + k0 + k] : A->in[7][(size_t)(bb - NBP) * 1024 + k0 + k]; sl[e] = c / (1.f + __expf(-c)); }
                asm volatile("s_waitcnt lgkmcnt(0)" ::: "memory");
                const float* W = A->in[9] + (size_t)l * 1024 * 3072 + (size_t)k0 * 3072 + jb * 64 + lane;
                for (int k = 0; k < 64; k += 4) {
                    const float w0 = W[(size_t)k * 3072], w1 = W[(size_t)(k + 1) * 3072], w2 = W[(size_t)(k + 2) * 3072], w3 = W[(size_t)(k + 3) * 3072];
#pragma unroll
                    for (int b = 0; b < 40; ++b) { const f32x4 sv = *(const LAS f32x4*)(sl + b * 64 + k); acc[b] += (sv[0] * w0 + sv[1] * w1) + (sv[2] * w2 + sv[3] * w3); }
                }
                asm volatile("s_waitcnt lgkmcnt(0)" ::: "memory");
            }
            __syncthreads();
            LAS float* red = (LAS float*)lds;
#pragma unroll
            for (int b = 0; b < 40; ++b) red[(wave * 40 + b) * 64 + lane] = acc[b];
            __syncthreads();
            for (int e = tid; e < 40 * 64; e += 512) { const int b = e >> 6, j = e & 63; float sum = A->in[10][(size_t)l * 3072 + jb * 64 + j];
#pragma unroll
                for (int w = 0; w < 8; ++w) sum += red[(w * 40 + b) * 64 + j];
                mod[((size_t)l * 40 + b) * 3072 + jb * 64 + j] = sum; }
            __syncthreads();
        }
        for (int i = gt; i < NBS * SA_STRIDE * 128; i += NGT) {
            const int c8 = i & 127, rr = (i >> 7) % SA_STRIDE, bs = (i >> 7) / SA_STRIDE;
            const size_t d = ((size_t)MP + (size_t)bs * SA_STRIDE + rr) * 1024 + c8 * 8;
            if (rr < 512) { const size_t s = ((size_t)bs * 512 + rr) * 1024 + c8 * 8; cvt8(A->in[2] + s, KA + d); cvt8(A->in[3] + s, VA + d); }
            else if (rr >= 544) { *(v4u*)(KA + d) = (v4u){0, 0, 0, 0}; *(v4u*)(VA + d) = (v4u){0, 0, 0, 0}; }
        }
        for (int i = gt; i < NBS * SB_STRIDE * 32; i += NGT) {
            const int c8 = i & 31, rr = (i >> 5) % SB_STRIDE, bs = (i >> 5) / SB_STRIDE;
            const size_t d = ((size_t)MP + (size_t)bs * SB_STRIDE + rr) * 256 + c8 * 8;
            if (rr < 2048) cvt8(A->in[4] + ((size_t)bs * 2048 + rr) * 256 + c8 * 8, CKV + d);
            else if (rr >= 2080) *(v4u*)(CKV + d) = (v4u){0, 0, 0, 0};
        }
        for (int i = gt; i < NBS * SB_STRIDE * 4; i += NGT) {
            const int c8 = i & 3, rr = (i >> 2) % SB_STRIDE, bs = (i >> 2) / SB_STRIDE;
            const size_t d = ((size_t)MP + (size_t)bs * SB_STRIDE + rr) * 32 + c8 * 8;
            if (rr < 2048) cvt8(A->in[5] + ((size_t)bs * 2048 + rr) * 32 + c8 * 8, KR + d);
            else if (rr >= 2080) *(v4u*)(KR + d) = (v4u){0, 0, 0, 0};
        }
        { float* SSQ = WSP(float, WS_SSQ); float* SQ2 = WSP(float, WS_SSQQ); float* SQ3 = WSP(float, WS_SSQKV); for (int i = gt; i < M1; i += NGT) { SSQ[i] = 0.f; SQ2[i] = 0.f; SQ3[i] = 0.f; } }
        for (int i = gt; i < 2112 * 16; i += NGT) {
            const int pos = i >> 4, k = i & 15;
            const float inv = exp2f(-(float)k * (13.287712379549449f / 16.f));
            const float ang = (float)pos * inv;
            const double tr = (double)ang * 0.15915494309189535;
            const float fr = (float)(tr - floor(tr + 0.5));
            CS[pos * 32 + k] = __builtin_amdgcn_cosf(fr); CS[pos * 32 + 16 + k] = __builtin_amdgcn_sinf(fr);
        }
    }
    SEAM(0);
    if (IN(1)) REP(1) { PHASE_ARGS();
        const float* mod1 = WSP(float, WS_MOD) + 40 * 3072;
        {
            float* G1 = WSP(float, WS_G1); const float* g1 = A->in[8] + 1024;
            for (int i = gt; i < 40 * 1024; i += NGT) { const int bb = i >> 10, c = i & 1023; G1[i] = g1[c] * (1.f + mod1[(size_t)bb * 3072 + 1024 + c]); }
            float* SW = WSP(float, WS_SW); const bf16* WB = WSP(bf16, WS_W_BIN);
            for (int lc = gw; lc < 1792; lc += NGW) {
                const int lg = lc >> 5, pn = lg >> 3, rem = lg & 7, crow_ = (pn * 8 + (rem & 1) * 4 + (rem >> 1)) * 32 + (lc & 31);
                const v4u w0 = *(const v4u*)(WB + (size_t)crow_ * 1024 + 16 * lane), w1 = *(const v4u*)(WB + (size_t)crow_ * 1024 + 16 * lane + 8);
                float wf[16];
#pragma unroll
                for (int e = 0; e < 4; ++e) { wf[2 * e] = __uint_as_float(w0[e] << 16); wf[2 * e + 1] = __uint_as_float(w0[e] & 0xffff0000u); wf[8 + 2 * e] = __uint_as_float(w1[e] << 16); wf[8 + 2 * e + 1] = __uint_as_float(w1[e] & 0xffff0000u); }
                for (int bb = 0; bb < 40; ++bb) { const float* sh = mod1 + (size_t)bb * 3072 + 16 * lane; float a = 0.f;
#pragma unroll
                    for (int e = 0; e < 4; ++e) { const f32x4 x = *(const f32x4*)(sh + 4 * e); a += (x[0] * wf[4 * e] + x[1] * wf[4 * e + 1]) + (x[2] * wf[4 * e + 2] + x[3] * wf[4 * e + 3]); }
                    a = wave_sum(a); if (lane == 0) SW[(size_t)bb * 1792 + lc] = a; }
            }
        }
        adanorm_rows(A->in[0], A->in[1], A->in[8], WSP(float, WS_MOD), WSP(bf16, WS_H), gw, NGW, lane); }
    SEAM(1);
    if (IN(2)) REP(2) {
        PHASE_ARGS();
        int Kop = 1024; asm volatile("" : "+s"(Kop)); pg8::Gemm g{WSP(bf16, WS_H), WSP(bf16, WS_W_AIN), M1, 4096, Kop}; pg8::StaticOrder S; S.init(M1, 4096, G, bid);
        pg8::EpiAin E{WSP(bf16, WS_QA), WSP(bf16, WS_KA), WSP(bf16, WS_VA), WSP(bf16, WS_ZA), A->in[12], A->in[13], out + O_AKP, out + O_AVP, out + O_AKS, out + O_AVS, lds + pg8::STG_OFF};
        pg8::gemm_phase<pg8::EpiAin, pg8::StaticOrder, true, true>(lds, g, S, E);
    }
    SEAM(2);
    if (IN(3)) REP(3) {
        PHASE_ARGS();
        bf16 *QA = WSP(bf16, WS_QA), *KA = WSP(bf16, WS_KA), *VA = WSP(bf16, WS_VA), *ZA = WSP(bf16, WS_ZA), *H = WSP(bf16, WS_H); const float* tblp = A->in[14];
        __syncthreads();
        { int bh, qb;
          for (int k = 0; at::prompt_unit(k, G, bid, bh, qb); ++k) {
            at::AttnUnit a; const int b = bh >> 4, c0 = 4 * qb, tf = c0 > 8 ? c0 - 8 : 0;
            a.qrow0 = b * SEQ + 256 * qb; a.nq = 256; a.krow0 = b * SEQ + 64 * tf; a.nt = c0 + 3 - tf + 1; a.lastvalid = 64; a.head = bh & 15; a.c0 = c0; a.tf = tf;
            at::attn_unit<false>(lds, a, QA, KA, nullptr, VA, ZA, H, tblp);
          } }
        for (int s = bid; s < 128; s += G) {
            at::AttnUnit a; const int bs = s >> 4;
            a.qrow0 = MP + bs * TS; a.nq = 32; a.krow0 = MP + bs * SA_STRIDE; a.nt = 9; a.lastvalid = 32; a.head = s & 15; a.c0 = 8; a.tf = 0;
            at::attn_unit<false>(lds, a, QA, KA, nullptr, VA, ZA, H, tblp);
        }
    }
    SEAM(3);
    if (IN(4)) REP(4) {
        PHASE_ARGS();
        int Kop = 1024; asm volatile("" : "+s"(Kop)); pg8::Gemm g{WSP(bf16, WS_H), WSP(bf16, WS_W_AOUT), M1, 1024, Kop}; pg8::StaticOrder S; S.init(M1, 1024, G, bid);
        pg8::EpiRes E{A->in[0], A->in[1], out + O_YP, out + O_YS, WSP(float, WS_MOD) + 2048, WSP(bf16, WS_YG), WSP(float, WS_G1), WSP(float, WS_SSQ), lds + pg8::STG_OFF, nullptr, WSP(bf16, WS_Y1B)};
        pg8::gemm_phase<pg8::EpiRes, pg8::StaticOrder, true, true>(lds, g, S, E);
    }
    if (IN(4) && IN(6)) { xcd_barrier(bar); }
    if (IN(6)) REP(6) {
        PHASE_ARGS();
        int Kop = 1024; asm volatile("" : "+s"(Kop)); pg8::Gemm g{WSP(bf16, WS_YG), WSP(bf16, WS_W_BIN), M1, 1792, Kop}; pg8::StaticOrder S; S.init(M1, 1792, G, bid);
        pg8::EpiBin E{WSP(bf16, WS_ZB), WSP(bf16, WS_CQ), WSP(bf16, WS_CKV), WSP(float, WS_RAW2), WSP(float, WS_SSQ), WSP(float, WS_SW), A->in[17], A->in[19], WSP(float, WS_SSQQ), WSP(float, WS_SSQKV), lds + pg8::STG_OFF};
        pg8::gemm_phase<pg8::EpiBin, pg8::StaticOrder, true, true>(lds, g, S, E);
    }
    if (IN(6) && IN(8)) { xcd_barrier(bar); }
    if (IN(8)) REP(8) {
        { PHASE_ARGS(); int Kop = 384; asm volatile("" : "+s"(Kop)); pg8::Gemm g{WSP(bf16, WS_CQ), WSP(bf16, WS_W_UQ), M1, 1536, Kop}; pg8::StaticOrder S; S.init(M1, 1536, G, bid);
          pg8::EpiUq E{WSP(bf16, WS_QB), A->in[21], A->in[22], WSP(float, WS_CS), WSP(float, WS_SSQQ), lds + pg8::STG_OFF};
          pg8::gemm_phase<pg8::EpiUq, pg8::StaticOrder, true, true>(lds, g, S, E); }
        __syncthreads();
        { PHASE_ARGS(); int Kop = 256; asm volatile("" : "+s"(Kop)); pg8::Gemm g{WSP(bf16, WS_CKV), WSP(bf16, WS_W_UKV), R2, 2048, Kop}; pg8::StaticOrder S; S.init(R2, 2048, G, G - 1 - bid);
          pg8::EpiUkv E{WSP(bf16, WS_KN), WSP(bf16, WS_VB), A->in[23], WSP(float, WS_SSQKV), lds + pg8::STG_OFF};
          pg8::gemm_phase<pg8::EpiUkv, pg8::StaticOrder, true, true>(lds, g, S, E); }
        __syncthreads();
        {
            PHASE_ARGS();
            const float* RAW2 = WSP(float, WS_RAW2); const float* CS = WSP(float, WS_CS); const float* SQ3 = WSP(float, WS_SSQKV); bf16* KR = WSP(bf16, WS_KR); const bf16* CKVb = WSP(bf16, WS_CKV);
            const float* gkr = A->in[24];
            unsigned* wq = (unsigned*)(ws + WS_BAR) + 3600;
            volatile LAS unsigned* slot = (volatile LAS unsigned*)(lds + LDS_MISC + 16);
            for (;;) {
                if (tid == 0) slot[0] = atomicAdd(wq, 1u);
                __syncthreads();
                const unsigned ch = slot[0];
                __syncthreads();
                if (ch >= (unsigned)(M1 / 128)) break;
              for (int rix = 0; rix < 16; ++rix) { const int row = (int)ch * 128 + rix * 8 + wave;
                const float* rw = RAW2 + (size_t)row * 32;
                int pos; size_t drow, orow;
                if (row < MP) { pos = row & (SEQ - 1); drow = (size_t)row; orow = (size_t)row; }
                else { const int rs = row - MP; pos = SEQ + (rs & 31); drow = (size_t)MP + (size_t)(rs >> 5) * SB_STRIDE + 2048 + (rs & 31); orow = (size_t)rs; }
                float* ockv = (row < MP ? out + O_CKVP : out + O_CKVS) + orow * 256;
                float* okr = (row < MP ? out + O_KRP : out + O_KRS) + orow * 32;
                const v2u kw = *(const v2u*)(CKVb + drow * 256 + 4 * lane);
                const f32x4 kv = (f32x4){__uint_as_float(kw.x << 16), __uint_as_float(kw.x & 0xffff0000u), __uint_as_float(kw.y << 16), __uint_as_float(kw.y & 0xffff0000u)};
                const float kr = lane < 32 ? rw[lane] : 0.f;
                float r = rsqrtf(SQ3[row] * (1.f / 256.f) + EPSN);
                *(f32x4*)(ockv + 4 * lane) = kv * r;
                r = rsqrtf(wave_sum(kr * kr) * (1.f / 32.f) + EPSN);
                const float kn = kr * r * (lane < 32 ? gkr[lane] : 0.f);
                const float pr = __shfl_xor(kn, 16);
                const float cs = CS[pos * 32 + (lane & 15)], sn = CS[pos * 32 + 16 + (lane & 15)];
                const float ro = (lane & 16) ? (kn * cs + pr * sn) : (kn * cs - pr * sn);
                if (lane < 32) { okr[lane] = ro; const unsigned b = pk2(ro, 0.f); KR[drow * 32 + lane] = (bf16)(b & 0xffffu); }
              }
            }
        }
    }
    SEAM(8);
    if (IN(9)) REP(9) {
        PHASE_ARGS();
        bf16 *QB = WSP(bf16, WS_QB), *KN = WSP(bf16, WS_KN), *KR = WSP(bf16, WS_KR), *VB = WSP(bf16, WS_VB), *ZB = WSP(bf16, WS_ZB), *H = WSP(bf16, WS_H);
        __syncthreads();
        const bool shed = (G == 256);
        { int bh, qb;
          for (int k = 0; at::prompt_unit(k, G, bid, bh, qb); ++k) {
            if (shed && bid < 128 && k < 8 && qb == 3) continue;
            at::AttnUnit a; const int b = bh >> 4;
            a.qrow0 = b * SEQ + 256 * qb; a.nq = 256; a.krow0 = b * SEQ; a.nt = 4 * qb + 4; a.lastvalid = 64; a.head = bh & 15; a.c0 = 4 * qb; a.tf = 0;
            at::attn_unit<true>(lds, a, QB, KN, KR, VB, ZB, H, nullptr);
          }
          if (shed && bid >= 128) {
            for (int k = 0; k < 8 && at::prompt_unit(k, G, bid - 128, bh, qb); ++k) { if (qb != 3) continue;
              at::AttnUnit a; const int b = bh >> 4;
              a.qrow0 = b * SEQ + 256 * qb; a.nq = 256; a.krow0 = b * SEQ; a.nt = 4 * qb + 4; a.lastvalid = 64; a.head = bh & 15; a.c0 = 4 * qb; a.tf = 0;
              at::attn_unit<true>(lds, a, QB, KN, KR, VB, ZB, H, nullptr); }
          } }
        for (int s = bid; s < 128; s += G) {
            at::AttnUnit a; const int bs = s >> 4;
            a.qrow0 = MP + bs * TS; a.nq = 32; a.krow0 = MP + bs * SB_STRIDE; a.nt = 33; a.lastvalid = 32; a.head = s & 15; a.c0 = 32; a.tf = 0;
            at::attn_unit<true>(lds, a, QB, KN, KR, VB, ZB, H, nullptr);
        }
    }
    SEAM(9);
    if (IN(10)) REP(10) {
        PHASE_ARGS();
        int Kop = 1024; asm volatile("" : "+s"(Kop)); pg8::Gemm g{WSP(bf16, WS_H), WSP(bf16, WS_W_BOUT), M1, 1024, Kop}; pg8::StaticOrder S; S.init(M1, 1024, G, bid);
        pg8::EpiRes E{out + O_YP, out + O_YS, out + O_YP, out + O_YS, WSP(float, WS_MOD) + 40 * 3072 + 2048, nullptr, nullptr, nullptr, lds + pg8::STG_OFF, WSP(bf16, WS_Y1B), nullptr};
        pg8::gemm_phase<pg8::EpiRes, pg8::StaticOrder, true, true>(lds, g, S, E);
    }
#if PROBE_SYNC
    if (hi - lo > 1) { for (int q = 0; q < 18; ++q) cg::this_grid().sync(); }
#endif
#undef IN
#undef SEAM
}

constexpr int N_PHASES = 11;
extern "C" void kernel_launch(void* const* d_in, const int* in_sizes, int n_in, void* d_out, int out_size, void* d_ws, size_t ws_size, hipStream_t stream) {
    static int grid = 0;
    if (grid == 0) {
        if (n_in != 26 || ws_size < WS_END) { fprintf(stderr, "kernel_launch: unexpected inputs (n_in %d, ws %zu, need %zu)\n", n_in, ws_size, (size_t)WS_END); grid = -1; return; }
        int dev = 0, cus = 0, per_cu = 0;
        hipGetDevice(&dev); hipDeviceGetAttribute(&cus, hipDeviceAttributeMultiprocessorCount, dev);
        hipFuncSetAttribute((const void*)hybrid_fwd, hipFuncAttributeMaxDynamicSharedMemorySize, LDS_TOTAL);
        hipOccupancyMaxActiveBlocksPerMultiprocessor(&per_cu, (const void*)hybrid_fwd, 512, LDS_TOTAL);
        if (per_cu < 1) { fprintf(stderr, "kernel_launch: occupancy query says %d blocks per CU\n", per_cu); per_cu = 1; }
        (void)hipGetLastError();
        grid = cus * per_cu;
    }
    if (grid < 0) return;
    hipMemsetAsync((char*)d_ws + WS_BAR, 0, 16384, stream);
    Args a{};
    for (int i = 0; i < 26; ++i) a.in[i] = (const float*)d_in[i];
    a.out = (float*)d_out; a.ws = (unsigned char*)d_ws;
#if MULTI_LAUNCH
    for (int p = 0; p < N_PHASES; ++p) { a.ph_lo = p; a.ph_hi = p + 1; hipLaunchKernelGGL(hybrid_fwd, dim3(grid), dim3(512), LDS_TOTAL, stream, a); }
#else
    a.ph_lo = 0; a.ph_hi = N_PHASES;
    void* kargs[] = {&a};
    hipError_t e = hipLaunchCooperativeKernel((const void*)hybrid_fwd, dim3(grid), dim3(512), kargs, LDS_TOTAL, stream);
    if (e != hipSuccess) fprintf(stderr, "cooperative launch failed: %s (grid %d)\n", hipGetErrorString(e), grid);
#endif
}
```

```cpp
#include <hip/hip_runtime.h>
#include <hip/hip_cooperative_groups.h>
#include <cstdio>
#include <cstdint>
namespace cg = cooperative_groups;
#ifndef MULTI_LAUNCH
#define MULTI_LAUNCH 0
#endif
constexpr int DMODEL = 1024, NBP = 32, SEQ = 2048, NBS = 8, TS = 32;
constexpr int MP = NBP * SEQ;
constexpr int M1 = MP + NBS * TS;
constexpr int SA_STRIDE = 576;
constexpr int RA = MP + NBS * SA_STRIDE;
constexpr int SB_STRIDE = 2112;
constexpr int R2 = MP + NBS * SB_STRIDE;
constexpr float EPSN = 1e-6f;
constexpr float LOG2E = 1.4426950408889634f;
constexpr float QSCALE_A = 0.125f * LOG2E;
constexpr float QSCALE_B = 0.10206207261596575f * LOG2E;
namespace pg8 {
#define PG8_LAS __attribute__((address_space(3)))
typedef unsigned short bf16_t;
typedef short bf16x8 __attribute__((ext_vector_type(8)));
typedef float f32x4 __attribute__((ext_vector_type(4)));
typedef unsigned u32x4 __attribute__((ext_vector_type(4)));
constexpr int BM = 256, BK = 64, HALF = 128, HTB = HALF * BK * 2  , STAGE_BYTES = 8 * HTB, NXCD = 8, WGM = 8;

__host__ __device__ __forceinline__ int lds_byte(int r, int c) { const int st = (r >> 4) * 2 + (c >> 5), rr = r & 15, cc = c & 31, ob = rr * 64 + cc * 2; return st * 1024 + (ob ^ (((ob >> 9) & 1) << 5)); }
__host__ __device__ __forceinline__ void stage_rc(int b, int& R, int& C) { const int st = b / 1024, sb = b % 1024, swz = sb ^ (((sb >> 9) & 1) << 5); R = (st >> 1) * 16 + swz / 64; C = (st & 1) * 32 + (swz % 64) / 2; }
__host__ __device__ __forceinline__ int perm32(int rho) { const int n = rho >> 4, i = rho & 15; return 8 * (i >> 2) + 4 * n + (i & 3); }

struct Unit { int pm, pn; };
struct Gemm { const bf16_t* A; const bf16_t* Bt; int M, N, K; };

struct StaticOrder {
    int nM, nN, nwg, G, c;
    __host__ __device__ void init(int M, int N, int G_, int c_) { nM = M / BM; nN = N / BM; nwg = nM * nN; G = G_; c = c_; }
    __host__ __device__ bool next(int i, Unit& u) const {
        const long L = (long)i * G + c; if (L >= nwg) return false;
        int wgid = (int)L; { const int q = nwg / NXCD, r = nwg % NXCD, xcd = wgid % NXCD, off = wgid / NXCD; wgid = (xcd < r ? xcd * (q + 1) : r * (q + 1) + (xcd - r) * q) + off; }
        const int nig = WGM * nN, gid = wgid / nig, fm = gid * WGM, gsz = (nM - fm) < WGM ? (nM - fm) : WGM;
        u.pm = fm + ((wgid % nig) % gsz); u.pn = (wgid % nig) / gsz; return true;
    }
    __device__ __forceinline__ void a_ready(const Unit&) const {}
    __device__ __forceinline__ void done(const Unit&) const {}
};

__device__ __forceinline__ unsigned cvt_pk_bf16(float lo, float hi) { unsigned r; asm volatile("v_cvt_pk_bf16_f32 %0, %1, %2" : "=v"(r) : "v"(lo), "v"(hi)); return r; }
template <class Epi, class Sched, bool ALIGN_EPI = false, bool SP2 = false>
__device__ __forceinline__ void gemm_phase(PG8_LAS unsigned char* lds, const Gemm g, const Sched& S, const Epi& E) {
    int tid_ = threadIdx.x; asm volatile("" : "+v"(tid_));
    const int tid = tid_, wid = __builtin_amdgcn_readfirstlane(tid >> 6), lane = tid & 63, wr = wid >> 2, wc = wid & 3, fr = lane & 15, fq = lane >> 4;
    const int K = g.K, nt = K / BK;
    unsigned voffA[2], voffB[2];
#pragma unroll
    for (int i = 0; i < 2; ++i) { int R, C; stage_rc(tid * 16 + i * 8192, R, C); const int Rb = Epi::PERM ? ((R & ~31) + perm32(R & 31)) : R;
        voffA[i] = (unsigned)(R * K + C) * 2u; voffB[i] = (unsigned)(Rb * K + C) * 2u; }
    const size_t kstep = (size_t)(BK * 2);
    const size_t hstep = (size_t)HALF * K * 2;
    const size_t tstep = 2 * hstep;
    const unsigned ldsw = (unsigned)wid * 1024u;
    const int aoff = lds_byte(wr * 64 + fr, fq * 8), boff = lds_byte(wc * 32 + fr, fq * 8);
#define PG8_SA(b, h) (((b) * 2 + (h)) * HTB)
#define PG8_SB(b, h) ((4 + (b) * 2 + (h)) * HTB)
#define PG8_STAGE(bufoff, gbase, voff) do { _Pragma("unroll") for (int _i = 0; _i < 2; ++_i) \
        __builtin_amdgcn_global_load_lds((const unsigned*)((const char*)(gbase) + (voff)[_i]), (PG8_LAS unsigned*)(lds + (bufoff) + ldsw + _i * 8192), 16, 0, 0); } while (0)
#define PG8_LDA(dst, b, h) do { _Pragma("unroll") for (int m = 0; m < 4; ++m) _Pragma("unroll") for (int k = 0; k < 2; ++k) dst[m][k] = *(const PG8_LAS bf16x8*)(lds + PG8_SA(b, h) + aoff + m * 2048 + k * 1024); } while (0)
#define PG8_LDB(dst, b, h) do { _Pragma("unroll") for (int n = 0; n < 2; ++n) _Pragma("unroll") for (int k = 0; k < 2; ++k) dst[n][k] = *(const PG8_LAS bf16x8*)(lds + PG8_SB(b, h) + boff + n * 2048 + k * 1024); } while (0)
#define PG8_MMA(ai, bj, At, Bt) do { __builtin_amdgcn_s_setprio(1); _Pragma("unroll") for (int m = 0; m < 4; ++m) _Pragma("unroll") for (int n = 0; n < 2; ++n) _Pragma("unroll") for (int k = 0; k < 2; ++k) \
        acc[ai][bj][m][n] = __builtin_amdgcn_mfma_f32_16x16x32_bf16(Bt[n][k], At[m][k], acc[ai][bj][m][n], 0, 0, 0); __builtin_amdgcn_s_setprio(0); } while (0)
#define PG8_WAIT_V(n) asm volatile("s_waitcnt vmcnt(" #n ")" ::: "memory")
#define PG8_WAIT_L(n) asm volatile("s_waitcnt lgkmcnt(" #n ")" ::: "memory")
#define PG8_BAR __builtin_amdgcn_s_barrier()
#define PG8_SCHED __builtin_amdgcn_sched_barrier(0)
    Unit cur, nxt; int ui = 0;
    if (!S.next(0, cur)) return;
    f32x4 acc[2][2][4][2];
#pragma unroll
    for (int a = 0; a < 2; ++a)
#pragma unroll
        for (int b = 0; b < 2; ++b)
#pragma unroll
            for (int m = 0; m < 4; ++m)
#pragma unroll
                for (int n = 0; n < 2; ++n) acc[a][b][m][n] = (f32x4){0.f, 0.f, 0.f, 0.f};
    bf16x8 At[4][2], B0[2][2], B1[2][2];
    const char* cA = (const char*)g.A + (size_t)cur.pm * tstep; const char* cB = (const char*)g.Bt + (size_t)cur.pn * tstep;
    S.a_ready(cur);
    if constexpr (SP2) {
        PG8_STAGE(PG8_SB(0, 0), cB, voffB); PG8_STAGE(PG8_SB(0, 1), cB + hstep, voffB); PG8_STAGE(PG8_SA(0, 0), cA, voffA); PG8_STAGE(PG8_SA(0, 1), cA + hstep, voffA);
        if (wr == 1) PG8_BAR;
        PG8_WAIT_V(2); PG8_BAR;
        PG8_STAGE(PG8_SB(1, 0), cB + kstep, voffB); PG8_STAGE(PG8_SA(1, 0), cA + kstep, voffA); PG8_STAGE(PG8_SB(1, 1), cB + hstep + kstep, voffB);
        PG8_WAIT_V(6); PG8_BAR;
    } else {
        PG8_STAGE(PG8_SB(0, 0), cB, voffB); PG8_STAGE(PG8_SA(0, 0), cA, voffA); PG8_STAGE(PG8_SB(0, 1), cB + hstep, voffB); PG8_STAGE(PG8_SA(0, 1), cA + hstep, voffA);
        if (wr == 1) PG8_BAR;
        PG8_WAIT_V(4); PG8_BAR;
        PG8_STAGE(PG8_SB(1, 0), cB + kstep, voffB); PG8_STAGE(PG8_SA(1, 0), cA + kstep, voffA); PG8_STAGE(PG8_SB(1, 1), cB + hstep + kstep, voffB);
        PG8_WAIT_V(6); PG8_BAR;
    }
    for (;;) {
        const bool has_next = S.next(ui + 1, nxt);
        const char* nA = has_next ? (const char*)g.A + (size_t)nxt.pm * tstep : cA; const char* nB = has_next ? (const char*)g.Bt + (size_t)nxt.pn * tstep : cB;
        for (int t = 0; t < nt; t += 2) {
            const bool last = (t == nt - 2);
            const char* a1 = cA + (size_t)(t + 1) * kstep;
            const char* a2 = last ? nA : cA + (size_t)(t + 2) * kstep; const char* b2 = last ? nB : cB + (size_t)(t + 2) * kstep;
            const char* a3 = a2 + kstep; const char* b3 = b2 + kstep;
            if (last && has_next) S.a_ready(nxt);
            if constexpr (SP2) {
            PG8_LDB(B0, 0, 0); PG8_LDB(B1, 0, 1); PG8_SCHED; PG8_LDA(At, 0, 0); PG8_STAGE(PG8_SA(1, 1), a1 + hstep, voffA);
            PG8_WAIT_V(8); PG8_WAIT_L(0); PG8_BAR; PG8_MMA(0, 0, At, B0); PG8_MMA(0, 1, At, B1); PG8_BAR; PG8_SCHED;
            PG8_LDA(At, 0, 1); PG8_STAGE(PG8_SB(0, 0), b2, voffB); PG8_STAGE(PG8_SB(0, 1), b2 + hstep, voffB); PG8_STAGE(PG8_SA(0, 0), a2, voffA);
            PG8_WAIT_V(8); PG8_WAIT_L(0); PG8_BAR; PG8_MMA(1, 0, At, B0); PG8_MMA(1, 1, At, B1); PG8_BAR; PG8_SCHED;
            PG8_LDB(B0, 1, 0); PG8_LDB(B1, 1, 1); PG8_SCHED; PG8_LDA(At, 1, 0); PG8_STAGE(PG8_SA(0, 1), a2 + hstep, voffA);
            PG8_WAIT_V(8); PG8_WAIT_L(0); PG8_BAR; PG8_MMA(0, 0, At, B0); PG8_MMA(0, 1, At, B1); PG8_BAR; PG8_SCHED;
            PG8_LDA(At, 1, 1); PG8_STAGE(PG8_SB(1, 0), b3, voffB); PG8_STAGE(PG8_SB(1, 1), b3 + hstep, voffB); PG8_STAGE(PG8_SA(1, 0), a3, voffA);
            PG8_WAIT_V(8); PG8_WAIT_L(0); PG8_BAR; PG8_MMA(1, 0, At, B0); PG8_MMA(1, 1, At, B1); PG8_BAR; PG8_SCHED;
            } else {
            PG8_LDB(B0, 0, 0); PG8_SCHED; PG8_LDA(At, 0, 0); PG8_STAGE(PG8_SA(1, 1), a1 + hstep, voffA);
            PG8_WAIT_L(8); PG8_BAR; PG8_WAIT_L(0); PG8_MMA(0, 0, At, B0); PG8_BAR; PG8_SCHED;
            PG8_LDB(B1, 0, 1); PG8_STAGE(PG8_SB(0, 0), b2, voffB);
            PG8_BAR; PG8_WAIT_L(0); PG8_MMA(0, 1, At, B1); PG8_BAR;
            PG8_LDA(At, 0, 1); PG8_STAGE(PG8_SA(0, 0), a2, voffA);
            PG8_BAR; PG8_WAIT_L(0); PG8_MMA(1, 0, At, B0); PG8_BAR; PG8_SCHED;
            PG8_STAGE(PG8_SB(0, 1), b2 + hstep, voffB);
            PG8_WAIT_V(6); PG8_BAR; PG8_MMA(1, 1, At, B1); PG8_BAR;
            PG8_LDB(B0, 1, 0); PG8_SCHED; PG8_LDA(At, 1, 0); PG8_STAGE(PG8_SA(0, 1), a2 + hstep, voffA);
            PG8_WAIT_L(8); PG8_BAR; PG8_WAIT_L(0); PG8_MMA(0, 0, At, B0); PG8_BAR; PG8_SCHED;
            PG8_LDB(B1, 1, 1); PG8_STAGE(PG8_SB(1, 0), b3, voffB);
            PG8_BAR; PG8_WAIT_L(0); PG8_MMA(0, 1, At, B1); PG8_BAR;
            PG8_LDA(At, 1, 1); PG8_STAGE(PG8_SA(1, 0), a3, voffA);
            PG8_BAR; PG8_WAIT_L(0); PG8_MMA(1, 0, At, B0); PG8_BAR; PG8_SCHED;
            PG8_STAGE(PG8_SB(1, 1), b3 + hstep, voffB);
            PG8_WAIT_V(6); PG8_BAR; PG8_MMA(1, 1, At, B1); PG8_BAR;
            }
        }
        if constexpr (ALIGN_EPI) { if (wr == 0) PG8_BAR; }
        if constexpr (!Epi::AFTER_DRAIN) { E(acc, cur, wr, wc, fr, fq); S.done(cur); }
        if (!has_next) break;
#pragma unroll
        for (int a = 0; a < 2; ++a)
#pragma unroll
            for (int b = 0; b < 2; ++b)
#pragma unroll
                for (int m = 0; m < 4; ++m)
#pragma unroll
                    for (int n = 0; n < 2; ++n) acc[a][b][m][n] = (f32x4){0.f, 0.f, 0.f, 0.f};
        cur = nxt; cA = nA; cB = nB; ++ui;
        if constexpr (ALIGN_EPI) { if (wr == 1) PG8_BAR; }
    }
    PG8_WAIT_V(0);
    if constexpr (!ALIGN_EPI) { if (wr == 0) PG8_BAR; }
    PG8_BAR;
    if constexpr (Epi::AFTER_DRAIN) { E.fused(acc, cur, wr, wc, fr, fq, lds, wid, lane); S.done(cur); }
#undef PG8_SA
#undef PG8_SB
#undef PG8_STAGE
#undef PG8_LDA
#undef PG8_LDB
#undef PG8_MMA
#undef PG8_WAIT_V
#undef PG8_WAIT_L
#undef PG8_BAR
#undef PG8_SCHED
}
typedef unsigned u32x2 __attribute__((ext_vector_type(2)));
typedef float f32x2 __attribute__((ext_vector_type(2)));
typedef __bf16 bf16x2_t __attribute__((ext_vector_type(2)));
__device__ __forceinline__ unsigned pkbf(float lo, float hi) { f32x2 v = {lo, hi}; bf16x2_t b = __builtin_convertvector(v, bf16x2_t); return __builtin_bit_cast(unsigned, b); }
__device__ __forceinline__ u32x2 pk4(f32x4 v) { u32x2 r; r.x = pkbf(v[0], v[1]); r.y = pkbf(v[2], v[3]); return r; }
__device__ __forceinline__ void st8(bf16_t* d, f32x4 a, f32x4 b) { u32x4 w; w.x = pkbf(a[0], a[1]); w.y = pkbf(a[2], a[3]); w.z = pkbf(b[0], b[1]); w.w = pkbf(b[2], b[3]); *(u32x4*)d = w; }
constexpr int STG_OFF = 131072 + 1024, STG_WAVE = 16 * 144;
__device__ __forceinline__ void stg_put(PG8_LAS unsigned char* stg, int fr, int fq, int bj, f32x4 a, f32x4 b) {
    u32x4 w; w.x = pkbf(a[0], a[1]); w.y = pkbf(a[2], a[3]); w.z = pkbf(b[0], b[1]); w.w = pkbf(b[2], b[3]);
    *(PG8_LAS u32x4*)(stg + fr * 144 + 64 * bj + 16 * fq) = w;
}
__device__ __forceinline__ void stg_flush(PG8_LAS unsigned char* stg, int fr, int fq, bf16_t* seg, int stride) {
    const int lane = fr + 16 * fq, r0 = lane >> 3, ch = lane & 7;
    bf16_t* p0 = seg + (r0 - fr) * stride + 8 * ch;
    asm volatile("s_waitcnt lgkmcnt(0)" ::: "memory");
    const u32x4 x0 = *(const PG8_LAS u32x4*)(stg + r0 * 144 + 16 * ch), x1 = *(const PG8_LAS u32x4*)(stg + (r0 + 8) * 144 + 16 * ch);
    *(u32x4*)p0 = x0; *(u32x4*)(p0 + 8 * stride) = x1;
    asm volatile("s_waitcnt lgkmcnt(0)" ::: "memory");
}
__device__ __forceinline__ void st_rows(PG8_LAS unsigned char* stg, int fr, int fq, bf16_t* seg, int stride, f32x4 a0, f32x4 a1, f32x4 b0, f32x4 b1) {
    stg_put(stg, fr, fq, 0, a0, a1); stg_put(stg, fr, fq, 1, b0, b1); stg_flush(stg, fr, fq, seg, stride);
}
__device__ __forceinline__ void stf_rows(PG8_LAS unsigned char* stg, int fr, int fq, float* seg, int stride, f32x4 a, f32x4 b) {
    const int lane = fr + 16 * fq, r0 = lane >> 3, ch = lane & 7;
    *(PG8_LAS f32x4*)(stg + fr * 144 + 32 * fq) = a; *(PG8_LAS f32x4*)(stg + fr * 144 + 32 * fq + 16) = b;
    float* p0 = seg + (r0 - fr) * stride + 4 * ch;
    asm volatile("s_waitcnt lgkmcnt(0)" ::: "memory");
    const f32x4 x0 = *(const PG8_LAS f32x4*)(stg + r0 * 144 + 16 * ch), x1 = *(const PG8_LAS f32x4*)(stg + (r0 + 8) * 144 + 16 * ch);
    *(f32x4*)p0 = x0; *(f32x4*)(p0 + 8 * stride) = x1;
    asm volatile("s_waitcnt lgkmcnt(0)" ::: "memory");
}
__device__ __forceinline__ void ldf_rows(PG8_LAS unsigned char* stg, int fr, int fq, const float* seg, int stride, f32x4& a, f32x4& b) {
    const int lane = fr + 16 * fq, r0 = lane >> 3, ch = lane & 7;
    const float* p0 = seg + (r0 - fr) * stride + 4 * ch;
    const f32x4 x0 = *(const f32x4*)p0, x1 = *(const f32x4*)(p0 + 8 * stride);
    *(PG8_LAS f32x4*)(stg + r0 * 144 + 16 * ch) = x0; *(PG8_LAS f32x4*)(stg + (r0 + 8) * 144 + 16 * ch) = x1;
    asm volatile("s_waitcnt lgkmcnt(0)" ::: "memory");
    a = *(const PG8_LAS f32x4*)(stg + fr * 144 + 32 * fq); b = *(const PG8_LAS f32x4*)(stg + fr * 144 + 32 * fq + 16);
    asm volatile("s_waitcnt lgkmcnt(0)" ::: "memory");
}
__device__ __forceinline__ float silu_f(float v) { return v * __builtin_amdgcn_rcpf(1.f + __expf(-v)); }
__device__ __forceinline__ f32x4 silu4(f32x4 v) { f32x4 o; o[0] = silu_f(v[0]); o[1] = silu_f(v[1]); o[2] = silu_f(v[2]); o[3] = silu_f(v[3]); return o; }
__device__ __forceinline__ float ssq4(f32x4 v) { return (v[0] * v[0] + v[1] * v[1]) + (v[2] * v[2] + v[3] * v[3]); }
__device__ __forceinline__ float red_fq(float s) { s += __shfl_xor(s, 16); s += __shfl_xor(s, 32); return s; }

struct EpiAin {
    static constexpr bool PERM = true, AFTER_DRAIN = false;
    bf16_t *Q, *K, *V, *Z; const float *gq, *gk; float *okp, *ovp, *oks, *ovs; PG8_LAS unsigned char* stg0;
    __device__ __forceinline__ void operator()(const f32x4 (&acc)[2][2][4][2], const Unit& u, int wr, int wc, int fr, int fq) const {
        const int sec = u.pn >> 2, head = (u.pn & 3) * 4 + wc, cb = head * 64 + 8 * fq;
        f32x4 g[2][2];
#pragma unroll
        for (int bj = 0; bj < 2; ++bj)
#pragma unroll
            for (int n = 0; n < 2; ++n) g[bj][n] = (sec < 2) ? *(const f32x4*)((sec == 0 ? gq : gk) + 32 * bj + 4 * n + 8 * fq) : (f32x4){1.f, 1.f, 1.f, 1.f};
#pragma unroll
        for (int ai = 0; ai < 2; ++ai)
#pragma unroll
            for (int m = 0; m < 4; ++m) {
                const int row = u.pm * BM + ai * HALF + wr * 64 + m * 16 + fr;
                f32x4 v[2][2];
#pragma unroll
                for (int bj = 0; bj < 2; ++bj)
#pragma unroll
                    for (int n = 0; n < 2; ++n) v[bj][n] = acc[ai][bj][m][n];
                if (sec < 2) {
                    float s = (ssq4(v[0][0]) + ssq4(v[0][1])) + (ssq4(v[1][0]) + ssq4(v[1][1]));
                    s = red_fq(s);
                    const float r = rsqrtf(s * (1.f / 64.f) + EPSN) * (sec == 0 ? QSCALE_A : 1.f);
#pragma unroll
                    for (int bj = 0; bj < 2; ++bj)
#pragma unroll
                        for (int n = 0; n < 2; ++n) v[bj][n] = v[bj][n] * g[bj][n] * r;
                } else if (sec == 3) {
#pragma unroll
                    for (int bj = 0; bj < 2; ++bj)
#pragma unroll
                        for (int n = 0; n < 2; ++n) v[bj][n] = silu4(v[bj][n]);
                }
                if (sec == 0 || sec == 3) {
                    bf16_t* d = (sec == 0 ? Q : Z) + (size_t)row * 1024 + cb;
                    st_rows(stg0 + (wr * 4 + wc) * STG_WAVE, fr, fq, d - 8 * fq, 1024, v[0][0], v[0][1], v[1][0], v[1][1]);
                } else {
                    size_t drow; float* of = nullptr;
                    if (row < MP) { drow = (size_t)row; const int pos = row & (SEQ - 1); if (pos >= SEQ - 512) of = (sec == 1 ? okp : ovp) + ((size_t)((row >> 11) * 512 + pos - (SEQ - 512))) * 1024; }
                    else { const int rs = row - MP; drow = (size_t)MP + (size_t)(rs >> 5) * SA_STRIDE + 512 + (rs & 31); of = (sec == 1 ? oks : ovs) + (size_t)rs * 1024; }
                    bf16_t* d = (sec == 1 ? K : V) + drow * 1024 + cb;
                    st_rows(stg0 + (wr * 4 + wc) * STG_WAVE, fr, fq, d - 8 * fq, 1024, v[0][0], v[0][1], v[1][0], v[1][1]);
#pragma unroll
                    for (int bj = 0; bj < 2; ++bj) { if (of) stf_rows(stg0 + (wr * 4 + wc) * STG_WAVE, fr, fq, of + cb - 8 * fq + 32 * bj, 1024, v[bj][0], v[bj][1]); }
                }
                asm volatile("" ::: "memory");
            }
    }
};
struct EpiRes {
    static constexpr bool PERM = true, AFTER_DRAIN = false;
    const float *xp, *xs; float *yp, *ys; const float* gate;
    bf16_t* YG; const float* G1; float* ssq;
    PG8_LAS unsigned char* stg0; const bf16_t* xb; bf16_t* yb;
    __device__ __forceinline__ void operator()(const f32x4 (&acc)[2][2][4][2], const Unit& u, int wr, int wc, int fr, int fq) const {
        const int cb = u.pn * 256 + wc * 64 + 8 * fq;
#pragma unroll
        for (int ai = 0; ai < 2; ++ai)
#pragma unroll
            for (int m = 0; m < 4; ++m) {
                const int row = u.pm * BM + ai * HALF + wr * 64 + m * 16 + fr;
                const float* xi; float* yo; int bb;
                if (row < MP) { xi = xp + (size_t)row * 1024; yo = yp + (size_t)row * 1024; bb = row >> 11; }
                else { const int rs = row - MP; xi = xs + (size_t)rs * 1024; yo = ys + (size_t)rs * 1024; bb = NBP + (rs >> 5); }
                const float* gp = gate + (size_t)bb * 3072;
                float sq = 0.f;
                f32x4 ov[2][2];
#pragma unroll
                for (int bj = 0; bj < 2; ++bj) { const int c = cb + 32 * bj;
                    f32x4 x0, x1;
                    if (xb) { const u32x4 w = *(const u32x4*)(xb + (size_t)row * 1024 + c);
                        x0 = (f32x4){__uint_as_float(w.x << 16), __uint_as_float(w.x & 0xffff0000u), __uint_as_float(w.y << 16), __uint_as_float(w.y & 0xffff0000u)};
                        x1 = (f32x4){__uint_as_float(w.z << 16), __uint_as_float(w.z & 0xffff0000u), __uint_as_float(w.w << 16), __uint_as_float(w.w & 0xffff0000u)}; }
                    else ldf_rows(stg0 + (wr * 4 + wc) * STG_WAVE, fr, fq, xi + c - 8 * fq, 1024, x0, x1);
                    ov[bj][0] = x0 + *(const f32x4*)(gp + c) * acc[ai][bj][m][0]; ov[bj][1] = x1 + *(const f32x4*)(gp + c + 4) * acc[ai][bj][m][1];
                    if (!yb) stf_rows(stg0 + (wr * 4 + wc) * STG_WAVE, fr, fq, yo + c - 8 * fq, 1024, ov[bj][0], ov[bj][1]); }
                if (yb) st_rows(stg0 + (wr * 4 + wc) * STG_WAVE, fr, fq, yb + (size_t)row * 1024 + cb - 8 * fq, 1024, ov[0][0], ov[0][1], ov[1][0], ov[1][1]);
                if (YG) { sq = (ssq4(ov[0][0]) + ssq4(ov[0][1])) + (ssq4(ov[1][0]) + ssq4(ov[1][1])); const float* gg = G1 + (size_t)bb * 1024 + cb;
                    st_rows(stg0 + (wr * 4 + wc) * STG_WAVE, fr, fq, YG + (size_t)row * 1024 + cb - 8 * fq, 1024, ov[0][0] * *(const f32x4*)gg, ov[0][1] * *(const f32x4*)(gg + 4), ov[1][0] * *(const f32x4*)(gg + 32), ov[1][1] * *(const f32x4*)(gg + 36)); }
                if (YG) { sq = red_fq(sq); if (fq == 0) atomicAdd(ssq + row, sq); }
                asm volatile("" ::: "memory");
            }
    }
};
struct EpiBin {
    static constexpr bool PERM = true, AFTER_DRAIN = false;
    bf16_t* Z; bf16_t* CQ; bf16_t* CKV; float* RAW2; const float* ssq; const float* SW; const float* gcq; const float* gckv; float* ssqq; float* ssqkv; PG8_LAS unsigned char* stg0;
    __device__ __forceinline__ void operator()(const f32x4 (&acc)[2][2][4][2], const Unit& u, int wr, int wc, int fr, int fq) const {
        const int cb = u.pn * 256 + wc * 64 + 8 * fq;
        const int sidx = (u.pn - 4) * 4 + wc;
#pragma unroll
        for (int ai = 0; ai < 2; ++ai)
#pragma unroll
            for (int m = 0; m < 4; ++m) {
                const int row = u.pm * BM + ai * HALF + wr * 64 + m * 16 + fr;
                const int bb = row < MP ? (row >> 11) : NBP + ((row - MP) >> 5);
                const float r = rsqrtf(ssq[row] * (1.f / 1024.f) + EPSN);
                const float* sw = SW + (size_t)bb * 1792;
                f32x4 v[2][2];
#pragma unroll
                for (int bj = 0; bj < 2; ++bj)
#pragma unroll
                    for (int n = 0; n < 2; ++n) v[bj][n] = acc[ai][bj][m][n] * r + *(const f32x4*)(sw + cb + 32 * bj + 4 * n);
                if (u.pn < 4) {
                    st_rows(stg0 + (wr * 4 + wc) * STG_WAVE, fr, fq, Z + (size_t)row * 1024 + cb - 8 * fq, 1024, silu4(v[0][0]), silu4(v[0][1]), silu4(v[1][0]), silu4(v[1][1]));
                } else if (sidx < 10) {
                    float sq = (ssq4(v[0][0]) + ssq4(v[0][1])) + (ssq4(v[1][0]) + ssq4(v[1][1]));
                    sq = red_fq(sq);
                    if (sidx < 6) {
                        const int c0 = cb - 1024;
                        if (fq == 0) atomicAdd(ssqq + row, sq);
                        st_rows(stg0 + (wr * 4 + wc) * STG_WAVE, fr, fq, CQ + (size_t)row * 384 + c0 - 8 * fq, 384, v[0][0] * *(const f32x4*)(gcq + c0), v[0][1] * *(const f32x4*)(gcq + c0 + 4), v[1][0] * *(const f32x4*)(gcq + c0 + 32), v[1][1] * *(const f32x4*)(gcq + c0 + 36));
                    } else {
                        const int c0 = cb - 1408;
                        const size_t drow = row < MP ? (size_t)row : (size_t)MP + (size_t)((row - MP) >> 5) * SB_STRIDE + 2048 + ((row - MP) & 31);
                        if (fq == 0) atomicAdd(ssqkv + row, sq);
                        st_rows(stg0 + (wr * 4 + wc) * STG_WAVE, fr, fq, CKV + drow * 256 + c0 - 8 * fq, 256, v[0][0] * *(const f32x4*)(gckv + c0), v[0][1] * *(const f32x4*)(gckv + c0 + 4), v[1][0] * *(const f32x4*)(gckv + c0 + 32), v[1][1] * *(const f32x4*)(gckv + c0 + 36));
                    }
                } else if (sidx == 10) {
#pragma unroll
                    for (int n = 0; n < 2; ++n) *(f32x4*)(RAW2 + (size_t)row * 32 + 8 * fq + 4 * n) = v[0][n];
                }
                asm volatile("" ::: "memory");
            }
    }
};
struct EpiUq {
    static constexpr bool PERM = true, AFTER_DRAIN = false;
    bf16_t* Q; const float *gqn, *gqr, *CS; const float* ssqq; PG8_LAS unsigned char* stg0;
    __device__ __forceinline__ void operator()(const f32x4 (&acc)[2][2][4][2], const Unit& u, int wr, int wc, int fr, int fq) const {
        if (u.pn < 4) {
            const int head = u.pn * 4 + wc;
#pragma unroll
            for (int ai = 0; ai < 2; ++ai)
#pragma unroll
                for (int m = 0; m < 4; ++m) {
                    const int row = u.pm * BM + ai * HALF + wr * 64 + m * 16 + fr;
                    float s = (ssq4(acc[ai][0][m][0]) + ssq4(acc[ai][0][m][1])) + (ssq4(acc[ai][1][m][0]) + ssq4(acc[ai][1][m][1]));
                    s = red_fq(s);
                    const float rq = rsqrtf(ssqq[row] * (1.f / 384.f) + EPSN);
                    const float r = rsqrtf(s * rq * rq * (1.f / 64.f) + EPSN) * rq * QSCALE_B;
                    bf16_t* d = Q + (size_t)row * 1536 + head * 96 + 8 * fq;
                    { PG8_LAS unsigned char* sg_ = stg0 + (wr * 4 + wc) * STG_WAVE;
#pragma unroll
                      for (int bj = 0; bj < 2; ++bj) stg_put(sg_, fr, fq, bj, acc[ai][bj][m][0] * *(const f32x4*)(gqn + 32 * bj + 8 * fq) * r, acc[ai][bj][m][1] * *(const f32x4*)(gqn + 32 * bj + 4 + 8 * fq) * r);
                      stg_flush(sg_, fr, fq, d - 8 * fq, 1536); }
                    asm volatile("" ::: "memory");
                }
        } else {
#pragma unroll
            for (int ai = 0; ai < 2; ++ai)
#pragma unroll
                for (int m = 0; m < 4; ++m) {
                    const int row = u.pm * BM + ai * HALF + wr * 64 + m * 16 + fr;
                    const int pos = row < MP ? (row & (SEQ - 1)) : SEQ + ((row - MP) & 31);
                    const float rq = rsqrtf(ssqq[row] * (1.f / 384.f) + EPSN);
#pragma unroll
                    for (int bj = 0; bj < 2; ++bj) {
                        const int hr = (u.pn - 4) * 8 + wc * 2 + bj;
                        float s = ssq4(acc[ai][bj][m][0]) + ssq4(acc[ai][bj][m][1]);
                        s = red_fq(s);
                        const float r = rsqrtf(s * rq * rq * (1.f / 32.f) + EPSN) * rq;
                        const f32x4 x1 = acc[ai][bj][m][0] * *(const f32x4*)(gqr + 4 * fq) * r, x2 = acc[ai][bj][m][1] * *(const f32x4*)(gqr + 16 + 4 * fq) * r;
                        const f32x4 cs = *(const f32x4*)(CS + pos * 32 + 4 * fq), sn = *(const f32x4*)(CS + pos * 32 + 16 + 4 * fq);
                        bf16_t* d = Q + (size_t)row * 1536 + hr * 96 + 64 + 4 * fq;
                        *(u32x2*)d = pk4((x1 * cs - x2 * sn) * QSCALE_B); *(u32x2*)(d + 16) = pk4((x2 * cs + x1 * sn) * QSCALE_B);
                        asm volatile("" ::: "memory");
                    }
                }
        }
    }
};
struct EpiUkv {
    static constexpr bool PERM = true, AFTER_DRAIN = false;
    bf16_t *KN, *VB; const float* gkn; const float* ssqkv; PG8_LAS unsigned char* stg0;
    __device__ __forceinline__ void operator()(const f32x4 (&acc)[2][2][4][2], const Unit& u, int wr, int wc, int fr, int fq) const {
        const bool isk = u.pn < 4; const int head = (u.pn & 3) * 4 + wc;
#pragma unroll
        for (int ai = 0; ai < 2; ++ai)
#pragma unroll
            for (int m = 0; m < 4; ++m) {
                const int row = u.pm * BM + ai * HALF + wr * 64 + m * 16 + fr;
                float rs = 1.f;
                if (u.pm < MP / BM) rs = rsqrtf(ssqkv[row] * (1.f / 256.f) + EPSN);
                else { const int q_ = row - MP, bs_ = q_ / SB_STRIDE, rr_ = q_ - bs_ * SB_STRIDE; if (rr_ >= 2048 && rr_ < 2080) rs = rsqrtf(ssqkv[MP + bs_ * TS + rr_ - 2048] * (1.f / 256.f) + EPSN); }
                float r = rs;
                if (isk) { float s = (ssq4(acc[ai][0][m][0]) + ssq4(acc[ai][0][m][1])) + (ssq4(acc[ai][1][m][0]) + ssq4(acc[ai][1][m][1])); s = red_fq(s); r = rsqrtf(s * rs * rs * (1.f / 64.f) + EPSN) * rs; }
                bf16_t* d = (isk ? KN : VB) + (size_t)row * 1024 + head * 64 + 8 * fq;
                { PG8_LAS unsigned char* sg_ = stg0 + (wr * 4 + wc) * STG_WAVE;
#pragma unroll
                  for (int bj = 0; bj < 2; ++bj) { const f32x4 g0 = isk ? *(const f32x4*)(gkn + 32 * bj + 8 * fq) : (f32x4){1.f, 1.f, 1.f, 1.f}, g1 = isk ? *(const f32x4*)(gkn + 32 * bj + 4 + 8 * fq) : (f32x4){1.f, 1.f, 1.f, 1.f};
                      stg_put(sg_, fr, fq, bj, acc[ai][bj][m][0] * g0 * r, acc[ai][bj][m][1] * g1 * r); }
                  stg_flush(sg_, fr, fq, d - 8 * fq, 1024); }
                asm volatile("" ::: "memory");
            }
    }
};
}
namespace at {
#define ALAS __attribute__((address_space(3)))
typedef unsigned short bf16_t;
typedef short bf16x8 __attribute__((ext_vector_type(8)));
typedef short s16x4 __attribute__((ext_vector_type(4)));
typedef float f32x16 __attribute__((ext_vector_type(16)));
typedef float f32x4 __attribute__((ext_vector_type(4)));
typedef unsigned u32x4 __attribute__((ext_vector_type(4)));
typedef unsigned u32x2 __attribute__((ext_vector_type(2)));
constexpr int KROW = 144, VROW = 144, RROW = 80;
constexpr int KBUF = 64 * KROW, VBUF = 64 * VROW, RBUF = 64 * RROW, STAGE = KBUF + VBUF + RBUF;
constexpr int NSTAGE = 2, TBL_OFF = NSTAGE * STAGE, OSTG_OFF = 49152, OSTG_WAVE = 32 * 272, LDS_BYTES = OSTG_OFF + 8 * OSTG_WAVE;
static_assert(TBL_OFF + 1280 <= OSTG_OFF, "attention LDS map");
struct AttnUnit { int qrow0, nq, krow0, nt, lastvalid, head, c0, tf; };
__device__ __forceinline__ int crow(int r, int hi) { return (r & 3) + 8 * (r >> 2) + 4 * hi; }

template <bool MLA>
__device__ __forceinline__ void attn_unit(ALAS unsigned char* lds, const AttnUnit u, const bf16_t* __restrict__ Q, const bf16_t* __restrict__ Kn, const bf16_t* __restrict__ Kr,
                                          const bf16_t* __restrict__ V, const bf16_t* __restrict__ Z, bf16_t* __restrict__ U, const float* __restrict__ tbl) {
    int tid_ = threadIdx.x; asm volatile("" : "+v"(tid_));
    const int tid = tid_, lane = tid & 63, wid = __builtin_amdgcn_readfirstlane(tid >> 6), l32 = lane & 31, hi = lane >> 5;
    const int ci = wid >> 1, qh = wid & 1;
    const bool active = ci * 64 + qh * 32 < u.nq;
    const int cq = u.c0 + ci;
    constexpr int QS = MLA ? 1536 : 1024, HS = MLA ? 96 : 64, ND0 = MLA ? 6 : 4;
    constexpr float THR = 8.f;
    ALAS float* tb = (ALAS float*)(lds + TBL_OFF);
    if (!MLA) { if (tid < 320) tb[tid] = tid < 257 ? (tbl[(size_t)u.head * 257 + tid] - tbl[(size_t)u.head * 257 + 256]) * LOG2E : 0.f; }
    const int qrow = u.qrow0 + (active ? ci * 64 + qh * 32 : 0) + l32;
    bf16x8 qf[ND0];
#pragma unroll
    for (int d0 = 0; d0 < ND0; ++d0) qf[d0] = *(const bf16x8*)(Q + (size_t)qrow * QS + u.head * HS + d0 * 16 + hi * 8);
    const char* kbase = (const char*)(Kn + (size_t)u.krow0 * 1024 + u.head * 64);
    const char* vbase = (const char*)(V + (size_t)u.krow0 * 1024 + u.head * 64);
    const char* rbase = MLA ? (const char*)(Kr + (size_t)u.krow0 * 32) : nullptr;
    const unsigned koff = (unsigned)(((tid >> 3) * 1024 + (tid & 7) * 8) * 2);
    const int vkvq = (tid & 3) + 4 * ((tid >> 6) & 3), vdq = (tid >> 2) & 15;
    const unsigned voff = (unsigned)(((vkvq * 4) * 1024 + vdq * 4) * 2);
    const int vpos8 = (vkvq & ~3) + ((vkvq & 1) << 1) + ((vkvq >> 1) & 1);
    const unsigned roff = (unsigned)(((((tid - 256) >> 2) & 63) * 32 + (tid & 3) * 8) * 2);
    u32x4 kreg[1]; u32x2 vreg[1][4]; u32x4 rreg[1];
#define AT_GLOAD(ti, sx) do { const int tl_ = (ti) < u.nt ? (ti) : u.nt - 1; \
        kreg[sx] = *(const u32x4*)(kbase + (size_t)tl_ * 131072 + koff); \
        if (tid < 256) { const char* vb_ = vbase + (size_t)tl_ * 131072; \
            vreg[sx][0] = *(const u32x2*)(vb_ + voff); vreg[sx][1] = *(const u32x2*)(vb_ + voff + 2048); vreg[sx][2] = *(const u32x2*)(vb_ + 4096 + voff); vreg[sx][3] = *(const u32x2*)(vb_ + 4096 + voff + 2048); } \
        else if (MLA) { rreg[sx] = *(const u32x4*)(rbase + (size_t)tl_ * 4096 + roff); } } while (0)
#define AT_SWRITE(st, sx) do { ALAS unsigned char* sb_ = lds + (st) * STAGE; \
        *(ALAS u32x4*)(sb_ + (tid >> 3) * KROW + (tid & 7) * 16) = kreg[sx]; \
        if (tid < 256) { \
            _Pragma("unroll") for (int jj_ = 0; jj_ < 4; ++jj_) { const int d_ = 4 * vdq + jj_; u32x2 o_; \
                const unsigned sel_ = (jj_ & 1) ? 0x07060302u : 0x05040100u; \
                if (jj_ < 2) { o_.x = __builtin_amdgcn_perm(vreg[sx][1].x, vreg[sx][0].x, sel_); o_.y = __builtin_amdgcn_perm(vreg[sx][3].x, vreg[sx][2].x, sel_); } \
                else         { o_.x = __builtin_amdgcn_perm(vreg[sx][1].y, vreg[sx][0].y, sel_); o_.y = __builtin_amdgcn_perm(vreg[sx][3].y, vreg[sx][2].y, sel_); } \
                *(ALAS u32x2*)(sb_ + KBUF + d_ * VROW + vpos8 * 8) = o_; } } \
        else if (MLA) { const int t2_ = tid - 256; *(ALAS u32x4*)(sb_ + KBUF + VBUF + (t2_ >> 2) * RROW + (t2_ & 3) * 16) = rreg[sx]; } } while (0)
    float mref = 0.f;
    bool first = true;
    f32x16 negm = f32x16{}; asm volatile("" : "+v"(negm));
    f32x16 o0 = f32x16{}, o1 = f32x16{}; float lrun = 0.f;
    f32x16 p[2];
    const int tgl = (qh * 32 + l32 + 128 - 4 * hi) * 4;
#define AT_QK(t, sg) do { const int kc_ = u.tf + (t); ALAS unsigned char* sb_ = lds + (sg) * STAGE; ALAS unsigned char* kb_ = sb_ + l32 * KROW + hi * 16; \
        bool near_ = false; \
        if (!MLA) { near_ = cq - kc_ < 3; \
            if (near_) { ALAS unsigned char* tp_ = (ALAS unsigned char*)tb + tgl + 256 * (cq - kc_); \
                _Pragma("unroll") for (int blk = 0; blk < 2; ++blk) _Pragma("unroll") for (int r = 0; r < 16; ++r) p[blk][r] = *(const ALAS float*)(tp_ - 4 * (32 * blk + (r & 3) + 8 * (r >> 2))) - mref; } } \
        bf16x8 ka_[4], kb2_[4]; ALAS unsigned char* rb_ = sb_ + KBUF + VBUF + l32 * RROW + hi * 16; \
        _Pragma("unroll") for (int d0 = 0; d0 < 4; ++d0) ka_[d0] = *(const ALAS bf16x8*)(kb_ + d0 * 32); \
        _Pragma("unroll") for (int d0 = 0; d0 < 4; ++d0) kb2_[d0] = *(const ALAS bf16x8*)(kb_ + 32 * KROW + d0 * 32); \
        __builtin_amdgcn_sched_barrier(0); \
        if (near_) { p[0] = __builtin_amdgcn_mfma_f32_32x32x16_bf16(ka_[0], qf[0], p[0], 0, 0, 0); p[1] = __builtin_amdgcn_mfma_f32_32x32x16_bf16(kb2_[0], qf[0], p[1], 0, 0, 0); } \
        else       { p[0] = __builtin_amdgcn_mfma_f32_32x32x16_bf16(ka_[0], qf[0], negm, 0, 0, 0); p[1] = __builtin_amdgcn_mfma_f32_32x32x16_bf16(kb2_[0], qf[0], negm, 0, 0, 0); } \
        _Pragma("unroll") for (int d0 = 1; d0 < 4; ++d0) { p[0] = __builtin_amdgcn_mfma_f32_32x32x16_bf16(ka_[d0], qf[d0], p[0], 0, 0, 0); p[1] = __builtin_amdgcn_mfma_f32_32x32x16_bf16(kb2_[d0], qf[d0], p[1], 0, 0, 0); \
            if (MLA && d0 == 1) { ka_[0] = *(const ALAS bf16x8*)(rb_); kb2_[0] = *(const ALAS bf16x8*)(rb_ + 32 * RROW); ka_[1] = *(const ALAS bf16x8*)(rb_ + 32); kb2_[1] = *(const ALAS bf16x8*)(rb_ + 32 * RROW + 32); } } \
        if (MLA) { p[0] = __builtin_amdgcn_mfma_f32_32x32x16_bf16(ka_[0], qf[4], p[0], 0, 0, 0); p[1] = __builtin_amdgcn_mfma_f32_32x32x16_bf16(kb2_[0], qf[4], p[1], 0, 0, 0); \
                   p[0] = __builtin_amdgcn_mfma_f32_32x32x16_bf16(ka_[1], qf[ND0 - 1], p[0], 0, 0, 0); p[1] = __builtin_amdgcn_mfma_f32_32x32x16_bf16(kb2_[1], qf[ND0 - 1], p[1], 0, 0, 0); } \
        if ((t) == u.nt - 1 && u.lastvalid < 64) { _Pragma("unroll") for (int r = 0; r < 16; ++r) p[1][r] = -__builtin_inff(); } } while (0)
#define AT_SMPV(t, sg) do { ALAS unsigned char* vb_ = lds + (sg) * STAGE + KBUF + l32 * VROW + hi * 16; \
        bf16x8 vf_[2][4]; \
        _Pragma("unroll") for (int dblk = 0; dblk < 2; ++dblk) _Pragma("unroll") for (int j = 0; j < 4; ++j) vf_[dblk][j] = *(const ALAS bf16x8*)(vb_ + dblk * 32 * VROW + j * 32); \
        __builtin_amdgcn_sched_barrier(0); \
        float rm = p[0][0]; \
        _Pragma("unroll") for (int r = 1; r < 16; ++r) rm = fmaxf(rm, p[0][r]); \
        _Pragma("unroll") for (int r = 0; r < 16; ++r) rm = fmaxf(rm, p[1][r]); \
        rm = fmaxf(rm, __shfl_xor(rm, 32)); \
        if (first || __any(rm > THR)) { \
            const float dl = first ? rm : fmaxf(rm, 0.f); mref += dl; \
            _Pragma("unroll") for (int r = 0; r < 16; ++r) { p[0][r] -= dl; p[1][r] -= dl; } \
            _Pragma("unroll") for (int r = 0; r < 16; ++r) negm[r] = -mref; \
            asm volatile("" : "+v"(negm)); \
            if (!first) { const float al = __builtin_amdgcn_exp2f(-dl); lrun *= al; \
                _Pragma("unroll") for (int r = 0; r < 16; ++r) { o0[r] *= al; o1[r] *= al; } } \
            first = false; } \
        _Pragma("unroll") for (int blk = 0; blk < 2; ++blk) _Pragma("unroll") for (int r = 0; r < 16; ++r) p[blk][r] = __builtin_amdgcn_exp2f(p[blk][r]); \
        { float ls0 = 0.f, ls1 = 0.f; _Pragma("unroll") for (int r = 0; r < 16; ++r) { ls0 += p[0][r]; ls1 += p[1][r]; } lrun += ls0 + ls1; } \
        bf16x8 pk[4]; \
        _Pragma("unroll") for (int j = 0; j < 4; ++j) { u32x4 w; const int b = j >> 1, r0 = 8 * (j & 1); \
            w.x = pg8::pkbf(p[b][r0 + 0], p[b][r0 + 1]); w.y = pg8::pkbf(p[b][r0 + 2], p[b][r0 + 3]); w.z = pg8::pkbf(p[b][r0 + 4], p[b][r0 + 5]); w.w = pg8::pkbf(p[b][r0 + 6], p[b][r0 + 7]); \
            pk[j] = __builtin_bit_cast(bf16x8, w); } \
        _Pragma("unroll") for (int j = 0; j < 4; ++j) { \
            o0 = __builtin_amdgcn_mfma_f32_32x32x16_bf16(vf_[0][j], pk[j], o0, 0, 0, 0); \
            o1 = __builtin_amdgcn_mfma_f32_32x32x16_bf16(vf_[1][j], pk[j], o1, 0, 0, 0); \
            } } while (0)
#define AT_TAKE(t) (active && (u.tf + (t)) <= cq && (MLA || (u.tf + (t)) >= cq - 8))
    AT_GLOAD(0, 0); AT_SWRITE(0, 0);
    __syncthreads();
    for (int ti = 0; ti < u.nt; ++ti) {
        const bool more = ti + 1 < u.nt;
        if (more) AT_GLOAD(ti + 1, 0);
        if (AT_TAKE(ti)) { AT_QK(ti, ti & 1); AT_SMPV(ti, ti & 1); }
        if (more) AT_SWRITE((ti + 1) & 1, 0);
        __syncthreads();
    }
#undef AT_QK
#undef AT_SMPV
#undef AT_TAKE
    if (active) {
        const float inv = 1.f / (lrun + __shfl_xor(lrun, 32));
        ALAS unsigned char* ot = lds + OSTG_OFF + wid * OSTG_WAVE;
#pragma unroll
        for (int dblk = 0; dblk < 2; ++dblk)
#pragma unroll
            for (int g = 0; g < 4; ++g) { const f32x16& o = dblk == 0 ? o0 : o1;
                *(ALAS f32x4*)(ot + l32 * 272 + (32 * dblk + 8 * g + 4 * hi) * 4) = (f32x4){o[4 * g + 0] * inv, o[4 * g + 1] * inv, o[4 * g + 2] * inv, o[4 * g + 3] * inv}; }
        asm volatile("s_waitcnt lgkmcnt(0)" ::: "memory");
        const size_t rb = (size_t)(qrow - l32) * 1024 + u.head * 64 + (lane & 7) * 8;
#pragma unroll
        for (int i = 0; i < 4; ++i) { const int r = i * 8 + (lane >> 3);
            const f32x4 a0 = *(const ALAS f32x4*)(ot + r * 272 + (lane & 7) * 32), a1 = *(const ALAS f32x4*)(ot + r * 272 + (lane & 7) * 32 + 16);
            const u32x4 zz = *(const u32x4*)(Z + rb + (size_t)r * 1024);
            u32x4 w;
            w.x = pg8::pkbf(a0[0] * __uint_as_float(zz.x << 16), a0[1] * __uint_as_float(zz.x & 0xffff0000u)); w.y = pg8::pkbf(a0[2] * __uint_as_float(zz.y << 16), a0[3] * __uint_as_float(zz.y & 0xffff0000u));
            w.z = pg8::pkbf(a1[0] * __uint_as_float(zz.z << 16), a1[1] * __uint_as_float(zz.z & 0xffff0000u)); w.w = pg8::pkbf(a1[2] * __uint_as_float(zz.w << 16), a1[3] * __uint_as_float(zz.w & 0xffff0000u));
            *(u32x4*)(U + rb + (size_t)r * 1024) = w; }
        asm volatile("s_waitcnt lgkmcnt(0)" ::: "memory");
    }
#undef AT_GLOAD
#undef AT_SWRITE
}
__device__ __forceinline__ bool prompt_unit(int k, int G, int bid, int& bh, int& qb) {
    if (G == 256) { if (k >= 16) return false; const int x = bid & 7, j = bid >> 3; bh = (4 * k + (j >> 3)) * 8 + x; qb = ((j & 7) + k) & 7; return true; }
    const int u = bid + k * G; if (u >= 4096) return false; bh = u >> 3; qb = u & 7; return true;
}
}
#define LAS __attribute__((address_space(3)))
typedef unsigned short bf16;
typedef unsigned v4u __attribute__((ext_vector_type(4)));
typedef unsigned v2u __attribute__((ext_vector_type(2)));
typedef float f32x4 __attribute__((ext_vector_type(4)));
constexpr size_t MiB = 1u << 20;
constexpr size_t WS_MOD = 0;
constexpr size_t MOD_BYTES = 2 * 40 * 3072 * 4;
constexpr size_t WS_BAR = 1 * MiB - 16384;
constexpr size_t WS_CS = 1 * MiB;
constexpr size_t WS_G1 = 2 * MiB;
constexpr size_t WS_SW = 2 * MiB + 256 * 1024;
constexpr size_t WS_SSQ = 3 * MiB;
constexpr size_t WS_SSQQ = 3 * MiB + 320 * 1024, WS_SSQKV = 3 * MiB + 640 * 1024;
constexpr size_t WS_RAW2 = 24 * MiB;
constexpr size_t WS_W_AIN = 4 * MiB, WS_W_AOUT = 12 * MiB, WS_W_BIN = 14 * MiB, WS_W_UQ = 18 * MiB, WS_W_UKV = 20 * MiB, WS_W_BOUT = 22 * MiB;
constexpr size_t WS_H = 24 * MiB;
constexpr size_t WS_CKV = 153 * MiB;
constexpr size_t WS_KR = 194 * MiB;
constexpr size_t WS_X = 200 * MiB;
constexpr size_t WS_QA = WS_X, WS_KA = WS_X + 129 * MiB, WS_VA = WS_X + 267 * MiB, WS_ZA = WS_X + 405 * MiB;
constexpr size_t WS_YG = WS_ZA;
constexpr size_t WS_ZB = WS_X, WS_RAW = WS_X + 129 * MiB, WS_QB = WS_RAW, WS_CQ = WS_X + 322 * MiB, WS_KN = WS_X + 371 * MiB, WS_VB = WS_X + 532 * MiB;
constexpr size_t WS_Y1B = WS_X + 694 * MiB;
constexpr size_t WS_END = WS_Y1B + 129 * MiB;
static_assert((size_t)M1 * 1024 * 2 <= 129 * MiB && (size_t)RA * 1024 * 2 <= 138 * MiB && (size_t)M1 * 768 * 4 <= 193 * MiB && (size_t)M1 * 384 * 2 <= 49 * MiB && (size_t)R2 * 1024 * 2 <= 161 * MiB, "ws map");
static_assert((size_t)R2 * 256 * 2 <= 41 * MiB && (size_t)R2 * 32 * 2 <= 6 * MiB && WS_ZA + 129 * MiB <= WS_END && WS_VB + 161 * MiB <= WS_END && WS_END <= 1024 * MiB, "ws map");
constexpr size_t O_YP = 0, O_YS = 67108864, O_AKP = 67371008, O_AVP = 84148224, O_AKS = 100925440, O_AVS = 101187584, O_CKVP = 101449728, O_KRP = 118226944, O_CKVS = 120324096, O_KRS = 120389632;
constexpr int LDS_TOTAL = 151552, LDS_MISC = 131072 + 320;
static_assert(at::LDS_BYTES <= LDS_TOTAL && pg8::STAGE_BYTES <= LDS_TOTAL && pg8::STG_OFF + 8 * pg8::STG_WAVE <= LDS_TOTAL, "LDS");

__device__ __forceinline__ float wave_sum(float v) {
#pragma unroll
    for (int o = 1; o < 64; o <<= 1) v += __shfl_xor(v, o);
    return v;
}
__device__ __forceinline__ unsigned pk2(float lo, float hi) { return pg8::pkbf(lo, hi); }
__device__ __forceinline__ int src_col(int gemm, int g) {
    const int lc = ((g >> 3) * 8 + (g & 3) * 2 + ((g >> 2) & 1)) * 32;
    switch (gemm) {
    case 2: if (lc < 1024) return 672 + lc; if (lc < 1408) return lc - 1024; if (lc < 1664) return 384 + (lc - 1408); if (lc < 1696) return 640 + (lc - 1664); return -1;
    case 3: if (lc < 1024) return (lc >> 6) * 96 + (lc & 63); return ((lc - 1024) >> 5) * 96 + 64;
    case 4: if (lc < 1024) return (lc >> 6) * 128 + (lc & 63); return ((lc - 1024) >> 6) * 128 + 64 + (lc & 63);
    default: return lc;
    }
}
__device__ __forceinline__ void transpose_item(const float* W, int K, int Nsrc, int sc, bf16* WT, int g, int k0, LAS float* scr, int lane, bool cperm = false) {
    const int jl = lane & 31, sj = cperm ? 16 * ((jl >> 2) & 1) + 4 * (jl >> 3) + (jl & 3) : jl;
#pragma unroll 8
    for (int i = 0; i < 32; ++i) { const int kk = 2 * i + (lane >> 5); scr[kk * 33 + (lane & 31)] = sc >= 0 ? W[(size_t)(k0 + kk) * Nsrc + sc + sj] : 0.f; }
    asm volatile("s_waitcnt lgkmcnt(0)" ::: "memory");
    const int c = lane & 7;
#pragma unroll
    for (int j = 0; j < 4; ++j) { const int n = (lane >> 3) + 8 * j; const LAS float* s = scr + (8 * c) * 33 + n;
        v4u o; o.x = pk2(s[0 * 33], s[1 * 33]); o.y = pk2(s[2 * 33], s[3 * 33]); o.z = pk2(s[4 * 33], s[5 * 33]); o.w = pk2(s[6 * 33], s[7 * 33]);
        *(v4u*)(WT + (size_t)(32 * g + n) * K + k0 + 8 * c) = o; }
    asm volatile("s_waitcnt lgkmcnt(0)" ::: "memory");
}
__device__ __forceinline__ void cvt8(const float* s, bf16* d) { const f32x4 a = *(const f32x4*)s, b = *(const f32x4*)(s + 4); v4u o; o.x = pk2(a[0], a[1]); o.y = pk2(a[2], a[3]); o.z = pk2(b[0], b[1]); o.w = pk2(b[2], b[3]); *(v4u*)d = o; }

#define GAS __attribute__((address_space(1)))
#define RLX_AGENT __ATOMIC_RELAXED, __HIP_MEMORY_SCOPE_AGENT
#define XB_TMO      128
#define XB_XCNT(j)  (256  + 64 * (j))
#define XB_XSUB(j)  (1280 + 64 * (j))
#define XB_XGEN(j)  (2304 + 64 * (j))
#define XB_TOP      3328
#define XB_TOPGEN   3392
#define XCD_BAR_WORDS 3456
#define XB_SPIN_CAP (1u << 18)

__device__ __forceinline__ unsigned xb_ld(unsigned* p)              { return __hip_atomic_load(p, __ATOMIC_RELAXED, __HIP_MEMORY_SCOPE_AGENT); }
__device__ __forceinline__ unsigned xb_add(unsigned* p, unsigned v) { return __hip_atomic_fetch_add(p, v, __ATOMIC_RELAXED, __HIP_MEMORY_SCOPE_AGENT); }
__device__ __forceinline__ unsigned xb_xcc_id() { return (unsigned)__builtin_amdgcn_s_getreg((3 << 11) | 20) & 0xFu; }
#define XB_SPIN(cond, bar) do { unsigned _sp = 0; while (cond) { __builtin_amdgcn_s_sleep(1); \
    if ((++_sp & 255u) == 0u) { if (xb_ld(&(bar)[XB_TMO])) break; if (_sp > XB_SPIN_CAP) { atomicAdd(&(bar)[XB_TMO], 1u); break; } } } } while (0)

struct XcdBarrier {
    unsigned* bar; unsigned x;
    volatile LAS unsigned* st;
};

__device__ __forceinline__ XcdBarrier xcd_barrier_post(unsigned* bar, volatile LAS unsigned* st) {
    XcdBarrier b; b.bar = bar; b.x = xb_xcc_id(); b.st = st;
    if (threadIdx.x == 0) (void)xb_add(&bar[XB_XCNT(b.x)], 1u);
    return b;
}
__device__ __forceinline__ void xcd_barrier_complete(unsigned* bar, unsigned x, unsigned& nloc, unsigned& nx) {
    const unsigned G = gridDim.x * gridDim.y * gridDim.z;
    unsigned sum, cnt, mine, sp = 0u;
    for (;;) {
        sum = 0u; cnt = 0u; mine = 0u;
#pragma unroll
        for (unsigned j = 0; j < 16; ++j) { const unsigned c = xb_ld(&bar[XB_XCNT(j)]); sum += c; cnt += (c > 0u) ? 1u : 0u; mine = (j == x) ? c : mine; }
        if (sum == G) break;
        __builtin_amdgcn_s_sleep(1);
        if ((++sp & 255u) == 0u) { if (xb_ld(&bar[XB_TMO])) break; if (sp > XB_SPIN_CAP) { atomicAdd(&bar[XB_TMO], 1u); break; } }
    }
    nloc = mine > 0u ? mine : 1u; nx = cnt > 0u ? cnt : 1u;
}

__device__ __forceinline__ void xcd_barrier(const XcdBarrier& b) {
    asm volatile("s_waitcnt vmcnt(0)" ::: "memory");
    __syncthreads();
    if (threadIdx.x == 0) {
        unsigned* bar = b.bar;
        __builtin_amdgcn_s_waitcnt(0);
        unsigned nloc = b.st[0], nx = b.st[1];
        if (nloc == 0u) { xcd_barrier_complete(bar, b.x, nloc, nx); b.st[0] = nloc; b.st[1] = nx; }
        const unsigned old = xb_add(&bar[XB_XSUB(b.x)], 1u);
        const unsigned gen = old / nloc;
        if (old + 1u == (gen + 1u) * nloc) {
            __builtin_amdgcn_fence(__ATOMIC_RELEASE, "agent");
            asm volatile("s_waitcnt vmcnt(0)" ::: "memory");
            const unsigned og = xb_add(&bar[XB_TOP], 1u);
            const unsigned tg = og / nx;
            if (og + 1u == (tg + 1u) * nx) xb_add(&bar[XB_TOPGEN], 1u);
            else XB_SPIN(xb_ld(&bar[XB_TOPGEN]) == tg, bar);
            __builtin_amdgcn_fence(__ATOMIC_ACQUIRE, "agent");
            xb_add(&bar[XB_XGEN(b.x)], 1u);
            asm volatile("s_waitcnt vmcnt(0)" ::: "memory");
        } else {
            XB_SPIN(xb_ld(&bar[XB_XGEN(b.x)]) == gen, bar);
            __builtin_amdgcn_fence(__ATOMIC_ACQUIRE, "agent");
            asm volatile("s_waitcnt vmcnt(0)" ::: "memory");
        }
    }
    __syncthreads();
}

struct Args { const float* in[26]; float* out; unsigned char* ws; int ph_lo, ph_hi; };

__device__ __forceinline__ void adanorm_rows(const float* xp, const float* xs, const float* g, const float* mod, bf16* H, int gw, int NGW, int lane) {
    for (int grp = gw; grp < M1 / 4; grp += NGW) {
        const int row0 = grp * 4;
        const float* xr; int bb;
        if (row0 < MP) { xr = xp + (size_t)row0 * 1024; bb = row0 >> 11; } else { xr = xs + (size_t)(row0 - MP) * 1024; bb = NBP + ((row0 - MP) >> 5); }
        const float* md = mod + (size_t)bb * 3072;
        f32x4 v[4][4]; float s[4];
#pragma unroll
        for (int q = 0; q < 4; ++q) { s[q] = 0.f;
#pragma unroll
            for (int j = 0; j < 4; ++j) v[q][j] = *(const f32x4*)(xr + (size_t)q * 1024 + 4 * lane + 256 * j); }
#pragma unroll
        for (int q = 0; q < 4; ++q)
#pragma unroll
            for (int j = 0; j < 4; ++j) s[q] += pg8::ssq4(v[q][j]);
#pragma unroll
        for (int o = 1; o < 64; o <<= 1) {
#pragma unroll
            for (int q = 0; q < 4; ++q) s[q] += __shfl_xor(s[q], o); }
#pragma unroll
        for (int q = 0; q < 4; ++q) s[q] = rsqrtf(s[q] * (1.f / 1024.f) + EPSN);
#pragma unroll
        for (int j = 0; j < 4; ++j) { const int c = 4 * lane + 256 * j;
            const f32x4 gg = *(const f32x4*)(g + c) * (*(const f32x4*)(md + 1024 + c) + 1.f), sh = *(const f32x4*)(md + c);
#pragma unroll
            for (int q = 0; q < 4; ++q) { const f32x4 h = v[q][j] * s[q] * gg + sh;
                v2u o; o.x = pk2(h[0], h[1]); o.y = pk2(h[2], h[3]); *(v2u*)(H + (size_t)(row0 + q) * 1024 + c) = o; } }
    }
}

__global__ void __launch_bounds__(512, 2) hybrid_fwd(Args args) {
    extern __shared__ __attribute__((aligned(16))) unsigned char lds_raw[];
    LAS unsigned char* lds = (LAS unsigned char*)lds_raw;
    const int tid = threadIdx.x, lane = tid & 63, wave = __builtin_amdgcn_readfirstlane(tid >> 6);
    const int G = gridDim.x, bid = blockIdx.x;
    const int gw = bid * 8 + wave, NGW = G * 8;
    const int gt = bid * 512 + tid, NGT = G * 512;
    const int lo = args.ph_lo, hi = args.ph_hi;
    volatile LAS unsigned* MISC = (volatile LAS unsigned*)(lds + LDS_MISC);
    if (tid < 16) MISC[tid] = 0u;
    __syncthreads();
    XcdBarrier bar; bar.bar = nullptr; bar.x = 0; bar.st = nullptr;
    if (hi - lo > 1) { bar = xcd_barrier_post((unsigned*)(args.ws + WS_BAR), MISC + 8); cg::this_grid().sync(); }
#ifndef PHMASK
#define PHMASK 0x7ff
#endif
#ifndef PROBE_SYNC
#define PROBE_SYNC 0
#endif
#ifndef PROBE_REP
#define PROBE_REP 0
#endif
#define REP(k) for (int rep_ = 0; rep_ < 1 + ((PROBE_REP >> (k)) & 1); ++rep_)
#define IN(k) (((PHMASK >> (k)) & 1) && lo <= (k) && (k) < hi)
typedef const __attribute__((address_space(4))) Args* KArgs;
#define PHASE_ARGS() KArgs A = (KArgs)__builtin_amdgcn_kernarg_segment_ptr(); asm volatile("" : "+s"(A)); unsigned char* ws = A->ws; float* out = A->out; (void)ws; (void)out
#define WSP(T, off) ((T*)(ws + (off)))
#define SEAM(k) do { if (IN(k) && IN((k) + 1)) { xcd_barrier(bar); } } while (0)

    if (IN(0)) REP(0) {
        PHASE_ARGS();
        float* mod = WSP(float, WS_MOD); float* CS = WSP(float, WS_CS);
        bf16 *W_AIN = WSP(bf16, WS_W_AIN), *W_AOUT = WSP(bf16, WS_W_AOUT), *W_BIN = WSP(bf16, WS_W_BIN), *W_UQ = WSP(bf16, WS_W_UQ), *W_UKV = WSP(bf16, WS_W_UKV), *W_BOUT = WSP(bf16, WS_W_BOUT);
        bf16 *KA = WSP(bf16, WS_KA), *VA = WSP(bf16, WS_VA), *CKV = WSP(bf16, WS_CKV), *KR = WSP(bf16, WS_KR);
        {
            LAS float* scr = (LAS float*)(lds + wave * 10240);
            constexpr int I0 = 16 * 128, I1 = 16 * 32, I2 = 16 * 56, I3 = 6 * 48, I4 = 4 * 64, I5 = 16 * 32;
            for (int it = gw; it < I0 + I1 + I2 + I3 + I4 + I5; it += NGW) {
                int r = it;
                if (r < I0) { const int g = r % 128; transpose_item(A->in[11], 1024, 4096, src_col(0, g), W_AIN, g, (r / 128) * 64, scr, lane); continue; } r -= I0;
                if (r < I1) { const int g = r % 32; transpose_item(A->in[15], 1024, 1024, src_col(1, g), W_AOUT, g, (r / 32) * 64, scr, lane); continue; } r -= I1;
                if (r < I2) { const int g = r % 56; transpose_item(A->in[16], 1024, 1696, src_col(2, g), W_BIN, g, (r / 56) * 64, scr, lane); continue; } r -= I2;
                if (r < I3) { const int g = r % 48; transpose_item(A->in[18], 384, 1536, src_col(3, g), W_UQ, g, (r / 48) * 64, scr, lane, g >= 32); continue; } r -= I3;
                if (r < I4) { const int g = r % 64; transpose_item(A->in[20], 256, 2048, src_col(4, g), W_UKV, g, (r / 64) * 64, scr, lane); continue; } r -= I4;
                { const int g = r % 32; transpose_item(A->in[25], 1024, 1024, src_col(5, g), W_BOUT, g, (r / 32) * 64, scr, lane); }
            }
        }
        for (int it = bid; it < 2 * 48; it += G) {
            const int l = it / 48, jb = it % 48;
            LAS float* sl = (LAS float*)(lds + wave * 10240);
            float acc[40];
#pragma unroll
            for (int b = 0; b < 40; ++b) acc[b] = 0.f;
            for (int pass = 0; pass < 2; ++pass) {
                const int k0 = (wave + 8 * pass) * 64;
                for (int e = lane; e < 40 * 64; e += 64) { const int bb = e >> 6, k = e & 63; const float c = bb < NBP ? A->in[6][(size_t)bb * 1024 + k0 + k] : A->in[7][(size_t)(bb - NBP) * 1024 + k0 + k]; sl[e] = c / (1.f + __expf(-c)); }
                asm volatile("s_waitcnt lgkmcnt(0)" ::: "memory");
                const float* W = A->in[9] + (size_t)l * 1024 * 3072 + (size_t)k0 * 3072 + jb * 64 + lane;
                for (int k = 0; k < 64; k += 4) {
                    const float w0 = W[(size_t)k * 3072], w1 = W[(size_t)(k + 1) * 3072], w2 = W[(size_t)(k + 2) * 3072], w3 = W[(size_t)(k + 3) * 3072];
#pragma unroll
                    for (int b = 0; b < 40; ++b) { const f32x4 sv = *(const LAS f32x4*)(sl + b * 64 + k); acc[b] += (sv[0] * w0 + sv[1] * w1) + (sv[2] * w2 + sv[3] * w3); }
                }
                asm volatile("s_waitcnt lgkmcnt(0)" ::: "memory");
            }
            __syncthreads();
            LAS float* red = (LAS float*)lds;
#pragma unroll
            for (int b = 0; b < 40; ++b) red[(wave * 40 + b) * 64 + lane] = acc[b];
            __syncthreads();
            for (int e = tid; e < 40 * 64; e += 512) { const int b = e >> 6, j = e & 63; float sum = A->in[10][(size_t)l * 3072 + jb * 64 + j];
#pragma unroll
                for (int w = 0; w < 8; ++w) sum += red[(w * 40 + b) * 64 + j];
                mod[((size_t)l * 40 + b) * 3072 + jb * 64 + j] = sum; }
            __syncthreads();
        }
        for (int i = gt; i < NBS * SA_STRIDE * 128; i += NGT) {
            const int c8 = i & 127, rr = (i >> 7) % SA_STRIDE, bs = (i >> 7) / SA_STRIDE;
            const size_t d = ((size_t)MP + (size_t)bs * SA_STRIDE + rr) * 1024 + c8 * 8;
            if (rr < 512) { const size_t s = ((size_t)bs * 512 + rr) * 1024 + c8 * 8; cvt8(A->in[2] + s, KA + d); cvt8(A->in[3] + s, VA + d); }
            else if (rr >= 544) { *(v4u*)(KA + d) = (v4u){0, 0, 0, 0}; *(v4u*)(VA + d) = (v4u){0, 0, 0, 0}; }
        }
        for (int i = gt; i < NBS * SB_STRIDE * 32; i += NGT) {
            const int c8 = i & 31, rr = (i >> 5) % SB_STRIDE, bs = (i >> 5) / SB_STRIDE;
            const size_t d = ((size_t)MP + (size_t)bs * SB_STRIDE + rr) * 256 + c8 * 8;
            if (rr < 2048) cvt8(A->in[4] + ((size_t)bs * 2048 + rr) * 256 + c8 * 8, CKV + d);
            else if (rr >= 2080) *(v4u*)(CKV + d) = (v4u){0, 0, 0, 0};
        }
        for (int i = gt; i < NBS * SB_STRIDE * 4; i += NGT) {
            const int c8 = i & 3, rr = (i >> 2) % SB_STRIDE, bs = (i >> 2) / SB_STRIDE;
            const size_t d = ((size_t)MP + (size_t)bs * SB_STRIDE + rr) * 32 + c8 * 8;
            if (rr < 2048) cvt8(A->in[5] + ((size_t)bs * 2048 + rr) * 32 + c8 * 8, KR + d);
            else if (rr >= 2080) *(v4u*)(KR + d) = (v4u){0, 0, 0, 0};
        }
        { float* SSQ = WSP(float, WS_SSQ); float* SQ2 = WSP(float, WS_SSQQ); float* SQ3 = WSP(float, WS_SSQKV); for (int i = gt; i < M1; i += NGT) { SSQ[i] = 0.f; SQ2[i] = 0.f; SQ3[i] = 0.f; } }
        for (int i = gt; i < 2112 * 16; i += NGT) {
            const int pos = i >> 4, k = i & 15;
            const float inv = exp2f(-(float)k * (13.287712379549449f / 16.f));
            const float ang = (float)pos * inv;
            const double tr = (double)ang * 0.15915494309189535;
            const float fr = (float)(tr - floor(tr + 0.5));
            CS[pos * 32 + k] = __builtin_amdgcn_cosf(fr); CS[pos * 32 + 16 + k] = __builtin_amdgcn_sinf(fr);
        }
    }
    SEAM(0);
    if (IN(1)) REP(1) { PHASE_ARGS();
        const float* mod1 = WSP(float, WS_MOD) + 40 * 3072;
        {
            float* G1 = WSP(float, WS_G1); const float* g1 = A->in[8] + 1024;
            for (int i = gt; i < 40 * 1024; i += NGT) { const int bb = i >> 10, c = i & 1023; G1[i] = g1[c] * (1.f + mod1[(size_t)bb * 3072 + 1024 + c]); }
            float* SW = WSP(float, WS_SW); const bf16* WB = WSP(bf16, WS_W_BIN);
            for (int lc = gw; lc < 1792; lc += NGW) {
                const int lg = lc >> 5, pn = lg >> 3, rem = lg & 7, crow_ = (pn * 8 + (rem & 1) * 4 + (rem >> 1)) * 32 + (lc & 31);
                const v4u w0 = *(const v4u*)(WB + (size_t)crow_ * 1024 + 16 * lane), w1 = *(const v4u*)(WB + (size_t)crow_ * 1024 + 16 * lane + 8);
                float wf[16];
#pragma unroll
                for (int e = 0; e < 4; ++e) { wf[2 * e] = __uint_as_float(w0[e] << 16); wf[2 * e + 1] = __uint_as_float(w0[e] & 0xffff0000u); wf[8 + 2 * e] = __uint_as_float(w1[e] << 16); wf[8 + 2 * e + 1] = __uint_as_float(w1[e] & 0xffff0000u); }
                for (int bb = 0; bb < 40; ++bb) { const float* sh = mod1 + (size_t)bb * 3072 + 16 * lane; float a = 0.f;
#pragma unroll
                    for (int e = 0; e < 4; ++e) { const f32x4 x = *(const f32x4*)(sh + 4 * e); a += (x[0] * wf[4 * e] + x[1] * wf[4 * e + 1]) + (x[2] * wf[4 * e + 2] + x[3] * wf[4 * e + 3]); }
                    a = wave_sum(a); if (lane == 0) SW[(size_t)bb * 1792 + lc] = a; }
            }
        }
        adanorm_rows(A->in[0], A->in[1], A->in[8], WSP(float, WS_MOD), WSP(bf16, WS_H), gw, NGW, lane); }
    SEAM(1);
    if (IN(2)) REP(2) {
        PHASE_ARGS();
        int Kop = 1024; asm volatile("" : "+s"(Kop)); pg8::Gemm g{WSP(bf16, WS_H), WSP(bf16, WS_W_AIN), M1, 4096, Kop}; pg8::StaticOrder S; S.init(M1, 4096, G, bid);
        pg8::EpiAin E{WSP(bf16, WS_QA), WSP(bf16, WS_KA), WSP(bf16, WS_VA), WSP(bf16, WS_ZA), A->in[12], A->in[13], out + O_AKP, out + O_AVP, out + O_AKS, out + O_AVS, lds + pg8::STG_OFF};
        pg8::gemm_phase<pg8::EpiAin, pg8::StaticOrder, true, true>(lds, g, S, E);
    }
    SEAM(2);
    if (IN(3)) REP(3) {
        PHASE_ARGS();
        bf16 *QA = WSP(bf16, WS_QA), *KA = WSP(bf16, WS_KA), *VA = WSP(bf16, WS_VA), *ZA = WSP(bf16, WS_ZA), *H = WSP(bf16, WS_H); const float* tblp = A->in[14];
        __syncthreads();
        { int bh, qb;
          for (int k = 0; at::prompt_unit(k, G, bid, bh, qb); ++k) {
            at::AttnUnit a; const int b = bh >> 4, c0 = 4 * qb, tf = c0 > 8 ? c0 - 8 : 0;
            a.qrow0 = b * SEQ + 256 * qb; a.nq = 256; a.krow0 = b * SEQ + 64 * tf; a.nt = c0 + 3 - tf + 1; a.lastvalid = 64; a.head = bh & 15; a.c0 = c0; a.tf = tf;
            at::attn_unit<false>(lds, a, QA, KA, nullptr, VA, ZA, H, tblp);
          } }
        for (int s = bid; s < 128; s += G) {
            at::AttnUnit a; const int bs = s >> 4;
            a.qrow0 = MP + bs * TS; a.nq = 32; a.krow0 = MP + bs * SA_STRIDE; a.nt = 9; a.lastvalid = 32; a.head = s & 15; a.c0 = 8; a.tf = 0;
            at::attn_unit<false>(lds, a, QA, KA, nullptr, VA, ZA, H, tblp);
        }
    }
    SEAM(3);
    if (IN(4)) REP(4) {
        PHASE_ARGS();
        int Kop = 1024; asm volatile("" : "+s"(Kop)); pg8::Gemm g{WSP(bf16, WS_H), WSP(bf16, WS_W_AOUT), M1, 1024, Kop}; pg8::StaticOrder S; S.init(M1, 1024, G, bid);
        pg8::EpiRes E{A->in[0], A->in[1], out + O_YP, out + O_YS, WSP(float, WS_MOD) + 2048, WSP(bf16, WS_YG), WSP(float, WS_G1), WSP(float, WS_SSQ), lds + pg8::STG_OFF, nullptr, WSP(bf16, WS_Y1B)};
        pg8::gemm_phase<pg8::EpiRes, pg8::StaticOrder, true, true>(lds, g, S, E);
    }
    if (IN(4) && IN(6)) { xcd_barrier(bar); }
    if (IN(6)) REP(6) {
        PHASE_ARGS();
        int Kop = 1024; asm volatile("" : "+s"(Kop)); pg8::Gemm g{WSP(bf16, WS_YG), WSP(bf16, WS_W_BIN), M1, 1792, Kop}; pg8::StaticOrder S; S.init(M1, 1792, G, bid);
        pg8::EpiBin E{WSP(bf16, WS_ZB), WSP(bf16, WS_CQ), WSP(bf16, WS_CKV), WSP(float, WS_RAW2), WSP(float, WS_SSQ), WSP(float, WS_SW), A->in[17], A->in[19], WSP(float, WS_SSQQ), WSP(float, WS_SSQKV), lds + pg8::STG_OFF};
        pg8::gemm_phase<pg8::EpiBin, pg8::StaticOrder, true, true>(lds, g, S, E);
    }
    if (IN(6) && IN(8)) { xcd_barrier(bar); }
    if (IN(8)) REP(8) {
        { PHASE_ARGS(); int Kop = 384; asm volatile("" : "+s"(Kop)); pg8::Gemm g{WSP(bf16, WS_CQ), WSP(bf16, WS_W_UQ), M1, 1536, Kop}; pg8::StaticOrder S; S.init(M1, 1536, G, bid);
          pg8::EpiUq E{WSP(bf16, WS_QB), A->in[21], A->in[22], WSP(float, WS_CS), WSP(float, WS_SSQQ), lds + pg8::STG_OFF};
          pg8::gemm_phase<pg8::EpiUq, pg8::StaticOrder, true, true>(lds, g, S, E); }
        __syncthreads();
        { PHASE_ARGS(); int Kop = 256; asm volatile("" : "+s"(Kop)); pg8::Gemm g{WSP(bf16, WS_CKV), WSP(bf16, WS_W_UKV), R2, 2048, Kop}; pg8::StaticOrder S; S.init(R2, 2048, G, G - 1 - bid);
          pg8::EpiUkv E{WSP(bf16, WS_KN), WSP(bf16, WS_VB), A->in[23], WSP(float, WS_SSQKV), lds + pg8::STG_OFF};
          pg8::gemm_phase<pg8::EpiUkv, pg8::StaticOrder, true, true>(lds, g, S, E); }
        __syncthreads();
        {
            PHASE_ARGS();
            const float* RAW2 = WSP(float, WS_RAW2); const float* CS = WSP(float, WS_CS); const float* SQ3 = WSP(float, WS_SSQKV); bf16* KR = WSP(bf16, WS_KR); const bf16* CKVb = WSP(bf16, WS_CKV);
            const float* gkr = A->in[24];
            unsigned* wq = (unsigned*)(ws + WS_BAR) + 3600;
            volatile LAS unsigned* slot = (volatile LAS unsigned*)(lds + LDS_MISC + 16);
            for (;;) {
                if (tid == 0) slot[0] = atomicAdd(wq, 1u);
                __syncthreads();
                const unsigned ch = slot[0];
                __syncthreads();
                if (ch >= (unsigned)(M1 / 128)) break;
              for (int rix = 0; rix < 16; ++rix) { const int row = (int)ch * 128 + rix * 8 + wave;
                const float* rw = RAW2 + (size_t)row * 32;
                int pos; size_t drow, orow;
                if (row < MP) { pos = row & (SEQ - 1); drow = (size_t)row; orow = (size_t)row; }
                else { const int rs = row - MP; pos = SEQ + (rs & 31); drow = (size_t)MP + (size_t)(rs >> 5) * SB_STRIDE + 2048 + (rs & 31); orow = (size_t)rs; }
                float* ockv = (row < MP ? out + O_CKVP : out + O_CKVS) + orow * 256;
                float* okr = (row < MP ? out + O_KRP : out + O_KRS) + orow * 32;
                const v2u kw = *(const v2u*)(CKVb + drow * 256 + 4 * lane);
                const f32x4 kv = (f32x4){__uint_as_float(kw.x << 16), __uint_as_float(kw.x & 0xffff0000u), __uint_as_float(kw.y << 16), __uint_as_float(kw.y & 0xffff0000u)};
                const float kr = lane < 32 ? rw[lane] : 0.f;
                float r = rsqrtf(SQ3[row] * (1.f / 256.f) + EPSN);
                *(f32x4*)(ockv + 4 * lane) = kv * r;
                r = rsqrtf(wave_sum(kr * kr) * (1.f / 32.f) + EPSN);
                const float kn = kr * r * (lane < 32 ? gkr[lane] : 0.f);
                const float pr = __shfl_xor(kn, 16);
                const float cs = CS[pos * 32 + (lane & 15)], sn = CS[pos * 32 + 16 + (lane & 15)];
                const float ro = (lane & 16) ? (kn * cs + pr * sn) : (kn * cs - pr * sn);
                if (lane < 32) { okr[lane] = ro; const unsigned b = pk2(ro, 0.f); KR[drow * 32 + lane] = (bf16)(b & 0xffffu); }
              }
            }
        }
    }
    SEAM(8);
    if (IN(9)) REP(9) {
        PHASE_ARGS();
        bf16 *QB = WSP(bf16, WS_QB), *KN = WSP(bf16, WS_KN), *KR = WSP(bf16, WS_KR), *VB = WSP(bf16, WS_VB), *ZB = WSP(bf16, WS_ZB), *H = WSP(bf16, WS_H);
        __syncthreads();
        const bool shed = (G == 256);
        { int bh, qb;
          for (int k = 0; at::prompt_unit(k, G, bid, bh, qb); ++k) {
            if (shed && bid < 128 && k < 8 && qb == 3) continue;
            at::AttnUnit a; const int b = bh >> 4;
            a.qrow0 = b * SEQ + 256 * qb; a.nq = 256; a.krow0 = b * SEQ; a.nt = 4 * qb + 4; a.lastvalid = 64; a.head = bh & 15; a.c0 = 4 * qb; a.tf = 0;
            at::attn_unit<true>(lds, a, QB, KN, KR, VB, ZB, H, nullptr);
          }
          if (shed && bid >= 128) {
            for (int k = 0; k < 8 && at::prompt_unit(k, G, bid - 128, bh, qb); ++k) { if (qb != 3) continue;
              at::AttnUnit a; const int b = bh >> 4;
              a.qrow0 = b * SEQ + 256 * qb; a.nq = 256; a.krow0 = b * SEQ; a.nt = 4 * qb + 4; a.lastvalid = 64; a.head = bh & 15; a.c0 = 4 * qb; a.tf = 0;
              at::attn_unit<true>(lds, a, QB, KN, KR, VB, ZB, H, nullptr); }
          } }
        for (int s = bid; s < 128; s += G) {
            at::AttnUnit a; const int bs = s >> 4;
            a.qrow0 = MP + bs * TS; a.nq = 32; a.krow0 = MP + bs * SB_STRIDE; a.nt = 33; a.lastvalid = 32; a.head = s & 15; a.c0 = 32; a.tf = 0;
            at::attn_unit<true>(lds, a, QB, KN, KR, VB, ZB, H, nullptr);
        }
    }
    SEAM(9);
    if (IN(10)) REP(10) {
        PHASE_ARGS();
        int Kop = 1024; asm volatile("" : "+s"(Kop)); pg8::Gemm g{WSP(bf16, WS_H), WSP(bf16, WS_W_BOUT), M1, 1024, Kop}; pg8::StaticOrder S; S.init(M1, 1024, G, bid);
        pg8::EpiRes E{out + O_YP, out + O_YS, out + O_YP, out + O_YS, WSP(float, WS_MOD) + 40 * 3072 + 2048, nullptr, nullptr, nullptr, lds + pg8::STG_OFF, WSP(bf16, WS_Y1B), nullptr};
        pg8::gemm_phase<pg8::EpiRes, pg8::StaticOrder, true, true>(lds, g, S, E);
    }
#if PROBE_SYNC
    if (hi - lo > 1) { for (int q = 0; q < 18; ++q) cg::this_grid().sync(); }
#endif
#undef IN
#undef SEAM
}

constexpr int N_PHASES = 11;
extern "C" void kernel_launch(void* const* d_in, const int* in_sizes, int n_in, void* d_out, int out_size, void* d_ws, size_t ws_size, hipStream_t stream) {
    static int grid = 0;
    if (grid == 0) {
        if (n_in != 26 || ws_size < WS_END) { fprintf(stderr, "kernel_launch: unexpected inputs (n_in %d, ws %zu, need %zu)\n", n_in, ws_size, (size_t)WS_END); grid = -1; return; }
        int dev = 0, cus = 0, per_cu = 0;
        hipGetDevice(&dev); hipDeviceGetAttribute(&cus, hipDeviceAttributeMultiprocessorCount, dev);
        hipFuncSetAttribute((const void*)hybrid_fwd, hipFuncAttributeMaxDynamicSharedMemorySize, LDS_TOTAL);
        hipOccupancyMaxActiveBlocksPerMultiprocessor(&per_cu, (const void*)hybrid_fwd, 512, LDS_TOTAL);
        if (per_cu < 1) { fprintf(stderr, "kernel_launch: occupancy query says %d blocks per CU\n", per_cu); per_cu = 1; }
        (void)hipGetLastError();
        grid = cus * per_cu;
    }
    if (grid < 0) return;
    hipMemsetAsync((char*)d_ws + WS_BAR, 0, 16384, stream);
    Args a{};
    for (int i = 0; i < 26; ++i) a.in[i] = (const float*)d_in[i];
    a.out = (float*)d_out; a.ws = (unsigned char*)d_ws;
#if MULTI_LAUNCH
    for (int p = 0; p < N_PHASES; ++p) { a.ph_lo = p; a.ph_hi = p + 1; hipLaunchKernelGGL(hybrid_fwd, dim3(grid), dim3(512), LDS_TOTAL, stream, a); }
#else
    a.ph_lo = 0; a.ph_hi = N_PHASES;
    void* kargs[] = {&a};
    hipError_t e = hipLaunchCooperativeKernel((const void*)hybrid_fwd, dim3(grid), dim3(512), kargs, LDS_TOTAL, stream);
    if (e != hipSuccess) fprintf(stderr, "cooperative launch failed: %s (grid %d)\n", hipGetErrorString(e), grid);
#endif
}
```

```cpp
#include <hip/hip_runtime.h>
#include <hip/hip_cooperative_groups.h>
#include <cstdio>
#include <cstdint>
namespace cg = cooperative_groups;
#ifndef MULTI_LAUNCH
#define MULTI_LAUNCH 0
#endif
constexpr int DMODEL = 1024, NBP = 32, SEQ = 2048, NBS = 8, TS = 32;
constexpr int MP = NBP * SEQ;
constexpr int M1 = MP + NBS * TS;
constexpr int SA_STRIDE = 576;
constexpr int RA = MP + NBS * SA_STRIDE;
constexpr int SB_STRIDE = 2112;
constexpr int R2 = MP + NBS * SB_STRIDE;
constexpr float EPSN = 1e-6f;
constexpr float LOG2E = 1.4426950408889634f;
constexpr float QSCALE_A = 0.125f * LOG2E;
constexpr float QSCALE_B = 0.10206207261596575f * LOG2E;
namespace pg8 {
#define PG8_LAS __attribute__((address_space(3)))
typedef unsigned short bf16_t;
typedef short bf16x8 __attribute__((ext_vector_type(8)));
typedef float f32x4 __attribute__((ext_vector_type(4)));
typedef unsigned u32x4 __attribute__((ext_vector_type(4)));
constexpr int BM = 256, BK = 64, HALF = 128, HTB = HALF * BK * 2  , STAGE_BYTES = 8 * HTB, NXCD = 8, WGM = 8;

__host__ __device__ __forceinline__ int lds_byte(int r, int c) { const int st = (r >> 4) * 2 + (c >> 5), rr = r & 15, cc = c & 31, ob = rr * 64 + cc * 2; return st * 1024 + (ob ^ (((ob >> 9) & 1) << 5)); }
__host__ __device__ __forceinline__ void stage_rc(int b, int& R, int& C) { const int st = b / 1024, sb = b % 1024, swz = sb ^ (((sb >> 9) & 1) << 5); R = (st >> 1) * 16 + swz / 64; C = (st & 1) * 32 + (swz % 64) / 2; }
__host__ __device__ __forceinline__ int perm32(int rho) { const int n = rho >> 4, i = rho & 15; return 8 * (i >> 2) + 4 * n + (i & 3); }

struct Unit { int pm, pn; };
struct Gemm { const bf16_t* A; const bf16_t* Bt; int M, N, K; };

struct StaticOrder {
    int nM, nN, nwg, G, c;
    __host__ __device__ void init(int M, int N, int G_, int c_) { nM = M / BM; nN = N / BM; nwg = nM * nN; G = G_; c = c_; }
    __host__ __device__ bool next(int i, Unit& u) const {
        const long L = (long)i * G + c; if (L >= nwg) return false;
        int wgid = (int)L; { const int q = nwg / NXCD, r = nwg % NXCD, xcd = wgid % NXCD, off = wgid / NXCD; wgid = (xcd < r ? xcd * (q + 1) : r * (q + 1) + (xcd - r) * q) + off; }
        const int nig = WGM * nN, gid = wgid / nig, fm = gid * WGM, gsz = (nM - fm) < WGM ? (nM - fm) : WGM;
        u.pm = fm + ((wgid % nig) % gsz); u.pn = (wgid % nig) / gsz; return true;
    }
    __device__ __forceinline__ void a_ready(const Unit&) const {}
    __device__ __forceinline__ void done(const Unit&) const {}
};

__device__ __forceinline__ unsigned cvt_pk_bf16(float lo, float hi) { unsigned r; asm volatile("v_cvt_pk_bf16_f32 %0, %1, %2" : "=v"(r) : "v"(lo), "v"(hi)); return r; }
template <class Epi, class Sched, bool ALIGN_EPI = false, bool SP2 = false>
__device__ __forceinline__ void gemm_phase(PG8_LAS unsigned char* lds, const Gemm g, const Sched& S, const Epi& E) {
    int tid_ = threadIdx.x; asm volatile("" : "+v"(tid_));
    const int tid = tid_, wid = __builtin_amdgcn_readfirstlane(tid >> 6), lane = tid & 63, wr = wid >> 2, wc = wid & 3, fr = lane & 15, fq = lane >> 4;
    const int K = g.K, nt = K / BK;
    unsigned voffA[2], voffB[2];
#pragma unroll
    for (int i = 0; i < 2; ++i) { int R, C; stage_rc(tid * 16 + i * 8192, R, C); const int Rb = Epi::PERM ? ((R & ~31) + perm32(R & 31)) : R;
        voffA[i] = (unsigned)(R * K + C) * 2u; voffB[i] = (unsigned)(Rb * K + C) * 2u; }
    const size_t kstep = (size_t)(BK * 2);
    const size_t hstep = (size_t)HALF * K * 2;
    const size_t tstep = 2 * hstep;
    const unsigned ldsw = (unsigned)wid * 1024u;
    const int aoff = lds_byte(wr * 64 + fr, fq * 8), boff = lds_byte(wc * 32 + fr, fq * 8);
#define PG8_SA(b, h) (((b) * 2 + (h)) * HTB)
#define PG8_SB(b, h) ((4 + (b) * 2 + (h)) * HTB)
#define PG8_STAGE(bufoff, gbase, voff) do { _Pragma("unroll") for (int _i = 0; _i < 2; ++_i) \
        __builtin_amdgcn_global_load_lds((const unsigned*)((const char*)(gbase) + (voff)[_i]), (PG8_LAS unsigned*)(lds + (bufoff) + ldsw + _i * 8192), 16, 0, 0); } while (0)
#define PG8_LDA(dst, b, h) do { _Pragma("unroll") for (int m = 0; m < 4; ++m) _Pragma("unroll") for (int k = 0; k < 2; ++k) dst[m][k] = *(const PG8_LAS bf16x8*)(lds + PG8_SA(b, h) + aoff + m * 2048 + k * 1024); } while (0)
#define PG8_LDB(dst, b, h) do { _Pragma("unroll") for (int n = 0; n < 2; ++n) _Pragma("unroll") for (int k = 0; k < 2; ++k) dst[n][k] = *(const PG8_LAS bf16x8*)(lds + PG8_SB(b, h) + boff + n * 2048 + k * 1024); } while (0)
#define PG8_MMA(ai, bj, At, Bt) do { __builtin_amdgcn_s_setprio(1); _Pragma("unroll") for (int m = 0; m < 4; ++m) _Pragma("unroll") for (int n = 0; n < 2; ++n) _Pragma("unroll") for (int k = 0; k < 2; ++k) \
        acc[ai][bj][m][n] = __builtin_amdgcn_mfma_f32_16x16x32_bf16(Bt[n][k], At[m][k], acc[ai][bj][m][n], 0, 0, 0); __builtin_amdgcn_s_setprio(0); } while (0)
#define PG8_WAIT_V(n) asm volatile("s_waitcnt vmcnt(" #n ")" ::: "memory")
#define PG8_WAIT_L(n) asm volatile("s_waitcnt lgkmcnt(" #n ")" ::: "memory")
#define PG8_BAR __builtin_amdgcn_s_barrier()
#define PG8_SCHED __builtin_amdgcn_sched_barrier(0)
    Unit cur, nxt; int ui = 0;
    if (!S.next(0, cur)) return;
    f32x4 acc[2][2][4][2];
#pragma unroll
    for (int a = 0; a < 2; ++a)
#pragma unroll
        for (int b = 0; b < 2; ++b)
#pragma unroll
            for (int m = 0; m < 4; ++m)
#pragma unroll
                for (int n = 0; n < 2; ++n) acc[a][b][m][n] = (f32x4){0.f, 0.f, 0.f, 0.f};
    bf16x8 At[4][2], B0[2][2], B1[2][2];
    const char* cA = (const char*)g.A + (size_t)cur.pm * tstep; const char* cB = (const char*)g.Bt + (size_t)cur.pn * tstep;
    S.a_ready(cur);
    if constexpr (SP2) {
        PG8_STAGE(PG8_SB(0, 0), cB, voffB); PG8_STAGE(PG8_SB(0, 1), cB + hstep, voffB); PG8_STAGE(PG8_SA(0, 0), cA, voffA); PG8_STAGE(PG8_SA(0, 1), cA + hstep, voffA);
        if (wr == 1) PG8_BAR;
        PG8_WAIT_V(2); PG8_BAR;
        PG8_STAGE(PG8_SB(1, 0), cB + kstep, voffB); PG8_STAGE(PG8_SA(1, 0), cA + kstep, voffA); PG8_STAGE(PG8_SB(1, 1), cB + hstep + kstep, voffB);
        PG8_WAIT_V(6); PG8_BAR;
    } else {
        PG8_STAGE(PG8_SB(0, 0), cB, voffB); PG8_STAGE(PG8_SA(0, 0), cA, voffA); PG8_STAGE(PG8_SB(0, 1), cB + hstep, voffB); PG8_STAGE(PG8_SA(0, 1), cA + hstep, voffA);
        if (wr == 1) PG8_BAR;
        PG8_WAIT_V(4); PG8_BAR;
        PG8_STAGE(PG8_SB(1, 0), cB + kstep, voffB); PG8_STAGE(PG8_SA(1, 0), cA + kstep, voffA); PG8_STAGE(PG8_SB(1, 1), cB + hstep + kstep, voffB);
        PG8_WAIT_V(6); PG8_BAR;
    }
    for (;;) {
        const bool has_next = S.next(ui + 1, nxt);
        const char* nA = has_next ? (const char*)g.A + (size_t)nxt.pm * tstep : cA; const char* nB = has_next ? (const char*)g.Bt + (size_t)nxt.pn * tstep : cB;
        for (int t = 0; t < nt; t += 2) {
            const bool last = (t == nt - 2);
            const char* a1 = cA + (size_t)(t + 1) * kstep;
            const char* a2 = last ? nA : cA + (size_t)(t + 2) * kstep; const char* b2 = last ? nB : cB + (size_t)(t + 2) * kstep;
            const char* a3 = a2 + kstep; const char* b3 = b2 + kstep;
            if (last && has_next) S.a_ready(nxt);
            if constexpr (SP2) {
            PG8_LDB(B0, 0, 0); PG8_LDB(B1, 0, 1); PG8_SCHED; PG8_LDA(At, 0, 0); PG8_STAGE(PG8_SA(1, 1), a1 + hstep, voffA);
            PG8_WAIT_V(8); PG8_WAIT_L(0); PG8_BAR; PG8_MMA(0, 0, At, B0); PG8_MMA(0, 1, At, B1); PG8_BAR; PG8_SCHED;
            PG8_LDA(At, 0, 1); PG8_STAGE(PG8_SB(0, 0), b2, voffB); PG8_STAGE(PG8_SB(0, 1), b2 + hstep, voffB); PG8_STAGE(PG8_SA(0, 0), a2, voffA);
            PG8_WAIT_V(8); PG8_WAIT_L(0); PG8_BAR; PG8_MMA(1, 0, At, B0); PG8_MMA(1, 1, At, B1); PG8_BAR; PG8_SCHED;
            PG8_LDB(B0, 1, 0); PG8_LDB(B1, 1, 1); PG8_SCHED; PG8_LDA(At, 1, 0); PG8_STAGE(PG8_SA(0, 1), a2 + hstep, voffA);
            PG8_WAIT_V(8); PG8_WAIT_L(0); PG8_BAR; PG8_MMA(0, 0, At, B0); PG8_MMA(0, 1, At, B1); PG8_BAR; PG8_SCHED;
            PG8_LDA(At, 1, 1); PG8_STAGE(PG8_SB(1, 0), b3, voffB); PG8_STAGE(PG8_SB(1, 1), b3 + hstep, voffB); PG8_STAGE(PG8_SA(1, 0), a3, voffA);
            PG8_WAIT_V(8); PG8_WAIT_L(0); PG8_BAR; PG8_MMA(1, 0, At, B0); PG8_MMA(1, 1, At, B1); PG8_BAR; PG8_SCHED;
            } else {
            PG8_LDB(B0, 0, 0); PG8_SCHED; PG8_LDA(At, 0, 0); PG8_STAGE(PG8_SA(1, 1), a1 + hstep, voffA);
            PG8_WAIT_L(8); PG8_BAR; PG8_WAIT_L(0); PG8_MMA(0, 0, At, B0); PG8_BAR; PG8_SCHED;
            PG8_LDB(B1, 0, 1); PG8_STAGE(PG8_SB(0, 0), b2, voffB);
            PG8_BAR; PG8_WAIT_L(0); PG8_MMA(0, 1, At, B1); PG8_BAR;
            PG8_LDA(At, 0, 1); PG8_STAGE(PG8_SA(0, 0), a2, voffA);
            PG8_BAR; PG8_WAIT_L(0); PG8_MMA(1, 0, At, B0); PG8_BAR; PG8_SCHED;
            PG8_STAGE(PG8_SB(0, 1), b2 + hstep, voffB);
            PG8_WAIT_V(6); PG8_BAR; PG8_MMA(1, 1, At, B1); PG8_BAR;
            PG8_LDB(B0, 1, 0); PG8_SCHED; PG8_LDA(At, 1, 0); PG8_STAGE(PG8_SA(0, 1), a2 + hstep, voffA);
            PG8_WAIT_L(8); PG8_BAR; PG8_WAIT_L(0); PG8_MMA(0, 0, At, B0); PG8_BAR; PG8_SCHED;
            PG8_LDB(B1, 1, 1); PG8_STAGE(PG8_SB(1, 0), b3, voffB);
            PG8_BAR; PG8_WAIT_L(0); PG8_MMA(0, 1, At, B1); PG8_BAR;
            PG8_LDA(At, 1, 1); PG8_STAGE(PG8_SA(1, 0), a3, voffA);
            PG8_BAR; PG8_WAIT_L(0); PG8_MMA(1, 0, At, B0); PG8_BAR; PG8_SCHED;
            PG8_STAGE(PG8_SB(1, 1), b3 + hstep, voffB);
            PG8_WAIT_V(6); PG8_BAR; PG8_MMA(1, 1, At, B1); PG8_BAR;
            }
        }
        if constexpr (ALIGN_EPI) { if (wr == 0) PG8_BAR; }
        if constexpr (!Epi::AFTER_DRAIN) { E(acc, cur, wr, wc, fr, fq); S.done(cur); }
        if (!has_next) break;
#pragma unroll
        for (int a = 0; a < 2; ++a)
#pragma unroll
            for (int b = 0; b < 2; ++b)
#pragma unroll
                for (int m = 0; m < 4; ++m)
#pragma unroll
                    for (int n = 0; n < 2; ++n) acc[a][b][m][n] = (f32x4){0.f, 0.f, 0.f, 0.f};
        cur = nxt; cA = nA; cB = nB; ++ui;
        if constexpr (ALIGN_EPI) { if (wr == 1) PG8_BAR; }
    }
    PG8_WAIT_V(0);
    if constexpr (!ALIGN_EPI) { if (wr == 0) PG8_BAR; }
    PG8_BAR;
    if constexpr (Epi::AFTER_DRAIN) { E.fused(acc, cur, wr, wc, fr, fq, lds, wid, lane); S.done(cur); }
#undef PG8_SA
#undef PG8_SB
#undef PG8_STAGE
#undef PG8_LDA
#undef PG8_LDB
#undef PG8_MMA
#undef PG8_WAIT_V
#undef PG8_WAIT_L
#undef PG8_BAR
#undef PG8_SCHED
}
typedef unsigned u32x2 __attribute__((ext_vector_type(2)));
typedef float f32x2 __attribute__((ext_vector_type(2)));
typedef __bf16 bf16x2_t __attribute__((ext_vector_type(2)));
__device__ __forceinline__ unsigned pkbf(float lo, float hi) { f32x2 v = {lo, hi}; bf16x2_t b = __builtin_convertvector(v, bf16x2_t); return __builtin_bit_cast(unsigned, b); }
__device__ __forceinline__ u32x2 pk4(f32x4 v) { u32x2 r; r.x = pkbf(v[0], v[1]); r.y = pkbf(v[2], v[3]); return r; }
__device__ __forceinline__ void st8(bf16_t* d, f32x4 a, f32x4 b) { u32x4 w; w.x = pkbf(a[0], a[1]); w.y = pkbf(a[2], a[3]); w.z = pkbf(b[0], b[1]); w.w = pkbf(b[2], b[3]); *(u32x4*)d = w; }
constexpr int STG_OFF = 131072 + 1024, STG_WAVE = 16 * 144;
__device__ __forceinline__ void stg_put(PG8_LAS unsigned char* stg, int fr, int fq, int bj, f32x4 a, f32x4 b) {
    u32x4 w; w.x = pkbf(a[0], a[1]); w.y = pkbf(a[2], a[3]); w.z = pkbf(b[0], b[1]); w.w = pkbf(b[2], b[3]);
    *(PG8_LAS u32x4*)(stg + fr * 144 + 64 * bj + 16 * fq) = w;
}
__device__ __forceinline__ void stg_flush(PG8_LAS unsigned char* stg, int fr, int fq, bf16_t* seg, int stride) {
    const int lane = fr + 16 * fq, r0 = lane >> 3, ch = lane & 7;
    bf16_t* p0 = seg + (r0 - fr) * stride + 8 * ch;
    asm volatile("s_waitcnt lgkmcnt(0)" ::: "memory");
    const u32x4 x0 = *(const PG8_LAS u32x4*)(stg + r0 * 144 + 16 * ch), x1 = *(const PG8_LAS u32x4*)(stg + (r0 + 8) * 144 + 16 * ch);
    *(u32x4*)p0 = x0; *(u32x4*)(p0 + 8 * stride) = x1;
    asm volatile("s_waitcnt lgkmcnt(0)" ::: "memory");
}
__device__ __forceinline__ void st_rows(PG8_LAS unsigned char* stg, int fr, int fq, bf16_t* seg, int stride, f32x4 a0, f32x4 a1, f32x4 b0, f32x4 b1) {
    stg_put(stg, fr, fq, 0, a0, a1); stg_put(stg, fr, fq, 1, b0, b1); stg_flush(stg, fr, fq, seg, stride);
}
__device__ __forceinline__ void stf_rows(PG8_LAS unsigned char* stg, int fr, int fq, float* seg, int stride, f32x4 a, f32x4 b) {
    const int lane = fr + 16 * fq, r0 = lane >> 3, ch = lane & 7;
    *(PG8_LAS f32x4*)(stg + fr * 144 + 32 * fq) = a; *(PG8_LAS f32x4*)(stg + fr * 144 + 32 * fq + 16) = b;
    float* p0 = seg + (r0 - fr) * stride + 4 * ch;
    asm volatile("s_waitcnt lgkmcnt(0)" ::: "memory");
    const f32x4 x0 = *(const PG8_LAS f32x4*)(stg + r0 * 144 + 16 * ch), x1 = *(const PG8_LAS f32x4*)(stg + (r0 + 8) * 144 + 16 * ch);
    *(f32x4*)p0 = x0; *(f32x4*)(p0 + 8 * stride) = x1;
    asm volatile("s_waitcnt lgkmcnt(0)" ::: "memory");
}
__device__ __forceinline__ void ldf_rows(PG8_LAS unsigned char* stg, int fr, int fq, const float* seg, int stride, f32x4& a, f32x4& b) {
    const int lane = fr + 16 * fq, r0 = lane >> 3, ch = lane & 7;
    const float* p0 = seg + (r0 - fr) * stride + 4 * ch;
    const f32x4 x0 = *(const f32x4*)p0, x1 = *(const f32x4*)(p0 + 8 * stride);
    *(PG8_LAS f32x4*)(stg + r0 * 144 + 16 * ch) = x0; *(PG8_LAS f32x4*)(stg + (r0 + 8) * 144 + 16 * ch) = x1;
    asm volatile("s_waitcnt lgkmcnt(0)" ::: "memory");
    a = *(const PG8_LAS f32x4*)(stg + fr * 144 + 32 * fq); b = *(const PG8_LAS f32x4*)(stg + fr * 144 + 32 * fq + 16);
    asm volatile("s_waitcnt lgkmcnt(0)" ::: "memory");
}
__device__ __forceinline__ float silu_f(float v) { return v * __builtin_amdgcn_rcpf(1.f + __expf(-v)); }
__device__ __forceinline__ f32x4 silu4(f32x4 v) { f32x4 o; o[0] = silu_f(v[0]); o[1] = silu_f(v[1]); o[2] = silu_f(v[2]); o[3] = silu_f(v[3]); return o; }
__device__ __forceinline__ float ssq4(f32x4 v) { return (v[0] * v[0] + v[1] * v[1]) + (v[2] * v[2] + v[3] * v[3]); }
__device__ __forceinline__ float red_fq(float s) { s += __shfl_xor(s, 16); s += __shfl_xor(s, 32); return s; }

struct EpiAin {
    static constexpr bool PERM = true, AFTER_DRAIN = false;
    bf16_t *Q, *K, *V, *Z; const float *gq, *gk; float *okp, *ovp, *oks, *ovs; PG8_LAS unsigned char* stg0;
    __device__ __forceinline__ void operator()(const f32x4 (&acc)[2][2][4][2], const Unit& u, int wr, int wc, int fr, int fq) const {
        const int sec = u.pn >> 2, head = (u.pn & 3) * 4 + wc, cb = head * 64 + 8 * fq;
        f32x4 g[2][2];
#pragma unroll
        for (int bj = 0; bj < 2; ++bj)
#pragma unroll
            for (int n = 0; n < 2; ++n) g[bj][n] = (sec < 2) ? *(const f32x4*)((sec == 0 ? gq : gk) + 32 * bj + 4 * n + 8 * fq) : (f32x4){1.f, 1.f, 1.f, 1.f};
#pragma unroll
        for (int ai = 0; ai < 2; ++ai)
#pragma unroll
            for (int m = 0; m < 4; ++m) {
                const int row = u.pm * BM + ai * HALF + wr * 64 + m * 16 + fr;
                f32x4 v[2][2];
#pragma unroll
                for (int bj = 0; bj < 2; ++bj)
#pragma unroll
                    for (int n = 0; n < 2; ++n) v[bj][n] = acc[ai][bj][m][n];
                if (sec < 2) {
                    float s = (ssq4(v[0][0]) + ssq4(v[0][1])) + (ssq4(v[1][0]) + ssq4(v[1][1]));
                    s = red_fq(s);
                    const float r = rsqrtf(s * (1.f / 64.f) + EPSN) * (sec == 0 ? QSCALE_A : 1.f);
#pragma unroll
                    for (int bj = 0; bj < 2; ++bj)
#pragma unroll
                        for (int n = 0; n < 2; ++n) v[bj][n] = v[bj][n] * g[bj][n] * r;
                } else if (sec == 3) {
#pragma unroll
                    for (int bj = 0; bj < 2; ++bj)
#pragma unroll
                        for (int n = 0; n < 2; ++n) v[bj][n] = silu4(v[bj][n]);
                }
                if (sec == 0 || sec == 3) {
                    bf16_t* d = (sec == 0 ? Q : Z) + (size_t)row * 1024 + cb;
                    st_rows(stg0 + (wr * 4 + wc) * STG_WAVE, fr, fq, d - 8 * fq, 1024, v[0][0], v[0][1], v[1][0], v[1][1]);
                } else {
                    size_t drow; float* of = nullptr;
                    if (row < MP) { drow = (size_t)row; const int pos = row & (SEQ - 1); if (pos >= SEQ - 512) of = (sec == 1 ? okp : ovp) + ((size_t)((row >> 11) * 512 + pos - (SEQ - 512))) * 1024; }
                    else { const int rs = row - MP; drow = (size_t)MP + (size_t)(rs >> 5) * SA_STRIDE + 512 + (rs & 31); of = (sec == 1 ? oks : ovs) + (size_t)rs * 1024; }
                    bf16_t* d = (sec == 1 ? K : V) + drow * 1024 + cb;
                    st_rows(stg0 + (wr * 4 + wc) * STG_WAVE, fr, fq, d - 8 * fq, 1024, v[0][0], v[0][1], v[1][0], v[1][1]);
#pragma unroll
                    for (int bj = 0; bj < 2; ++bj) { if (of) stf_rows(stg0 + (wr * 4 + wc) * STG_WAVE, fr, fq, of + cb - 8 * fq + 32 * bj, 1024, v[bj][0], v[bj][1]); }
                }
                asm volatile("" ::: "memory");
            }
    }
};
struct EpiRes {
    static constexpr bool PERM = true, AFTER_DRAIN = false;
    const float *xp, *xs; float *yp, *ys; const float* gate;
    bf16_t* YG; const float* G1; float* ssq;
    PG8_LAS unsigned char* stg0; const bf16_t* xb; bf16_t* yb;
    __device__ __forceinline__ void operator()(const f32x4 (&acc)[2][2][4][2], const Unit& u, int wr, int wc, int fr, int fq) const {
        const int cb = u.pn * 256 + wc * 64 + 8 * fq;
#pragma unroll
        for (int ai = 0; ai < 2; ++ai)
#pragma unroll
            for (int m = 0; m < 4; ++m) {
                const int row = u.pm * BM + ai * HALF + wr * 64 + m * 16 + fr;
                const float* xi; float* yo; int bb;
                if (row < MP) { xi = xp + (size_t)row * 1024; yo = yp + (size_t)row * 1024; bb = row >> 11; }
                else { const int rs = row - MP; xi = xs + (size_t)rs * 1024; yo = ys + (size_t)rs * 1024; bb = NBP + (rs >> 5); }
                const float* gp = gate + (size_t)bb * 3072;
                float sq = 0.f;
                f32x4 ov[2][2];
#pragma unroll
                for (int bj = 0; bj < 2; ++bj) { const int c = cb + 32 * bj;
                    f32x4 x0, x1;
                    if (xb) { const u32x4 w = *(const u32x4*)(xb + (size_t)row * 1024 + c);
                        x0 = (f32x4){__uint_as_float(w.x << 16), __uint_as_float(w.x & 0xffff0000u), __uint_as_float(w.y << 16), __uint_as_float(w.y & 0xffff0000u)};
                        x1 = (f32x4){__uint_as_float(w.z << 16), __uint_as_float(w.z & 0xffff0000u), __uint_as_float(w.w << 16), __uint_as_float(w.w & 0xffff0000u)}; }
                    else ldf_rows(stg0 + (wr * 4 + wc) * STG_WAVE, fr, fq, xi + c - 8 * fq, 1024, x0, x1);
                    ov[bj][0] = x0 + *(const f32x4*)(gp + c) * acc[ai][bj][m][0]; ov[bj][1] = x1 + *(const f32x4*)(gp + c + 4) * acc[ai][bj][m][1];
                    if (!yb) stf_rows(stg0 + (wr * 4 + wc) * STG_WAVE, fr, fq, yo + c - 8 * fq, 1024, ov[bj][0], ov[bj][1]); }
                if (yb) st_rows(stg0 + (wr * 4 + wc) * STG_WAVE, fr, fq, yb + (size_t)row * 1024 + cb - 8 * fq, 1024, ov[0][0], ov[0][1], ov[1][0], ov[1][1]);
                if (YG) { sq = (ssq4(ov[0][0]) + ssq4(ov[0][1])) + (ssq4(ov[1][0]) + ssq4(ov[1][1])); const float* gg = G1 + (size_t)bb * 1024 + cb;
                    st_rows(stg0 + (wr * 4 + wc) * STG_WAVE, fr, fq, YG + (size_t)row * 1024 + cb - 8 * fq, 1024, ov[0][0] * *(const f32x4*)gg, ov[0][1] * *(const f32x4*)(gg + 4), ov[1][0] * *(const f32x4*)(gg + 32), ov[1][1] * *(const f32x4*)(gg + 36)); }
                if (YG) { sq = red_fq(sq); if (fq == 0) atomicAdd(ssq + row, sq); }
                asm volatile("" ::: "memory");
            }
    }
};
struct EpiBin {
    static constexpr bool PERM = true, AFTER_DRAIN = false;
    bf16_t* Z; bf16_t* CQ; bf16_t* CKV; float* RAW2; const float* ssq; const float* SW; const float* gcq; const float* gckv; float* ssqq; float* ssqkv; PG8_LAS unsigned char* stg0;
    __device__ __forceinline__ void operator()(const f32x4 (&acc)[2][2][4][2], const Unit& u, int wr, int wc, int fr, int fq) const {
        const int cb = u.pn * 256 + wc * 64 + 8 * fq;
        const int sidx = (u.pn - 4) * 4 + wc;
#pragma unroll
        for (int ai = 0; ai < 2; ++ai)
#pragma unroll
            for (int m = 0; m < 4; ++m) {
                const int row = u.pm * BM + ai * HALF + wr * 64 + m * 16 + fr;
                const int bb = row < MP ? (row >> 11) : NBP + ((row - MP) >> 5);
                const float r = rsqrtf(ssq[row] * (1.f / 1024.f) + EPSN);
                const float* sw = SW + (size_t)bb * 1792;
                f32x4 v[2][2];
#pragma unroll
                for (int bj = 0; bj < 2; ++bj)
#pragma unroll
                    for (int n = 0; n < 2; ++n) v[bj][n] = acc[ai][bj][m][n] * r + *(const f32x4*)(sw + cb + 32 * bj + 4 * n);
                if (u.pn < 4) {
                    st_rows(stg0 + (wr * 4 + wc) * STG_WAVE, fr, fq, Z + (size_t)row * 1024 + cb - 8 * fq, 1024, silu4(v[0][0]), silu4(v[0][1]), silu4(v[1][0]), silu4(v[1][1]));
                } else if (sidx < 10) {
                    float sq = (ssq4(v[0][0]) + ssq4(v[0][1])) + (ssq4(v[1][0]) + ssq4(v[1][1]));
                    sq = red_fq(sq);
                    if (sidx < 6) {
                        const int c0 = cb - 1024;
                        if (fq == 0) atomicAdd(ssqq + row, sq);
                        st_rows(stg0 + (wr * 4 + wc) * STG_WAVE, fr, fq, CQ + (size_t)row * 384 + c0 - 8 * fq, 384, v[0][0] * *(const f32x4*)(gcq + c0), v[0][1] * *(const f32x4*)(gcq + c0 + 4), v[1][0] * *(const f32x4*)(gcq + c0 + 32), v[1][1] * *(const f32x4*)(gcq + c0 + 36));
                    } else {
                        const int c0 = cb - 1408;
                        const size_t drow = row < MP ? (size_t)row : (size_t)MP + (size_t)((row - MP) >> 5) * SB_STRIDE + 2048 + ((row - MP) & 31);
                        if (fq == 0) atomicAdd(ssqkv + row, sq);
                        st_rows(stg0 + (wr * 4 + wc) * STG_WAVE, fr, fq, CKV + drow * 256 + c0 - 8 * fq, 256, v[0][0] * *(const f32x4*)(gckv + c0), v[0][1] * *(const f32x4*)(gckv + c0 + 4), v[1][0] * *(const f32x4*)(gckv + c0 + 32), v[1][1] * *(const f32x4*)(gckv + c0 + 36));
                    }
                } else if (sidx == 10) {
#pragma unroll
                    for (int n = 0; n < 2; ++n) *(f32x4*)(RAW2 + (size_t)row * 32 + 8 * fq + 4 * n) = v[0][n];
                }
                asm volatile("" ::: "memory");
            }
    }
};
struct EpiUq {
    static constexpr bool PERM = true, AFTER_DRAIN = false;
    bf16_t* Q; const float *gqn, *gqr, *CS; const float* ssqq; PG8_LAS unsigned char* stg0;
    __device__ __forceinline__ void operator()(const f32x4 (&acc)[2][2][4][2], const Unit& u, int wr, int wc, int fr, int fq) const {
        if (u.pn < 4) {
            const int head = u.pn * 4 + wc;
#pragma unroll
            for (int ai = 0; ai < 2; ++ai)
#pragma unroll
                for (int m = 0; m < 4; ++m) {
                    const int row = u.pm * BM + ai * HALF + wr * 64 + m * 16 + fr;
                    float s = (ssq4(acc[ai][0][m][0]) + ssq4(acc[ai][0][m][1])) + (ssq4(acc[ai][1][m][0]) + ssq4(acc[ai][1][m][1]));
                    s = red_fq(s);
                    const float rq = rsqrtf(ssqq[row] * (1.f / 384.f) + EPSN);
                    const float r = rsqrtf(s * rq * rq * (1.f / 64.f) + EPSN) * rq * QSCALE_B;
                    bf16_t* d = Q + (size_t)row * 1536 + head * 96 + 8 * fq;
                    { PG8_LAS unsigned char* sg_ = stg0 + (wr * 4 + wc) * STG_WAVE;
#pragma unroll
                      for (int bj = 0; bj < 2; ++bj) stg_put(sg_, fr, fq, bj, acc[ai][bj][m][0] * *(const f32x4*)(gqn + 32 * bj + 8 * fq) * r, acc[ai][bj][m][1] * *(const f32x4*)(gqn + 32 * bj + 4 + 8 * fq) * r);
                      stg_flush(sg_, fr, fq, d - 8 * fq, 1536); }
                    asm volatile("" ::: "memory");
                }
        } else {
#pragma unroll
            for (int ai = 0; ai < 2; ++ai)
#pragma unroll
                for (int m = 0; m < 4; ++m) {
                    const int row = u.pm * BM + ai * HALF + wr * 64 + m * 16 + fr;
                    const int pos = row < MP ? (row & (SEQ - 1)) : SEQ + ((row - MP) & 31);
                    const float rq = rsqrtf(ssqq[row] * (1.f / 384.f) + EPSN);
#pragma unroll
                    for (int bj = 0; bj < 2; ++bj) {
                        const int hr = (u.pn - 4) * 8 + wc * 2 + bj;
                        float s = ssq4(acc[ai][bj][m][0]) + ssq4(acc[ai][bj][m][1]);
                        s = red_fq(s);
                        const float r = rsqrtf(s * rq * rq * (1.f / 32.f) + EPSN) * rq;
                        const f32x4 x1 = acc[ai][bj][m][0] * *(const f32x4*)(gqr + 4 * fq) * r, x2 = acc[ai][bj][m][1] * *(const f32x4*)(gqr + 16 + 4 * fq) * r;
                        const f32x4 cs = *(const f32x4*)(CS + pos * 32 + 4 * fq), sn = *(const f32x4*)(CS + pos * 32 + 16 + 4 * fq);
                        PG8_LAS unsigned char* sg_ = stg0 + (wr * 4 + wc) * STG_WAVE + fr * 144 + bj * 64 + 8 * fq; (void)hr;
                        *(PG8_LAS u32x2*)sg_ = pk4((x1 * cs - x2 * sn) * QSCALE_B); *(PG8_LAS u32x2*)(sg_ + 32) = pk4((x2 * cs + x1 * sn) * QSCALE_B);
                        asm volatile("" ::: "memory");
                    }
                    {
                        const int lane_ = fr + 16 * fq, r0 = lane_ >> 3, ch = lane_ & 7, bjc = ch >> 2, pc = ch & 3;
                        PG8_LAS unsigned char* sr_ = stg0 + (wr * 4 + wc) * STG_WAVE + r0 * 144 + bjc * 64 + pc * 16;
                        bf16_t* p0 = Q + (size_t)(row - fr + r0) * 1536 + ((u.pn - 4) * 8 + wc * 2 + bjc) * 96 + 64 + pc * 8;
                        asm volatile("s_waitcnt lgkmcnt(0)" ::: "memory");
                        const u32x4 x0_ = *(const PG8_LAS u32x4*)sr_, x1_ = *(const PG8_LAS u32x4*)(sr_ + 8 * 144);
                        *(u32x4*)p0 = x0_; *(u32x4*)(p0 + 8 * 1536) = x1_;
                        asm volatile("s_waitcnt lgkmcnt(0)" ::: "memory");
                    }
                }
        }
    }
};
struct EpiUkv {
    static constexpr bool PERM = true, AFTER_DRAIN = false;
    bf16_t *KN, *VB; const float* gkn; const float* ssqkv; PG8_LAS unsigned char* stg0;
    __device__ __forceinline__ void operator()(const f32x4 (&acc)[2][2][4][2], const Unit& u, int wr, int wc, int fr, int fq) const {
        const bool isk = u.pn < 4; const int head = (u.pn & 3) * 4 + wc;
#pragma unroll
        for (int ai = 0; ai < 2; ++ai)
#pragma unroll
            for (int m = 0; m < 4; ++m) {
                const int row = u.pm * BM + ai * HALF + wr * 64 + m * 16 + fr;
                float rs = 1.f;
                if (u.pm < MP / BM) rs = rsqrtf(ssqkv[row] * (1.f / 256.f) + EPSN);
                else { const int q_ = row - MP, bs_ = q_ / SB_STRIDE, rr_ = q_ - bs_ * SB_STRIDE; if (rr_ >= 2048 && rr_ < 2080) rs = rsqrtf(ssqkv[MP + bs_ * TS + rr_ - 2048] * (1.f / 256.f) + EPSN); }
                float r = rs;
                if (isk) { float s = (ssq4(acc[ai][0][m][0]) + ssq4(acc[ai][0][m][1])) + (ssq4(acc[ai][1][m][0]) + ssq4(acc[ai][1][m][1])); s = red_fq(s); r = rsqrtf(s * rs * rs * (1.f / 64.f) + EPSN) * rs; }
                bf16_t* d = (isk ? KN : VB) + (size_t)row * 1024 + head * 64 + 8 * fq;
                { PG8_LAS unsigned char* sg_ = stg0 + (wr * 4 + wc) * STG_WAVE;
#pragma unroll
                  for (int bj = 0; bj < 2; ++bj) { const f32x4 g0 = isk ? *(const f32x4*)(gkn + 32 * bj + 8 * fq) : (f32x4){1.f, 1.f, 1.f, 1.f}, g1 = isk ? *(const f32x4*)(gkn + 32 * bj + 4 + 8 * fq) : (f32x4){1.f, 1.f, 1.f, 1.f};
                      stg_put(sg_, fr, fq, bj, acc[ai][bj][m][0] * g0 * r, acc[ai][bj][m][1] * g1 * r); }
                  stg_flush(sg_, fr, fq, d - 8 * fq, 1024); }
                asm volatile("" ::: "memory");
            }
    }
};
}
namespace at {
#define ALAS __attribute__((address_space(3)))
typedef unsigned short bf16_t;
typedef short bf16x8 __attribute__((ext_vector_type(8)));
typedef short s16x4 __attribute__((ext_vector_type(4)));
typedef float f32x16 __attribute__((ext_vector_type(16)));
typedef float f32x4 __attribute__((ext_vector_type(4)));
typedef unsigned u32x4 __attribute__((ext_vector_type(4)));
typedef unsigned u32x2 __attribute__((ext_vector_type(2)));
constexpr int KROW = 144, VROW = 144, RROW = 80;
constexpr int KBUF = 64 * KROW, VBUF = 64 * VROW, RBUF = 64 * RROW, STAGE = KBUF + VBUF + RBUF;
constexpr int NSTAGE = 2, TBL_OFF = NSTAGE * STAGE, OSTG_OFF = 49152, OSTG_WAVE = 32 * 272, LDS_BYTES = OSTG_OFF + 8 * OSTG_WAVE;
static_assert(TBL_OFF + 1280 <= OSTG_OFF, "attention LDS map");
struct AttnUnit { int qrow0, nq, krow0, nt, lastvalid, head, c0, tf; };
__device__ __forceinline__ int crow(int r, int hi) { return (r & 3) + 8 * (r >> 2) + 4 * hi; }

template <bool MLA>
__device__ __forceinline__ void attn_unit(ALAS unsigned char* lds, const AttnUnit u, const bf16_t* __restrict__ Q, const bf16_t* __restrict__ Kn, const bf16_t* __restrict__ Kr,
                                          const bf16_t* __restrict__ V, const bf16_t* __restrict__ Z, bf16_t* __restrict__ U, const float* __restrict__ tbl) {
    int tid_ = threadIdx.x; asm volatile("" : "+v"(tid_));
    const int tid = tid_, lane = tid & 63, wid = __builtin_amdgcn_readfirstlane(tid >> 6), l32 = lane & 31, hi = lane >> 5;
    const int ci = wid >> 1, qh = wid & 1;
    const bool active = ci * 64 + qh * 32 < u.nq;
    const int cq = u.c0 + ci;
    constexpr int QS = MLA ? 1536 : 1024, HS = MLA ? 96 : 64, ND0 = MLA ? 6 : 4;
    constexpr float THR = 8.f;
    ALAS float* tb = (ALAS float*)(lds + TBL_OFF);
    if (!MLA) { if (tid < 320) tb[tid] = tid < 257 ? (tbl[(size_t)u.head * 257 + tid] - tbl[(size_t)u.head * 257 + 256]) * LOG2E : 0.f; }
    const int qrow = u.qrow0 + (active ? ci * 64 + qh * 32 : 0) + l32;
    bf16x8 qf[ND0];
#pragma unroll
    for (int d0 = 0; d0 < ND0; ++d0) qf[d0] = *(const bf16x8*)(Q + (size_t)qrow * QS + u.head * HS + d0 * 16 + hi * 8);
    const char* kbase = (const char*)(Kn + (size_t)u.krow0 * 1024 + u.head * 64);
    const char* vbase = (const char*)(V + (size_t)u.krow0 * 1024 + u.head * 64);
    const char* rbase = MLA ? (const char*)(Kr + (size_t)u.krow0 * 32) : nullptr;
    const unsigned koff = (unsigned)(((tid >> 3) * 1024 + (tid & 7) * 8) * 2);
    const int vkvq = (tid & 3) + 4 * ((tid >> 6) & 3), vdq = (tid >> 2) & 15;
    const unsigned voff = (unsigned)(((vkvq * 4) * 1024 + vdq * 4) * 2);
    const int vpos8 = (vkvq & ~3) + ((vkvq & 1) << 1) + ((vkvq >> 1) & 1);
    const unsigned roff = (unsigned)(((((tid - 256) >> 2) & 63) * 32 + (tid & 3) * 8) * 2);
    u32x4 kreg[1]; u32x2 vreg[1][4]; u32x4 rreg[1];
#define AT_GLOAD(ti, sx) do { const int tl_ = (ti) < u.nt ? (ti) : u.nt - 1; \
        kreg[sx] = *(const u32x4*)(kbase + (size_t)tl_ * 131072 + koff); \
        if (tid < 256) { const char* vb_ = vbase + (size_t)tl_ * 131072; \
            vreg[sx][0] = *(const u32x2*)(vb_ + voff); vreg[sx][1] = *(const u32x2*)(vb_ + voff + 2048); vreg[sx][2] = *(const u32x2*)(vb_ + 4096 + voff); vreg[sx][3] = *(const u32x2*)(vb_ + 4096 + voff + 2048); } \
        else if (MLA) { rreg[sx] = *(const u32x4*)(rbase + (size_t)tl_ * 4096 + roff); } } while (0)
#define AT_SWRITE(st, sx) do { ALAS unsigned char* sb_ = lds + (st) * STAGE; \
        *(ALAS u32x4*)(sb_ + (tid >> 3) * KROW + (tid & 7) * 16) = kreg[sx]; \
        if (tid < 256) { \
            _Pragma("unroll") for (int jj_ = 0; jj_ < 4; ++jj_) { const int d_ = 4 * vdq + jj_; u32x2 o_; \
                const unsigned sel_ = (jj_ & 1) ? 0x07060302u : 0x05040100u; \
                if (jj_ < 2) { o_.x = __builtin_amdgcn_perm(vreg[sx][1].x, vreg[sx][0].x, sel_); o_.y = __builtin_amdgcn_perm(vreg[sx][3].x, vreg[sx][2].x, sel_); } \
                else         { o_.x = __builtin_amdgcn_perm(vreg[sx][1].y, vreg[sx][0].y, sel_); o_.y = __builtin_amdgcn_perm(vreg[sx][3].y, vreg[sx][2].y, sel_); } \
                *(ALAS u32x2*)(sb_ + KBUF + d_ * VROW + vpos8 * 8) = o_; } } \
        else if (MLA) { const int t2_ = tid - 256; *(ALAS u32x4*)(sb_ + KBUF + VBUF + (t2_ >> 2) * RROW + (t2_ & 3) * 16) = rreg[sx]; } } while (0)
    float mref = 0.f;
    bool first = true;
    f32x16 negm = f32x16{}; asm volatile("" : "+v"(negm));
    f32x16 o0 = f32x16{}, o1 = f32x16{}; float lrun = 0.f;
    f32x16 p[2];
    const int tgl = (qh * 32 + l32 + 128 - 4 * hi) * 4;
#define AT_QK(t, sg) do { const int kc_ = u.tf + (t); ALAS unsigned char* sb_ = lds + (sg) * STAGE; ALAS unsigned char* kb_ = sb_ + l32 * KROW + hi * 16; \
        bool near_ = false; \
        if (!MLA) { near_ = cq - kc_ < 3; \
            if (near_) { ALAS unsigned char* tp_ = (ALAS unsigned char*)tb + tgl + 256 * (cq - kc_); \
                _Pragma("unroll") for (int blk = 0; blk < 2; ++blk) _Pragma("unroll") for (int r = 0; r < 16; ++r) p[blk][r] = *(const ALAS float*)(tp_ - 4 * (32 * blk + (r & 3) + 8 * (r >> 2))) - mref; } } \
        bf16x8 ka_[4], kb2_[4]; ALAS unsigned char* rb_ = sb_ + KBUF + VBUF + l32 * RROW + hi * 16; \
        _Pragma("unroll") for (int d0 = 0; d0 < 4; ++d0) ka_[d0] = *(const ALAS bf16x8*)(kb_ + d0 * 32); \
        _Pragma("unroll") for (int d0 = 0; d0 < 4; ++d0) kb2_[d0] = *(const ALAS bf16x8*)(kb_ + 32 * KROW + d0 * 32); \
        __builtin_amdgcn_sched_barrier(0); \
        if (near_) { p[0] = __builtin_amdgcn_mfma_f32_32x32x16_bf16(ka_[0], qf[0], p[0], 0, 0, 0); p[1] = __builtin_amdgcn_mfma_f32_32x32x16_bf16(kb2_[0], qf[0], p[1], 0, 0, 0); } \
        else       { p[0] = __builtin_amdgcn_mfma_f32_32x32x16_bf16(ka_[0], qf[0], negm, 0, 0, 0); p[1] = __builtin_amdgcn_mfma_f32_32x32x16_bf16(kb2_[0], qf[0], negm, 0, 0, 0); } \
        _Pragma("unroll") for (int d0 = 1; d0 < 4; ++d0) { p[0] = __builtin_amdgcn_mfma_f32_32x32x16_bf16(ka_[d0], qf[d0], p[0], 0, 0, 0); p[1] = __builtin_amdgcn_mfma_f32_32x32x16_bf16(kb2_[d0], qf[d0], p[1], 0, 0, 0); \
            if (MLA && d0 == 1) { ka_[0] = *(const ALAS bf16x8*)(rb_); kb2_[0] = *(const ALAS bf16x8*)(rb_ + 32 * RROW); ka_[1] = *(const ALAS bf16x8*)(rb_ + 32); kb2_[1] = *(const ALAS bf16x8*)(rb_ + 32 * RROW + 32); } } \
        if (MLA) { p[0] = __builtin_amdgcn_mfma_f32_32x32x16_bf16(ka_[0], qf[4], p[0], 0, 0, 0); p[1] = __builtin_amdgcn_mfma_f32_32x32x16_bf16(kb2_[0], qf[4], p[1], 0, 0, 0); \
                   p[0] = __builtin_amdgcn_mfma_f32_32x32x16_bf16(ka_[1], qf[ND0 - 1], p[0], 0, 0, 0); p[1] = __builtin_amdgcn_mfma_f32_32x32x16_bf16(kb2_[1], qf[ND0 - 1], p[1], 0, 0, 0); } \
        if ((t) == u.nt - 1 && u.lastvalid < 64) { _Pragma("unroll") for (int r = 0; r < 16; ++r) p[1][r] = -__builtin_inff(); } } while (0)
#define AT_SMPV(t, sg) do { ALAS unsigned char* vb_ = lds + (sg) * STAGE + KBUF + l32 * VROW + hi * 16; \
        bf16x8 vf_[2][4]; \
        _Pragma("unroll") for (int dblk = 0; dblk < 2; ++dblk) _Pragma("unroll") for (int j = 0; j < 4; ++j) vf_[dblk][j] = *(const ALAS bf16x8*)(vb_ + dblk * 32 * VROW + j * 32); \
        __builtin_amdgcn_sched_barrier(0); \
        float rm = p[0][0]; \
        _Pragma("unroll") for (int r = 1; r < 16; ++r) rm = fmaxf(rm, p[0][r]); \
        _Pragma("unroll") for (int r = 0; r < 16; ++r) rm = fmaxf(rm, p[1][r]); \
        rm = fmaxf(rm, __shfl_xor(rm, 32)); \
        if (first || __any(rm > THR)) { \
            const float dl = first ? rm : fmaxf(rm, 0.f); mref += dl; \
            _Pragma("unroll") for (int r = 0; r < 16; ++r) { p[0][r] -= dl; p[1][r] -= dl; } \
            _Pragma("unroll") for (int r = 0; r < 16; ++r) negm[r] = -mref; \
            asm volatile("" : "+v"(negm)); \
            if (!first) { const float al = __builtin_amdgcn_exp2f(-dl); lrun *= al; \
                _Pragma("unroll") for (int r = 0; r < 16; ++r) { o0[r] *= al; o1[r] *= al; } } \
            first = false; } \
        _Pragma("unroll") for (int blk = 0; blk < 2; ++blk) _Pragma("unroll") for (int r = 0; r < 16; ++r) p[blk][r] = __builtin_amdgcn_exp2f(p[blk][r]); \
        { float ls0 = 0.f, ls1 = 0.f; _Pragma("unroll") for (int r = 0; r < 16; ++r) { ls0 += p[0][r]; ls1 += p[1][r]; } lrun += ls0 + ls1; } \
        bf16x8 pk[4]; \
        _Pragma("unroll") for (int j = 0; j < 4; ++j) { u32x4 w; const int b = j >> 1, r0 = 8 * (j & 1); \
            w.x = pg8::pkbf(p[b][r0 + 0], p[b][r0 + 1]); w.y = pg8::pkbf(p[b][r0 + 2], p[b][r0 + 3]); w.z = pg8::pkbf(p[b][r0 + 4], p[b][r0 + 5]); w.w = pg8::pkbf(p[b][r0 + 6], p[b][r0 + 7]); \
            pk[j] = __builtin_bit_cast(bf16x8, w); } \
        _Pragma("unroll") for (int j = 0; j < 4; ++j) { \
            o0 = __builtin_amdgcn_mfma_f32_32x32x16_bf16(vf_[0][j], pk[j], o0, 0, 0, 0); \
            o1 = __builtin_amdgcn_mfma_f32_32x32x16_bf16(vf_[1][j], pk[j], o1, 0, 0, 0); \
            } } while (0)
#define AT_TAKE(t) (active && (u.tf + (t)) <= cq && (MLA || (u.tf + (t)) >= cq - 8))
    AT_GLOAD(0, 0); AT_SWRITE(0, 0);
    __syncthreads();
    for (int ti = 0; ti < u.nt; ++ti) {
        const bool more = ti + 1 < u.nt;
        if (more) AT_GLOAD(ti + 1, 0);
        if (AT_TAKE(ti)) { AT_QK(ti, ti & 1); AT_SMPV(ti, ti & 1); }
        if (more) AT_SWRITE((ti + 1) & 1, 0);
        __syncthreads();
    }
#undef AT_QK
#undef AT_SMPV
#undef AT_TAKE
    if (active) {
        const float inv = 1.f / (lrun + __shfl_xor(lrun, 32));
        ALAS unsigned char* ot = lds + OSTG_OFF + wid * OSTG_WAVE;
#pragma unroll
        for (int dblk = 0; dblk < 2; ++dblk)
#pragma unroll
            for (int g = 0; g < 4; ++g) { const f32x16& o = dblk == 0 ? o0 : o1;
                *(ALAS f32x4*)(ot + l32 * 272 + (32 * dblk + 8 * g + 4 * hi) * 4) = (f32x4){o[4 * g + 0] * inv, o[4 * g + 1] * inv, o[4 * g + 2] * inv, o[4 * g + 3] * inv}; }
        asm volatile("s_waitcnt lgkmcnt(0)" ::: "memory");
        const size_t rb = (size_t)(qrow - l32) * 1024 + u.head * 64 + (lane & 7) * 8;
#pragma unroll
        for (int i = 0; i < 4; ++i) { const int r = i * 8 + (lane >> 3);
            const f32x4 a0 = *(const ALAS f32x4*)(ot + r * 272 + (lane & 7) * 32), a1 = *(const ALAS f32x4*)(ot + r * 272 + (lane & 7) * 32 + 16);
            const u32x4 zz = *(const u32x4*)(Z + rb + (size_t)r * 1024);
            u32x4 w;
            w.x = pg8::pkbf(a0[0] * __uint_as_float(zz.x << 16), a0[1] * __uint_as_float(zz.x & 0xffff0000u)); w.y = pg8::pkbf(a0[2] * __uint_as_float(zz.y << 16), a0[3] * __uint_as_float(zz.y & 0xffff0000u));
            w.z = pg8::pkbf(a1[0] * __uint_as_float(zz.z << 16), a1[1] * __uint_as_float(zz.z & 0xffff0000u)); w.w = pg8::pkbf(a1[2] * __uint_as_float(zz.w << 16), a1[3] * __uint_as_float(zz.w & 0xffff0000u));
            *(u32x4*)(U + rb + (size_t)r * 1024) = w; }
        asm volatile("s_waitcnt lgkmcnt(0)" ::: "memory");
    }
#undef AT_GLOAD
#undef AT_SWRITE
}
__device__ __forceinline__ bool prompt_unit(int k, int G, int bid, int& bh, int& qb) {
    if (G == 256) { if (k >= 16) return false; const int x = bid & 7, j = bid >> 3; bh = (4 * k + (j >> 3)) * 8 + x; qb = ((j & 7) + k) & 7; return true; }
    const int u = bid + k * G; if (u >= 4096) return false; bh = u >> 3; qb = u & 7; return true;
}
}
#define LAS __attribute__((address_space(3)))
typedef unsigned short bf16;
typedef unsigned v4u __attribute__((ext_vector_type(4)));
typedef unsigned v2u __attribute__((ext_vector_type(2)));
typedef float f32x4 __attribute__((ext_vector_type(4)));
constexpr size_t MiB = 1u << 20;
constexpr size_t WS_MOD = 0;
constexpr size_t MOD_BYTES = 2 * 40 * 3072 * 4;
constexpr size_t WS_BAR = 1 * MiB - 16384;
constexpr size_t WS_CS = 1 * MiB;
constexpr size_t WS_G1 = 2 * MiB;
constexpr size_t WS_SW = 2 * MiB + 256 * 1024;
constexpr size_t WS_SSQ = 3 * MiB;
constexpr size_t WS_SSQQ = 3 * MiB + 320 * 1024, WS_SSQKV = 3 * MiB + 640 * 1024;
constexpr size_t WS_RAW2 = 24 * MiB;
constexpr size_t WS_W_AIN = 4 * MiB, WS_W_AOUT = 12 * MiB, WS_W_BIN = 14 * MiB, WS_W_UQ = 18 * MiB, WS_W_UKV = 20 * MiB, WS_W_BOUT = 22 * MiB;
constexpr size_t WS_H = 24 * MiB;
constexpr size_t WS_CKV = 153 * MiB;
constexpr size_t WS_KR = 194 * MiB;
constexpr size_t WS_X = 200 * MiB;
constexpr size_t WS_QA = WS_X, WS_KA = WS_X + 129 * MiB, WS_VA = WS_X + 267 * MiB, WS_ZA = WS_X + 405 * MiB;
constexpr size_t WS_YG = WS_ZA;
constexpr size_t WS_ZB = WS_X, WS_RAW = WS_X + 129 * MiB, WS_QB = WS_RAW, WS_CQ = WS_X + 322 * MiB, WS_KN = WS_X + 371 * MiB, WS_VB = WS_X + 532 * MiB;
constexpr size_t WS_Y1B = WS_X + 694 * MiB;
constexpr size_t WS_END = WS_Y1B + 129 * MiB;
static_assert((size_t)M1 * 1024 * 2 <= 129 * MiB && (size_t)RA * 1024 * 2 <= 138 * MiB && (size_t)M1 * 768 * 4 <= 193 * MiB && (size_t)M1 * 384 * 2 <= 49 * MiB && (size_t)R2 * 1024 * 2 <= 161 * MiB, "ws map");
static_assert((size_t)R2 * 256 * 2 <= 41 * MiB && (size_t)R2 * 32 * 2 <= 6 * MiB && WS_ZA + 129 * MiB <= WS_END && WS_VB + 161 * MiB <= WS_END && WS_END <= 1024 * MiB, "ws map");
constexpr size_t O_YP = 0, O_YS = 67108864, O_AKP = 67371008, O_AVP = 84148224, O_AKS = 100925440, O_AVS = 101187584, O_CKVP = 101449728, O_KRP = 118226944, O_CKVS = 120324096, O_KRS = 120389632;
constexpr int LDS_TOTAL = 151552, LDS_MISC = 131072 + 320;
static_assert(at::LDS_BYTES <= LDS_TOTAL && pg8::STAGE_BYTES <= LDS_TOTAL && pg8::STG_OFF + 8 * pg8::STG_WAVE <= LDS_TOTAL, "LDS");

__device__ __forceinline__ float wave_sum(float v) {
#pragma unroll
    for (int o = 1; o < 64; o <<= 1) v += __shfl_xor(v, o);
    return v;
}
__device__ __forceinline__ unsigned pk2(float lo, float hi) { return pg8::pkbf(lo, hi); }
__device__ __forceinline__ int src_col(int gemm, int g) {
    const int lc = ((g >> 3) * 8 + (g & 3) * 2 + ((g >> 2) & 1)) * 32;
    switch (gemm) {
    case 2: if (lc < 1024) return 672 + lc; if (lc < 1408) return lc - 1024; if (lc < 1664) return 384 + (lc - 1408); if (lc < 1696) return 640 + (lc - 1664); return -1;
    case 3: if (lc < 1024) return (lc >> 6) * 96 + (lc & 63); return ((lc - 1024) >> 5) * 96 + 64;
    case 4: if (lc < 1024) return (lc >> 6) * 128 + (lc & 63); return ((lc - 1024) >> 6) * 128 + 64 + (lc & 63);
    default: return lc;
    }
}
__device__ __forceinline__ void transpose_item(const float* W, int K, int Nsrc, int sc, bf16* WT, int g, int k0, LAS float* scr, int lane, bool cperm = false) {
    const int jl = lane & 31, sj = cperm ? 16 * ((jl >> 2) & 1) + 4 * (jl >> 3) + (jl & 3) : jl;
#pragma unroll 8
    for (int i = 0; i < 32; ++i) { const int kk = 2 * i + (lane >> 5); scr[kk * 33 + (lane & 31)] = sc >= 0 ? W[(size_t)(k0 + kk) * Nsrc + sc + sj] : 0.f; }
    asm volatile("s_waitcnt lgkmcnt(0)" ::: "memory");
    const int c = lane & 7;
#pragma unroll
    for (int j = 0; j < 4; ++j) { const int n = (lane >> 3) + 8 * j; const LAS float* s = scr + (8 * c) * 33 + n;
        v4u o; o.x = pk2(s[0 * 33], s[1 * 33]); o.y = pk2(s[2 * 33], s[3 * 33]); o.z = pk2(s[4 * 33], s[5 * 33]); o.w = pk2(s[6 * 33], s[7 * 33]);
        *(v4u*)(WT + (size_t)(32 * g + n) * K + k0 + 8 * c) = o; }
    asm volatile("s_waitcnt lgkmcnt(0)" ::: "memory");
}
__device__ __forceinline__ void cvt8(const float* s, bf16* d) { const f32x4 a = *(const f32x4*)s, b = *(const f32x4*)(s + 4); v4u o; o.x = pk2(a[0], a[1]); o.y = pk2(a[2], a[3]); o.z = pk2(b[0], b[1]); o.w = pk2(b[2], b[3]); *(v4u*)d = o; }

#define GAS __attribute__((address_space(1)))
#define RLX_AGENT __ATOMIC_RELAXED, __HIP_MEMORY_SCOPE_AGENT
#define XB_TMO      128
#define XB_XCNT(j)  (256  + 64 * (j))
#define XB_XSUB(j)  (1280 + 64 * (j))
#define XB_XGEN(j)  (2304 + 64 * (j))
#define XB_TOP      3328
#define XB_TOPGEN   3392
#define XCD_BAR_WORDS 3456
#define XB_SPIN_CAP (1u << 18)

__device__ __forceinline__ unsigned xb_ld(unsigned* p)              { return __hip_atomic_load(p, __ATOMIC_RELAXED, __HIP_MEMORY_SCOPE_AGENT); }
__device__ __forceinline__ unsigned xb_add(unsigned* p, unsigned v) { return __hip_atomic_fetch_add(p, v, __ATOMIC_RELAXED, __HIP_MEMORY_SCOPE_AGENT); }
__device__ __forceinline__ unsigned xb_xcc_id() { return (unsigned)__builtin_amdgcn_s_getreg((3 << 11) | 20) & 0xFu; }
#define XB_SPIN(cond, bar) do { unsigned _sp = 0; while (cond) { __builtin_amdgcn_s_sleep(1); \
    if ((++_sp & 255u) == 0u) { if (xb_ld(&(bar)[XB_TMO])) break; if (_sp > XB_SPIN_CAP) { atomicAdd(&(bar)[XB_TMO], 1u); break; } } } } while (0)

struct XcdBarrier {
    unsigned* bar; unsigned x;
    volatile LAS unsigned* st;
};

__device__ __forceinline__ XcdBarrier xcd_barrier_post(unsigned* bar, volatile LAS unsigned* st) {
    XcdBarrier b; b.bar = bar; b.x = xb_xcc_id(); b.st = st;
    if (threadIdx.x == 0) (void)xb_add(&bar[XB_XCNT(b.x)], 1u);
    return b;
}
__device__ __forceinline__ void xcd_barrier_complete(unsigned* bar, unsigned x, unsigned& nloc, unsigned& nx) {
    const unsigned G = gridDim.x * gridDim.y * gridDim.z;
    unsigned sum, cnt, mine, sp = 0u;
    for (;;) {
        sum = 0u; cnt = 0u; mine = 0u;
#pragma unroll
        for (unsigned j = 0; j < 16; ++j) { const unsigned c = xb_ld(&bar[XB_XCNT(j)]); sum += c; cnt += (c > 0u) ? 1u : 0u; mine = (j == x) ? c : mine; }
        if (sum == G) break;
        __builtin_amdgcn_s_sleep(1);
        if ((++sp & 255u) == 0u) { if (xb_ld(&bar[XB_TMO])) break; if (sp > XB_SPIN_CAP) { atomicAdd(&bar[XB_TMO], 1u); break; } }
    }
    nloc = mine > 0u ? mine : 1u; nx = cnt > 0u ? cnt : 1u;
}

__device__ __forceinline__ void xcd_barrier(const XcdBarrier& b) {
    asm volatile("s_waitcnt vmcnt(0)" ::: "memory");
    __syncthreads();
    if (threadIdx.x == 0) {
        unsigned* bar = b.bar;
        __builtin_amdgcn_s_waitcnt(0);
        unsigned nloc = b.st[0], nx = b.st[1];
        if (nloc == 0u) { xcd_barrier_complete(bar, b.x, nloc, nx); b.st[0] = nloc; b.st[1] = nx; }
        const unsigned old = xb_add(&bar[XB_XSUB(b.x)], 1u);
        const unsigned gen = old / nloc;
        if (old + 1u == (gen + 1u) * nloc) {
            __builtin_amdgcn_fence(__ATOMIC_RELEASE, "agent");
            asm volatile("s_waitcnt vmcnt(0)" ::: "memory");
            const unsigned og = xb_add(&bar[XB_TOP], 1u);
            const unsigned tg = og / nx;
            if (og + 1u == (tg + 1u) * nx) xb_add(&bar[XB_TOPGEN], 1u);
            else XB_SPIN(xb_ld(&bar[XB_TOPGEN]) == tg, bar);
            __builtin_amdgcn_fence(__ATOMIC_ACQUIRE, "agent");
            xb_add(&bar[XB_XGEN(b.x)], 1u);
            asm volatile("s_waitcnt vmcnt(0)" ::: "memory");
        } else {
            XB_SPIN(xb_ld(&bar[XB_XGEN(b.x)]) == gen, bar);
            __builtin_amdgcn_fence(__ATOMIC_ACQUIRE, "agent");
            asm volatile("s_waitcnt vmcnt(0)" ::: "memory");
        }
    }
    __syncthreads();
}

struct Args { const float* in[26]; float* out; unsigned char* ws; int ph_lo, ph_hi; };

__device__ __forceinline__ void adanorm_rows(const float* xp, const float* xs, const float* g, const float* mod, bf16* H, int gw, int NGW, int lane) {
    for (int grp = gw; grp < M1 / 4; grp += NGW) {
        const int row0 = grp * 4;
        const float* xr; int bb;
        if (row0 < MP) { xr = xp + (size_t)row0 * 1024; bb = row0 >> 11; } else { xr = xs + (size_t)(row0 - MP) * 1024; bb = NBP + ((row0 - MP) >> 5); }
        const float* md = mod + (size_t)bb * 3072;
        f32x4 v[4][4]; float s[4];
#pragma unroll
        for (int q = 0; q < 4; ++q) { s[q] = 0.f;
#pragma unroll
            for (int j = 0; j < 4; ++j) v[q][j] = *(const f32x4*)(xr + (size_t)q * 1024 + 4 * lane + 256 * j); }
#pragma unroll
        for (int q = 0; q < 4; ++q)
#pragma unroll
            for (int j = 0; j < 4; ++j) s[q] += pg8::ssq4(v[q][j]);
#pragma unroll
        for (int o = 1; o < 64; o <<= 1) {
#pragma unroll
            for (int q = 0; q < 4; ++q) s[q] += __shfl_xor(s[q], o); }
#pragma unroll
        for (int q = 0; q < 4; ++q) s[q] = rsqrtf(s[q] * (1.f / 1024.f) + EPSN);
#pragma unroll
        for (int j = 0; j < 4; ++j) { const int c = 4 * lane + 256 * j;
            const f32x4 gg = *(const f32x4*)(g + c) * (*(const f32x4*)(md + 1024 + c) + 1.f), sh = *(const f32x4*)(md + c);
#pragma unroll
            for (int q = 0; q < 4; ++q) { const f32x4 h = v[q][j] * s[q] * gg + sh;
                v2u o; o.x = pk2(h[0], h[1]); o.y = pk2(h[2], h[3]); *(v2u*)(H + (size_t)(row0 + q) * 1024 + c) = o; } }
    }
}

__global__ void __launch_bounds__(512, 2) hybrid_fwd(Args args) {
    extern __shared__ __attribute__((aligned(16))) unsigned char lds_raw[];
    LAS unsigned char* lds = (LAS unsigned char*)lds_raw;
    const int tid = threadIdx.x, lane = tid & 63, wave = __builtin_amdgcn_readfirstlane(tid >> 6);
    const int G = gridDim.x, bid = blockIdx.x;
    const int gw = bid * 8 + wave, NGW = G * 8;
    const int gt = bid * 512 + tid, NGT = G * 512;
    const int lo = args.ph_lo, hi = args.ph_hi;
    volatile LAS unsigned* MISC = (volatile LAS unsigned*)(lds + LDS_MISC);
    if (tid < 16) MISC[tid] = 0u;
    __syncthreads();
    XcdBarrier bar; bar.bar = nullptr; bar.x = 0; bar.st = nullptr;
    if (hi - lo > 1) { bar = xcd_barrier_post((unsigned*)(args.ws + WS_BAR), MISC + 8); cg::this_grid().sync(); }
#ifndef PHMASK
#define PHMASK 0x7ff
#endif
#ifndef PROBE_SYNC
#define PROBE_SYNC 0
#endif
#ifndef PROBE_REP
#define PROBE_REP 0
#endif
#define REP(k) for (int rep_ = 0; rep_ < 1 + ((PROBE_REP >> (k)) & 1); ++rep_)
#define IN(k) (((PHMASK >> (k)) & 1) && lo <= (k) && (k) < hi)
typedef const __attribute__((address_space(4))) Args* KArgs;
#define PHASE_ARGS() KArgs A = (KArgs)__builtin_amdgcn_kernarg_segment_ptr(); asm volatile("" : "+s"(A)); unsigned char* ws = A->ws; float* out = A->out; (void)ws; (void)out
#define WSP(T, off) ((T*)(ws + (off)))
#define SEAM(k) do { if (IN(k) && IN((k) + 1)) { xcd_barrier(bar); } } while (0)

    if (IN(0)) REP(0) {
        PHASE_ARGS();
        float* mod = WSP(float, WS_MOD); float* CS = WSP(float, WS_CS);
        bf16 *W_AIN = WSP(bf16, WS_W_AIN), *W_AOUT = WSP(bf16, WS_W_AOUT), *W_BIN = WSP(bf16, WS_W_BIN), *W_UQ = WSP(bf16, WS_W_UQ), *W_UKV = WSP(bf16, WS_W_UKV), *W_BOUT = WSP(bf16, WS_W_BOUT);
        bf16 *KA = WSP(bf16, WS_KA), *VA = WSP(bf16, WS_VA), *CKV = WSP(bf16, WS_CKV), *KR = WSP(bf16, WS_KR);
        {
            LAS float* scr = (LAS float*)(lds + wave * 10240);
            constexpr int I0 = 16 * 128, I1 = 16 * 32, I2 = 16 * 56, I3 = 6 * 48, I4 = 4 * 64, I5 = 16 * 32;
            const bool split = (G == 256);
            const int tgw = split ? (bid - 96) * 8 + wave : gw, tngw = split ? 160 * 8 : NGW;
            if (!split || bid >= 96)
            for (int it = tgw; it < I0 + I1 + I2 + I3 + I4 + I5; it += tngw) {
                int r = it;
                if (r < I0) { const int g = r % 128; transpose_item(A->in[11], 1024, 4096, src_col(0, g), W_AIN, g, (r / 128) * 64, scr, lane); continue; } r -= I0;
                if (r < I1) { const int g = r % 32; transpose_item(A->in[15], 1024, 1024, src_col(1, g), W_AOUT, g, (r / 32) * 64, scr, lane); continue; } r -= I1;
                if (r < I2) { const int g = r % 56; transpose_item(A->in[16], 1024, 1696, src_col(2, g), W_BIN, g, (r / 56) * 64, scr, lane); continue; } r -= I2;
                if (r < I3) { const int g = r % 48; transpose_item(A->in[18], 384, 1536, src_col(3, g), W_UQ, g, (r / 48) * 64, scr, lane, g >= 32); continue; } r -= I3;
                if (r < I4) { const int g = r % 64; transpose_item(A->in[20], 256, 2048, src_col(4, g), W_UKV, g, (r / 64) * 64, scr, lane); continue; } r -= I4;
                { const int g = r % 32; transpose_item(A->in[25], 1024, 1024, src_col(5, g), W_BOUT, g, (r / 32) * 64, scr, lane); }
            }
        }
        for (int it = bid; it < 2 * 48; it += G) {
            const int l = it / 48, jb = it % 48;
            LAS float* sl = (LAS float*)(lds + wave * 10240);
            float acc[40];
#pragma unroll
            for (int b = 0; b < 40; ++b) acc[b] = 0.f;
            for (int pass = 0; pass < 2; ++pass) {
                const int k0 = (wave + 8 * pass) * 64;
                for (int e = lane; e < 40 * 64; e += 64) { const int bb = e >> 6, k = e & 63; const float c = bb < NBP ? A->in[6][(size_t)bb * 1024 + k0 + k] : A->in[7][(size_t)(bb - NBP) * 1024 + k0 + k]; sl[e] = c / (1.f + __expf(-c)); }
                asm volatile("s_waitcnt lgkmcnt(0)" ::: "memory");
                const float* W = A->in[9] + (size_t)l * 1024 * 3072 + (size_t)k0 * 3072 + jb * 64 + lane;
                for (int k = 0; k < 64; k += 4) {
                    const float w0 = W[(size_t)k * 3072], w1 = W[(size_t)(k + 1) * 3072], w2 = W[(size_t)(k + 2) * 3072], w3 = W[(size_t)(k + 3) * 3072];
#pragma unroll
                    for (int b = 0; b < 40; ++b) { const f32x4 sv = *(const LAS f32x4*)(sl + b * 64 + k); acc[b] += (sv[0] * w0 + sv[1] * w1) + (sv[2] * w2 + sv[3] * w3); }
                }
                asm volatile("s_waitcnt lgkmcnt(0)" ::: "memory");
            }
            __syncthreads();
            LAS float* red = (LAS float*)lds;
#pragma unroll
            for (int b = 0; b < 40; ++b) red[(wave * 40 + b) * 64 + lane] = acc[b];
            __syncthreads();
            for (int e = tid; e < 40 * 64; e += 512) { const int b = e >> 6, j = e & 63; float sum = A->in[10][(size_t)l * 3072 + jb * 64 + j];
#pragma unroll
                for (int w = 0; w < 8; ++w) sum += red[(w * 40 + b) * 64 + j];
                mod[((size_t)l * 40 + b) * 3072 + jb * 64 + j] = sum; }
            __syncthreads();
        }
        for (int i = gt; i < NBS * SA_STRIDE * 128; i += NGT) {
            const int c8 = i & 127, rr = (i >> 7) % SA_STRIDE, bs = (i >> 7) / SA_STRIDE;
            const size_t d = ((size_t)MP + (size_t)bs * SA_STRIDE + rr) * 1024 + c8 * 8;
            if (rr < 512) { const size_t s = ((size_t)bs * 512 + rr) * 1024 + c8 * 8; cvt8(A->in[2] + s, KA + d); cvt8(A->in[3] + s, VA + d); }
            else if (rr >= 544) { *(v4u*)(KA + d) = (v4u){0, 0, 0, 0}; *(v4u*)(VA + d) = (v4u){0, 0, 0, 0}; }
        }
        for (int i = gt; i < NBS * SB_STRIDE * 32; i += NGT) {
            const int c8 = i & 31, rr = (i >> 5) % SB_STRIDE, bs = (i >> 5) / SB_STRIDE;
            const size_t d = ((size_t)MP + (size_t)bs * SB_STRIDE + rr) * 256 + c8 * 8;
            if (rr < 2048) cvt8(A->in[4] + ((size_t)bs * 2048 + rr) * 256 + c8 * 8, CKV + d);
            else if (rr >= 2080) *(v4u*)(CKV + d) = (v4u){0, 0, 0, 0};
        }
        for (int i = gt; i < NBS * SB_STRIDE * 4; i += NGT) {
            const int c8 = i & 3, rr = (i >> 2) % SB_STRIDE, bs = (i >> 2) / SB_STRIDE;
            const size_t d = ((size_t)MP + (size_t)bs * SB_STRIDE + rr) * 32 + c8 * 8;
            if (rr < 2048) cvt8(A->in[5] + ((size_t)bs * 2048 + rr) * 32 + c8 * 8, KR + d);
            else if (rr >= 2080) *(v4u*)(KR + d) = (v4u){0, 0, 0, 0};
        }
        { float* SSQ = WSP(float, WS_SSQ); float* SQ2 = WSP(float, WS_SSQQ); float* SQ3 = WSP(float, WS_SSQKV); for (int i = gt; i < M1; i += NGT) { SSQ[i] = 0.f; SQ2[i] = 0.f; SQ3[i] = 0.f; } }
        for (int i = gt; i < 2112 * 16; i += NGT) {
            const int pos = i >> 4, k = i & 15;
            const float inv = exp2f(-(float)k * (13.287712379549449f / 16.f));
            const float ang = (float)pos * inv;
            const double tr = (double)ang * 0.15915494309189535;
            const float fr = (float)(tr - floor(tr + 0.5));
            CS[pos * 32 + k] = __builtin_amdgcn_cosf(fr); CS[pos * 32 + 16 + k] = __builtin_amdgcn_sinf(fr);
        }
    }
    SEAM(0);
    if (IN(1)) REP(1) { PHASE_ARGS();
        const float* mod1 = WSP(float, WS_MOD) + 40 * 3072;
        {
            float* G1 = WSP(float, WS_G1); const float* g1 = A->in[8] + 1024;
            for (int i = gt; i < 40 * 1024; i += NGT) { const int bb = i >> 10, c = i & 1023; G1[i] = g1[c] * (1.f + mod1[(size_t)bb * 3072 + 1024 + c]); }
            float* SW = WSP(float, WS_SW); const bf16* WB = WSP(bf16, WS_W_BIN);
            for (int lc = gw; lc < 1792; lc += NGW) {
                const int lg = lc >> 5, pn = lg >> 3, rem = lg & 7, crow_ = (pn * 8 + (rem & 1) * 4 + (rem >> 1)) * 32 + (lc & 31);
                const v4u w0 = *(const v4u*)(WB + (size_t)crow_ * 1024 + 16 * lane), w1 = *(const v4u*)(WB + (size_t)crow_ * 1024 + 16 * lane + 8);
                float wf[16];
#pragma unroll
                for (int e = 0; e < 4; ++e) { wf[2 * e] = __uint_as_float(w0[e] << 16); wf[2 * e + 1] = __uint_as_float(w0[e] & 0xffff0000u); wf[8 + 2 * e] = __uint_as_float(w1[e] << 16); wf[8 + 2 * e + 1] = __uint_as_float(w1[e] & 0xffff0000u); }
                for (int bb = 0; bb < 40; ++bb) { const float* sh = mod1 + (size_t)bb * 3072 + 16 * lane; float a = 0.f;
#pragma unroll
                    for (int e = 0; e < 4; ++e) { const f32x4 x = *(const f32x4*)(sh + 4 * e); a += (x[0] * wf[4 * e] + x[1] * wf[4 * e + 1]) + (x[2] * wf[4 * e + 2] + x[3] * wf[4 * e + 3]); }
                    a = wave_sum(a); if (lane == 0) SW[(size_t)bb * 1792 + lc] = a; }
            }
        }
        adanorm_rows(A->in[0], A->in[1], A->in[8], WSP(float, WS_MOD), WSP(bf16, WS_H), gw, NGW, lane); }
    SEAM(1);
    if (IN(2)) REP(2) {
        PHASE_ARGS();
        int Kop = 1024; asm volatile("" : "+s"(Kop)); pg8::Gemm g{WSP(bf16, WS_H), WSP(bf16, WS_W_AIN), M1, 4096, Kop}; pg8::StaticOrder S; S.init(M1, 4096, G, bid);
        pg8::EpiAin E{WSP(bf16, WS_QA), WSP(bf16, WS_KA), WSP(bf16, WS_VA), WSP(bf16, WS_ZA), A->in[12], A->in[13], out + O_AKP, out + O_AVP, out + O_AKS, out + O_AVS, lds + pg8::STG_OFF};
        pg8::gemm_phase<pg8::EpiAin, pg8::StaticOrder, true, true>(lds, g, S, E);
    }
    SEAM(2);
    if (IN(3)) REP(3) {
        PHASE_ARGS();
        bf16 *QA = WSP(bf16, WS_QA), *KA = WSP(bf16, WS_KA), *VA = WSP(bf16, WS_VA), *ZA = WSP(bf16, WS_ZA), *H = WSP(bf16, WS_H); const float* tblp = A->in[14];
        __syncthreads();
        { int bh, qb;
          for (int k = 0; at::prompt_unit(k, G, bid, bh, qb); ++k) {
            at::AttnUnit a; const int b = bh >> 4, c0 = 4 * qb, tf = c0 > 8 ? c0 - 8 : 0;
            a.qrow0 = b * SEQ + 256 * qb; a.nq = 256; a.krow0 = b * SEQ + 64 * tf; a.nt = c0 + 3 - tf + 1; a.lastvalid = 64; a.head = bh & 15; a.c0 = c0; a.tf = tf;
            at::attn_unit<false>(lds, a, QA, KA, nullptr, VA, ZA, H, tblp);
          } }
        for (int s = bid; s < 128; s += G) {
            at::AttnUnit a; const int bs = s >> 4;
            a.qrow0 = MP + bs * TS; a.nq = 32; a.krow0 = MP + bs * SA_STRIDE; a.nt = 9; a.lastvalid = 32; a.head = s & 15; a.c0 = 8; a.tf = 0;
            at::attn_unit<false>(lds, a, QA, KA, nullptr, VA, ZA, H, tblp);
        }
    }
    SEAM(3);
    if (IN(4)) REP(4) {
        PHASE_ARGS();
        int Kop = 1024; asm volatile("" : "+s"(Kop)); pg8::Gemm g{WSP(bf16, WS_H), WSP(bf16, WS_W_AOUT), M1, 1024, Kop}; pg8::StaticOrder S; S.init(M1, 1024, G, bid);
        pg8::EpiRes E{A->in[0], A->in[1], out + O_YP, out + O_YS, WSP(float, WS_MOD) + 2048, WSP(bf16, WS_YG), WSP(float, WS_G1), WSP(float, WS_SSQ), lds + pg8::STG_OFF, nullptr, WSP(bf16, WS_Y1B)};
        pg8::gemm_phase<pg8::EpiRes, pg8::StaticOrder, true, true>(lds, g, S, E);
    }
    if (IN(4) && IN(6)) { xcd_barrier(bar); }
    if (IN(6)) REP(6) {
        PHASE_ARGS();
        int Kop = 1024; asm volatile("" : "+s"(Kop)); pg8::Gemm g{WSP(bf16, WS_YG), WSP(bf16, WS_W_BIN), M1, 1792, Kop}; pg8::StaticOrder S; S.init(M1, 1792, G, bid);
        pg8::EpiBin E{WSP(bf16, WS_ZB), WSP(bf16, WS_CQ), WSP(bf16, WS_CKV), WSP(float, WS_RAW2), WSP(float, WS_SSQ), WSP(float, WS_SW), A->in[17], A->in[19], WSP(float, WS_SSQQ), WSP(float, WS_SSQKV), lds + pg8::STG_OFF};
        pg8::gemm_phase<pg8::EpiBin, pg8::StaticOrder, true, true>(lds, g, S, E);
    }
    if (IN(6) && IN(8)) { xcd_barrier(bar); }
    if (IN(8)) REP(8) {
        { PHASE_ARGS(); int Kop = 384; asm volatile("" : "+s"(Kop)); pg8::Gemm g{WSP(bf16, WS_CQ), WSP(bf16, WS_W_UQ), M1, 1536, Kop}; pg8::StaticOrder S; S.init(M1, 1536, G, bid);
          pg8::EpiUq E{WSP(bf16, WS_QB), A->in[21], A->in[22], WSP(float, WS_CS), WSP(float, WS_SSQQ), lds + pg8::STG_OFF};
          pg8::gemm_phase<pg8::EpiUq, pg8::StaticOrder, true, true>(lds, g, S, E); }
        __syncthreads();
        { PHASE_ARGS(); int Kop = 256; asm volatile("" : "+s"(Kop)); pg8::Gemm g{WSP(bf16, WS_CKV), WSP(bf16, WS_W_UKV), R2, 2048, Kop}; pg8::StaticOrder S; S.init(R2, 2048, G, G - 1 - bid);
          pg8::EpiUkv E{WSP(bf16, WS_KN), WSP(bf16, WS_VB), A->in[23], WSP(float, WS_SSQKV), lds + pg8::STG_OFF};
          pg8::gemm_phase<pg8::EpiUkv, pg8::StaticOrder, true, true>(lds, g, S, E); }
        __syncthreads();
        {
            PHASE_ARGS();
            const float* RAW2 = WSP(float, WS_RAW2); const float* CS = WSP(float, WS_CS); const float* SQ3 = WSP(float, WS_SSQKV); bf16* KR = WSP(bf16, WS_KR); const bf16* CKVb = WSP(bf16, WS_CKV);
            const float* gkr = A->in[24];
            unsigned* wq = (unsigned*)(ws + WS_BAR) + 3600;
            volatile LAS unsigned* slot = (volatile LAS unsigned*)(lds + LDS_MISC + 16);
            for (;;) {
                if (tid == 0) slot[0] = atomicAdd(wq, 1u);
                __syncthreads();
                const unsigned ch = slot[0];
                __syncthreads();
                if (ch >= (unsigned)(M1 / 128)) break;
              for (int rix = 0; rix < 16; ++rix) { const int row = (int)ch * 128 + rix * 8 + wave;
                const float* rw = RAW2 + (size_t)row * 32;
                int pos; size_t drow, orow;
                if (row < MP) { pos = row & (SEQ - 1); drow = (size_t)row; orow = (size_t)row; }
                else { const int rs = row - MP; pos = SEQ + (rs & 31); drow = (size_t)MP + (size_t)(rs >> 5) * SB_STRIDE + 2048 + (rs & 31); orow = (size_t)rs; }
                float* ockv = (row < MP ? out + O_CKVP : out + O_CKVS) + orow * 256;
                float* okr = (row < MP ? out + O_KRP : out + O_KRS) + orow * 32;
                const v2u kw = *(const v2u*)(CKVb + drow * 256 + 4 * lane);
                const f32x4 kv = (f32x4){__uint_as_float(kw.x << 16), __uint_as_float(kw.x & 0xffff0000u), __uint_as_float(kw.y << 16), __uint_as_float(kw.y & 0xffff0000u)};
                const float kr = lane < 32 ? rw[lane] : 0.f;
                float r = rsqrtf(SQ3[row] * (1.f / 256.f) + EPSN);
                *(f32x4*)(ockv + 4 * lane) = kv * r;
                r = rsqrtf(wave_sum(kr * kr) * (1.f / 32.f) + EPSN);
                const float kn = kr * r * (lane < 32 ? gkr[lane] : 0.f);
                const float pr = __shfl_xor(kn, 16);
                const float cs = CS[pos * 32 + (lane & 15)], sn = CS[pos * 32 + 16 + (lane & 15)];
                const float ro = (lane & 16) ? (kn * cs + pr * sn) : (kn * cs - pr * sn);
                if (lane < 32) { okr[lane] = ro; const unsigned b = pk2(ro, 0.f); KR[drow * 32 + lane] = (bf16)(b & 0xffffu); }
              }
            }
        }
    }
    SEAM(8);
    if (IN(9)) REP(9) {
        PHASE_ARGS();
        bf16 *QB = WSP(bf16, WS_QB), *KN = WSP(bf16, WS_KN), *KR = WSP(bf16, WS_KR), *VB = WSP(bf16, WS_VB), *ZB = WSP(bf16, WS_ZB), *H = WSP(bf16, WS_H);
        __syncthreads();
        const bool shed = (G == 256);
        { int bh, qb;
          for (int k = 0; at::prompt_unit(k, G, bid, bh, qb); ++k) {
            if (shed && bid < 128 && k < 8 && qb == 3) continue;
            at::AttnUnit a; const int b = bh >> 4;
            a.qrow0 = b * SEQ + 256 * qb; a.nq = 256; a.krow0 = b * SEQ; a.nt = 4 * qb + 4; a.lastvalid = 64; a.head = bh & 15; a.c0 = 4 * qb; a.tf = 0;
            at::attn_unit<true>(lds, a, QB, KN, KR, VB, ZB, H, nullptr);
          }
          if (shed && bid >= 128) {
            for (int k = 0; k < 8 && at::prompt_unit(k, G, bid - 128, bh, qb); ++k) { if (qb != 3) continue;
              at::AttnUnit a; const int b = bh >> 4;
              a.qrow0 = b * SEQ + 256 * qb; a.nq = 256; a.krow0 = b * SEQ; a.nt = 4 * qb + 4; a.lastvalid = 64; a.head = bh & 15; a.c0 = 4 * qb; a.tf = 0;
              at::attn_unit<true>(lds, a, QB, KN, KR, VB, ZB, H, nullptr); }
          } }
        for (int s = bid; s < 128; s += G) {
            at::AttnUnit a; const int bs = s >> 4;
            a.qrow0 = MP + bs * TS; a.nq = 32; a.krow0 = MP + bs * SB_STRIDE; a.nt = 33; a.lastvalid = 32; a.head = s & 15; a.c0 = 32; a.tf = 0;
            at::attn_unit<true>(lds, a, QB, KN, KR, VB, ZB, H, nullptr);
        }
    }
    SEAM(9);
    if (IN(10)) REP(10) {
        PHASE_ARGS();
        int Kop = 1024; asm volatile("" : "+s"(Kop)); pg8::Gemm g{WSP(bf16, WS_H), WSP(bf16, WS_W_BOUT), M1, 1024, Kop}; pg8::StaticOrder S; S.init(M1, 1024, G, bid);
        pg8::EpiRes E{out + O_YP, out + O_YS, out + O_YP, out + O_YS, WSP(float, WS_MOD) + 40 * 3072 + 2048, nullptr, nullptr, nullptr, lds + pg8::STG_OFF, WSP(bf16, WS_Y1B), nullptr};
        pg8::gemm_phase<pg8::EpiRes, pg8::StaticOrder, true, true>(lds, g, S, E);
    }
#if PROBE_SYNC
    if (hi - lo > 1) { for (int q = 0; q < 18; ++q) cg::this_grid().sync(); }
#endif
#undef IN
#undef SEAM
}

constexpr int N_PHASES = 11;
extern "C" void kernel_launch(void* const* d_in, const int* in_sizes, int n_in, void* d_out, int out_size, void* d_ws, size_t ws_size, hipStream_t stream) {
    static int grid = 0;
    if (grid == 0) {
        if (n_in != 26 || ws_size < WS_END) { fprintf(stderr, "kernel_launch: unexpected inputs (n_in %d, ws %zu, need %zu)\n", n_in, ws_size, (size_t)WS_END); grid = -1; return; }
        int dev = 0, cus = 0, per_cu = 0;
        hipGetDevice(&dev); hipDeviceGetAttribute(&cus, hipDeviceAttributeMultiprocessorCount, dev);
        hipFuncSetAttribute((const void*)hybrid_fwd, hipFuncAttributeMaxDynamicSharedMemorySize, LDS_TOTAL);
        hipOccupancyMaxActiveBlocksPerMultiprocessor(&per_cu, (const void*)hybrid_fwd, 512, LDS_TOTAL);
        if (per_cu < 1) { fprintf(stderr, "kernel_launch: occupancy query says %d blocks per CU\n", per_cu); per_cu = 1; }
        (void)hipGetLastError();
        grid = cus * per_cu;
    }
    if (grid < 0) return;
    hipMemsetAsync((char*)d_ws + WS_BAR, 0, 16384, stream);
    Args a{};
    for (int i = 0; i < 26; ++i) a.in[i] = (const float*)d_in[i];
    a.out = (float*)d_out; a.ws = (unsigned char*)d_ws;
#if MULTI_LAUNCH
    for (int p = 0; p < N_PHASES; ++p) { a.ph_lo = p; a.ph_hi = p + 1; hipLaunchKernelGGL(hybrid_fwd, dim3(grid), dim3(512), LDS_TOTAL, stream, a); }
#else
    a.ph_lo = 0; a.ph_hi = N_PHASES;
    void* kargs[] = {&a};
    hipError_t e = hipLaunchCooperativeKernel((const void*)hybrid_fwd, dim3(grid), dim3(512), kargs, LDS_TOTAL, stream);
    if (e != hipSuccess) fprintf(stderr, "cooperative launch failed: %s (grid %d)\n", hipGetErrorString(e), grid);
#endif
}
```

```cpp
#include <hip/hip_runtime.h>
#include <hip/hip_cooperative_groups.h>
#include <cstdio>
#include <cstdint>
namespace cg = cooperative_groups;
#ifndef MULTI_LAUNCH
#define MULTI_LAUNCH 0
#endif
constexpr int DMODEL = 1024, NBP = 32, SEQ = 2048, NBS = 8, TS = 32;
constexpr int MP = NBP * SEQ;
constexpr int M1 = MP + NBS * TS;
constexpr int SA_STRIDE = 576;
constexpr int RA = MP + NBS * SA_STRIDE;
constexpr int SB_STRIDE = 2112;
constexpr int R2 = MP + NBS * SB_STRIDE;
constexpr float EPSN = 1e-6f;
constexpr float LOG2E = 1.4426950408889634f;
constexpr float QSCALE_A = 0.125f * LOG2E;
constexpr float QSCALE_B = 0.10206207261596575f * LOG2E;
namespace pg8 {
#define PG8_LAS __attribute__((address_space(3)))
typedef unsigned short bf16_t;
typedef short bf16x8 __attribute__((ext_vector_type(8)));
typedef float f32x4 __attribute__((ext_vector_type(4)));
typedef unsigned u32x4 __attribute__((ext_vector_type(4)));
constexpr int BM = 256, BK = 64, HALF = 128, HTB = HALF * BK * 2  , STAGE_BYTES = 8 * HTB, NXCD = 8, WGM = 8;

__host__ __device__ __forceinline__ int lds_byte(int r, int c) { const int st = (r >> 4) * 2 + (c >> 5), rr = r & 15, cc = c & 31, ob = rr * 64 + cc * 2; return st * 1024 + (ob ^ (((ob >> 9) & 1) << 5)); }
__host__ __device__ __forceinline__ void stage_rc(int b, int& R, int& C) { const int st = b / 1024, sb = b % 1024, swz = sb ^ (((sb >> 9) & 1) << 5); R = (st >> 1) * 16 + swz / 64; C = (st & 1) * 32 + (swz % 64) / 2; }
__host__ __device__ __forceinline__ int perm32(int rho) { const int n = rho >> 4, i = rho & 15; return 8 * (i >> 2) + 4 * n + (i & 3); }

struct Unit { int pm, pn; };
struct Gemm { const bf16_t* A; const bf16_t* Bt; int M, N, K; };

struct StaticOrder {
    int nM, nN, nwg, G, c;
    __host__ __device__ void init(int M, int N, int G_, int c_) { nM = M / BM; nN = N / BM; nwg = nM * nN; G = G_; c = c_; }
    __host__ __device__ bool next(int i, Unit& u) const {
        const long L = (long)i * G + c; if (L >= nwg) return false;
        int wgid = (int)L; { const int q = nwg / NXCD, r = nwg % NXCD, xcd = wgid % NXCD, off = wgid / NXCD; wgid = (xcd < r ? xcd * (q + 1) : r * (q + 1) + (xcd - r) * q) + off; }
        const int nig = WGM * nN, gid = wgid / nig, fm = gid * WGM, gsz = (nM - fm) < WGM ? (nM - fm) : WGM;
        u.pm = fm + ((wgid % nig) % gsz); u.pn = (wgid % nig) / gsz; return true;
    }
    __device__ __forceinline__ void a_ready(const Unit&) const {}
    __device__ __forceinline__ void done(const Unit&) const {}
};

__device__ __forceinline__ unsigned cvt_pk_bf16(float lo, float hi) { unsigned r; asm volatile("v_cvt_pk_bf16_f32 %0, %1, %2" : "=v"(r) : "v"(lo), "v"(hi)); return r; }
template <class Epi, class Sched, bool ALIGN_EPI = false, bool SP2 = false>
__device__ __forceinline__ void gemm_phase(PG8_LAS unsigned char* lds, const Gemm g, const Sched& S, const Epi& E) {
    int tid_ = threadIdx.x; asm volatile("" : "+v"(tid_));
    const int tid = tid_, wid = __builtin_amdgcn_readfirstlane(tid >> 6), lane = tid & 63, wr = wid >> 2, wc = wid & 3, fr = lane & 15, fq = lane >> 4;
    const int K = g.K, nt = K / BK;
    unsigned voffA[2], voffB[2];
#pragma unroll
    for (int i = 0; i < 2; ++i) { int R, C; stage_rc(tid * 16 + i * 8192, R, C); const int Rb = Epi::PERM ? ((R & ~31) + perm32(R & 31)) : R;
        voffA[i] = (unsigned)(R * K + C) * 2u; voffB[i] = (unsigned)(Rb * K + C) * 2u; }
    const size_t kstep = (size_t)(BK * 2);
    const size_t hstep = (size_t)HALF * K * 2;
    const size_t tstep = 2 * hstep;
    const unsigned ldsw = (unsigned)wid * 1024u;
    const int aoff = lds_byte(wr * 64 + fr, fq * 8), boff = lds_byte(wc * 32 + fr, fq * 8);
#define PG8_SA(b, h) (((b) * 2 + (h)) * HTB)
#define PG8_SB(b, h) ((4 + (b) * 2 + (h)) * HTB)
#define PG8_STAGE(bufoff, gbase, voff) do { _Pragma("unroll") for (int _i = 0; _i < 2; ++_i) \
        __builtin_amdgcn_global_load_lds((const unsigned*)((const char*)(gbase) + (voff)[_i]), (PG8_LAS unsigned*)(lds + (bufoff) + ldsw + _i * 8192), 16, 0, 0); } while (0)
#define PG8_LDA(dst, b, h) do { _Pragma("unroll") for (int m = 0; m < 4; ++m) _Pragma("unroll") for (int k = 0; k < 2; ++k) dst[m][k] = *(const PG8_LAS bf16x8*)(lds + PG8_SA(b, h) + aoff + m * 2048 + k * 1024); } while (0)
#define PG8_LDB(dst, b, h) do { _Pragma("unroll") for (int n = 0; n < 2; ++n) _Pragma("unroll") for (int k = 0; k < 2; ++k) dst[n][k] = *(const PG8_LAS bf16x8*)(lds + PG8_SB(b, h) + boff + n * 2048 + k * 1024); } while (0)
#define PG8_MMA(ai, bj, At, Bt) do { __builtin_amdgcn_s_setprio(1); _Pragma("unroll") for (int m = 0; m < 4; ++m) _Pragma("unroll") for (int n = 0; n < 2; ++n) _Pragma("unroll") for (int k = 0; k < 2; ++k) \
        acc[ai][bj][m][n] = __builtin_amdgcn_mfma_f32_16x16x32_bf16(Bt[n][k], At[m][k], acc[ai][bj][m][n], 0, 0, 0); __builtin_amdgcn_s_setprio(0); } while (0)
#define PG8_WAIT_V(n) asm volatile("s_waitcnt vmcnt(" #n ")" ::: "memory")
#define PG8_WAIT_L(n) asm volatile("s_waitcnt lgkmcnt(" #n ")" ::: "memory")
#define PG8_BAR __builtin_amdgcn_s_barrier()
#define PG8_SCHED __builtin_amdgcn_sched_barrier(0)
    Unit cur, nxt; int ui = 0;
    if (!S.next(0, cur)) return;
    f32x4 acc[2][2][4][2];
#pragma unroll
    for (int a = 0; a < 2; ++a)
#pragma unroll
        for (int b = 0; b < 2; ++b)
#pragma unroll
            for (int m = 0; m < 4; ++m)
#pragma unroll
                for (int n = 0; n < 2; ++n) acc[a][b][m][n] = (f32x4){0.f, 0.f, 0.f, 0.f};
    bf16x8 At[4][2], B0[2][2], B1[2][2];
    const char* cA = (const char*)g.A + (size_t)cur.pm * tstep; const char* cB = (const char*)g.Bt + (size_t)cur.pn * tstep;
    S.a_ready(cur);
    if constexpr (SP2) {
        PG8_STAGE(PG8_SB(0, 0), cB, voffB); PG8_STAGE(PG8_SB(0, 1), cB + hstep, voffB); PG8_STAGE(PG8_SA(0, 0), cA, voffA); PG8_STAGE(PG8_SA(0, 1), cA + hstep, voffA);
        if (wr == 1) PG8_BAR;
        PG8_WAIT_V(2); PG8_BAR;
        PG8_STAGE(PG8_SB(1, 0), cB + kstep, voffB); PG8_STAGE(PG8_SA(1, 0), cA + kstep, voffA); PG8_STAGE(PG8_SB(1, 1), cB + hstep + kstep, voffB);
        PG8_WAIT_V(6); PG8_BAR;
    } else {
        PG8_STAGE(PG8_SB(0, 0), cB, voffB); PG8_STAGE(PG8_SA(0, 0), cA, voffA); PG8_STAGE(PG8_SB(0, 1), cB + hstep, voffB); PG8_STAGE(PG8_SA(0, 1), cA + hstep, voffA);
        if (wr == 1) PG8_BAR;
        PG8_WAIT_V(4); PG8_BAR;
        PG8_STAGE(PG8_SB(1, 0), cB + kstep, voffB); PG8_STAGE(PG8_SA(1, 0), cA + kstep, voffA); PG8_STAGE(PG8_SB(1, 1), cB + hstep + kstep, voffB);
        PG8_WAIT_V(6); PG8_BAR;
    }
    for (;;) {
        const bool has_next = S.next(ui + 1, nxt);
        const char* nA = has_next ? (const char*)g.A + (size_t)nxt.pm * tstep : cA; const char* nB = has_next ? (const char*)g.Bt + (size_t)nxt.pn * tstep : cB;
        for (int t = 0; t < nt; t += 2) {
            const bool last = (t == nt - 2);
            const char* a1 = cA + (size_t)(t + 1) * kstep;
            const char* a2 = last ? nA : cA + (size_t)(t + 2) * kstep; const char* b2 = last ? nB : cB + (size_t)(t + 2) * kstep;
            const char* a3 = a2 + kstep; const char* b3 = b2 + kstep;
            if (last && has_next) S.a_ready(nxt);
            if constexpr (SP2) {
            PG8_LDB(B0, 0, 0); PG8_LDB(B1, 0, 1); PG8_SCHED; PG8_LDA(At, 0, 0); PG8_STAGE(PG8_SA(1, 1), a1 + hstep, voffA);
            PG8_WAIT_V(8); PG8_WAIT_L(0); PG8_BAR; PG8_MMA(0, 0, At, B0); PG8_MMA(0, 1, At, B1); PG8_BAR; PG8_SCHED;
            PG8_LDA(At, 0, 1); PG8_STAGE(PG8_SB(0, 0), b2, voffB); PG8_STAGE(PG8_SB(0, 1), b2 + hstep, voffB); PG8_STAGE(PG8_SA(0, 0), a2, voffA);
            PG8_WAIT_V(8); PG8_WAIT_L(0); PG8_BAR; PG8_MMA(1, 0, At, B0); PG8_MMA(1, 1, At, B1); PG8_BAR; PG8_SCHED;
            PG8_LDB(B0, 1, 0); PG8_LDB(B1, 1, 1); PG8_SCHED; PG8_LDA(At, 1, 0); PG8_STAGE(PG8_SA(0, 1), a2 + hstep, voffA);
            PG8_WAIT_V(8); PG8_WAIT_L(0); PG8_BAR; PG8_MMA(0, 0, At, B0); PG8_MMA(0, 1, At, B1); PG8_BAR; PG8_SCHED;
            PG8_LDA(At, 1, 1); PG8_STAGE(PG8_SB(1, 0), b3, voffB); PG8_STAGE(PG8_SB(1, 1), b3 + hstep, voffB); PG8_STAGE(PG8_SA(1, 0), a3, voffA);
            PG8_WAIT_V(8); PG8_WAIT_L(0); PG8_BAR; PG8_MMA(1, 0, At, B0); PG8_MMA(1, 1, At, B1); PG8_BAR; PG8_SCHED;
            } else {
            PG8_LDB(B0, 0, 0); PG8_SCHED; PG8_LDA(At, 0, 0); PG8_STAGE(PG8_SA(1, 1), a1 + hstep, voffA);
            PG8_WAIT_L(8); PG8_BAR; PG8_WAIT_L(0); PG8_MMA(0, 0, At, B0); PG8_BAR; PG8_SCHED;
            PG8_LDB(B1, 0, 1); PG8_STAGE(PG8_SB(0, 0), b2, voffB);
            PG8_BAR; PG8_WAIT_L(0); PG8_MMA(0, 1, At, B1); PG8_BAR;
            PG8_LDA(At, 0, 1); PG8_STAGE(PG8_SA(0, 0), a2, voffA);
            PG8_BAR; PG8_WAIT_L(0); PG8_MMA(1, 0, At, B0); PG8_BAR; PG8_SCHED;
            PG8_STAGE(PG8_SB(0, 1), b2 + hstep, voffB);
            PG8_WAIT_V(6); PG8_BAR; PG8_MMA(1, 1, At, B1); PG8_BAR;
            PG8_LDB(B0, 1, 0); PG8_SCHED; PG8_LDA(At, 1, 0); PG8_STAGE(PG8_SA(0, 1), a2 + hstep, voffA);
            PG8_WAIT_L(8); PG8_BAR; PG8_WAIT_L(0); PG8_MMA(0, 0, At, B0); PG8_BAR; PG8_SCHED;
            PG8_LDB(B1, 1, 1); PG8_STAGE(PG8_SB(1, 0), b3, voffB);
            PG8_BAR; PG8_WAIT_L(0); PG8_MMA(0, 1, At, B1); PG8_BAR;
            PG8_LDA(At, 1, 1); PG8_STAGE(PG8_SA(1, 0), a3, voffA);
            PG8_BAR; PG8_WAIT_L(0); PG8_MMA(1, 0, At, B0); PG8_BAR; PG8_SCHED;
            PG8_STAGE(PG8_SB(1, 1), b3 + hstep, voffB);
            PG8_WAIT_V(6); PG8_BAR; PG8_MMA(1, 1, At, B1); PG8_BAR;
            }
        }
        if constexpr (ALIGN_EPI) { if (wr == 0) PG8_BAR; }
        if constexpr (!Epi::AFTER_DRAIN) { E(acc, cur, wr, wc, fr, fq); S.done(cur); }
        if (!has_next) break;
#pragma unroll
        for (int a = 0; a < 2; ++a)
#pragma unroll
            for (int b = 0; b < 2; ++b)
#pragma unroll
                for (int m = 0; m < 4; ++m)
#pragma unroll
                    for (int n = 0; n < 2; ++n) acc[a][b][m][n] = (f32x4){0.f, 0.f, 0.f, 0.f};
        cur = nxt; cA = nA; cB = nB; ++ui;
        if constexpr (ALIGN_EPI) { if (wr == 1) PG8_BAR; }
    }
    PG8_WAIT_V(0);
    if constexpr (!ALIGN_EPI) { if (wr == 0) PG8_BAR; }
    PG8_BAR;
    if constexpr (Epi::AFTER_DRAIN) { E.fused(acc, cur, wr, wc, fr, fq, lds, wid, lane); S.done(cur); }
#undef PG8_SA
#undef PG8_SB
#undef PG8_STAGE
#undef PG8_LDA
#undef PG8_LDB
#undef PG8_MMA
#undef PG8_WAIT_V
#undef PG8_WAIT_L
#undef PG8_BAR
#undef PG8_SCHED
}
typedef unsigned u32x2 __attribute__((ext_vector_type(2)));
typedef float f32x2 __attribute__((ext_vector_type(2)));
typedef __bf16 bf16x2_t __attribute__((ext_vector_type(2)));
__device__ __forceinline__ unsigned pkbf(float lo, float hi) { f32x2 v = {lo, hi}; bf16x2_t b = __builtin_convertvector(v, bf16x2_t); return __builtin_bit_cast(unsigned, b); }
__device__ __forceinline__ u32x2 pk4(f32x4 v) { u32x2 r; r.x = pkbf(v[0], v[1]); r.y = pkbf(v[2], v[3]); return r; }
__device__ __forceinline__ void st8(bf16_t* d, f32x4 a, f32x4 b) { u32x4 w; w.x = pkbf(a[0], a[1]); w.y = pkbf(a[2], a[3]); w.z = pkbf(b[0], b[1]); w.w = pkbf(b[2], b[3]); *(u32x4*)d = w; }
constexpr int STG_OFF = 131072 + 1024, STG_WAVE = 16 * 144;
__device__ __forceinline__ void stg_put(PG8_LAS unsigned char* stg, int fr, int fq, int bj, f32x4 a, f32x4 b) {
    u32x4 w; w.x = pkbf(a[0], a[1]); w.y = pkbf(a[2], a[3]); w.z = pkbf(b[0], b[1]); w.w = pkbf(b[2], b[3]);
    *(PG8_LAS u32x4*)(stg + fr * 144 + 64 * bj + 16 * fq) = w;
}
__device__ __forceinline__ void stg_flush(PG8_LAS unsigned char* stg, int fr, int fq, bf16_t* seg, int stride) {
    const int lane = fr + 16 * fq, r0 = lane >> 3, ch = lane & 7;
    bf16_t* p0 = seg + (r0 - fr) * stride + 8 * ch;
    asm volatile("s_waitcnt lgkmcnt(0)" ::: "memory");
    const u32x4 x0 = *(const PG8_LAS u32x4*)(stg + r0 * 144 + 16 * ch), x1 = *(const PG8_LAS u32x4*)(stg + (r0 + 8) * 144 + 16 * ch);
    *(u32x4*)p0 = x0; *(u32x4*)(p0 + 8 * stride) = x1;
    asm volatile("s_waitcnt lgkmcnt(0)" ::: "memory");
}
__device__ __forceinline__ void st_rows(PG8_LAS unsigned char* stg, int fr, int fq, bf16_t* seg, int stride, f32x4 a0, f32x4 a1, f32x4 b0, f32x4 b1) {
    stg_put(stg, fr, fq, 0, a0, a1); stg_put(stg, fr, fq, 1, b0, b1); stg_flush(stg, fr, fq, seg, stride);
}
__device__ __forceinline__ void stf_rows(PG8_LAS unsigned char* stg, int fr, int fq, float* seg, int stride, f32x4 a, f32x4 b) {
    const int lane = fr + 16 * fq, r0 = lane >> 3, ch = lane & 7;
    *(PG8_LAS f32x4*)(stg + fr * 144 + 32 * fq) = a; *(PG8_LAS f32x4*)(stg + fr * 144 + 32 * fq + 16) = b;
    float* p0 = seg + (r0 - fr) * stride + 4 * ch;
    asm volatile("s_waitcnt lgkmcnt(0)" ::: "memory");
    const f32x4 x0 = *(const PG8_LAS f32x4*)(stg + r0 * 144 + 16 * ch), x1 = *(const PG8_LAS f32x4*)(stg + (r0 + 8) * 144 + 16 * ch);
    __builtin_nontemporal_store(x0, (f32x4*)p0); __builtin_nontemporal_store(x1, (f32x4*)(p0 + 8 * stride));
    asm volatile("s_waitcnt lgkmcnt(0)" ::: "memory");
}
__device__ __forceinline__ void ldf_rows(PG8_LAS unsigned char* stg, int fr, int fq, const float* seg, int stride, f32x4& a, f32x4& b) {
    const int lane = fr + 16 * fq, r0 = lane >> 3, ch = lane & 7;
    const float* p0 = seg + (r0 - fr) * stride + 4 * ch;
    const f32x4 x0 = __builtin_nontemporal_load((const f32x4*)p0), x1 = __builtin_nontemporal_load((const f32x4*)(p0 + 8 * stride));
    *(PG8_LAS f32x4*)(stg + r0 * 144 + 16 * ch) = x0; *(PG8_LAS f32x4*)(stg + (r0 + 8) * 144 + 16 * ch) = x1;
    asm volatile("s_waitcnt lgkmcnt(0)" ::: "memory");
    a = *(const PG8_LAS f32x4*)(stg + fr * 144 + 32 * fq); b = *(const PG8_LAS f32x4*)(stg + fr * 144 + 32 * fq + 16);
    asm volatile("s_waitcnt lgkmcnt(0)" ::: "memory");
}
__device__ __forceinline__ float silu_f(float v) { return v * __builtin_amdgcn_rcpf(1.f + __expf(-v)); }
__device__ __forceinline__ f32x4 silu4(f32x4 v) { f32x4 o; o[0] = silu_f(v[0]); o[1] = silu_f(v[1]); o[2] = silu_f(v[2]); o[3] = silu_f(v[3]); return o; }
__device__ __forceinline__ float ssq4(f32x4 v) { return (v[0] * v[0] + v[1] * v[1]) + (v[2] * v[2] + v[3] * v[3]); }
__device__ __forceinline__ float red_fq(float s) { s += __shfl_xor(s, 16); s += __shfl_xor(s, 32); return s; }

struct EpiAin {
    static constexpr bool PERM = true, AFTER_DRAIN = false;
    bf16_t *Q, *K, *V, *Z; const float *gq, *gk; float *okp, *ovp, *oks, *ovs; PG8_LAS unsigned char* stg0;
    __device__ __forceinline__ void operator()(const f32x4 (&acc)[2][2][4][2], const Unit& u, int wr, int wc, int fr, int fq) const {
        const int sec = u.pn >> 2, head = (u.pn & 3) * 4 + wc, cb = head * 64 + 8 * fq;
        f32x4 g[2][2];
#pragma unroll
        for (int bj = 0; bj < 2; ++bj)
#pragma unroll
            for (int n = 0; n < 2; ++n) g[bj][n] = (sec < 2) ? *(const f32x4*)((sec == 0 ? gq : gk) + 32 * bj + 4 * n + 8 * fq) : (f32x4){1.f, 1.f, 1.f, 1.f};
#pragma unroll
        for (int ai = 0; ai < 2; ++ai)
#pragma unroll
            for (int m = 0; m < 4; ++m) {
                const int row = u.pm * BM + ai * HALF + wr * 64 + m * 16 + fr;
                f32x4 v[2][2];
#pragma unroll
                for (int bj = 0; bj < 2; ++bj)
#pragma unroll
                    for (int n = 0; n < 2; ++n) v[bj][n] = acc[ai][bj][m][n];
                if (sec < 2) {
                    float s = (ssq4(v[0][0]) + ssq4(v[0][1])) + (ssq4(v[1][0]) + ssq4(v[1][1]));
                    s = red_fq(s);
                    const float r = rsqrtf(s * (1.f / 64.f) + EPSN) * (sec == 0 ? QSCALE_A : 1.f);
#pragma unroll
                    for (int bj = 0; bj < 2; ++bj)
#pragma unroll
                        for (int n = 0; n < 2; ++n) v[bj][n] = v[bj][n] * g[bj][n] * r;
                } else if (sec == 3) {
#pragma unroll
                    for (int bj = 0; bj < 2; ++bj)
#pragma unroll
                        for (int n = 0; n < 2; ++n) v[bj][n] = silu4(v[bj][n]);
                }
                if (sec == 0 || sec == 3) {
                    bf16_t* d = (sec == 0 ? Q : Z) + (size_t)row * 1024 + cb;
                    st_rows(stg0 + (wr * 4 + wc) * STG_WAVE, fr, fq, d - 8 * fq, 1024, v[0][0], v[0][1], v[1][0], v[1][1]);
                } else {
                    size_t drow; float* of = nullptr;
                    if (row < MP) { drow = (size_t)row; const int pos = row & (SEQ - 1); if (pos >= SEQ - 512) of = (sec == 1 ? okp : ovp) + ((size_t)((row >> 11) * 512 + pos - (SEQ - 512))) * 1024; }
                    else { const int rs = row - MP; drow = (size_t)MP + (size_t)(rs >> 5) * SA_STRIDE + 512 + (rs & 31); of = (sec == 1 ? oks : ovs) + (size_t)rs * 1024; }
                    bf16_t* d = (sec == 1 ? K : V) + drow * 1024 + cb;
                    st_rows(stg0 + (wr * 4 + wc) * STG_WAVE, fr, fq, d - 8 * fq, 1024, v[0][0], v[0][1], v[1][0], v[1][1]);
#pragma unroll
                    for (int bj = 0; bj < 2; ++bj) { if (of) stf_rows(stg0 + (wr * 4 + wc) * STG_WAVE, fr, fq, of + cb - 8 * fq + 32 * bj, 1024, v[bj][0], v[bj][1]); }
                }
                asm volatile("" ::: "memory");
            }
    }
};
struct EpiRes {
    static constexpr bool PERM = true, AFTER_DRAIN = false;
    const float *xp, *xs; float *yp, *ys; const float* gate;
    bf16_t* YG; const float* G1; float* ssq;
    PG8_LAS unsigned char* stg0; const bf16_t* xb; bf16_t* yb;
    __device__ __forceinline__ void operator()(const f32x4 (&acc)[2][2][4][2], const Unit& u, int wr, int wc, int fr, int fq) const {
        const int cb = u.pn * 256 + wc * 64 + 8 * fq;
#pragma unroll
        for (int ai = 0; ai < 2; ++ai)
#pragma unroll
            for (int m = 0; m < 4; ++m) {
                const int row = u.pm * BM + ai * HALF + wr * 64 + m * 16 + fr;
                const float* xi; float* yo; int bb;
                if (row < MP) { xi = xp + (size_t)row * 1024; yo = yp + (size_t)row * 1024; bb = row >> 11; }
                else { const int rs = row - MP; xi = xs + (size_t)rs * 1024; yo = ys + (size_t)rs * 1024; bb = NBP + (rs >> 5); }
                const float* gp = gate + (size_t)bb * 3072;
                float sq = 0.f;
                f32x4 ov[2][2];
#pragma unroll
                for (int bj = 0; bj < 2; ++bj) { const int c = cb + 32 * bj;
                    f32x4 x0, x1;
                    if (xb) { const u32x4 w = *(const u32x4*)(xb + (size_t)row * 1024 + c);
                        x0 = (f32x4){__uint_as_float(w.x << 16), __uint_as_float(w.x & 0xffff0000u), __uint_as_float(w.y << 16), __uint_as_float(w.y & 0xffff0000u)};
                        x1 = (f32x4){__uint_as_float(w.z << 16), __uint_as_float(w.z & 0xffff0000u), __uint_as_float(w.w << 16), __uint_as_float(w.w & 0xffff0000u)}; }
                    else ldf_rows(stg0 + (wr * 4 + wc) * STG_WAVE, fr, fq, xi + c - 8 * fq, 1024, x0, x1);
                    ov[bj][0] = x0 + *(const f32x4*)(gp + c) * acc[ai][bj][m][0]; ov[bj][1] = x1 + *(const f32x4*)(gp + c + 4) * acc[ai][bj][m][1];
                    if (!yb) stf_rows(stg0 + (wr * 4 + wc) * STG_WAVE, fr, fq, yo + c - 8 * fq, 1024, ov[bj][0], ov[bj][1]); }
                if (yb) st_rows(stg0 + (wr * 4 + wc) * STG_WAVE, fr, fq, yb + (size_t)row * 1024 + cb - 8 * fq, 1024, ov[0][0], ov[0][1], ov[1][0], ov[1][1]);
                if (YG) { sq = (ssq4(ov[0][0]) + ssq4(ov[0][1])) + (ssq4(ov[1][0]) + ssq4(ov[1][1])); const float* gg = G1 + (size_t)bb * 1024 + cb;
                    st_rows(stg0 + (wr * 4 + wc) * STG_WAVE, fr, fq, YG + (size_t)row * 1024 + cb - 8 * fq, 1024, ov[0][0] * *(const f32x4*)gg, ov[0][1] * *(const f32x4*)(gg + 4), ov[1][0] * *(const f32x4*)(gg + 32), ov[1][1] * *(const f32x4*)(gg + 36)); }
                if (YG) { sq = red_fq(sq); if (fq == 0) atomicAdd(ssq + row, sq); }
                asm volatile("" ::: "memory");
            }
    }
};
struct EpiBin {
    static constexpr bool PERM = true, AFTER_DRAIN = false;
    bf16_t* Z; bf16_t* CQ; bf16_t* CKV; float* RAW2; const float* ssq; const float* SW; const float* gcq; const float* gckv; float* ssqq; float* ssqkv; PG8_LAS unsigned char* stg0;
    __device__ __forceinline__ void operator()(const f32x4 (&acc)[2][2][4][2], const Unit& u, int wr, int wc, int fr, int fq) const {
        const int cb = u.pn * 256 + wc * 64 + 8 * fq;
        const int sidx = (u.pn - 4) * 4 + wc;
#pragma unroll
        for (int ai = 0; ai < 2; ++ai)
#pragma unroll
            for (int m = 0; m < 4; ++m) {
                const int row = u.pm * BM + ai * HALF + wr * 64 + m * 16 + fr;
                const int bb = row < MP ? (row >> 11) : NBP + ((row - MP) >> 5);
                const float r = rsqrtf(ssq[row] * (1.f / 1024.f) + EPSN);
                const float* sw = SW + (size_t)bb * 1792;
                f32x4 v[2][2];
#pragma unroll
                for (int bj = 0; bj < 2; ++bj)
#pragma unroll
                    for (int n = 0; n < 2; ++n) v[bj][n] = acc[ai][bj][m][n] * r + *(const f32x4*)(sw + cb + 32 * bj + 4 * n);
                if (u.pn < 4) {
                    st_rows(stg0 + (wr * 4 + wc) * STG_WAVE, fr, fq, Z + (size_t)row * 1024 + cb - 8 * fq, 1024, silu4(v[0][0]), silu4(v[0][1]), silu4(v[1][0]), silu4(v[1][1]));
                } else if (sidx < 10) {
                    float sq = (ssq4(v[0][0]) + ssq4(v[0][1])) + (ssq4(v[1][0]) + ssq4(v[1][1]));
                    sq = red_fq(sq);
                    if (sidx < 6) {
                        const int c0 = cb - 1024;
                        if (fq == 0) atomicAdd(ssqq + row, sq);
                        st_rows(stg0 + (wr * 4 + wc) * STG_WAVE, fr, fq, CQ + (size_t)row * 384 + c0 - 8 * fq, 384, v[0][0] * *(const f32x4*)(gcq + c0), v[0][1] * *(const f32x4*)(gcq + c0 + 4), v[1][0] * *(const f32x4*)(gcq + c0 + 32), v[1][1] * *(const f32x4*)(gcq + c0 + 36));
                    } else {
                        const int c0 = cb - 1408;
                        const size_t drow = row < MP ? (size_t)row : (size_t)MP + (size_t)((row - MP) >> 5) * SB_STRIDE + 2048 + ((row - MP) & 31);
                        if (fq == 0) atomicAdd(ssqkv + row, sq);
                        st_rows(stg0 + (wr * 4 + wc) * STG_WAVE, fr, fq, CKV + drow * 256 + c0 - 8 * fq, 256, v[0][0] * *(const f32x4*)(gckv + c0), v[0][1] * *(const f32x4*)(gckv + c0 + 4), v[1][0] * *(const f32x4*)(gckv + c0 + 32), v[1][1] * *(const f32x4*)(gckv + c0 + 36));
                    }
                } else if (sidx == 10) {
#pragma unroll
                    for (int n = 0; n < 2; ++n) *(f32x4*)(RAW2 + (size_t)row * 32 + 8 * fq + 4 * n) = v[0][n];
                }
                asm volatile("" ::: "memory");
            }
    }
};
struct EpiUq {
    static constexpr bool PERM = true, AFTER_DRAIN = false;
    bf16_t* Q; const float *gqn, *gqr, *CS; const float* ssqq; PG8_LAS unsigned char* stg0;
    __device__ __forceinline__ void operator()(const f32x4 (&acc)[2][2][4][2], const Unit& u, int wr, int wc, int fr, int fq) const {
        if (u.pn < 4) {
            const int head = u.pn * 4 + wc;
#pragma unroll
            for (int ai = 0; ai < 2; ++ai)
#pragma unroll
                for (int m = 0; m < 4; ++m) {
                    const int row = u.pm * BM + ai * HALF + wr * 64 + m * 16 + fr;
                    float s = (ssq4(acc[ai][0][m][0]) + ssq4(acc[ai][0][m][1])) + (ssq4(acc[ai][1][m][0]) + ssq4(acc[ai][1][m][1]));
                    s = red_fq(s);
                    const float rq = rsqrtf(ssqq[row] * (1.f / 384.f) + EPSN);
                    const float r = rsqrtf(s * rq * rq * (1.f / 64.f) + EPSN) * rq * QSCALE_B;
                    bf16_t* d = Q + (size_t)row * 1536 + head * 96 + 8 * fq;
                    { PG8_LAS unsigned char* sg_ = stg0 + (wr * 4 + wc) * STG_WAVE;
#pragma unroll
                      for (int bj = 0; bj < 2; ++bj) stg_put(sg_, fr, fq, bj, acc[ai][bj][m][0] * *(const f32x4*)(gqn + 32 * bj + 8 * fq) * r, acc[ai][bj][m][1] * *(const f32x4*)(gqn + 32 * bj + 4 + 8 * fq) * r);
                      stg_flush(sg_, fr, fq, d - 8 * fq, 1536); }
                    asm volatile("" ::: "memory");
                }
        } else {
#pragma unroll
            for (int ai = 0; ai < 2; ++ai)
#pragma unroll
                for (int m = 0; m < 4; ++m) {
                    const int row = u.pm * BM + ai * HALF + wr * 64 + m * 16 + fr;
                    const int pos = row < MP ? (row & (SEQ - 1)) : SEQ + ((row - MP) & 31);
                    const float rq = rsqrtf(ssqq[row] * (1.f / 384.f) + EPSN);
#pragma unroll
                    for (int bj = 0; bj < 2; ++bj) {
                        const int hr = (u.pn - 4) * 8 + wc * 2 + bj;
                        float s = ssq4(acc[ai][bj][m][0]) + ssq4(acc[ai][bj][m][1]);
                        s = red_fq(s);
                        const float r = rsqrtf(s * rq * rq * (1.f / 32.f) + EPSN) * rq;
                        const f32x4 x1 = acc[ai][bj][m][0] * *(const f32x4*)(gqr + 4 * fq) * r, x2 = acc[ai][bj][m][1] * *(const f32x4*)(gqr + 16 + 4 * fq) * r;
                        const f32x4 cs = *(const f32x4*)(CS + pos * 32 + 4 * fq), sn = *(const f32x4*)(CS + pos * 32 + 16 + 4 * fq);
                        PG8_LAS unsigned char* sg_ = stg0 + (wr * 4 + wc) * STG_WAVE + fr * 144 + bj * 64 + 8 * fq; (void)hr;
                        *(PG8_LAS u32x2*)sg_ = pk4((x1 * cs - x2 * sn) * QSCALE_B); *(PG8_LAS u32x2*)(sg_ + 32) = pk4((x2 * cs + x1 * sn) * QSCALE_B);
                        asm volatile("" ::: "memory");
                    }
                    {
                        const int lane_ = fr + 16 * fq, r0 = lane_ >> 3, ch = lane_ & 7, bjc = ch >> 2, pc = ch & 3;
                        PG8_LAS unsigned char* sr_ = stg0 + (wr * 4 + wc) * STG_WAVE + r0 * 144 + bjc * 64 + pc * 16;
                        bf16_t* p0 = Q + (size_t)(row - fr + r0) * 1536 + ((u.pn - 4) * 8 + wc * 2 + bjc) * 96 + 64 + pc * 8;
                        asm volatile("s_waitcnt lgkmcnt(0)" ::: "memory");
                        const u32x4 x0_ = *(const PG8_LAS u32x4*)sr_, x1_ = *(const PG8_LAS u32x4*)(sr_ + 8 * 144);
                        *(u32x4*)p0 = x0_; *(u32x4*)(p0 + 8 * 1536) = x1_;
                        asm volatile("s_waitcnt lgkmcnt(0)" ::: "memory");
                    }
                }
        }
    }
};
struct EpiUkv {
    static constexpr bool PERM = true, AFTER_DRAIN = false;
    bf16_t *KN, *VB; const float* gkn; const float* ssqkv; PG8_LAS unsigned char* stg0;
    __device__ __forceinline__ void operator()(const f32x4 (&acc)[2][2][4][2], const Unit& u, int wr, int wc, int fr, int fq) const {
        const bool isk = u.pn < 4; const int head = (u.pn & 3) * 4 + wc;
#pragma unroll
        for (int ai = 0; ai < 2; ++ai)
#pragma unroll
            for (int m = 0; m < 4; ++m) {
                const int row = u.pm * BM + ai * HALF + wr * 64 + m * 16 + fr;
                float rs = 1.f;
                if (u.pm < MP / BM) rs = rsqrtf(ssqkv[row] * (1.f / 256.f) + EPSN);
                else { const int q_ = row - MP, bs_ = q_ / SB_STRIDE, rr_ = q_ - bs_ * SB_STRIDE; if (rr_ >= 2048 && rr_ < 2080) rs = rsqrtf(ssqkv[MP + bs_ * TS + rr_ - 2048] * (1.f / 256.f) + EPSN); }
                float r = rs;
                if (isk) { float s = (ssq4(acc[ai][0][m][0]) + ssq4(acc[ai][0][m][1])) + (ssq4(acc[ai][1][m][0]) + ssq4(acc[ai][1][m][1])); s = red_fq(s); r = rsqrtf(s * rs * rs * (1.f / 64.f) + EPSN) * rs; }
                bf16_t* d = (isk ? KN : VB) + (size_t)row * 1024 + head * 64 + 8 * fq;
                { PG8_LAS unsigned char* sg_ = stg0 + (wr * 4 + wc) * STG_WAVE;
#pragma unroll
                  for (int bj = 0; bj < 2; ++bj) { const f32x4 g0 = isk ? *(const f32x4*)(gkn + 32 * bj + 8 * fq) : (f32x4){1.f, 1.f, 1.f, 1.f}, g1 = isk ? *(const f32x4*)(gkn + 32 * bj + 4 + 8 * fq) : (f32x4){1.f, 1.f, 1.f, 1.f};
                      stg_put(sg_, fr, fq, bj, acc[ai][bj][m][0] * g0 * r, acc[ai][bj][m][1] * g1 * r); }
                  stg_flush(sg_, fr, fq, d - 8 * fq, 1024); }
                asm volatile("" ::: "memory");
            }
    }
};
}
namespace at {
#define ALAS __attribute__((address_space(3)))
typedef unsigned short bf16_t;
typedef short bf16x8 __attribute__((ext_vector_type(8)));
typedef short s16x4 __attribute__((ext_vector_type(4)));
typedef float f32x16 __attribute__((ext_vector_type(16)));
typedef float f32x4 __attribute__((ext_vector_type(4)));
typedef unsigned u32x4 __attribute__((ext_vector_type(4)));
typedef unsigned u32x2 __attribute__((ext_vector_type(2)));
constexpr int KROW = 144, VROW = 144, RROW = 80;
constexpr int KBUF = 64 * KROW, VBUF = 64 * VROW, RBUF = 64 * RROW, STAGE = KBUF + VBUF + RBUF;
constexpr int NSTAGE = 2, TBL_OFF = NSTAGE * STAGE, OSTG_OFF = 49152, OSTG_WAVE = 32 * 272, LDS_BYTES = OSTG_OFF + 8 * OSTG_WAVE;
static_assert(TBL_OFF + 1280 <= OSTG_OFF, "attention LDS map");
struct AttnUnit { int qrow0, nq, krow0, nt, lastvalid, head, c0, tf; };
__device__ __forceinline__ int crow(int r, int hi) { return (r & 3) + 8 * (r >> 2) + 4 * hi; }

template <bool MLA>
__device__ __forceinline__ void attn_unit(ALAS unsigned char* lds, const AttnUnit u, const bf16_t* __restrict__ Q, const bf16_t* __restrict__ Kn, const bf16_t* __restrict__ Kr,
                                          const bf16_t* __restrict__ V, const bf16_t* __restrict__ Z, bf16_t* __restrict__ U, const float* __restrict__ tbl) {
    int tid_ = threadIdx.x; asm volatile("" : "+v"(tid_));
    const int tid = tid_, lane = tid & 63, wid = __builtin_amdgcn_readfirstlane(tid >> 6), l32 = lane & 31, hi = lane >> 5;
    const int ci = wid >> 1, qh = wid & 1;
    const bool active = ci * 64 + qh * 32 < u.nq;
    const int cq = u.c0 + ci;
    constexpr int QS = MLA ? 1536 : 1024, HS = MLA ? 96 : 64, ND0 = MLA ? 6 : 4;
    constexpr float THR = 8.f;
    ALAS float* tb = (ALAS float*)(lds + TBL_OFF);
    if (!MLA) { if (tid < 320) tb[tid] = tid < 257 ? (tbl[(size_t)u.head * 257 + tid] - tbl[(size_t)u.head * 257 + 256]) * LOG2E : 0.f; }
    const int qrow = u.qrow0 + (active ? ci * 64 + qh * 32 : 0) + l32;
    bf16x8 qf[ND0];
#pragma unroll
    for (int d0 = 0; d0 < ND0; ++d0) qf[d0] = *(const bf16x8*)(Q + (size_t)qrow * QS + u.head * HS + d0 * 16 + hi * 8);
    const char* kbase = (const char*)(Kn + (size_t)u.krow0 * 1024 + u.head * 64);
    const char* vbase = (const char*)(V + (size_t)u.krow0 * 1024 + u.head * 64);
    const char* rbase = MLA ? (const char*)(Kr + (size_t)u.krow0 * 32) : nullptr;
    const unsigned koff = (unsigned)(((tid >> 3) * 1024 + (tid & 7) * 8) * 2);
    const int vkvq = (tid & 3) + 4 * ((tid >> 6) & 3), vdq = (tid >> 2) & 15;
    const unsigned voff = (unsigned)(((vkvq * 4) * 1024 + vdq * 4) * 2);
    const int vpos8 = (vkvq & ~3) + ((vkvq & 1) << 1) + ((vkvq >> 1) & 1);
    const unsigned roff = (unsigned)(((((tid - 256) >> 2) & 63) * 32 + (tid & 3) * 8) * 2);
    u32x4 kreg[1]; u32x2 vreg[1][4]; u32x4 rreg[1];
#define AT_GLOAD(ti, sx) do { const int tl_ = (ti) < u.nt ? (ti) : u.nt - 1; \
        kreg[sx] = *(const u32x4*)(kbase + (size_t)tl_ * 131072 + koff); \
        if (tid < 256) { const char* vb_ = vbase + (size_t)tl_ * 131072; \
            vreg[sx][0] = *(const u32x2*)(vb_ + voff); vreg[sx][1] = *(const u32x2*)(vb_ + voff + 2048); vreg[sx][2] = *(const u32x2*)(vb_ + 4096 + voff); vreg[sx][3] = *(const u32x2*)(vb_ + 4096 + voff + 2048); } \
        else if (MLA) { rreg[sx] = *(const u32x4*)(rbase + (size_t)tl_ * 4096 + roff); } } while (0)
#define AT_SWRITE(st, sx) do { ALAS unsigned char* sb_ = lds + (st) * STAGE; \
        *(ALAS u32x4*)(sb_ + (tid >> 3) * KROW + (tid & 7) * 16) = kreg[sx]; \
        if (tid < 256) { \
            _Pragma("unroll") for (int jj_ = 0; jj_ < 4; ++jj_) { const int d_ = 4 * vdq + jj_; u32x2 o_; \
                const unsigned sel_ = (jj_ & 1) ? 0x07060302u : 0x05040100u; \
                if (jj_ < 2) { o_.x = __builtin_amdgcn_perm(vreg[sx][1].x, vreg[sx][0].x, sel_); o_.y = __builtin_amdgcn_perm(vreg[sx][3].x, vreg[sx][2].x, sel_); } \
                else         { o_.x = __builtin_amdgcn_perm(vreg[sx][1].y, vreg[sx][0].y, sel_); o_.y = __builtin_amdgcn_perm(vreg[sx][3].y, vreg[sx][2].y, sel_); } \
                *(ALAS u32x2*)(sb_ + KBUF + d_ * VROW + vpos8 * 8) = o_; } } \
        else if (MLA) { const int t2_ = tid - 256; *(ALAS u32x4*)(sb_ + KBUF + VBUF + (t2_ >> 2) * RROW + (t2_ & 3) * 16) = rreg[sx]; } } while (0)
    float mref = 0.f;
    bool first = true;
    f32x16 negm = f32x16{}; asm volatile("" : "+v"(negm));
    f32x16 o0 = f32x16{}, o1 = f32x16{}; float lrun = 0.f;
    f32x16 p[2];
    const int tgl = (qh * 32 + l32 + 128 - 4 * hi) * 4;
#define AT_QK(t, sg) do { const int kc_ = u.tf + (t); ALAS unsigned char* sb_ = lds + (sg) * STAGE; ALAS unsigned char* kb_ = sb_ + l32 * KROW + hi * 16; \
        bool near_ = false; \
        if (!MLA) { near_ = cq - kc_ < 3; \
            if (near_) { ALAS unsigned char* tp_ = (ALAS unsigned char*)tb + tgl + 256 * (cq - kc_); \
                _Pragma("unroll") for (int blk = 0; blk < 2; ++blk) _Pragma("unroll") for (int r = 0; r < 16; ++r) p[blk][r] = *(const ALAS float*)(tp_ - 4 * (32 * blk + (r & 3) + 8 * (r >> 2))) - mref; } } \
        bf16x8 ka_[4], kb2_[4]; ALAS unsigned char* rb_ = sb_ + KBUF + VBUF + l32 * RROW + hi * 16; \
        _Pragma("unroll") for (int d0 = 0; d0 < 4; ++d0) ka_[d0] = *(const ALAS bf16x8*)(kb_ + d0 * 32); \
        _Pragma("unroll") for (int d0 = 0; d0 < 4; ++d0) kb2_[d0] = *(const ALAS bf16x8*)(kb_ + 32 * KROW + d0 * 32); \
        __builtin_amdgcn_sched_barrier(0); \
        if (near_) { p[0] = __builtin_amdgcn_mfma_f32_32x32x16_bf16(ka_[0], qf[0], p[0], 0, 0, 0); p[1] = __builtin_amdgcn_mfma_f32_32x32x16_bf16(kb2_[0], qf[0], p[1], 0, 0, 0); } \
        else       { p[0] = __builtin_amdgcn_mfma_f32_32x32x16_bf16(ka_[0], qf[0], negm, 0, 0, 0); p[1] = __builtin_amdgcn_mfma_f32_32x32x16_bf16(kb2_[0], qf[0], negm, 0, 0, 0); } \
        _Pragma("unroll") for (int d0 = 1; d0 < 4; ++d0) { p[0] = __builtin_amdgcn_mfma_f32_32x32x16_bf16(ka_[d0], qf[d0], p[0], 0, 0, 0); p[1] = __builtin_amdgcn_mfma_f32_32x32x16_bf16(kb2_[d0], qf[d0], p[1], 0, 0, 0); \
            if (MLA && d0 == 1) { ka_[0] = *(const ALAS bf16x8*)(rb_); kb2_[0] = *(const ALAS bf16x8*)(rb_ + 32 * RROW); ka_[1] = *(const ALAS bf16x8*)(rb_ + 32); kb2_[1] = *(const ALAS bf16x8*)(rb_ + 32 * RROW + 32); } } \
        if (MLA) { p[0] = __builtin_amdgcn_mfma_f32_32x32x16_bf16(ka_[0], qf[4], p[0], 0, 0, 0); p[1] = __builtin_amdgcn_mfma_f32_32x32x16_bf16(kb2_[0], qf[4], p[1], 0, 0, 0); \
                   p[0] = __builtin_amdgcn_mfma_f32_32x32x16_bf16(ka_[1], qf[ND0 - 1], p[0], 0, 0, 0); p[1] = __builtin_amdgcn_mfma_f32_32x32x16_bf16(kb2_[1], qf[ND0 - 1], p[1], 0, 0, 0); } \
        if ((t) == u.nt - 1 && u.lastvalid < 64) { _Pragma("unroll") for (int r = 0; r < 16; ++r) p[1][r] = -__builtin_inff(); } } while (0)
#define AT_SMPV(t, sg) do { ALAS unsigned char* vb_ = lds + (sg) * STAGE + KBUF + l32 * VROW + hi * 16; \
        bf16x8 vf_[2][4]; \
        _Pragma("unroll") for (int dblk = 0; dblk < 2; ++dblk) _Pragma("unroll") for (int j = 0; j < 4; ++j) vf_[dblk][j] = *(const ALAS bf16x8*)(vb_ + dblk * 32 * VROW + j * 32); \
        __builtin_amdgcn_sched_barrier(0); \
        float rm = p[0][0]; \
        _Pragma("unroll") for (int r = 1; r < 16; ++r) rm = fmaxf(rm, p[0][r]); \
        _Pragma("unroll") for (int r = 0; r < 16; ++r) rm = fmaxf(rm, p[1][r]); \
        rm = fmaxf(rm, __shfl_xor(rm, 32)); \
        if (first || __any(rm > THR)) { \
            const float dl = first ? rm : fmaxf(rm, 0.f); mref += dl; \
            _Pragma("unroll") for (int r = 0; r < 16; ++r) { p[0][r] -= dl; p[1][r] -= dl; } \
            _Pragma("unroll") for (int r = 0; r < 16; ++r) negm[r] = -mref; \
            asm volatile("" : "+v"(negm)); \
            if (!first) { const float al = __builtin_amdgcn_exp2f(-dl); lrun *= al; \
                _Pragma("unroll") for (int r = 0; r < 16; ++r) { o0[r] *= al; o1[r] *= al; } } \
            first = false; } \
        _Pragma("unroll") for (int blk = 0; blk < 2; ++blk) _Pragma("unroll") for (int r = 0; r < 16; ++r) p[blk][r] = __builtin_amdgcn_exp2f(p[blk][r]); \
        { float ls0 = 0.f, ls1 = 0.f; _Pragma("unroll") for (int r = 0; r < 16; ++r) { ls0 += p[0][r]; ls1 += p[1][r]; } lrun += ls0 + ls1; } \
        bf16x8 pk[4]; \
        _Pragma("unroll") for (int j = 0; j < 4; ++j) { u32x4 w; const int b = j >> 1, r0 = 8 * (j & 1); \
            w.x = pg8::pkbf(p[b][r0 + 0], p[b][r0 + 1]); w.y = pg8::pkbf(p[b][r0 + 2], p[b][r0 + 3]); w.z = pg8::pkbf(p[b][r0 + 4], p[b][r0 + 5]); w.w = pg8::pkbf(p[b][r0 + 6], p[b][r0 + 7]); \
            pk[j] = __builtin_bit_cast(bf16x8, w); } \
        _Pragma("unroll") for (int j = 0; j < 4; ++j) { \
            o0 = __builtin_amdgcn_mfma_f32_32x32x16_bf16(vf_[0][j], pk[j], o0, 0, 0, 0); \
            o1 = __builtin_amdgcn_mfma_f32_32x32x16_bf16(vf_[1][j], pk[j], o1, 0, 0, 0); \
            } } while (0)
#define AT_TAKE(t) (active && (u.tf + (t)) <= cq && (MLA || (u.tf + (t)) >= cq - 8))
    AT_GLOAD(0, 0); AT_SWRITE(0, 0);
    __syncthreads();
    for (int ti = 0; ti < u.nt; ++ti) {
        const bool more = ti + 1 < u.nt;
        if (more) AT_GLOAD(ti + 1, 0);
        if (AT_TAKE(ti)) { AT_QK(ti, ti & 1); AT_SMPV(ti, ti & 1); }
        if (more) AT_SWRITE((ti + 1) & 1, 0);
        __syncthreads();
    }
#undef AT_QK
#undef AT_SMPV
#undef AT_TAKE
    if (active) {
        const float inv = 1.f / (lrun + __shfl_xor(lrun, 32));
        ALAS unsigned char* ot = lds + OSTG_OFF + wid * OSTG_WAVE;
#pragma unroll
        for (int dblk = 0; dblk < 2; ++dblk)
#pragma unroll
            for (int g = 0; g < 4; ++g) { const f32x16& o = dblk == 0 ? o0 : o1;
                *(ALAS f32x4*)(ot + l32 * 272 + (32 * dblk + 8 * g + 4 * hi) * 4) = (f32x4){o[4 * g + 0] * inv, o[4 * g + 1] * inv, o[4 * g + 2] * inv, o[4 * g + 3] * inv}; }
        asm volatile("s_waitcnt lgkmcnt(0)" ::: "memory");
        const size_t rb = (size_t)(qrow - l32) * 1024 + u.head * 64 + (lane & 7) * 8;
#pragma unroll
        for (int i = 0; i < 4; ++i) { const int r = i * 8 + (lane >> 3);
            const f32x4 a0 = *(const ALAS f32x4*)(ot + r * 272 + (lane & 7) * 32), a1 = *(const ALAS f32x4*)(ot + r * 272 + (lane & 7) * 32 + 16);
            const u32x4 zz = *(const u32x4*)(Z + rb + (size_t)r * 1024);
            u32x4 w;
            w.x = pg8::pkbf(a0[0] * __uint_as_float(zz.x << 16), a0[1] * __uint_as_float(zz.x & 0xffff0000u)); w.y = pg8::pkbf(a0[2] * __uint_as_float(zz.y << 16), a0[3] * __uint_as_float(zz.y & 0xffff0000u));
            w.z = pg8::pkbf(a1[0] * __uint_as_float(zz.z << 16), a1[1] * __uint_as_float(zz.z & 0xffff0000u)); w.w = pg8::pkbf(a1[2] * __uint_as_float(zz.w << 16), a1[3] * __uint_as_float(zz.w & 0xffff0000u));
            *(u32x4*)(U + rb + (size_t)r * 1024) = w; }
        asm volatile("s_waitcnt lgkmcnt(0)" ::: "memory");
    }
#undef AT_GLOAD
#undef AT_SWRITE
}
__device__ __forceinline__ bool prompt_unit(int k, int G, int bid, int& bh, int& qb) {
    if (G == 256) { if (k >= 16) return false; const int x = bid & 7, j = bid >> 3; bh = (4 * k + (j >> 3)) * 8 + x; qb = ((j & 7) + k) & 7; return true; }
    const int u = bid + k * G; if (u >= 4096) return false; bh = u >> 3; qb = u & 7; return true;
}
}
#define LAS __attribute__((address_space(3)))
typedef unsigned short bf16;
typedef unsigned v4u __attribute__((ext_vector_type(4)));
typedef unsigned v2u __attribute__((ext_vector_type(2)));
typedef float f32x4 __attribute__((ext_vector_type(4)));
constexpr size_t MiB = 1u << 20;
constexpr size_t WS_MOD = 0;
constexpr size_t MOD_BYTES = 2 * 40 * 3072 * 4;
constexpr size_t WS_BAR = 1 * MiB - 16384;
constexpr size_t WS_CS = 1 * MiB;
constexpr size_t WS_G1 = 2 * MiB;
constexpr size_t WS_SW = 2 * MiB + 256 * 1024;
constexpr size_t WS_SSQ = 3 * MiB;
constexpr size_t WS_SSQQ = 3 * MiB + 320 * 1024, WS_SSQKV = 3 * MiB + 640 * 1024;
constexpr size_t WS_RAW2 = 24 * MiB;
constexpr size_t WS_W_AIN = 4 * MiB, WS_W_AOUT = 12 * MiB, WS_W_BIN = 14 * MiB, WS_W_UQ = 18 * MiB, WS_W_UKV = 20 * MiB, WS_W_BOUT = 22 * MiB;
constexpr size_t WS_H = 24 * MiB;
constexpr size_t WS_CKV = 153 * MiB;
constexpr size_t WS_KR = 194 * MiB;
constexpr size_t WS_X = 200 * MiB;
constexpr size_t WS_QA = WS_X, WS_KA = WS_X + 129 * MiB, WS_VA = WS_X + 267 * MiB, WS_ZA = WS_X + 405 * MiB;
constexpr size_t WS_YG = WS_ZA;
constexpr size_t WS_ZB = WS_X, WS_RAW = WS_X + 129 * MiB, WS_QB = WS_RAW, WS_CQ = WS_X + 322 * MiB, WS_KN = WS_X + 371 * MiB, WS_VB = WS_X + 532 * MiB;
constexpr size_t WS_Y1B = WS_X + 694 * MiB;
constexpr size_t WS_END = WS_Y1B + 129 * MiB;
static_assert((size_t)M1 * 1024 * 2 <= 129 * MiB && (size_t)RA * 1024 * 2 <= 138 * MiB && (size_t)M1 * 768 * 4 <= 193 * MiB && (size_t)M1 * 384 * 2 <= 49 * MiB && (size_t)R2 * 1024 * 2 <= 161 * MiB, "ws map");
static_assert((size_t)R2 * 256 * 2 <= 41 * MiB && (size_t)R2 * 32 * 2 <= 6 * MiB && WS_ZA + 129 * MiB <= WS_END && WS_VB + 161 * MiB <= WS_END && WS_END <= 1024 * MiB, "ws map");
constexpr size_t O_YP = 0, O_YS = 67108864, O_AKP = 67371008, O_AVP = 84148224, O_AKS = 100925440, O_AVS = 101187584, O_CKVP = 101449728, O_KRP = 118226944, O_CKVS = 120324096, O_KRS = 120389632;
constexpr int LDS_TOTAL = 151552, LDS_MISC = 131072 + 320;
static_assert(at::LDS_BYTES <= LDS_TOTAL && pg8::STAGE_BYTES <= LDS_TOTAL && pg8::STG_OFF + 8 * pg8::STG_WAVE <= LDS_TOTAL, "LDS");

__device__ __forceinline__ float wave_sum(float v) {
#pragma unroll
    for (int o = 1; o < 64; o <<= 1) v += __shfl_xor(v, o);
    return v;
}
__device__ __forceinline__ unsigned pk2(float lo, float hi) { return pg8::pkbf(lo, hi); }
__device__ __forceinline__ int src_col(int gemm, int g) {
    const int lc = ((g >> 3) * 8 + (g & 3) * 2 + ((g >> 2) & 1)) * 32;
    switch (gemm) {
    case 2: if (lc < 1024) return 672 + lc; if (lc < 1408) return lc - 1024; if (lc < 1664) return 384 + (lc - 1408); if (lc < 1696) return 640 + (lc - 1664); return -1;
    case 3: if (lc < 1024) return (lc >> 6) * 96 + (lc & 63); return ((lc - 1024) >> 5) * 96 + 64;
    case 4: if (lc < 1024) return (lc >> 6) * 128 + (lc & 63); return ((lc - 1024) >> 6) * 128 + 64 + (lc & 63);
    default: return lc;
    }
}
__device__ __forceinline__ void transpose_item(const float* W, int K, int Nsrc, int sc, bf16* WT, int g, int k0, LAS float* scr, int lane, bool cperm = false) {
    const int jl = lane & 31, sj = cperm ? 16 * ((jl >> 2) & 1) + 4 * (jl >> 3) + (jl & 3) : jl;
#pragma unroll 8
    for (int i = 0; i < 32; ++i) { const int kk = 2 * i + (lane >> 5); scr[kk * 33 + (lane & 31)] = sc >= 0 ? W[(size_t)(k0 + kk) * Nsrc + sc + sj] : 0.f; }
    asm volatile("s_waitcnt lgkmcnt(0)" ::: "memory");
    const int c = lane & 7;
#pragma unroll
    for (int j = 0; j < 4; ++j) { const int n = (lane >> 3) + 8 * j; const LAS float* s = scr + (8 * c) * 33 + n;
        v4u o; o.x = pk2(s[0 * 33], s[1 * 33]); o.y = pk2(s[2 * 33], s[3 * 33]); o.z = pk2(s[4 * 33], s[5 * 33]); o.w = pk2(s[6 * 33], s[7 * 33]);
        *(v4u*)(WT + (size_t)(32 * g + n) * K + k0 + 8 * c) = o; }
    asm volatile("s_waitcnt lgkmcnt(0)" ::: "memory");
}
__device__ __forceinline__ void cvt8(const float* s, bf16* d) { const f32x4 a = *(const f32x4*)s, b = *(const f32x4*)(s + 4); v4u o; o.x = pk2(a[0], a[1]); o.y = pk2(a[2], a[3]); o.z = pk2(b[0], b[1]); o.w = pk2(b[2], b[3]); *(v4u*)d = o; }

#define GAS __attribute__((address_space(1)))
#define RLX_AGENT __ATOMIC_RELAXED, __HIP_MEMORY_SCOPE_AGENT
#define XB_TMO      128
#define XB_XCNT(j)  (256  + 64 * (j))
#define XB_XSUB(j)  (1280 + 64 * (j))
#define XB_XGEN(j)  (2304 + 64 * (j))
#define XB_TOP      3328
#define XB_TOPGEN   3392
#define XCD_BAR_WORDS 3456
#define XB_SPIN_CAP (1u << 18)

__device__ __forceinline__ unsigned xb_ld(unsigned* p)              { return __hip_atomic_load(p, __ATOMIC_RELAXED, __HIP_MEMORY_SCOPE_AGENT); }
__device__ __forceinline__ unsigned xb_add(unsigned* p, unsigned v) { return __hip_atomic_fetch_add(p, v, __ATOMIC_RELAXED, __HIP_MEMORY_SCOPE_AGENT); }
__device__ __forceinline__ unsigned xb_xcc_id() { return (unsigned)__builtin_amdgcn_s_getreg((3 << 11) | 20) & 0xFu; }
#define XB_SPIN(cond, bar) do { unsigned _sp = 0; while (cond) { __builtin_amdgcn_s_sleep(1); \
    if ((++_sp & 255u) == 0u) { if (xb_ld(&(bar)[XB_TMO])) break; if (_sp > XB_SPIN_CAP) { atomicAdd(&(bar)[XB_TMO], 1u); break; } } } } while (0)

struct XcdBarrier {
    unsigned* bar; unsigned x;
    volatile LAS unsigned* st;
};

__device__ __forceinline__ XcdBarrier xcd_barrier_post(unsigned* bar, volatile LAS unsigned* st) {
    XcdBarrier b; b.bar = bar; b.x = xb_xcc_id(); b.st = st;
    if (threadIdx.x == 0) (void)xb_add(&bar[XB_XCNT(b.x)], 1u);
    return b;
}
__device__ __forceinline__ void xcd_barrier_complete(unsigned* bar, unsigned x, unsigned& nloc, unsigned& nx) {
    const unsigned G = gridDim.x * gridDim.y * gridDim.z;
    unsigned sum, cnt, mine, sp = 0u;
    for (;;) {
        sum = 0u; cnt = 0u; mine = 0u;
#pragma unroll
        for (unsigned j = 0; j < 16; ++j) { const unsigned c = xb_ld(&bar[XB_XCNT(j)]); sum += c; cnt += (c > 0u) ? 1u : 0u; mine = (j == x) ? c : mine; }
        if (sum == G) break;
        __builtin_amdgcn_s_sleep(1);
        if ((++sp & 255u) == 0u) { if (xb_ld(&bar[XB_TMO])) break; if (sp > XB_SPIN_CAP) { atomicAdd(&bar[XB_TMO], 1u); break; } }
    }
    nloc = mine > 0u ? mine : 1u; nx = cnt > 0u ? cnt : 1u;
}

__device__ __forceinline__ void xcd_barrier(const XcdBarrier& b) {
    asm volatile("s_waitcnt vmcnt(0)" ::: "memory");
    __syncthreads();
    if (threadIdx.x == 0) {
        unsigned* bar = b.bar;
        __builtin_amdgcn_s_waitcnt(0);
        unsigned nloc = b.st[0], nx = b.st[1];
        if (nloc == 0u) { xcd_barrier_complete(bar, b.x, nloc, nx); b.st[0] = nloc; b.st[1] = nx; }
        const unsigned old = xb_add(&bar[XB_XSUB(b.x)], 1u);
        const unsigned gen = old / nloc;
        if (old + 1u == (gen + 1u) * nloc) {
            __builtin_amdgcn_fence(__ATOMIC_RELEASE, "agent");
            asm volatile("s_waitcnt vmcnt(0)" ::: "memory");
            const unsigned og = xb_add(&bar[XB_TOP], 1u);
            const unsigned tg = og / nx;
            if (og + 1u == (tg + 1u) * nx) xb_add(&bar[XB_TOPGEN], 1u);
            else XB_SPIN(xb_ld(&bar[XB_TOPGEN]) == tg, bar);
            __builtin_amdgcn_fence(__ATOMIC_ACQUIRE, "agent");
            xb_add(&bar[XB_XGEN(b.x)], 1u);
            asm volatile("s_waitcnt vmcnt(0)" ::: "memory");
        } else {
            XB_SPIN(xb_ld(&bar[XB_XGEN(b.x)]) == gen, bar);
            __builtin_amdgcn_fence(__ATOMIC_ACQUIRE, "agent");
            asm volatile("s_waitcnt vmcnt(0)" ::: "memory");
        }
    }
    __syncthreads();
}

struct Args { const float* in[26]; float* out; unsigned char* ws; int ph_lo, ph_hi; };

__device__ __forceinline__ void adanorm_rows(const float* xp, const float* xs, const float* g, const float* mod, bf16* H, int gw, int NGW, int lane) {
    for (int grp = gw; grp < M1 / 4; grp += NGW) {
        const int row0 = grp * 4;
        const float* xr; int bb;
        if (row0 < MP) { xr = xp + (size_t)row0 * 1024; bb = row0 >> 11; } else { xr = xs + (size_t)(row0 - MP) * 1024; bb = NBP + ((row0 - MP) >> 5); }
        const float* md = mod + (size_t)bb * 3072;
        f32x4 v[4][4]; float s[4];
#pragma unroll
        for (int q = 0; q < 4; ++q) { s[q] = 0.f;
#pragma unroll
            for (int j = 0; j < 4; ++j) v[q][j] = *(const f32x4*)(xr + (size_t)q * 1024 + 4 * lane + 256 * j); }
#pragma unroll
        for (int q = 0; q < 4; ++q)
#pragma unroll
            for (int j = 0; j < 4; ++j) s[q] += pg8::ssq4(v[q][j]);
#pragma unroll
        for (int o = 1; o < 64; o <<= 1) {
#pragma unroll
            for (int q = 0; q < 4; ++q) s[q] += __shfl_xor(s[q], o); }
#pragma unroll
        for (int q = 0; q < 4; ++q) s[q] = rsqrtf(s[q] * (1.f / 1024.f) + EPSN);
#pragma unroll
        for (int j = 0; j < 4; ++j) { const int c = 4 * lane + 256 * j;
            const f32x4 gg = *(const f32x4*)(g + c) * (*(const f32x4*)(md + 1024 + c) + 1.f), sh = *(const f32x4*)(md + c);
#pragma unroll
            for (int q = 0; q < 4; ++q) { const f32x4 h = v[q][j] * s[q] * gg + sh;
                v2u o; o.x = pk2(h[0], h[1]); o.y = pk2(h[2], h[3]); *(v2u*)(H + (size_t)(row0 + q) * 1024 + c) = o; } }
    }
}

__global__ void __launch_bounds__(512, 2) hybrid_fwd(Args args) {
    extern __shared__ __attribute__((aligned(16))) unsigned char lds_raw[];
    LAS unsigned char* lds = (LAS unsigned char*)lds_raw;
    const int tid = threadIdx.x, lane = tid & 63, wave = __builtin_amdgcn_readfirstlane(tid >> 6);
    const int G = gridDim.x, bid = blockIdx.x;
    const int gw = bid * 8 + wave, NGW = G * 8;
    const int gt = bid * 512 + tid, NGT = G * 512;
    const int lo = args.ph_lo, hi = args.ph_hi;
    volatile LAS unsigned* MISC = (volatile LAS unsigned*)(lds + LDS_MISC);
    if (tid < 16) MISC[tid] = 0u;
    __syncthreads();
    XcdBarrier bar; bar.bar = nullptr; bar.x = 0; bar.st = nullptr;
    if (hi - lo > 1) { bar = xcd_barrier_post((unsigned*)(args.ws + WS_BAR), MISC + 8); cg::this_grid().sync(); }
#ifndef PHMASK
#define PHMASK 0x7ff
#endif
#ifndef PROBE_SYNC
#define PROBE_SYNC 0
#endif
#ifndef PROBE_REP
#define PROBE_REP 0
#endif
#define REP(k) for (int rep_ = 0; rep_ < 1 + ((PROBE_REP >> (k)) & 1); ++rep_)
#define IN(k) (((PHMASK >> (k)) & 1) && lo <= (k) && (k) < hi)
typedef const __attribute__((address_space(4))) Args* KArgs;
#define PHASE_ARGS() KArgs A = (KArgs)__builtin_amdgcn_kernarg_segment_ptr(); asm volatile("" : "+s"(A)); unsigned char* ws = A->ws; float* out = A->out; (void)ws; (void)out
#define WSP(T, off) ((T*)(ws + (off)))
#define SEAM(k) do { if (IN(k) && IN((k) + 1)) { xcd_barrier(bar); } } while (0)

    if (IN(0)) REP(0) {
        PHASE_ARGS();
        float* mod = WSP(float, WS_MOD); float* CS = WSP(float, WS_CS);
        bf16 *W_AIN = WSP(bf16, WS_W_AIN), *W_AOUT = WSP(bf16, WS_W_AOUT), *W_BIN = WSP(bf16, WS_W_BIN), *W_UQ = WSP(bf16, WS_W_UQ), *W_UKV = WSP(bf16, WS_W_UKV), *W_BOUT = WSP(bf16, WS_W_BOUT);
        bf16 *KA = WSP(bf16, WS_KA), *VA = WSP(bf16, WS_VA), *CKV = WSP(bf16, WS_CKV), *KR = WSP(bf16, WS_KR);
        {
            LAS float* scr = (LAS float*)(lds + wave * 10240);
            constexpr int I0 = 16 * 128, I1 = 16 * 32, I2 = 16 * 56, I3 = 6 * 48, I4 = 4 * 64, I5 = 16 * 32;
            const bool split = (G == 256);
            const int tgw = split ? (bid - 96) * 8 + wave : gw, tngw = split ? 160 * 8 : NGW;
            if (!split || bid >= 96)
            for (int it = tgw; it < I0 + I1 + I2 + I3 + I4 + I5; it += tngw) {
                int r = it;
                if (r < I0) { const int g = r % 128; transpose_item(A->in[11], 1024, 4096, src_col(0, g), W_AIN, g, (r / 128) * 64, scr, lane); continue; } r -= I0;
                if (r < I1) { const int g = r % 32; transpose_item(A->in[15], 1024, 1024, src_col(1, g), W_AOUT, g, (r / 32) * 64, scr, lane); continue; } r -= I1;
                if (r < I2) { const int g = r % 56; transpose_item(A->in[16], 1024, 1696, src_col(2, g), W_BIN, g, (r / 56) * 64, scr, lane); continue; } r -= I2;
                if (r < I3) { const int g = r % 48; transpose_item(A->in[18], 384, 1536, src_col(3, g), W_UQ, g, (r / 48) * 64, scr, lane, g >= 32); continue; } r -= I3;
                if (r < I4) { const int g = r % 64; transpose_item(A->in[20], 256, 2048, src_col(4, g), W_UKV, g, (r / 64) * 64, scr, lane); continue; } r -= I4;
                { const int g = r % 32; transpose_item(A->in[25], 1024, 1024, src_col(5, g), W_BOUT, g, (r / 32) * 64, scr, lane); }
            }
        }
        for (int it = bid; it < 2 * 48; it += G) {
            const int l = it / 48, jb = it % 48;
            LAS float* sl = (LAS float*)(lds + wave * 10240);
            float acc[40];
#pragma unroll
            for (int b = 0; b < 40; ++b) acc[b] = 0.f;
            for (int pass = 0; pass < 2; ++pass) {
                const int k0 = (wave + 8 * pass) * 64;
                for (int e = lane; e < 40 * 64; e += 64) { const int bb = e >> 6, k = e & 63; const float c = bb < NBP ? A->in[6][(size_t)bb * 1024 + k0 + k] : A->in[7][(size_t)(bb - NBP) * 1024 + k0 + k]; sl[e] = c / (1.f + __expf(-c)); }
                asm volatile("s_waitcnt lgkmcnt(0)" ::: "memory");
                const float* W = A->in[9] + (size_t)l * 1024 * 3072 + (size_t)k0 * 3072 + jb * 64 + lane;
                for (int k = 0; k < 64; k += 4) {
                    const float w0 = W[(size_t)k * 3072], w1 = W[(size_t)(k + 1) * 3072], w2 = W[(size_t)(k + 2) * 3072], w3 = W[(size_t)(k + 3) * 3072];
#pragma unroll
                    for (int b = 0; b < 40; ++b) { const f32x4 sv = *(const LAS f32x4*)(sl + b * 64 + k); acc[b] += (sv[0] * w0 + sv[1] * w1) + (sv[2] * w2 + sv[3] * w3); }
                }
                asm volatile("s_waitcnt lgkmcnt(0)" ::: "memory");
            }
            __syncthreads();
            LAS float* red = (LAS float*)lds;
#pragma unroll
            for (int b = 0; b < 40; ++b) red[(wave * 40 + b) * 64 + lane] = acc[b];
            __syncthreads();
            for (int e = tid; e < 40 * 64; e += 512) { const int b = e >> 6, j = e & 63; float sum = A->in[10][(size_t)l * 3072 + jb * 64 + j];
#pragma unroll
                for (int w = 0; w < 8; ++w) sum += red[(w * 40 + b) * 64 + j];
                mod[((size_t)l * 40 + b) * 3072 + jb * 64 + j] = sum; }
            __syncthreads();
        }
        for (int i = gt; i < NBS * SA_STRIDE * 128; i += NGT) {
            const int c8 = i & 127, rr = (i >> 7) % SA_STRIDE, bs = (i >> 7) / SA_STRIDE;
            const size_t d = ((size_t)MP + (size_t)bs * SA_STRIDE + rr) * 1024 + c8 * 8;
            if (rr < 512) { const size_t s = ((size_t)bs * 512 + rr) * 1024 + c8 * 8; cvt8(A->in[2] + s, KA + d); cvt8(A->in[3] + s, VA + d); }
            else if (rr >= 544) { *(v4u*)(KA + d) = (v4u){0, 0, 0, 0}; *(v4u*)(VA + d) = (v4u){0, 0, 0, 0}; }
        }
        for (int i = gt; i < NBS * SB_STRIDE * 32; i += NGT) {
            const int c8 = i & 31, rr = (i >> 5) % SB_STRIDE, bs = (i >> 5) / SB_STRIDE;
            const size_t d = ((size_t)MP + (size_t)bs * SB_STRIDE + rr) * 256 + c8 * 8;
            if (rr < 2048) cvt8(A->in[4] + ((size_t)bs * 2048 + rr) * 256 + c8 * 8, CKV + d);
            else if (rr >= 2080) *(v4u*)(CKV + d) = (v4u){0, 0, 0, 0};
        }
        for (int i = gt; i < NBS * SB_STRIDE * 4; i += NGT) {
            const int c8 = i & 3, rr = (i >> 2) % SB_STRIDE, bs = (i >> 2) / SB_STRIDE;
            const size_t d = ((size_t)MP + (size_t)bs * SB_STRIDE + rr) * 32 + c8 * 8;
            if (rr < 2048) cvt8(A->in[5] + ((size_t)bs * 2048 + rr) * 32 + c8 * 8, KR + d);
            else if (rr >= 2080) *(v4u*)(KR + d) = (v4u){0, 0, 0, 0};
        }
        { float* SSQ = WSP(float, WS_SSQ); float* SQ2 = WSP(float, WS_SSQQ); float* SQ3 = WSP(float, WS_SSQKV); for (int i = gt; i < M1; i += NGT) { SSQ[i] = 0.f; SQ2[i] = 0.f; SQ3[i] = 0.f; } }
        for (int i = gt; i < 2112 * 16; i += NGT) {
            const int pos = i >> 4, k = i & 15;
            const float inv = exp2f(-(float)k * (13.287712379549449f / 16.f));
            const float ang = (float)pos * inv;
            const double tr = (double)ang * 0.15915494309189535;
            const float fr = (float)(tr - floor(tr + 0.5));
            CS[pos * 32 + k] = __builtin_amdgcn_cosf(fr); CS[pos * 32 + 16 + k] = __builtin_amdgcn_sinf(fr);
        }
    }
    SEAM(0);
    if (IN(1)) REP(1) { PHASE_ARGS();
        const float* mod1 = WSP(float, WS_MOD) + 40 * 3072;
        {
            float* G1 = WSP(float, WS_G1); const float* g1 = A->in[8] + 1024;
            for (int i = gt; i < 40 * 1024; i += NGT) { const int bb = i >> 10, c = i & 1023; G1[i] = g1[c] * (1.f + mod1[(size_t)bb * 3072 + 1024 + c]); }
            float* SW = WSP(float, WS_SW); const bf16* WB = WSP(bf16, WS_W_BIN);
            for (int lc = gw; lc < 1792; lc += NGW) {
                const int lg = lc >> 5, pn = lg >> 3, rem = lg & 7, crow_ = (pn * 8 + (rem & 1) * 4 + (rem >> 1)) * 32 + (lc & 31);
                const v4u w0 = *(const v4u*)(WB + (size_t)crow_ * 1024 + 16 * lane), w1 = *(const v4u*)(WB + (size_t)crow_ * 1024 + 16 * lane + 8);
                float wf[16];
#pragma unroll
                for (int e = 0; e < 4; ++e) { wf[2 * e] = __uint_as_float(w0[e] << 16); wf[2 * e + 1] = __uint_as_float(w0[e] & 0xffff0000u); wf[8 + 2 * e] = __uint_as_float(w1[e] << 16); wf[8 + 2 * e + 1] = __uint_as_float(w1[e] & 0xffff0000u); }
                for (int bb = 0; bb < 40; ++bb) { const float* sh = mod1 + (size_t)bb * 3072 + 16 * lane; float a = 0.f;
#pragma unroll
                    for (int e = 0; e < 4; ++e) { const f32x4 x = *(const f32x4*)(sh + 4 * e); a += (x[0] * wf[4 * e] + x[1] * wf[4 * e + 1]) + (x[2] * wf[4 * e + 2] + x[3] * wf[4 * e + 3]); }
                    a = wave_sum(a); if (lane == 0) SW[(size_t)bb * 1792 + lc] = a; }
            }
        }
        adanorm_rows(A->in[0], A->in[1], A->in[8], WSP(float, WS_MOD), WSP(bf16, WS_H), gw, NGW, lane); }
    SEAM(1);
    if (IN(2)) REP(2) {
        PHASE_ARGS();
        int Kop = 1024; asm volatile("" : "+s"(Kop)); pg8::Gemm g{WSP(bf16, WS_H), WSP(bf16, WS_W_AIN), M1, 4096, Kop}; pg8::StaticOrder S; S.init(M1, 4096, G, bid);
        pg8::EpiAin E{WSP(bf16, WS_QA), WSP(bf16, WS_KA), WSP(bf16, WS_VA), WSP(bf16, WS_ZA), A->in[12], A->in[13], out + O_AKP, out + O_AVP, out + O_AKS, out + O_AVS, lds + pg8::STG_OFF};
        pg8::gemm_phase<pg8::EpiAin, pg8::StaticOrder, true, true>(lds, g, S, E);
    }
    SEAM(2);
    if (IN(3)) REP(3) {
        PHASE_ARGS();
        bf16 *QA = WSP(bf16, WS_QA), *KA = WSP(bf16, WS_KA), *VA = WSP(bf16, WS_VA), *ZA = WSP(bf16, WS_ZA), *H = WSP(bf16, WS_H); const float* tblp = A->in[14];
        __syncthreads();
        { int bh, qb;
          for (int k = 0; at::prompt_unit(k, G, bid, bh, qb); ++k) {
            at::AttnUnit a; const int b = bh >> 4, c0 = 4 * qb, tf = c0 > 8 ? c0 - 8 : 0;
            a.qrow0 = b * SEQ + 256 * qb; a.nq = 256; a.krow0 = b * SEQ + 64 * tf; a.nt = c0 + 3 - tf + 1; a.lastvalid = 64; a.head = bh & 15; a.c0 = c0; a.tf = tf;
            at::attn_unit<false>(lds, a, QA, KA, nullptr, VA, ZA, H, tblp);
          } }
        for (int s = bid; s < 128; s += G) {
            at::AttnUnit a; const int bs = s >> 4;
            a.qrow0 = MP + bs * TS; a.nq = 32; a.krow0 = MP + bs * SA_STRIDE; a.nt = 9; a.lastvalid = 32; a.head = s & 15; a.c0 = 8; a.tf = 0;
            at::attn_unit<false>(lds, a, QA, KA, nullptr, VA, ZA, H, tblp);
        }
    }
    SEAM(3);
    if (IN(4)) REP(4) {
        PHASE_ARGS();
        int Kop = 1024; asm volatile("" : "+s"(Kop)); pg8::Gemm g{WSP(bf16, WS_H), WSP(bf16, WS_W_AOUT), M1, 1024, Kop}; pg8::StaticOrder S; S.init(M1, 1024, G, bid);
        pg8::EpiRes E{A->in[0], A->in[1], out + O_YP, out + O_YS, WSP(float, WS_MOD) + 2048, WSP(bf16, WS_YG), WSP(float, WS_G1), WSP(float, WS_SSQ), lds + pg8::STG_OFF, nullptr, WSP(bf16, WS_Y1B)};
        pg8::gemm_phase<pg8::EpiRes, pg8::StaticOrder, true, true>(lds, g, S, E);
    }
    if (IN(4) && IN(6)) { xcd_barrier(bar); }
    if (IN(6)) REP(6) {
        PHASE_ARGS();
        int Kop = 1024; asm volatile("" : "+s"(Kop)); pg8::Gemm g{WSP(bf16, WS_YG), WSP(bf16, WS_W_BIN), M1, 1792, Kop}; pg8::StaticOrder S; S.init(M1, 1792, G, bid);
        pg8::EpiBin E{WSP(bf16, WS_ZB), WSP(bf16, WS_CQ), WSP(bf16, WS_CKV), WSP(float, WS_RAW2), WSP(float, WS_SSQ), WSP(float, WS_SW), A->in[17], A->in[19], WSP(float, WS_SSQQ), WSP(float, WS_SSQKV), lds + pg8::STG_OFF};
        pg8::gemm_phase<pg8::EpiBin, pg8::StaticOrder, true, true>(lds, g, S, E);
    }
    if (IN(6) && IN(8)) { xcd_barrier(bar); }
    if (IN(8)) REP(8) {
        { PHASE_ARGS(); int Kop = 384; asm volatile("" : "+s"(Kop)); pg8::Gemm g{WSP(bf16, WS_CQ), WSP(bf16, WS_W_UQ), M1, 1536, Kop}; pg8::StaticOrder S; S.init(M1, 1536, G, bid);
          pg8::EpiUq E{WSP(bf16, WS_QB), A->in[21], A->in[22], WSP(float, WS_CS), WSP(float, WS_SSQQ), lds + pg8::STG_OFF};
          pg8::gemm_phase<pg8::EpiUq, pg8::StaticOrder, true, true>(lds, g, S, E); }
        __syncthreads();
        { PHASE_ARGS(); int Kop = 256; asm volatile("" : "+s"(Kop)); pg8::Gemm g{WSP(bf16, WS_CKV), WSP(bf16, WS_W_UKV), R2, 2048, Kop}; pg8::StaticOrder S; S.init(R2, 2048, G, G - 1 - bid);
          pg8::EpiUkv E{WSP(bf16, WS_KN), WSP(bf16, WS_VB), A->in[23], WSP(float, WS_SSQKV), lds + pg8::STG_OFF};
          pg8::gemm_phase<pg8::EpiUkv, pg8::StaticOrder, true, true>(lds, g, S, E); }
        __syncthreads();
        {
            PHASE_ARGS();
            const float* RAW2 = WSP(float, WS_RAW2); const float* CS = WSP(float, WS_CS); const float* SQ3 = WSP(float, WS_SSQKV); bf16* KR = WSP(bf16, WS_KR); const bf16* CKVb = WSP(bf16, WS_CKV);
            const float* gkr = A->in[24];
            unsigned* wq = (unsigned*)(ws + WS_BAR) + 3600;
            volatile LAS unsigned* slot = (volatile LAS unsigned*)(lds + LDS_MISC + 16);
            for (;;) {
                if (tid == 0) slot[0] = atomicAdd(wq, 1u);
                __syncthreads();
                const unsigned ch = slot[0];
                __syncthreads();
                if (ch >= (unsigned)(M1 / 128)) break;
              for (int rix = 0; rix < 16; ++rix) { const int row = (int)ch * 128 + rix * 8 + wave;
                const float* rw = RAW2 + (size_t)row * 32;
                int pos; size_t drow, orow;
                if (row < MP) { pos = row & (SEQ - 1); drow = (size_t)row; orow = (size_t)row; }
                else { const int rs = row - MP; pos = SEQ + (rs & 31); drow = (size_t)MP + (size_t)(rs >> 5) * SB_STRIDE + 2048 + (rs & 31); orow = (size_t)rs; }
                float* ockv = (row < MP ? out + O_CKVP : out + O_CKVS) + orow * 256;
                float* okr = (row < MP ? out + O_KRP : out + O_KRS) + orow * 32;
                const v2u kw = *(const v2u*)(CKVb + drow * 256 + 4 * lane);
                const f32x4 kv = (f32x4){__uint_as_float(kw.x << 16), __uint_as_float(kw.x & 0xffff0000u), __uint_as_float(kw.y << 16), __uint_as_float(kw.y & 0xffff0000u)};
                const float kr = lane < 32 ? rw[lane] : 0.f;
                float r = rsqrtf(SQ3[row] * (1.f / 256.f) + EPSN);
                __builtin_nontemporal_store(kv * r, (f32x4*)(ockv + 4 * lane));
                r = rsqrtf(wave_sum(kr * kr) * (1.f / 32.f) + EPSN);
                const float kn = kr * r * (lane < 32 ? gkr[lane] : 0.f);
                const float pr = __shfl_xor(kn, 16);
                const float cs = CS[pos * 32 + (lane & 15)], sn = CS[pos * 32 + 16 + (lane & 15)];
                const float ro = (lane & 16) ? (kn * cs + pr * sn) : (kn * cs - pr * sn);
                if (lane < 32) { okr[lane] = ro; const unsigned b = pk2(ro, 0.f); KR[drow * 32 + lane] = (bf16)(b & 0xffffu); }
              }
            }
        }
    }
    SEAM(8);
    if (IN(9)) REP(9) {
        PHASE_ARGS();
        bf16 *QB = WSP(bf16, WS_QB), *KN = WSP(bf16, WS_KN), *KR = WSP(bf16, WS_KR), *VB = WSP(bf16, WS_VB), *ZB = WSP(bf16, WS_ZB), *H = WSP(bf16, WS_H);
        __syncthreads();
        const bool shed = (G == 256);
        { int bh, qb;
          for (int k = 0; at::prompt_unit(k, G, bid, bh, qb); ++k) {
            if (shed && bid < 128 && k < 8 && qb == 3) continue;
            at::AttnUnit a; const int b = bh >> 4;
            a.qrow0 = b * SEQ + 256 * qb; a.nq = 256; a.krow0 = b * SEQ; a.nt = 4 * qb + 4; a.lastvalid = 64; a.head = bh & 15; a.c0 = 4 * qb; a.tf = 0;
            at::attn_unit<true>(lds, a, QB, KN, KR, VB, ZB, H, nullptr);
          }
          if (shed && bid >= 128) {
            for (int k = 0; k < 8 && at::prompt_unit(k, G, bid - 128, bh, qb); ++k) { if (qb != 3) continue;
              at::AttnUnit a; const int b = bh >> 4;
              a.qrow0 = b * SEQ + 256 * qb; a.nq = 256; a.krow0 = b * SEQ; a.nt = 4 * qb + 4; a.lastvalid = 64; a.head = bh & 15; a.c0 = 4 * qb; a.tf = 0;
              at::attn_unit<true>(lds, a, QB, KN, KR, VB, ZB, H, nullptr); }
          } }
        for (int s = bid; s < 128; s += G) {
            at::AttnUnit a; const int bs = s >> 4;
            a.qrow0 = MP + bs * TS; a.nq = 32; a.krow0 = MP + bs * SB_STRIDE; a.nt = 33; a.lastvalid = 32; a.head = s & 15; a.c0 = 32; a.tf = 0;
            at::attn_unit<true>(lds, a, QB, KN, KR, VB, ZB, H, nullptr);
        }
    }
    SEAM(9);
    if (IN(10)) REP(10) {
        PHASE_ARGS();
        int Kop = 1024; asm volatile("" : "+s"(Kop)); pg8::Gemm g{WSP(bf16, WS_H), WSP(bf16, WS_W_BOUT), M1, 1024, Kop}; pg8::StaticOrder S; S.init(M1, 1024, G, bid);
        pg8::EpiRes E{out + O_YP, out + O_YS, out + O_YP, out + O_YS, WSP(float, WS_MOD) + 40 * 3072 + 2048, nullptr, nullptr, nullptr, lds + pg8::STG_OFF, WSP(bf16, WS_Y1B), nullptr};
        pg8::gemm_phase<pg8::EpiRes, pg8::StaticOrder, true, true>(lds, g, S, E);
    }
#if PROBE_SYNC
    if (hi - lo > 1) { for (int q = 0; q < 18; ++q) cg::this_grid().sync(); }
#endif
#undef IN
#undef SEAM
}

constexpr int N_PHASES = 11;
extern "C" void kernel_launch(void* const* d_in, const int* in_sizes, int n_in, void* d_out, int out_size, void* d_ws, size_t ws_size, hipStream_t stream) {
    static int grid = 0;
    if (grid == 0) {
        if (n_in != 26 || ws_size < WS_END) { fprintf(stderr, "kernel_launch: unexpected inputs (n_in %d, ws %zu, need %zu)\n", n_in, ws_size, (size_t)WS_END); grid = -1; return; }
        int dev = 0, cus = 0, per_cu = 0;
        hipGetDevice(&dev); hipDeviceGetAttribute(&cus, hipDeviceAttributeMultiprocessorCount, dev);
        hipFuncSetAttribute((const void*)hybrid_fwd, hipFuncAttributeMaxDynamicSharedMemorySize, LDS_TOTAL);
        hipOccupancyMaxActiveBlocksPerMultiprocessor(&per_cu, (const void*)hybrid_fwd, 512, LDS_TOTAL);
        if (per_cu < 1) { fprintf(stderr, "kernel_launch: occupancy query says %d blocks per CU\n", per_cu); per_cu = 1; }
        (void)hipGetLastError();
        grid = cus * per_cu;
    }
    if (grid < 0) return;
    hipMemsetAsync((char*)d_ws + WS_BAR, 0, 16384, stream);
    Args a{};
    for (int i = 0; i < 26; ++i) a.in[i] = (const float*)d_in[i];
    a.out = (float*)d_out; a.ws = (unsigned char*)d_ws;
#if MULTI_LAUNCH
    for (int p = 0; p < N_PHASES; ++p) { a.ph_lo = p; a.ph_hi = p + 1; hipLaunchKernelGGL(hybrid_fwd, dim3(grid), dim3(512), LDS_TOTAL, stream, a); }
#else
    a.ph_lo = 0; a.ph_hi = N_PHASES;
    void* kargs[] = {&a};
    hipError_t e = hipLaunchCooperativeKernel((const void*)hybrid_fwd, dim3(grid), dim3(512), kargs, LDS_TOTAL, stream);
    if (e != hipSuccess) fprintf(stderr, "cooperative launch failed: %s (grid %d)\n", hipGetErrorString(e), grid);
#endif
}
```
